# Optimizing an MI355X kernel written in HIP

```python
import jax, jax.numpy as jnp
from jax import lax
import numpy as np

D_MODEL = 1024
BATCH = 2
SEQ = 8192
DEPTH = 2

GRID_W = 64
CTX_LEN = 256

NA_HEADS = 4
NA_HEAD_DIM = 64
NA_W = NA_HEADS * NA_HEAD_DIM
WIN_ROWS = 8
WIN_COLS = 16

LRU_W = 512
LRU_BLOCKS = 8
LRU_BLOCK_W = LRU_W // LRU_BLOCKS
CONV_W = 4
LRU_C = 8.0

MLA_HEADS = 4
Q_LORA = 256
KV_LORA = 128
QK_NOPE = 64
QK_ROPE = 32
V_HEAD = 64
MLA_W = MLA_HEADS * V_HEAD
ROPE_BASE = 10000.0
Q_BLOCK = 128

MIX_W = NA_W + LRU_W + MLA_W
IN_SPLITS = (NA_W, NA_W, NA_W, LRU_W, LRU_W, Q_LORA, KV_LORA, QK_ROPE)
IN_W = sum(IN_SPLITS)
IN_OFFSETS = tuple(int(v) for v in np.cumsum(IN_SPLITS)[:-1])

N_EXPERTS = 16
N_GROUPS = 4
EXPERTS_PER_GROUP = N_EXPERTS // N_GROUPS
GROUP_SCORE_K = 2
TOP_K = 2
D_EXPERT = 512

RMS_EPS = 1e-6
N_MOD = 6

kernel_name = "hybrid_na_rglru_mla_moe_dit"


def rms_norm(x, g):
    xf = x.astype(jnp.float32)
    y = xf * lax.rsqrt(jnp.mean(xf * xf, axis=-1, keepdims=True) + RMS_EPS)
    return (y * g.astype(jnp.float32)).astype(x.dtype)


def modulate(h, shift, scale):
    return h * (1 + scale) + shift


def split_heads(t, n):
    b, l, _ = t.shape
    return t.reshape(b, l, n, -1).transpose(0, 2, 1, 3)


def merge_heads(t):
    b, h, l, d = t.shape
    return t.transpose(0, 2, 1, 3).reshape(b, l, h * d)


def dense_attention(q, k, v, scale):
    s = jnp.einsum('bhqd,bhkd->bhqk', q, k) * scale
    p = jax.nn.softmax(s.astype(jnp.float32), axis=-1).astype(v.dtype)
    return jnp.einsum('bhqk,bhkd->bhqd', p, v)


def blocked_attention(q, k, v, scale):
    b, h, s, d = q.shape
    nb = s // Q_BLOCK
    qb = q.reshape(b, h, nb, Q_BLOCK, d).transpose(2, 0, 1, 3, 4)
    ob = lax.map(lambda qi: dense_attention(qi, k, v, scale), qb)
    return ob.transpose(1, 2, 0, 3, 4).reshape(b, h, s, v.shape[-1])


def neighbourhood_attention(q, k, v, k_ctx, v_ctx, rpb):
    b, h, s, dh = q.shape
    rows = s // GRID_W
    kr = min(WIN_ROWS, rows)
    n_win = kr * WIN_COLS
    scale = dh ** -0.5
    qg = q.reshape(b, h, rows, GRID_W, dh)
    kg = k.reshape(b, h, rows, GRID_W, dh)
    vg = v.reshape(b, h, rows, GRID_W, dh)
    col = jnp.arange(GRID_W)
    col_start = jnp.clip(col - WIN_COLS // 2, 0, GRID_W - WIN_COLS)
    col_idx = col_start[:, None] + jnp.arange(WIN_COLS)[None, :]
    dc = col_idx - col[:, None] + (WIN_COLS - 1)

    def row_block(r):
        rs = jnp.clip(r - kr // 2, 0, rows - kr)
        q_r = lax.dynamic_index_in_dim(qg, r, axis=2, keepdims=False)
        k_win = lax.dynamic_slice_in_dim(kg, rs, kr, axis=2)[:, :, :, col_idx]
        v_win = lax.dynamic_slice_in_dim(vg, rs, kr, axis=2)[:, :, :, col_idx]
        dr = rs + jnp.arange(kr) - r + (WIN_ROWS - 1)
        bias = rpb[:, dr[None, :, None], dc[:, None, :]]
        s_win = jnp.einsum('bhqd,bhiqjd->bhqij', q_r, k_win) * scale + bias.astype(q.dtype)[None]
        s_ctx = jnp.einsum('bhqd,bhcd->bhqc', q_r, k_ctx) * scale
        scores = jnp.concatenate([s_win.reshape(b, h, GRID_W, n_win), s_ctx], axis=-1)
        p = jax.nn.softmax(scores.astype(jnp.float32), axis=-1).astype(v.dtype)
        p_win = p[..., :n_win].reshape(b, h, GRID_W, kr, WIN_COLS)
        return (jnp.einsum('bhqij,bhiqjd->bhqd', p_win, v_win)
                + jnp.einsum('bhqc,bhcd->bhqd', p[..., n_win:], v_ctx))

    out = lax.map(row_block, jnp.arange(rows))
    return out.transpose(1, 2, 0, 3, 4).reshape(b, h, s, dh)


def depthwise_conv_centred(u, w, bias):
    L = u.shape[1]
    left = (CONV_W - 1) // 2
    up = jnp.pad(u, ((0, 0), (left, CONV_W - 1 - left), (0, 0)))
    out = up[:, 0:L] * w[0] + bias
    for j in range(1, CONV_W):
        out = out + up[:, j:j + L] * w[j]
    return out


def rglru_coeffs(u, w_a, b_a, w_i, b_i, lam):
    b, l, _ = u.shape
    uf = u.astype(jnp.float32)
    ub = uf.reshape(b, l, LRU_BLOCKS, LRU_BLOCK_W)
    r = jax.nn.sigmoid(jnp.einsum('blnk,nkj->blnj', ub, w_a.astype(jnp.float32)).reshape(b, l, LRU_W) + b_a)
    i = jax.nn.sigmoid(jnp.einsum('blnk,nkj->blnj', ub, w_i.astype(jnp.float32)).reshape(b, l, LRU_W) + b_i)
    log_a = -LRU_C * r * jax.nn.softplus(-lam.astype(jnp.float32))
    a = jnp.exp(log_a)
    gain = jnp.sqrt(-jnp.expm1(2.0 * log_a))
    return a, gain * (i * uf)


def linear_scan(a, x, h0, reverse):
    if h0 is not None:
        edge = -1 if reverse else 0
        x = x.at[:, edge].add(a[:, edge] * h0)

    def combine(lhs, rhs):
        return (lhs[0] * rhs[0], rhs[0] * lhs[1] + rhs[1])

    _, h = lax.associative_scan(combine, (a, x), reverse=reverse, axis=1)
    return h


def rglru_bidirectional(u_x, u_c, w_a, b_a, w_i, b_i, lam):
    out_x = 0.0
    out_c = 0.0
    for d, reverse in enumerate((False, True)):
        a_c, x_c = rglru_coeffs(u_c, w_a[d], b_a[d], w_i[d], b_i[d], lam[d])
        h_c = linear_scan(a_c, x_c, None, reverse)
        h_end = h_c[:, 0] if reverse else h_c[:, -1]
        a_x, x_x = rglru_coeffs(u_x, w_a[d], b_a[d], w_i[d], b_i[d], lam[d])
        h_x = linear_scan(a_x, x_x, h_end, reverse)
        out_x = out_x + h_x
        out_c = out_c + h_c
    return out_x.astype(u_x.dtype), out_c.astype(u_c.dtype)


def axial_rope_tables(s):
    t = jnp.arange(s, dtype=jnp.int32)
    row = (t // GRID_W).astype(jnp.float32)
    col = (t % GRID_W).astype(jnp.float32)
    axis_dim = QK_ROPE // 2
    inv = ROPE_BASE ** (-jnp.arange(0, axis_dim, 2, dtype=jnp.float32) / axis_dim)
    ang_r = row[:, None] * inv
    ang_c = col[:, None] * inv
    return (jnp.cos(ang_r)[:, None], jnp.sin(ang_r)[:, None], jnp.cos(ang_c)[:, None], jnp.sin(ang_c)[:, None])


def rope_2d(x, tabs):
    cos_r, sin_r, cos_c, sin_c = tabs
    dt = x.dtype

    def rot(xs, cos, sin):
        x1, x2 = jnp.split(xs, 2, axis=-1)
        cos = cos.astype(dt)
        sin = sin.astype(dt)
        return jnp.concatenate([x1 * cos - x2 * sin, x2 * cos + x1 * sin], axis=-1)

    half = x.shape[-1] // 2
    return jnp.concatenate([rot(x[..., :half], cos_r, sin_r), rot(x[..., half:], cos_c, sin_c)], axis=-1)


def mla_q(cq, g_q, w_q, tabs):
    b, l, _ = cq.shape
    q = (rms_norm(cq, g_q) @ w_q).reshape(b, l, MLA_HEADS, QK_NOPE + QK_ROPE)
    q_nope, q_rope = q[..., :QK_NOPE], q[..., QK_NOPE:]
    if tabs is not None:
        q_rope = rope_2d(q_rope, tabs)
    return jnp.concatenate([q_nope, q_rope], axis=-1).transpose(0, 2, 1, 3)


def mla_kv(ckv, kr, g_kv, w_kv, tabs):
    b, l, _ = ckv.shape
    kv = (rms_norm(ckv, g_kv) @ w_kv).reshape(b, l, MLA_HEADS, QK_NOPE + V_HEAD)
    k_nope, v = kv[..., :QK_NOPE], kv[..., QK_NOPE:]
    k_rope = kr[:, :, None, :]
    if tabs is not None:
        k_rope = rope_2d(k_rope, tabs)
    k = jnp.concatenate([k_nope, jnp.broadcast_to(k_rope, (b, l, MLA_HEADS, QK_ROPE))], axis=-1)
    return k.transpose(0, 2, 1, 3), v.transpose(0, 2, 1, 3)


def token_mixer(hx, hc, w_in, w_out, rpb, conv_w, conv_b, lru_w_a, lru_b_a, lru_w_i, lru_b_i, lru_lam,
                g_q, w_q, g_kv, w_kv, tabs, need_ctx):
    qa_x, ka_x, va_x, u_x, gate_x, cq_x, ckv_x, kr_x = jnp.split(hx @ w_in, IN_OFFSETS, axis=-1)
    qa_c, ka_c, va_c, u_c, gate_c, cq_c, ckv_c, kr_c = jnp.split(hc @ w_in, IN_OFFSETS, axis=-1)

    k_ac = split_heads(ka_c, NA_HEADS)
    v_ac = split_heads(va_c, NA_HEADS)
    ya_x = merge_heads(neighbourhood_attention(split_heads(qa_x, NA_HEADS), split_heads(ka_x, NA_HEADS),
                                               split_heads(va_x, NA_HEADS), k_ac, v_ac, rpb))

    hb_x, hb_c = rglru_bidirectional(depthwise_conv_centred(u_x, conv_w, conv_b),
                                     depthwise_conv_centred(u_c, conv_w, conv_b),
                                     lru_w_a, lru_b_a, lru_w_i, lru_b_i, lru_lam)
    yb_x = hb_x * jax.nn.gelu(gate_x)

    mla_scale = (QK_NOPE + QK_ROPE) ** -0.5
    k_cc, v_cc = mla_kv(ckv_c, kr_c, g_kv, w_kv, None)
    k_cx, v_cx = mla_kv(ckv_x, kr_x, g_kv, w_kv, tabs)
    q_cx = mla_q(cq_x, g_q, w_q, tabs)
    yc_x = merge_heads(blocked_attention(q_cx, jnp.concatenate([k_cc, k_cx], axis=2),
                                         jnp.concatenate([v_cc, v_cx], axis=2), mla_scale))

    yx = jnp.concatenate([ya_x, yb_x, yc_x], axis=-1) @ w_out
    if not need_ctx:
        return yx, None

    ya_c = merge_heads(dense_attention(split_heads(qa_c, NA_HEADS), k_ac, v_ac, NA_HEAD_DIM ** -0.5))
    yb_c = hb_c * jax.nn.gelu(gate_c)
    yc_c = merge_heads(dense_attention(mla_q(cq_c, g_q, w_q, None), k_cc, v_cc, mla_scale))
    yc = jnp.concatenate([ya_c, yb_c, yc_c], axis=-1) @ w_out
    return yx, yc


def moe_ffn(h, router_w, router_b, w_gate, w_up, w_down):
    b, l, d = h.shape
    t = h.reshape(b * l, d)
    aff = jax.nn.sigmoid((t @ router_w).astype(jnp.float32))
    sel = aff + router_b.astype(jnp.float32)
    grp_top, _ = lax.top_k(sel.reshape(-1, N_GROUPS, EXPERTS_PER_GROUP), GROUP_SCORE_K)
    best = jnp.argmax(grp_top.sum(-1), axis=-1)
    in_grp = jnp.repeat(jnp.arange(N_GROUPS)[None, :] == best[:, None], EXPERTS_PER_GROUP, axis=1)
    _, idx = lax.top_k(jnp.where(in_grp, sel, -jnp.inf), TOP_K)
    wsel = jnp.take_along_axis(aff, idx, axis=-1)
    wsel = wsel / jnp.sum(wsel, axis=-1, keepdims=True)
    combine = jnp.sum(jax.nn.one_hot(idx, N_EXPERTS, dtype=jnp.float32) * wsel[..., None], axis=1).astype(h.dtype)
    out = jnp.zeros_like(t)
    for e in range(N_EXPERTS):
        he = jax.nn.silu(t @ w_gate[e]) * (t @ w_up[e])
        out = out + combine[:, e:e + 1] * (he @ w_down[e])
    return out.reshape(b, l, d)


def setup_inputs(seed: int = 0) -> dict:
    key = jax.random.key(seed)
    ks = jax.random.split(key, 26)
    f32 = jnp.float32

    def nrm(k, shape, scale):
        return jax.random.normal(k, shape, f32) * scale

    a_decay = jax.random.uniform(ks[16], (DEPTH, 2, LRU_W), f32, 0.9, 0.999)
    a_base = a_decay ** (1.0 / LRU_C)
    return {
        "x": nrm(ks[0], (BATCH, SEQ, D_MODEL), 1.0),
        "c": nrm(ks[1], (BATCH, D_MODEL), 1.0),
        "ctx": nrm(ks[2], (BATCH, CTX_LEN, D_MODEL), 1.0),
        "c_ctx": nrm(ks[3], (D_MODEL,), 1.0),
        "w_ada": nrm(ks[4], (DEPTH, D_MODEL, N_MOD * D_MODEL), 0.3 * D_MODEL ** -0.5),
        "b_ada": nrm(ks[5], (DEPTH, N_MOD * D_MODEL), 0.02),
        "g_norm": 1.0 + nrm(ks[6], (DEPTH, 4, D_MODEL), 0.05),
        "w_in": nrm(ks[7], (DEPTH, D_MODEL, IN_W), D_MODEL ** -0.5),
        "w_out": nrm(ks[8], (DEPTH, MIX_W, D_MODEL), MIX_W ** -0.5),
        "na_rpb": nrm(ks[9], (DEPTH, NA_HEADS, 2 * WIN_ROWS - 1, 2 * WIN_COLS - 1), 0.2),
        "conv_w": nrm(ks[10], (DEPTH, CONV_W, LRU_W), CONV_W ** -0.5),
        "conv_b": nrm(ks[11], (DEPTH, LRU_W), 0.02),
        "lru_w_a": nrm(ks[12], (DEPTH, 2, LRU_BLOCKS, LRU_BLOCK_W, LRU_BLOCK_W), LRU_BLOCK_W ** -0.5),
        "lru_b_a": nrm(ks[13], (DEPTH, 2, LRU_W), 0.02),
        "lru_w_i": nrm(ks[14], (DEPTH, 2, LRU_BLOCKS, LRU_BLOCK_W, LRU_BLOCK_W), LRU_BLOCK_W ** -0.5),
        "lru_b_i": nrm(ks[15], (DEPTH, 2, LRU_W), 0.02),
        "lru_lam": jnp.log(a_base) - jnp.log1p(-a_base),
        "mla_g_q": 1.0 + nrm(ks[17], (DEPTH, Q_LORA), 0.05),
        "mla_w_q": nrm(ks[18], (DEPTH, Q_LORA, MLA_HEADS * (QK_NOPE + QK_ROPE)), Q_LORA ** -0.5),
        "mla_g_kv": 1.0 + nrm(ks[19], (DEPTH, KV_LORA), 0.05),
        "mla_w_kv": nrm(ks[20], (DEPTH, KV_LORA, MLA_HEADS * (QK_NOPE + V_HEAD)), KV_LORA ** -0.5),
        "router_w": nrm(ks[21], (D_MODEL, N_EXPERTS), D_MODEL ** -0.5),
        "router_b": nrm(ks[22], (N_EXPERTS,), 0.01),
        "exp_w_gate": nrm(ks[23], (DEPTH, N_EXPERTS, D_MODEL, D_EXPERT), D_MODEL ** -0.5),
        "exp_w_up": nrm(ks[24], (DEPTH, N_EXPERTS, D_MODEL, D_EXPERT), D_MODEL ** -0.5),
        "exp_w_down": nrm(ks[25], (DEPTH, N_EXPERTS, D_EXPERT, D_MODEL), D_EXPERT ** -0.5),
    }


def reference(x, c, ctx, c_ctx, w_ada, b_ada, g_norm, w_in, w_out, na_rpb, conv_w, conv_b,
              lru_w_a, lru_b_a, lru_w_i, lru_b_i, lru_lam, mla_g_q, mla_w_q, mla_g_kv, mla_w_kv,
              router_w, router_b, exp_w_gate, exp_w_up, exp_w_down):
    b, s, d = x.shape
    tabs = axial_rope_tables(s)
    sc = jax.nn.silu(c)
    scc = jax.nn.silu(c_ctx)
    cx = ctx
    for l in range(DEPTH):
        last = l == DEPTH - 1
        mod_x = (sc @ w_ada[l] + b_ada[l]).reshape(b, N_MOD, 1, d)
        mod_c = (scc @ w_ada[l] + b_ada[l]).reshape(N_MOD, 1, 1, d)
        g = g_norm[l]

        hx = modulate(rms_norm(x, g[0]), mod_x[:, 0], mod_x[:, 1])
        hc = modulate(rms_norm(cx, g[0]), mod_c[0], mod_c[1])
        yx, yc = token_mixer(hx, hc, w_in[l], w_out[l], na_rpb[l], conv_w[l], conv_b[l],
                             lru_w_a[l], lru_b_a[l], lru_w_i[l], lru_b_i[l], lru_lam[l],
                             mla_g_q[l], mla_w_q[l], mla_g_kv[l], mla_w_kv[l], tabs, not last)
        x = x + mod_x[:, 2] * rms_norm(yx, g[1])

        hx = modulate(rms_norm(x, g[2]), mod_x[:, 3], mod_x[:, 4])
        if last:
            x = x + mod_x[:, 5] * rms_norm(moe_ffn(hx, router_w, router_b, exp_w_gate[l], exp_w_up[l], exp_w_down[l]), g[3])
        else:
            cx = cx + mod_c[2] * rms_norm(yc, g[1])
            hc = modulate(rms_norm(cx, g[2]), mod_c[3], mod_c[4])
            n_ctx = cx.shape[1]
            f = moe_ffn(jnp.concatenate([hc, hx], axis=1), router_w, router_b,
                        exp_w_gate[l], exp_w_up[l], exp_w_down[l])
            cx = cx + mod_c[5] * rms_norm(f[:, :n_ctx], g[3])
            x = x + mod_x[:, 5] * rms_norm(f[:, n_ctx:], g[3])
    return x
```

```cpp
#include <hip/hip_runtime.h>
#include <cstdio>
#include <cstdint>

#ifndef N_LAUNCHES
#define N_LAUNCHES 0
#endif

#define LAS __attribute__((address_space(3)))
typedef unsigned short bf16_t;
typedef short bf16x8 __attribute__((ext_vector_type(8)));
typedef float f32x4 __attribute__((ext_vector_type(4)));
typedef unsigned u32x4 __attribute__((ext_vector_type(4)));
typedef unsigned u32x2 __attribute__((ext_vector_type(2)));

constexpr int D = 1024, NB = 2, S = 8192, CTX = 256, LT = CTX + S, M = NB * LT;
constexpr int GW = 64;
constexpr int INW = 2208, INP = 2304;
constexpr int OFF_QA = 0, OFF_KA = 256, OFF_VA = 512, OFF_U = 768, OFF_G = 1280, OFF_CQ = 1792, OFF_CKV = 2048, OFF_KR = 2176;
constexpr int LRU_W = 512;
constexpr int CH = 32, NCH = LT / CH, NCH_CTX = CTX / CH;
constexpr int NE = 16, DE = 512;
constexpr int NTHREADS = 512, NWAVES = 8;
constexpr int LDS_BYTES = 147456;

constexpr size_t MiB = 1u << 20;
constexpr size_t WS_CTL = 0, CTL_BYTES = 1 * MiB;
constexpr size_t WS_MODP = 1 * MiB;
constexpr size_t WS_WIN = 4 * MiB;
constexpr size_t WS_WOUT = 13 * MiB;
constexpr size_t WS_WGU = 17 * MiB;
constexpr size_t WS_WD = 81 * MiB;
constexpr size_t WS_XC = 113 * MiB;
constexpr size_t WS_RE = 115 * MiB;
constexpr size_t WS_RW = WS_RE + 256 * 1024;
constexpr size_t WS_PERM = WS_RW + 256 * 1024;
constexpr size_t WS_AGG = 117 * MiB;
constexpr size_t WS_CARRY = 122 * MiB;
constexpr size_t WS_H = 125 * MiB;
constexpr size_t WS_P = 158 * MiB;
constexpr size_t WS_Q = 233 * MiB;
constexpr size_t WS_K = 246 * MiB;
constexpr size_t WS_V = 259 * MiB;
constexpr size_t WS_Y = 268 * MiB;
constexpr size_t WS_END = 301 * MiB;
constexpr int CW_CNT = 64;
constexpr int CW_BAR = 4096;

__device__ __forceinline__ float bf2f(bf16_t v) { return __uint_as_float(((unsigned)v) << 16); }
__device__ __forceinline__ unsigned f2bf(float f) { unsigned u = __float_as_uint(f); return (u + 0x7fffu + ((u >> 16) & 1u)) >> 16; }
__device__ __forceinline__ unsigned pk2(float lo, float hi) { return f2bf(lo) | (f2bf(hi) << 16); }
__device__ __forceinline__ float lo_bf(unsigned w) { return __uint_as_float(w << 16); }
__device__ __forceinline__ float hi_bf(unsigned w) { return __uint_as_float(w & 0xffff0000u); }
__device__ __forceinline__ float wave_sum(float v) {
#pragma unroll
    for (int o = 1; o < 64; o <<= 1) v += __shfl_xor(v, o);
    return v;
}
__device__ __forceinline__ float sigmoidf_(float x) { return 1.f / (1.f + __expf(-x)); }
__device__ __forceinline__ float siluf_(float x) { return x / (1.f + __expf(-x)); }
__device__ __forceinline__ float gelu_tanh(float x) { const float u = 0.7978845608028654f * (x + 0.044715f * x * x * x); return 0.5f * x * (1.f + tanhf(u)); }

struct Params {
    const float *x, *c, *ctx, *c_ctx, *w_ada, *b_ada, *g_norm, *w_in, *w_out, *na_rpb, *conv_w, *conv_b,
        *lru_w_a, *lru_b_a, *lru_w_i, *lru_b_i, *lru_lam, *mla_g_q, *mla_w_q, *mla_g_kv, *mla_w_kv,
        *router_w, *router_b, *exp_w_gate, *exp_w_up, *exp_w_down;
    float* out; unsigned char* ws; int ph_lo, ph_hi;
};

struct Ctx {
    int tid, lane, wave, bid, nb, gw, ngw;
    LAS unsigned char* lds;
};

__device__ __forceinline__ const float* xin_row(const Params& p, int m) {
    const int b = m / LT, t = m - b * LT;
    return t < CTX ? p.ctx + (size_t)(b * CTX + t) * D : p.x + (size_t)(b * S + t - CTX) * D;
}
__device__ __forceinline__ float* res_row(const Params& p, int m) {
    const int b = m / LT, t = m - b * LT;
    return t < CTX ? (float*)(p.ws + WS_XC) + (size_t)(b * CTX + t) * D : p.out + (size_t)(b * S + t - CTX) * D;
}
__device__ __forceinline__ void load_mods(const Params& p, const Ctx& c, int l, int j, LAS float* dst) {
    const float* mp = (const float*)(p.ws + WS_MODP);
    for (int idx = c.tid; idx < 3 * D; idx += NTHREADS) {
        const int r = idx >> 10, n = idx & 1023;
        float v = p.b_ada[l * 6144 + j * D + n];
#pragma unroll
        for (int kc = 0; kc < 16; ++kc) v += mp[(size_t)((kc * 2 + l) * 3 + r) * 6144 + j * D + n];
        dst[idx] = v;
    }
}

#define XB_TMO      128
#define XB_XCNT(j)  (256  + 64 * (j))
#define XB_XSUB(j)  (1280 + 64 * (j))
#define XB_XGEN(j)  (2304 + 64 * (j))
#define XB_TOP      3328
#define XB_TOPGEN   3392
#define XCD_BAR_WORDS 3456
#define XB_SPIN_CAP (1u << 18)
__device__ __forceinline__ unsigned xb_ld(unsigned* p)              { return __hip_atomic_load(p, __ATOMIC_RELAXED, __HIP_MEMORY_SCOPE_AGENT); }
__device__ __forceinline__ unsigned xb_add(unsigned* p, unsigned v) { return __hip_atomic_fetch_add(p, v, __ATOMIC_RELAXED, __HIP_MEMORY_SCOPE_AGENT); }
__device__ __forceinline__ unsigned xb_xcc_id() { return (unsigned)__builtin_amdgcn_s_getreg((3 << 11) | 20) & 0xFu; }
#define XB_SPIN(cond, bar) do { unsigned _sp = 0; while (cond) { __builtin_amdgcn_s_sleep(1); \
    if ((++_sp & 255u) == 0u) { if (xb_ld(&(bar)[XB_TMO])) break; if (_sp > XB_SPIN_CAP) { atomicAdd(&(bar)[XB_TMO], 1u); break; } } } } while (0)
struct XcdBarrier { unsigned* bar; unsigned x; volatile LAS unsigned* st; };
__device__ __forceinline__ XcdBarrier xcd_barrier_post(unsigned* bar, volatile LAS unsigned* st) {
    XcdBarrier b; b.bar = bar; b.x = xb_xcc_id(); b.st = st;
    if (threadIdx.x == 0) (void)xb_add(&bar[XB_XCNT(b.x)], 1u);
    return b;
}
__device__ __forceinline__ void xcd_barrier_complete(unsigned* bar, unsigned x, unsigned& nloc, unsigned& nx) {
    const unsigned G = gridDim.x * gridDim.y * gridDim.z;
    unsigned sum, cnt, mine, sp = 0u;
    for (;;) {
        sum = 0u; cnt = 0u; mine = 0u;
#pragma unroll
        for (unsigned j = 0; j < 16; ++j) { const unsigned c = xb_ld(&bar[XB_XCNT(j)]); sum += c; cnt += (c > 0u) ? 1u : 0u; mine = (j == x) ? c : mine; }
        if (sum == G) break;
        __builtin_amdgcn_s_sleep(1);
        if ((++sp & 255u) == 0u) { if (xb_ld(&bar[XB_TMO])) break; if (sp > XB_SPIN_CAP) { atomicAdd(&bar[XB_TMO], 1u); break; } }
    }
    nloc = mine > 0u ? mine : 1u; nx = cnt > 0u ? cnt : 1u;
}
__device__ __forceinline__ void xcd_barrier(const XcdBarrier& b) {
    asm volatile("s_waitcnt vmcnt(0)" ::: "memory");
    __syncthreads();
    if (threadIdx.x == 0) {
        unsigned* bar = b.bar;
        __builtin_amdgcn_s_waitcnt(0);
        unsigned nloc = b.st[0], nx = b.st[1];
        if (nloc == 0u) { xcd_barrier_complete(bar, b.x, nloc, nx); b.st[0] = nloc; b.st[1] = nx; }
        const unsigned old = xb_add(&bar[XB_XSUB(b.x)], 1u);
        const unsigned gen = old / nloc;
        if (old + 1u == (gen + 1u) * nloc) {
            __builtin_amdgcn_fence(__ATOMIC_RELEASE, "agent");
            asm volatile("s_waitcnt vmcnt(0)" ::: "memory");
            const unsigned og = xb_add(&bar[XB_TOP], 1u);
            const unsigned tg = og / nx;
            if (og + 1u == (tg + 1u) * nx) xb_add(&bar[XB_TOPGEN], 1u);
            else XB_SPIN(xb_ld(&bar[XB_TOPGEN]) == tg, bar);
            __builtin_amdgcn_fence(__ATOMIC_ACQUIRE, "agent");
            xb_add(&bar[XB_XGEN(b.x)], 1u);
            asm volatile("s_waitcnt vmcnt(0)" ::: "memory");
        } else {
            XB_SPIN(xb_ld(&bar[XB_XGEN(b.x)]) == gen, bar);
            __builtin_amdgcn_fence(__ATOMIC_ACQUIRE, "agent");
            asm volatile("s_waitcnt vmcnt(0)" ::: "memory");
        }
    }
    __syncthreads();
}

__device__ __forceinline__ void transpose_item(const float* W, int K, int N, bf16_t* WT, int item, LAS float* scr, int lane) {
    const int nblk = N / 32, kb = item / nblk, nbk = item % nblk, k0 = 64 * kb, n0 = 32 * nbk;
#pragma unroll 8
    for (int i = 0; i < 32; ++i) { const int kk = 2 * i + (lane >> 5); scr[kk * 33 + (lane & 31)] = W[(size_t)(k0 + kk) * N + n0 + (lane & 31)]; }
    asm volatile("s_waitcnt lgkmcnt(0)" ::: "memory");
    const int cc = lane & 7;
#pragma unroll
    for (int j = 0; j < 4; ++j) { const int n = (lane >> 3) + 8 * j; const LAS float* s = scr + (8 * cc) * 33 + n;
        u32x4 o; o.x = pk2(s[0 * 33], s[1 * 33]); o.y = pk2(s[2 * 33], s[3 * 33]); o.z = pk2(s[4 * 33], s[5 * 33]); o.w = pk2(s[6 * 33], s[7 * 33]);
        *(u32x4*)(WT + (size_t)(n0 + n) * K + k0 + 8 * cc) = o; }
    asm volatile("s_waitcnt lgkmcnt(0)" ::: "memory");
}
__device__ __forceinline__ void phase_pro(const Params& p, const Ctx& c) {
    LAS float* scr = (LAS float*)(c.lds + c.wave * 16384);
    constexpr int I_IN = 16 * 69, I_OUT = 16 * 32, I_E = 16 * 256, I_L = I_IN + I_OUT + 3 * I_E;
    for (int it = c.gw; it < 2 * I_L; it += c.ngw) {
        const int l = it / I_L; int r = it % I_L;
        if (r < I_IN) { transpose_item(p.w_in + (size_t)l * D * INW, D, INW, (bf16_t*)(p.ws + WS_WIN) + (size_t)l * INP * D, r, scr, c.lane); continue; } r -= I_IN;
        if (r < I_OUT) { transpose_item(p.w_out + (size_t)l * D * D, D, D, (bf16_t*)(p.ws + WS_WOUT) + (size_t)l * D * D, r, scr, c.lane); continue; } r -= I_OUT;
        if (r < I_E) { const int e = r / 256; transpose_item(p.exp_w_gate + (size_t)(l * NE + e) * D * DE, D, DE, (bf16_t*)(p.ws + WS_WGU) + (size_t)(l * NE + e) * 1024 * 1024, r % 256, scr, c.lane); continue; } r -= I_E;
        if (r < I_E) { const int e = r / 256; transpose_item(p.exp_w_up + (size_t)(l * NE + e) * D * DE, D, DE, (bf16_t*)(p.ws + WS_WGU) + (size_t)(l * NE + e) * 1024 * 1024 + (size_t)512 * 1024, r % 256, scr, c.lane); continue; } r -= I_E;
        { const int e = r / 256; transpose_item(p.exp_w_down + (size_t)(l * NE + e) * DE * D, DE, D, (bf16_t*)(p.ws + WS_WD) + (size_t)(l * NE + e) * 1024 * 512, r % 256, scr, c.lane); }
    }
    for (int i = c.bid * NTHREADS + c.tid; i < 2 * 96 * D / 8; i += c.nb * NTHREADS) {
        const int l = i / (96 * D / 8), r = i % (96 * D / 8);
        *(u32x4*)((bf16_t*)(p.ws + WS_WIN) + (size_t)l * INP * D + (size_t)INW * D + (size_t)r * 8) = (u32x4){0u, 0u, 0u, 0u};
    }
    __syncthreads();
    LAS float* sv = (LAS float*)c.lds;
    float* mp = (float*)(p.ws + WS_MODP);
    for (int it = c.bid; it < 2 * 12 * 16; it += c.nb) {
        const int l = it / 192, rem = it % 192, nt = rem / 16, kc = rem % 16;
        __syncthreads();
        if (c.tid < 192) { const int r = c.tid / 64, kk = c.tid % 64; const float v = (r < 2) ? p.c[r * D + kc * 64 + kk] : p.c_ctx[kc * 64 + kk]; sv[c.tid] = siluf_(v); }
        __syncthreads();
        const int n = nt * 512 + c.tid;
        const float* w = p.w_ada + ((size_t)l * D + kc * 64) * 6144 + n;
        float a0 = 0.f, a1 = 0.f, a2 = 0.f;
#pragma unroll 8
        for (int kk = 0; kk < 64; ++kk) { const float wv = w[(size_t)kk * 6144]; a0 += sv[kk] * wv; a1 += sv[64 + kk] * wv; a2 += sv[128 + kk] * wv; }
        float* o = mp + (size_t)((kc * 2 + l) * 3) * 6144 + n;
        o[0] = a0; o[6144] = a1; o[2 * 6144] = a2;
    }
}

__device__ __forceinline__ void phase_n1(const Params& p, const Ctx& c, int l) {
    LAS float* sh = (LAS float*)c.lds;
    LAS float* sc = sh + 3 * D;
    load_mods(p, c, l, 0, sh); load_mods(p, c, l, 1, sc);
    __syncthreads();
    const float* g = p.g_norm + (size_t)(l * 4 + 0) * D;
    bf16_t* H = (bf16_t*)(p.ws + WS_H);
    for (int m = c.gw; m < M; m += c.ngw) {
        const int b = m / LT, t = m - b * LT, r = t < CTX ? 2 : b;
        const float* xr = (l == 0) ? xin_row(p, m) : res_row(p, m);
        f32x4 v[4]; float ss = 0.f;
#pragma unroll
        for (int j = 0; j < 4; ++j) { v[j] = *(const f32x4*)(xr + 4 * (c.lane + 64 * j)); ss += v[j].x * v[j].x + v[j].y * v[j].y + v[j].z * v[j].z + v[j].w * v[j].w; }
        const float rstd = rsqrtf(wave_sum(ss) * (1.f / D) + 1e-6f);
#pragma unroll
        for (int j = 0; j < 4; ++j) {
            const int n = 4 * (c.lane + 64 * j);
            const f32x4 gg = *(const f32x4*)(g + n);
            float o[4];
#pragma unroll
            for (int e = 0; e < 4; ++e) o[e] = v[j][e] * rstd * gg[e] * (1.f + sc[r * D + n + e]) + sh[r * D + n + e];
            u32x2 w; w.x = pk2(o[0], o[1]); w.y = pk2(o[2], o[3]);
            *(u32x2*)(H + (size_t)m * D + n) = w;
        }
    }
}

template <int NJ, class Op>
__device__ __forceinline__ void wave_gemm_tile(const Op& op, int r0, int c0, int K, int lane) {
    const int fr = lane & 15, fq = lane >> 4;
    const bf16_t* ap[4]; const bf16_t* bp[NJ];
#pragma unroll
    for (int i = 0; i < 4; ++i) ap[i] = op.arow(r0 + 16 * i + fr) + 8 * fq;
#pragma unroll
    for (int j = 0; j < NJ; ++j) bp[j] = op.brow(c0 + 16 * j + fr) + 8 * fq;
    f32x4 acc[4][NJ];
#pragma unroll
    for (int i = 0; i < 4; ++i)
#pragma unroll
        for (int j = 0; j < NJ; ++j) acc[i][j] = (f32x4){0.f, 0.f, 0.f, 0.f};
    for (int k0 = 0; k0 < K; k0 += 32) {
        bf16x8 a[4], b[NJ];
#pragma unroll
        for (int i = 0; i < 4; ++i) a[i] = *(const bf16x8*)(ap[i] + k0);
#pragma unroll
        for (int j = 0; j < NJ; ++j) b[j] = *(const bf16x8*)(bp[j] + k0);
#pragma unroll
        for (int i = 0; i < 4; ++i)
#pragma unroll
            for (int j = 0; j < NJ; ++j) acc[i][j] = __builtin_amdgcn_mfma_f32_16x16x32_bf16(a[i], b[j], acc[i][j], 0, 0, 0);
    }
#pragma unroll
    for (int i = 0; i < 4; ++i)
#pragma unroll
        for (int j = 0; j < NJ; ++j)
#pragma unroll
            for (int e = 0; e < 4; ++e) op.store(r0 + 16 * i + 4 * fq + e, c0 + 16 * j + fr, acc[i][j][e]);
}

struct OpG1 {
    const bf16_t* A; const bf16_t* Bt; bf16_t* C;
    __device__ __forceinline__ const bf16_t* arow(int r) const { return A + (size_t)r * D; }
    __device__ __forceinline__ const bf16_t* brow(int n) const { return Bt + (size_t)n * D; }
    __device__ __forceinline__ void store(int r, int cidx, float v) const { C[(size_t)r * INP + cidx] = (bf16_t)f2bf(v); }
};
__device__ __forceinline__ void phase_g1(const Params& p, const Ctx& c, int l) {
    OpG1 op{(const bf16_t*)(p.ws + WS_H), (const bf16_t*)(p.ws + WS_WIN) + (size_t)l * INP * D, (bf16_t*)(p.ws + WS_P)};
    constexpr int NT = INP / 64;
    for (int it = c.gw; it < (M / 64) * NT; it += c.ngw) wave_gemm_tile<4>(op, (it / NT) * 64, (it % NT) * 64, D, c.lane);
}
struct OpO1 {
    const bf16_t* A; const bf16_t* Bt; float* C;
    __device__ __forceinline__ const bf16_t* arow(int r) const { return A + (size_t)r * D; }
    __device__ __forceinline__ const bf16_t* brow(int n) const { return Bt + (size_t)n * D; }
    __device__ __forceinline__ void store(int r, int cidx, float v) const { C[(size_t)r * D + cidx] = v; }
};
__device__ __forceinline__ void phase_o1(const Params& p, const Ctx& c, int l) {
    OpO1 op{(const bf16_t*)(p.ws + WS_Y), (const bf16_t*)(p.ws + WS_WOUT) + (size_t)l * D * D, (float*)(p.ws + WS_P)};
    constexpr int NT = D / 64;
    for (int it = c.gw; it < (M / 64) * NT; it += c.ngw) wave_gemm_tile<4>(op, (it / NT) * 64, (it % NT) * 64, D, c.lane);
}

__device__ __forceinline__ void phase_c1(const Params& p, const Ctx& c, int l) {
    constexpr int R = 16;
    LAS float* cq = (LAS float*)c.lds;
    LAS float* ckv = cq + R * 256;
    LAS float* kr = ckv + R * 128;
    LAS float* qo = kr + R * 32;
    LAS float* kvo = qo + R * 384;
    const bf16_t* P = (const bf16_t*)(p.ws + WS_P);
    bf16_t* Q = (bf16_t*)(p.ws + WS_Q); bf16_t* Kb = (bf16_t*)(p.ws + WS_K); bf16_t* Vb = (bf16_t*)(p.ws + WS_V);
    const float* wq = p.mla_w_q + (size_t)l * 256 * 384; const float* wkv = p.mla_w_kv + (size_t)l * 128 * 512;
    for (int g = c.bid; g < M / R; g += c.nb) {
        const int m0 = g * R;
        __syncthreads();
        for (int i = c.tid; i < R * 416; i += NTHREADS) { const int r = i / 416, col = i % 416; const float v = bf2f(P[(size_t)(m0 + r) * INP + OFF_CQ + col]);
            if (col < 256) cq[r * 256 + col] = v; else if (col < 384) ckv[r * 128 + col - 256] = v; else kr[r * 32 + col - 384] = v; }
        __syncthreads();
        for (int rr = 0; rr < 2; ++rr) { const int r = c.wave * 2 + rr;
            float s = 0.f; for (int k = c.lane; k < 256; k += 64) { const float v = cq[r * 256 + k]; s += v * v; }
            const float rs = rsqrtf(wave_sum(s) * (1.f / 256.f) + 1e-6f);
            for (int k = c.lane; k < 256; k += 64) cq[r * 256 + k] *= rs * p.mla_g_q[l * 256 + k];
            float s2 = 0.f; for (int k = c.lane; k < 128; k += 64) { const float v = ckv[r * 128 + k]; s2 += v * v; }
            const float rs2 = rsqrtf(wave_sum(s2) * (1.f / 128.f) + 1e-6f);
            for (int k = c.lane; k < 128; k += 64) ckv[r * 128 + k] *= rs2 * p.mla_g_kv[l * 128 + k];
        }
        __syncthreads();
        if (c.tid < 384) { float acc[R];
#pragma unroll
            for (int r = 0; r < R; ++r) acc[r] = 0.f;
            for (int k = 0; k < 256; ++k) { const float w = wq[(size_t)k * 384 + c.tid];
#pragma unroll
                for (int r = 0; r < R; ++r) acc[r] += cq[r * 256 + k] * w; }
#pragma unroll
            for (int r = 0; r < R; ++r) qo[r * 384 + c.tid] = acc[r]; }
        { float acc[R];
#pragma unroll
            for (int r = 0; r < R; ++r) acc[r] = 0.f;
            for (int k = 0; k < 128; ++k) { const float w = wkv[(size_t)k * 512 + c.tid];
#pragma unroll
                for (int r = 0; r < R; ++r) acc[r] += ckv[r * 128 + k] * w; }
#pragma unroll
            for (int r = 0; r < R; ++r) kvo[r * 512 + c.tid] = acc[r]; }
        __syncthreads();
        for (int i = c.tid; i < R * 5 * 16; i += NTHREADS) {
            const int r = i / 80, rem = i % 80, which = rem / 16, ii = rem % 16;
            const int m = m0 + r, b = m / LT, t = m - b * LT;
            if (t >= CTX) {
                const int s = t - CTX, grow = s / GW, gcol = s % GW;
                const int fi = ii & 7, half = ii >> 3;
                const float inv = __powf(10000.f, -(float)fi * 0.125f);
                const float ang = (float)(half ? gcol : grow) * inv;
                const float cs = cosf(ang), sn = sinf(ang);
                LAS float* z = (which < 4) ? (qo + r * 384 + which * 96 + 64) : (kr + r * 32);
                const float x1 = z[half * 16 + fi], x2 = z[half * 16 + 8 + fi];
                z[half * 16 + fi] = x1 * cs - x2 * sn; z[half * 16 + 8 + fi] = x2 * cs + x1 * sn;
            }
        }
        __syncthreads();
        for (int i = c.tid; i < R * 384; i += NTHREADS) { const int r = i / 384, col = i % 384, h = col / 96, d = col % 96;
            Q[(size_t)(m0 + r) * 384 + col] = (bf16_t)f2bf(qo[r * 384 + col]);
            const float kv = d < 64 ? kvo[r * 512 + h * 128 + d] : kr[r * 32 + d - 64];
            Kb[(size_t)(m0 + r) * 384 + col] = (bf16_t)f2bf(kv); }
        for (int i = c.tid; i < R * 256; i += NTHREADS) { const int r = i / 256, col = i % 256, h = col / 64, d = col % 64;
            Vb[(size_t)(m0 + r) * 256 + col] = (bf16_t)f2bf(kvo[r * 512 + h * 128 + 64 + d]); }
    }
}

__device__ __forceinline__ void lru_load_uc(const Params& p, const Ctx& c, int l, int b, int ch, LAS float* ucs) {
    const int ch_c = c.tid, t0 = ch * CH, seq_lo = (ch < NCH_CTX) ? 0 : CTX, seq_hi = (ch < NCH_CTX) ? CTX : LT;
    const bf16_t* Pb = (const bf16_t*)(p.ws + WS_P) + (size_t)(b * LT) * INP + OFF_U + ch_c;
    const float w0 = p.conv_w[(l * 4 + 0) * LRU_W + ch_c], w1 = p.conv_w[(l * 4 + 1) * LRU_W + ch_c], w2 = p.conv_w[(l * 4 + 2) * LRU_W + ch_c], w3 = p.conv_w[(l * 4 + 3) * LRU_W + ch_c];
    const float cb = p.conv_b[l * LRU_W + ch_c];
#define LDU(t) (((t) >= seq_lo && (t) < seq_hi) ? bf2f(Pb[(size_t)(t) * INP]) : 0.f)
    float um1 = LDU(t0 - 1), u0 = LDU(t0), u1 = LDU(t0 + 1);
    for (int i = 0; i < CH; ++i) { const float u2 = LDU(t0 + i + 2); ucs[i * LRU_W + ch_c] = um1 * w0 + u0 * w1 + u1 * w2 + u2 * w3 + cb; um1 = u0; u0 = u1; u1 = u2; }
#undef LDU
}
template <int MODE>
__device__ __forceinline__ void lru_dir(const Params& p, const Ctx& c, int l, int b, int ch, int d, LAS const float* ucs, LAS float* hs) {
    const int chn = c.tid, n = chn >> 6, j = chn & 63;
    float wa[64], wi[64];
    const float* wap = p.lru_w_a + (size_t)(((l * 2 + d) * 8 + n) * 64) * 64 + j;
    const float* wip = p.lru_w_i + (size_t)(((l * 2 + d) * 8 + n) * 64) * 64 + j;
    asm volatile("" : "+v"(wap), "+v"(wip));
#pragma unroll
    for (int k = 0; k < 64; ++k) { wa[k] = wap[k * 64]; wi[k] = wip[k * 64]; }
    const float ba = p.lru_b_a[(l * 2 + d) * LRU_W + chn], bi = p.lru_b_i[(l * 2 + d) * LRU_W + chn];
    const float sp = log1pf(expf(-p.lru_lam[(l * 2 + d) * LRU_W + chn]));
    const size_t aidx = ((size_t)((b * 2 + d) * NCH + ch)) * LRU_W + chn;
    float h = 0.f, ap = 1.f;
    if (MODE == 1) h = ((const float*)(p.ws + WS_CARRY))[aidx];
    for (int st = 0; st < CH; ++st) {
        const int i = d == 0 ? st : CH - 1 - st;
        LAS const f32x4* ur = (LAS const f32x4*)(ucs + i * LRU_W + n * 64);
        float za = ba, zi = bi;
#pragma unroll
        for (int k4 = 0; k4 < 16; ++k4) { const f32x4 u = ur[k4];
#pragma unroll
            for (int e = 0; e < 4; ++e) { za += u[e] * wa[4 * k4 + e]; zi += u[e] * wi[4 * k4 + e]; } }
        const float r = sigmoidf_(za), ig = sigmoidf_(zi);
        const float la = -8.f * r * sp, a = expf(la), gain = sqrtf(-expm1f(2.f * la));
        const float xv = gain * ig * ucs[i * LRU_W + chn];
        h = a * h + xv; ap *= a;
        if (MODE == 1) {
            if (d == 1) hs[i * LRU_W + chn] = h;
            else {
                const size_t m = (size_t)b * LT + ch * CH + i;
                const float gate = bf2f(((const bf16_t*)(p.ws + WS_P))[m * INP + OFF_G + chn]);
                ((bf16_t*)(p.ws + WS_Y))[m * D + 256 + chn] = (bf16_t)f2bf((hs[i * LRU_W + chn] + h) * gelu_tanh(gate));
            }
        }
    }
    if (MODE == 0) { float* ag = (float*)(p.ws + WS_AGG) + 2 * aidx; ag[0] = ap; ag[1] = h; }
}
__device__ __forceinline__ void phase_c2(const Params& p, const Ctx& c, int l) {
    LAS float* ucs = (LAS float*)c.lds;
    for (int it = c.bid; it < NB * NCH; it += c.nb) {
        const int b = it / NCH, ch = it % NCH;
        __syncthreads();
        lru_load_uc(p, c, l, b, ch, ucs);
        __syncthreads();
        lru_dir<0>(p, c, l, b, ch, 0, ucs, nullptr);
        lru_dir<0>(p, c, l, b, ch, 1, ucs, nullptr);
    }
}
__device__ __forceinline__ void phase_c3(const Params& p, const Ctx& c) {
    const int g = c.bid * NTHREADS + c.tid;
    if (g < NB * 2 * LRU_W) {
        const int chn = g % LRU_W, d = (g / LRU_W) & 1, b = g / (2 * LRU_W);
        const float* ag = (const float*)(p.ws + WS_AGG); float* cr = (float*)(p.ws + WS_CARRY);
        float st = 0.f;
#pragma unroll 4
        for (int s = 0; s < NCH; ++s) {
            const int ch = d == 0 ? s : (s < NCH_CTX ? NCH_CTX - 1 - s : NCH - 1 - (s - NCH_CTX));
            const size_t idx = ((size_t)((b * 2 + d) * NCH + ch)) * LRU_W + chn;
            cr[idx] = st; st = ag[2 * idx] * st + ag[2 * idx + 1];
        }
    }
}
__device__ __forceinline__ void phase_c4(const Params& p, const Ctx& c, int l, bool last) {
    LAS float* ucs = (LAS float*)c.lds; LAS float* hs = ucs + CH * LRU_W;
    for (int it = c.bid; it < NB * NCH; it += c.nb) {
        const int b = it / NCH, ch = it % NCH;
        if (last && ch < NCH_CTX) continue;
        __syncthreads();
        lru_load_uc(p, c, l, b, ch, ucs);
        __syncthreads();
        lru_dir<1>(p, c, l, b, ch, 1, ucs, hs);
        lru_dir<1>(p, c, l, b, ch, 0, ucs, hs);
    }
}

template <int DQ>
__device__ __forceinline__ float dot_bf(const float (&q)[DQ], const bf16_t* kp) {
    float s = 0.f;
#pragma unroll
    for (int c8 = 0; c8 < DQ / 8; ++c8) { const u32x4 w = *(const u32x4*)(kp + 8 * c8);
        s += q[8 * c8 + 0] * lo_bf(w.x) + q[8 * c8 + 1] * hi_bf(w.x) + q[8 * c8 + 2] * lo_bf(w.y) + q[8 * c8 + 3] * hi_bf(w.y)
           + q[8 * c8 + 4] * lo_bf(w.z) + q[8 * c8 + 5] * hi_bf(w.z) + q[8 * c8 + 6] * lo_bf(w.w) + q[8 * c8 + 7] * hi_bf(w.w); }
    return s;
}
__device__ __forceinline__ void softmax_step(float s, const bf16_t* vp, float& mx, float& ls, float (&o)[64]) {
    const float mn = fmaxf(mx, s), al = __expf(mx - mn), pw = __expf(s - mn);
    ls = ls * al + pw; mx = mn;
#pragma unroll
    for (int c8 = 0; c8 < 8; ++c8) { const u32x4 w = *(const u32x4*)(vp + 8 * c8);
        o[8 * c8 + 0] = o[8 * c8 + 0] * al + pw * lo_bf(w.x); o[8 * c8 + 1] = o[8 * c8 + 1] * al + pw * hi_bf(w.x);
        o[8 * c8 + 2] = o[8 * c8 + 2] * al + pw * lo_bf(w.y); o[8 * c8 + 3] = o[8 * c8 + 3] * al + pw * hi_bf(w.y);
        o[8 * c8 + 4] = o[8 * c8 + 4] * al + pw * lo_bf(w.z); o[8 * c8 + 5] = o[8 * c8 + 5] * al + pw * hi_bf(w.z);
        o[8 * c8 + 6] = o[8 * c8 + 6] * al + pw * lo_bf(w.w); o[8 * c8 + 7] = o[8 * c8 + 7] * al + pw * hi_bf(w.w); }
}
__device__ __forceinline__ void store_o64(bf16_t* dst, const float (&o)[64], float inv) {
#pragma unroll
    for (int c8 = 0; c8 < 8; ++c8) { u32x4 w; w.x = pk2(o[8 * c8] * inv, o[8 * c8 + 1] * inv); w.y = pk2(o[8 * c8 + 2] * inv, o[8 * c8 + 3] * inv);
        w.z = pk2(o[8 * c8 + 4] * inv, o[8 * c8 + 5] * inv); w.w = pk2(o[8 * c8 + 6] * inv, o[8 * c8 + 7] * inv); *(u32x4*)(dst + 8 * c8) = w; }
}
__device__ __forceinline__ void phase_a1(const Params& p, const Ctx& c, int l, bool last) {
    const bf16_t* P = (const bf16_t*)(p.ws + WS_P); bf16_t* Y = (bf16_t*)(p.ws + WS_Y);
    const int n_lat = NB * 128 * 4, n_ctx = last ? 0 : NB * 4 * 4;
    for (int it = c.gw; it < n_lat + n_ctx; it += c.ngw) {
        int b, h, tq; bool lat = it < n_lat; int r = 0;
        if (lat) { b = it / 512; r = (it % 512) / 4; h = it % 4; tq = CTX + r * GW + c.lane; }
        else { const int i2 = it - n_lat; b = i2 / 16; h = (i2 % 16) / 4; tq = (i2 % 4) * 64 + c.lane; }
        const bf16_t* Pb = P + (size_t)(b * LT) * INP;
        float q[64], o[64];
        { const bf16_t* qp = Pb + (size_t)tq * INP + OFF_QA + h * 64;
#pragma unroll
          for (int c8 = 0; c8 < 8; ++c8) { const u32x4 w = *(const u32x4*)(qp + 8 * c8);
              q[8 * c8 + 0] = 0.125f * lo_bf(w.x); q[8 * c8 + 1] = 0.125f * hi_bf(w.x); q[8 * c8 + 2] = 0.125f * lo_bf(w.y); q[8 * c8 + 3] = 0.125f * hi_bf(w.y);
              q[8 * c8 + 4] = 0.125f * lo_bf(w.z); q[8 * c8 + 5] = 0.125f * hi_bf(w.z); q[8 * c8 + 6] = 0.125f * lo_bf(w.w); q[8 * c8 + 7] = 0.125f * hi_bf(w.w); } }
#pragma unroll
        for (int d = 0; d < 64; ++d) o[d] = 0.f;
        float mx = -INFINITY, ls = 0.f;
        if (lat) {
            const int rs = min(max(r - 4, 0), 120), cs = min(max(c.lane - 8, 0), 48);
            const float* rpb = p.na_rpb + (size_t)((l * 4 + h) * 15) * 31;
            for (int i = 0; i < 8; ++i)
                for (int j = 0; j < 16; ++j) {
                    const int tk = CTX + (rs + i) * GW + cs + j;
                    const bf16_t* kp = Pb + (size_t)tk * INP + OFF_KA + h * 64;
                    const float s = dot_bf<64>(q, kp) + rpb[(rs + i - r + 7) * 31 + (cs + j - c.lane + 15)];
                    softmax_step(s, kp + (OFF_VA - OFF_KA), mx, ls, o);
                }
        }
        for (int tk = 0; tk < CTX; ++tk) {
            const bf16_t* kp = Pb + (size_t)tk * INP + OFF_KA + h * 64;
            softmax_step(dot_bf<64>(q, kp), kp + (OFF_VA - OFF_KA), mx, ls, o);
        }
        store_o64(Y + (size_t)(b * LT + tq) * D + h * 64, o, 1.f / ls);
    }
}
__device__ __forceinline__ void phase_a2(const Params& p, const Ctx& c, bool last) {
    const bf16_t* Q = (const bf16_t*)(p.ws + WS_Q); const bf16_t* Kb = (const bf16_t*)(p.ws + WS_K); const bf16_t* Vb = (const bf16_t*)(p.ws + WS_V);
    bf16_t* Y = (bf16_t*)(p.ws + WS_Y);
    const int n_lat = NB * 4 * 128, n_ctx = last ? 0 : NB * 4 * 4;
    const float scale = 0.10206207261596575f;
    for (int it = c.gw; it < n_lat + n_ctx; it += c.ngw) {
        int b, h, tq, nk;
        if (it < n_lat) { b = it / 512; h = (it % 512) / 128; tq = CTX + (it % 128) * 64 + c.lane; nk = LT; }
        else { const int i2 = it - n_lat; b = i2 / 16; h = (i2 % 16) / 4; tq = (i2 % 4) * 64 + c.lane; nk = CTX; }
        float q[96], o[64];
        { const bf16_t* qp = Q + (size_t)(b * LT + tq) * 384 + h * 96;
#pragma unroll
          for (int c8 = 0; c8 < 12; ++c8) { const u32x4 w = *(const u32x4*)(qp + 8 * c8);
              q[8 * c8 + 0] = scale * lo_bf(w.x); q[8 * c8 + 1] = scale * hi_bf(w.x); q[8 * c8 + 2] = scale * lo_bf(w.y); q[8 * c8 + 3] = scale * hi_bf(w.y);
              q[8 * c8 + 4] = scale * lo_bf(w.z); q[8 * c8 + 5] = scale * hi_bf(w.z); q[8 * c8 + 6] = scale * lo_bf(w.w); q[8 * c8 + 7] = scale * hi_bf(w.w); } }
#pragma unroll
        for (int d = 0; d < 64; ++d) o[d] = 0.f;
        float mx = -INFINITY, ls = 0.f;
        const bf16_t* kp = Kb + (size_t)(b * LT) * 384 + h * 96; const bf16_t* vp = Vb + (size_t)(b * LT) * 256 + h * 64;
        for (int tk = 0; tk < nk; ++tk) softmax_step(dot_bf<96>(q, kp + (size_t)tk * 384), vp + (size_t)tk * 256, mx, ls, o);
        store_o64(Y + (size_t)(b * LT + tq) * D + 768 + h * 64, o, 1.f / ls);
    }
}

__device__ __forceinline__ void phase_o2(const Params& p, const Ctx& c, int l, bool last) {
    LAS float* gt = (LAS float*)c.lds;
    LAS float* sh = gt + 3 * D;
    LAS float* sc = sh + 3 * D;
    load_mods(p, c, l, 2, gt); load_mods(p, c, l, 3, sh); load_mods(p, c, l, 4, sc);
    __syncthreads();
    const float* g1 = p.g_norm + (size_t)(l * 4 + 1) * D; const float* g2 = p.g_norm + (size_t)(l * 4 + 2) * D;
    const float* YO = (const float*)(p.ws + WS_P); bf16_t* H = (bf16_t*)(p.ws + WS_H);
    int* RE = (int*)(p.ws + WS_RE); float* RW = (float*)(p.ws + WS_RW); int* PERM = (int*)(p.ws + WS_PERM);
    unsigned* cnt = (unsigned*)(p.ws + WS_CTL) + CW_CNT + l * 64;
    for (int m = c.gw; m < M; m += c.ngw) {
        const int b = m / LT, t = m - b * LT, r = t < CTX ? 2 : b;
        if (last && t < CTX) continue;
        const float* yr = YO + (size_t)m * D; const float* xr = (l == 0) ? xin_row(p, m) : res_row(p, m); float* xo = res_row(p, m);
        f32x4 y[4], xv[4]; float ss = 0.f;
#pragma unroll
        for (int j = 0; j < 4; ++j) { y[j] = *(const f32x4*)(yr + 4 * (c.lane + 64 * j)); xv[j] = *(const f32x4*)(xr + 4 * (c.lane + 64 * j));
            ss += y[j].x * y[j].x + y[j].y * y[j].y + y[j].z * y[j].z + y[j].w * y[j].w; }
        const float rstd = rsqrtf(wave_sum(ss) * (1.f / D) + 1e-6f);
        float s2 = 0.f;
#pragma unroll
        for (int j = 0; j < 4; ++j) { const int n = 4 * (c.lane + 64 * j); const f32x4 gg = *(const f32x4*)(g1 + n);
#pragma unroll
            for (int e = 0; e < 4; ++e) { xv[j][e] += gt[r * D + n + e] * (y[j][e] * rstd * gg[e]); s2 += xv[j][e] * xv[j][e]; }
            *(f32x4*)(xo + n) = xv[j]; }
        const float rstd2 = rsqrtf(wave_sum(s2) * (1.f / D) + 1e-6f);
        float lg[16];
#pragma unroll
        for (int e = 0; e < 16; ++e) lg[e] = 0.f;
#pragma unroll
        for (int j = 0; j < 4; ++j) { const int n = 4 * (c.lane + 64 * j); const f32x4 gg = *(const f32x4*)(g2 + n);
            float o[4];
#pragma unroll
            for (int e = 0; e < 4; ++e) { o[e] = xv[j][e] * rstd2 * gg[e] * (1.f + sc[r * D + n + e]) + sh[r * D + n + e];
                const f32x4* rw = (const f32x4*)(p.router_w + (size_t)(n + e) * 16);
#pragma unroll
                for (int q4 = 0; q4 < 4; ++q4) { const f32x4 w = rw[q4]; lg[4 * q4] += o[e] * w.x; lg[4 * q4 + 1] += o[e] * w.y; lg[4 * q4 + 2] += o[e] * w.z; lg[4 * q4 + 3] += o[e] * w.w; } }
            u32x2 w; w.x = pk2(o[0], o[1]); w.y = pk2(o[2], o[3]);
            *(u32x2*)(H + (size_t)m * D + n) = w; }
        float aff[16], sel[16];
#pragma unroll
        for (int e = 0; e < 16; ++e) { aff[e] = sigmoidf_(wave_sum(lg[e])); sel[e] = aff[e] + p.router_b[e]; }
        float bv = -INFINITY, ba0 = 0.f, ba1 = 0.f; int bi0 = 0, bi1 = 0;
#pragma unroll
        for (int g = 0; g < 4; ++g) {
            float m1 = sel[4 * g], a1 = aff[4 * g]; int i0 = 0;
#pragma unroll
            for (int i = 1; i < 4; ++i) if (sel[4 * g + i] > m1) { m1 = sel[4 * g + i]; a1 = aff[4 * g + i]; i0 = i; }
            float m2 = -INFINITY, a2 = 0.f; int i1 = 0;
#pragma unroll
            for (int i = 0; i < 4; ++i) if (i != i0 && sel[4 * g + i] > m2) { m2 = sel[4 * g + i]; a2 = aff[4 * g + i]; i1 = i; }
            const float gs = m1 + m2;
            if (gs > bv) { bv = gs; bi0 = 4 * g + i0; bi1 = 4 * g + i1; ba0 = a1; ba1 = a2; }
        }
        if (c.lane == 0) {
            const float inv = 1.f / (ba0 + ba1);
            RE[2 * m] = bi0; RE[2 * m + 1] = bi1; RW[2 * m] = ba0 * inv; RW[2 * m + 1] = ba1 * inv;
            const unsigned p0 = atomicAdd(cnt + bi0, 1u); PERM[(size_t)bi0 * M + p0] = 2 * m;
            const unsigned p1 = atomicAdd(cnt + bi1, 1u); PERM[(size_t)bi1 * M + p1] = 2 * m + 1;
        }
    }
}

struct MoeMap { int n[NE]; int toff[NE + 1]; };
__device__ __forceinline__ void moe_find(const unsigned* cnt, int tile, int& e, int& tl, int& ne, int& toff, int& total) {
    int acc = 0; e = 0; tl = 0; ne = 0; toff = 0; bool found = false;
#pragma unroll
    for (int i = 0; i < NE; ++i) { const int n = (int)cnt[i], nt = (n + 63) >> 6; if (!found && tile < acc + nt) { e = i; tl = tile - acc; ne = n; toff = acc; found = true; } acc += nt; }
    total = acc;
}
struct OpR2 {
};
__device__ __forceinline__ void phase_r2(const Params& p, const Ctx& c, int l) {
    const unsigned* cnt = (const unsigned*)(p.ws + WS_CTL) + CW_CNT + l * 64;
    const int* PERM = (const int*)(p.ws + WS_PERM); const bf16_t* H = (const bf16_t*)(p.ws + WS_H); bf16_t* HE = (bf16_t*)(p.ws + WS_Q);
    int total = 0; { int acc = 0; for (int i = 0; i < NE; ++i) acc += ((int)cnt[i] + 63) >> 6; total = acc; }
    const int fr = c.lane & 15, fq = c.lane >> 4;
    for (int it = c.gw; it < total * 16; it += c.ngw) {
        const int tile = it >> 4, ct = it & 15;
        int e, tl, ne, toff, tt; moe_find(cnt, tile, e, tl, ne, toff, tt);
        const bf16_t* Bt = (const bf16_t*)(p.ws + WS_WGU) + (size_t)(l * NE + e) * 1024 * 1024;
        const bf16_t* ap[4]; const bf16_t* bg[2]; const bf16_t* bu[2];
#pragma unroll
        for (int i = 0; i < 4; ++i) { const int sl = tl * 64 + 16 * i + fr; const int tok = sl < ne ? (PERM[(size_t)e * M + sl] >> 1) : 0; ap[i] = H + (size_t)tok * D + 8 * fq; }
#pragma unroll
        for (int j = 0; j < 2; ++j) { bg[j] = Bt + (size_t)(ct * 32 + 16 * j + fr) * D + 8 * fq; bu[j] = bg[j] + (size_t)512 * D; }
        f32x4 ag[4][2], au[4][2];
#pragma unroll
        for (int i = 0; i < 4; ++i)
#pragma unroll
            for (int j = 0; j < 2; ++j) { ag[i][j] = (f32x4){0.f, 0.f, 0.f, 0.f}; au[i][j] = (f32x4){0.f, 0.f, 0.f, 0.f}; }
        for (int k0 = 0; k0 < D; k0 += 32) {
            bf16x8 a[4], g[2], u[2];
#pragma unroll
            for (int i = 0; i < 4; ++i) a[i] = *(const bf16x8*)(ap[i] + k0);
#pragma unroll
            for (int j = 0; j < 2; ++j) { g[j] = *(const bf16x8*)(bg[j] + k0); u[j] = *(const bf16x8*)(bu[j] + k0); }
#pragma unroll
            for (int i = 0; i < 4; ++i)
#pragma unroll
                for (int j = 0; j < 2; ++j) { ag[i][j] = __builtin_amdgcn_mfma_f32_16x16x32_bf16(a[i], g[j], ag[i][j], 0, 0, 0); au[i][j] = __builtin_amdgcn_mfma_f32_16x16x32_bf16(a[i], u[j], au[i][j], 0, 0, 0); }
        }
#pragma unroll
        for (int i = 0; i < 4; ++i)
#pragma unroll
            for (int j = 0; j < 2; ++j)
#pragma unroll
                for (int q = 0; q < 4; ++q) { const int sl = tl * 64 + 16 * i + 4 * fq + q;
                    if (sl < ne) HE[(size_t)(toff * 64 + sl) * DE + ct * 32 + 16 * j + fr] = (bf16_t)f2bf(siluf_(ag[i][j][q]) * au[i][j][q]); }
    }
}
struct OpR3 {
    const bf16_t* A; const bf16_t* Bt; bf16_t* F; const int* perm; const float* rw; int ne, row0;
    __device__ __forceinline__ const bf16_t* arow(int r) const { return A + (size_t)(row0 + r) * DE; }
    __device__ __forceinline__ const bf16_t* brow(int n) const { return Bt + (size_t)n * DE; }
    __device__ __forceinline__ void store(int r, int cidx, float v) const {
        if (r < ne) { const int pk = perm[r]; const int tok = pk >> 1, k = pk & 1; F[((size_t)k * M + tok) * D + cidx] = (bf16_t)f2bf(v * rw[pk]); }
    }
};
__device__ __forceinline__ void phase_r3(const Params& p, const Ctx& c, int l) {
    const unsigned* cnt = (const unsigned*)(p.ws + WS_CTL) + CW_CNT + l * 64;
    int total = 0; { int acc = 0; for (int i = 0; i < NE; ++i) acc += ((int)cnt[i] + 63) >> 6; total = acc; }
    for (int it = c.gw; it < total * 16; it += c.ngw) {
        const int tile = it >> 4, ct = it & 15;
        int e, tl, ne, toff, tt; moe_find(cnt, tile, e, tl, ne, toff, tt);
        OpR3 op{(const bf16_t*)(p.ws + WS_Q), (const bf16_t*)(p.ws + WS_WD) + (size_t)(l * NE + e) * 1024 * 512, (bf16_t*)(p.ws + WS_P),
                (const int*)(p.ws + WS_PERM) + (size_t)e * M + tl * 64, (const float*)(p.ws + WS_RW), ne - tl * 64, (toff + tl) * 64};
        wave_gemm_tile<4>(op, 0, ct * 64, DE, c.lane);
    }
}

__device__ __forceinline__ void phase_f(const Params& p, const Ctx& c, int l, bool last) {
    LAS float* gt = (LAS float*)c.lds;
    load_mods(p, c, l, 5, gt);
    __syncthreads();
    const float* g3 = p.g_norm + (size_t)(l * 4 + 3) * D;
    const bf16_t* F0 = (const bf16_t*)(p.ws + WS_P); const bf16_t* F1 = F0 + (size_t)M * D;
    for (int m = c.gw; m < M; m += c.ngw) {
        const int b = m / LT, t = m - b * LT, r = t < CTX ? 2 : b;
        if (last && t < CTX) continue;
        float* xr = res_row(p, m);
        float f[16]; float ss = 0.f;
#pragma unroll
        for (int j = 0; j < 4; ++j) { const int n = 4 * (c.lane + 64 * j);
            const u32x2 a = *(const u32x2*)(F0 + (size_t)m * D + n), bb = *(const u32x2*)(F1 + (size_t)m * D + n);
            f[4 * j] = lo_bf(a.x) + lo_bf(bb.x); f[4 * j + 1] = hi_bf(a.x) + hi_bf(bb.x); f[4 * j + 2] = lo_bf(a.y) + lo_bf(bb.y); f[4 * j + 3] = hi_bf(a.y) + hi_bf(bb.y);
#pragma unroll
            for (int e = 0; e < 4; ++e) ss += f[4 * j + e] * f[4 * j + e]; }
        const float rstd = rsqrtf(wave_sum(ss) * (1.f / D) + 1e-6f);
#pragma unroll
        for (int j = 0; j < 4; ++j) { const int n = 4 * (c.lane + 64 * j); const f32x4 gg = *(const f32x4*)(g3 + n); f32x4 xv = *(const f32x4*)(xr + n);
#pragma unroll
            for (int e = 0; e < 4; ++e) xv[e] += gt[r * D + n + e] * (f[4 * j + e] * rstd * gg[e]);
            *(f32x4*)(xr + n) = xv; }
    }
}

constexpr int N_PHASES = 21;
__device__ __forceinline__ void run_phase(const Params& p, const Ctx& c, int ph) {
    if (ph == 0) { phase_pro(p, c); return; }
    const int l = (ph - 1) / 10, k = (ph - 1) % 10; const bool last = (l == 1);
    switch (k) {
        case 0: phase_n1(p, c, l); break;
        case 1: phase_g1(p, c, l); break;
        case 2: phase_c1(p, c, l); __syncthreads(); phase_c2(p, c, l); __syncthreads(); phase_a1(p, c, l, last); break;
        case 3: phase_c3(p, c); break;
        case 4: phase_c4(p, c, l, last); __syncthreads(); phase_a2(p, c, last); break;
        case 5: phase_o1(p, c, l); break;
        case 6: phase_o2(p, c, l, last); break;
        case 7: phase_r2(p, c, l); break;
        case 8: phase_r3(p, c, l); break;
        default: phase_f(p, c, l, last); break;
    }
}

template <int KIND>
__global__ void __launch_bounds__(NTHREADS, 2) phase_kernel(Params p) {
    extern __shared__ __attribute__((aligned(16))) unsigned char lds_raw[];
    Ctx c;
    c.lds = (LAS unsigned char*)lds_raw;
    c.tid = threadIdx.x; c.lane = c.tid & 63; c.wave = __builtin_amdgcn_readfirstlane(c.tid >> 6);
    c.bid = blockIdx.x; c.nb = gridDim.x; c.gw = c.bid * NWAVES + c.wave; c.ngw = c.nb * NWAVES;
    const int ph = p.ph_lo;
    if (KIND == 10) { phase_pro(p, c); return; }
    const int l = (ph - 1) / 10; const bool last = (l == 1);
    if (KIND == 0) phase_n1(p, c, l);
    if (KIND == 1) phase_g1(p, c, l);
    if (KIND == 2) phase_c1(p, c, l);
    if (KIND == 11) phase_c2(p, c, l);
    if (KIND == 12) phase_a1(p, c, l, last);
    if (KIND == 3) phase_c3(p, c);
    if (KIND == 4) phase_c4(p, c, l, last);
    if (KIND == 13) phase_a2(p, c, last);
    if (KIND == 5) phase_o1(p, c, l);
    if (KIND == 6) phase_o2(p, c, l, last);
    if (KIND == 7) phase_r2(p, c, l);
    if (KIND == 8) phase_r3(p, c, l);
    if (KIND == 9) phase_f(p, c, l, last);
}

#if N_LAUNCHES == 1
__global__ void __launch_bounds__(NTHREADS, 2) fwd_kernel(Params p) {
    extern __shared__ __attribute__((aligned(16))) unsigned char lds_raw[];
    Ctx c;
    c.lds = (LAS unsigned char*)lds_raw;
    c.tid = threadIdx.x; c.lane = c.tid & 63; c.wave = __builtin_amdgcn_readfirstlane(c.tid >> 6);
    c.bid = blockIdx.x; c.nb = gridDim.x; c.gw = c.bid * NWAVES + c.wave; c.ngw = c.nb * NWAVES;
    volatile LAS unsigned* misc = (volatile LAS unsigned*)(c.lds + LDS_BYTES - 64);
    XcdBarrier bar; bar.bar = nullptr; bar.x = 0; bar.st = nullptr;
    if (p.ph_hi - p.ph_lo > 1) {
        if (c.tid < 16) misc[c.tid] = 0u;
        __syncthreads();
        bar = xcd_barrier_post((unsigned*)(p.ws + WS_CTL) + CW_BAR, misc);
    }
    for (int ph = p.ph_lo; ph < p.ph_hi; ++ph) {
        run_phase(p, c, ph);
        if (ph + 1 < p.ph_hi) xcd_barrier(bar);
    }
}
#define MAIN_KERNEL fwd_kernel
#else
#define MAIN_KERNEL phase_kernel<4>
#endif

extern "C" void kernel_launch(void* const* d_in, const int* in_sizes, int n_in, void* d_out, int out_size, void* d_ws, size_t ws_size, hipStream_t stream) {
    static int grid = 0;
    if (grid == 0) {
        if (n_in != 26 || out_size != NB * S * D || ws_size < WS_END) { fprintf(stderr, "kernel_launch: unexpected shapes (n_in %d out %d ws %zu)\n", n_in, out_size, ws_size); grid = -1; return; }
        int dev = 0, cus = 0, per_cu = 0;
        hipGetDevice(&dev);
        hipDeviceGetAttribute(&cus, hipDeviceAttributeMultiprocessorCount, dev);
        #if N_LAUNCHES == 1
        hipFuncSetAttribute((const void*)fwd_kernel, hipFuncAttributeMaxDynamicSharedMemorySize, LDS_BYTES);
#else
#define SA(KIND) hipFuncSetAttribute((const void*)phase_kernel<KIND>, hipFuncAttributeMaxDynamicSharedMemorySize, LDS_BYTES)
        SA(0); SA(1); SA(2); SA(3); SA(4); SA(5); SA(6); SA(7); SA(8); SA(9); SA(10); SA(11); SA(12); SA(13);
#endif
        hipOccupancyMaxActiveBlocksPerMultiprocessor(&per_cu, (const void*)MAIN_KERNEL, NTHREADS, LDS_BYTES);
        (void)hipGetLastError();
        if (per_cu < 1) { fprintf(stderr, "kernel_launch: occupancy query says %d blocks per CU\n", per_cu); grid = -1; return; }
        grid = cus;
    }
    if (grid < 0) return;
    hipMemsetAsync((char*)d_ws + WS_CTL, 0, CTL_BYTES, stream);
    Params p{};
    const float** pp = (const float**)&p;
    for (int i = 0; i < 26; ++i) pp[i] = (const float*)d_in[i];
    p.out = (float*)d_out; p.ws = (unsigned char*)d_ws;
#if N_LAUNCHES == 1
    p.ph_lo = 0; p.ph_hi = N_PHASES;
    void* args[] = {&p};
    hipLaunchCooperativeKernel((const void*)fwd_kernel, dim3(grid), dim3(NTHREADS), args, LDS_BYTES, stream);
#else
#define LK(KIND) hipLaunchKernelGGL(phase_kernel<KIND>, dim3(grid), dim3(NTHREADS), LDS_BYTES, stream, p)
    p.ph_lo = 0; p.ph_hi = 1; LK(10);
    for (int l = 0; l < 2; ++l) {
        p.ph_lo = 1 + 10 * l; p.ph_hi = p.ph_lo + 1;
        LK(0); LK(1); LK(2); LK(11); LK(12); LK(3); LK(4); LK(13); LK(5); LK(6); LK(7); LK(8); LK(9);
    }
#endif
}
```

```cpp
#include <hip/hip_runtime.h>
#include <cstdio>
#include <cstdint>


#define LAS __attribute__((address_space(3)))
typedef unsigned short bf16_t;
typedef short bf16x8 __attribute__((ext_vector_type(8)));
typedef float f32x4 __attribute__((ext_vector_type(4)));
typedef float f32x2 __attribute__((ext_vector_type(2)));
typedef unsigned u32x4 __attribute__((ext_vector_type(4)));
typedef unsigned u32x2 __attribute__((ext_vector_type(2)));

constexpr int D = 1024, NB = 2, S = 8192, CTX = 256, LT = CTX + S, M = NB * LT;
constexpr int GW = 64;
constexpr int INW = 2208, INP = 2304;
constexpr int OFF_QA = 0, OFF_KA = 256, OFF_VA = 512, OFF_U = 768, OFF_G = 1280, OFF_CQ = 1792, OFF_CKV = 2048, OFF_KR = 2176;
constexpr int LRU_W = 512;
constexpr int CH = 32, NCH = LT / CH, NCH_CTX = CTX / CH;
constexpr int NE = 16, DE = 512;
constexpr int NTHREADS = 512, NWAVES = 8;
constexpr int LDS_BYTES = 147456;

constexpr size_t MiB = 1u << 20;
constexpr size_t WS_CTL = 0, CTL_BYTES = 1 * MiB;
constexpr size_t WS_MODP = 1 * MiB;
constexpr size_t WS_WIN = 4 * MiB;
constexpr size_t WS_WOUT = 13 * MiB;
constexpr size_t WS_WGU = 17 * MiB;
constexpr size_t WS_WD = 81 * MiB;
constexpr size_t WS_XC = 113 * MiB;
constexpr size_t WS_RE = 115 * MiB;
constexpr size_t WS_RW = WS_RE + 256 * 1024;
constexpr size_t WS_PERM = WS_RW + 256 * 1024;
constexpr size_t WS_S2P = 117 * MiB;
constexpr size_t WS_LRUW = 117 * MiB + 512 * 1024;
constexpr size_t WS_WQT = 118 * MiB;
constexpr size_t WS_WKVT = 118 * MiB + 512 * 1024;
constexpr size_t WS_AGG = 301 * MiB;
constexpr size_t WS_CARRY = 310 * MiB;
constexpr size_t WS_H = 125 * MiB;
constexpr size_t WS_P = 158 * MiB;
constexpr size_t WS_Q = 233 * MiB;
constexpr size_t WS_K = 246 * MiB;
constexpr size_t WS_V = 259 * MiB;
constexpr size_t WS_Y = 268 * MiB;
constexpr size_t WS_END = 315 * MiB;
constexpr int CW_CNT = 64;
constexpr int CW_BAR = 4096;

__device__ __forceinline__ float bf2f(bf16_t v) { return __uint_as_float(((unsigned)v) << 16); }
typedef __bf16 bf16x2_hw __attribute__((ext_vector_type(2)));
typedef float f32x2_hw __attribute__((ext_vector_type(2)));
__device__ __forceinline__ unsigned pk2(float lo, float hi) { const f32x2_hw v = {lo, hi}; return __builtin_bit_cast(unsigned, __builtin_convertvector(v, bf16x2_hw)); }
__device__ __forceinline__ unsigned f2bf(float f) { return pk2(f, 0.f) & 0xffffu; }
__device__ __forceinline__ float lo_bf(unsigned w) { return __uint_as_float(w << 16); }
__device__ __forceinline__ float hi_bf(unsigned w) { return __uint_as_float(w & 0xffff0000u); }
template <int CTRL> __device__ __forceinline__ float dpp_f(float v) { return __builtin_bit_cast(float, __builtin_amdgcn_update_dpp(0, __builtin_bit_cast(int, v), CTRL, 0xF, 0xF, true)); }
__device__ __forceinline__ float row16_sum(float v) {
    v += dpp_f<0xB1>(v);
    v += dpp_f<0x4E>(v);
    v += dpp_f<0x141>(v);
    v += dpp_f<0x140>(v);
    return v;
}
__device__ __forceinline__ float wave_sum(float v) {
    v = row16_sum(v);
    { auto r = __builtin_amdgcn_permlane16_swap(__float_as_uint(v), __float_as_uint(v), false, false); v = __uint_as_float(r[0]) + __uint_as_float(r[1]); }
    { auto r = __builtin_amdgcn_permlane32_swap(__float_as_uint(v), __float_as_uint(v), false, false); v = __uint_as_float(r[0]) + __uint_as_float(r[1]); }
    return v;
}
__device__ __forceinline__ float sigmoidf_(float x) { return __builtin_amdgcn_rcpf(1.f + __builtin_amdgcn_exp2f(-1.4426950408889634f * x)); }
__device__ __forceinline__ float siluf_(float x) { return x * sigmoidf_(x); }
__device__ __forceinline__ float gelu_tanh(float x) { return x * sigmoidf_(1.5957691216057308f * (x + 0.044715f * x * x * x)); }

struct Params {
    const float *x, *c, *ctx, *c_ctx, *w_ada, *b_ada, *g_norm, *w_in, *w_out, *na_rpb, *conv_w, *conv_b,
        *lru_w_a, *lru_b_a, *lru_w_i, *lru_b_i, *lru_lam, *mla_g_q, *mla_w_q, *mla_g_kv, *mla_w_kv,
        *router_w, *router_b, *exp_w_gate, *exp_w_up, *exp_w_down;
    float* out; unsigned char* ws; int ph_lo, ph_hi;
};

struct Ctx {
    int tid, lane, wave, bid, nb, gw, ngw;
    LAS unsigned char* lds;
};

__device__ __forceinline__ const float* xin_row(const Params& p, int m) {
    const int b = m / LT, t = m - b * LT;
    return t < CTX ? p.ctx + (size_t)(b * CTX + t) * D : p.x + (size_t)(b * S + t - CTX) * D;
}
__device__ __forceinline__ float* res_row(const Params& p, int m) {
    const int b = m / LT, t = m - b * LT;
    return t < CTX ? (float*)(p.ws + WS_XC) + (size_t)(b * CTX + t) * D : p.out + (size_t)(b * S + t - CTX) * D;
}
__device__ __forceinline__ void load_mods(const Params& p, const Ctx& c, int l, int j, LAS float* dst) {
    const float* mp = (const float*)(p.ws + WS_MODP);
    for (int idx = c.tid; idx < 3 * D; idx += NTHREADS) {
        const int r = idx >> 10, n = idx & 1023;
        dst[idx] = mp[(size_t)(l * 3 + r) * 6144 + j * D + n];
    }
}

#define XB_TMO      128
#define XB_XCNT(j)  (256  + 64 * (j))
#define XB_XSUB(j)  (1280 + 64 * (j))
#define XB_XGEN(j)  (2304 + 64 * (j))
#define XB_TOP      3328
#define XB_TOPGEN   3392
#define XCD_BAR_WORDS 3456
#define XB_SPIN_CAP (1u << 18)
__device__ __forceinline__ unsigned xb_ld(unsigned* p)              { return __hip_atomic_load(p, __ATOMIC_RELAXED, __HIP_MEMORY_SCOPE_AGENT); }
__device__ __forceinline__ unsigned xb_add(unsigned* p, unsigned v) { return __hip_atomic_fetch_add(p, v, __ATOMIC_RELAXED, __HIP_MEMORY_SCOPE_AGENT); }
__device__ __forceinline__ unsigned xb_xcc_id() { return (unsigned)__builtin_amdgcn_s_getreg((3 << 11) | 20) & 0xFu; }
#define XB_SPIN(cond, bar) do { unsigned _sp = 0; while (cond) { __builtin_amdgcn_s_sleep(1); \
    if ((++_sp & 255u) == 0u) { if (xb_ld(&(bar)[XB_TMO])) break; if (_sp > XB_SPIN_CAP) { atomicAdd(&(bar)[XB_TMO], 1u); break; } } } } while (0)
struct XcdBarrier { unsigned* bar; unsigned x; volatile LAS unsigned* st; };
__device__ __forceinline__ XcdBarrier xcd_barrier_post(unsigned* bar, volatile LAS unsigned* st, int tid) {
    XcdBarrier b; b.bar = bar; b.x = xb_xcc_id(); b.st = st;
    if (tid == 0) (void)xb_add(&bar[XB_XCNT(b.x)], 1u);
    return b;
}
__device__ __forceinline__ void xcd_barrier_complete(unsigned* bar, unsigned x, unsigned& nloc, unsigned& nx) {
    const unsigned G = gridDim.x * gridDim.y * gridDim.z;
    unsigned sum, cnt, mine, sp = 0u;
    for (;;) {
        sum = 0u; cnt = 0u; mine = 0u;
#pragma unroll
        for (unsigned j = 0; j < 16; ++j) { const unsigned c = xb_ld(&bar[XB_XCNT(j)]); sum += c; cnt += (c > 0u) ? 1u : 0u; mine = (j == x) ? c : mine; }
        if (sum == G) break;
        __builtin_amdgcn_s_sleep(1);
        if ((++sp & 255u) == 0u) { if (xb_ld(&bar[XB_TMO])) break; if (sp > XB_SPIN_CAP) { atomicAdd(&bar[XB_TMO], 1u); break; } }
    }
    nloc = mine > 0u ? mine : 1u; nx = cnt > 0u ? cnt : 1u;
}
__device__ __forceinline__ void xcd_barrier(const XcdBarrier& b, int tid) {
    asm volatile("s_waitcnt vmcnt(0)" ::: "memory");
    __syncthreads();
    if (tid == 0) {
        unsigned* bar = b.bar;
        __builtin_amdgcn_s_waitcnt(0);
        unsigned nloc = b.st[0], nx = b.st[1];
        if (nloc == 0u) { xcd_barrier_complete(bar, b.x, nloc, nx); b.st[0] = nloc; b.st[1] = nx; }
        const unsigned old = xb_add(&bar[XB_XSUB(b.x)], 1u);
        const unsigned gen = old / nloc;
        if (old + 1u == (gen + 1u) * nloc) {
            __builtin_amdgcn_fence(__ATOMIC_RELEASE, "agent");
            asm volatile("s_waitcnt vmcnt(0)" ::: "memory");
            const unsigned og = xb_add(&bar[XB_TOP], 1u);
            const unsigned tg = og / nx;
            if (og + 1u == (tg + 1u) * nx) xb_add(&bar[XB_TOPGEN], 1u);
            else XB_SPIN(xb_ld(&bar[XB_TOPGEN]) == tg, bar);
            __builtin_amdgcn_fence(__ATOMIC_ACQUIRE, "agent");
            xb_add(&bar[XB_XGEN(b.x)], 1u);
            asm volatile("s_waitcnt vmcnt(0)" ::: "memory");
        } else {
            XB_SPIN(xb_ld(&bar[XB_XGEN(b.x)]) == gen, bar);
            __builtin_amdgcn_fence(__ATOMIC_ACQUIRE, "agent");
            asm volatile("s_waitcnt vmcnt(0)" ::: "memory");
        }
    }
    __syncthreads();
}


namespace pg8 {
#define PG8_LAS __attribute__((address_space(3)))
typedef unsigned short bf16_t;
typedef short bf16x8 __attribute__((ext_vector_type(8)));
typedef float f32x4 __attribute__((ext_vector_type(4)));
typedef unsigned u32x4 __attribute__((ext_vector_type(4)));
constexpr int BM = 256, BK = 64, HALF = 128, HTB = HALF * BK * 2  , STAGE_BYTES = 8 * HTB, NXCD = 8, WGM = 8;

__host__ __device__ __forceinline__ int lds_byte(int r, int c) { const int st = (r >> 4) * 2 + (c >> 5), rr = r & 15, cc = c & 31, ob = rr * 64 + cc * 2; return st * 1024 + (ob ^ (((ob >> 9) & 1) << 5)); }
__host__ __device__ __forceinline__ void stage_rc(int b, int& R, int& C) { const int st = b / 1024, sb = b % 1024, swz = sb ^ (((sb >> 9) & 1) << 5); R = (st >> 1) * 16 + swz / 64; C = (st & 1) * 32 + (swz % 64) / 2; }
__host__ __device__ __forceinline__ int perm32(int rho) { const int n = rho >> 4, i = rho & 15; return 8 * (i >> 2) + 4 * n + (i & 3); }

struct Unit { int pm, pn, aux0, aux1; };
struct Gemm { const bf16_t* A; const bf16_t* Bt; int M, N, K; };
__device__ __forceinline__ unsigned cvt_pk_bf16(float lo, float hi) { return ::pk2(lo, hi); }
typedef float f32x2 __attribute__((ext_vector_type(2)));
__device__ __forceinline__ f32x2 gelu_pk(f32x2 v) {
    const f32x2 av = __builtin_elementwise_abs(v), d = av * 0.2316418882f + 1.0f;
    f32x2 t; t.x = __builtin_amdgcn_rcpf(d.x); t.y = __builtin_amdgcn_rcpf(d.y);
    f32x2 q = t * 0.5307027145f + (-0.7265760135f); q = q * t + 0.7107068705f; q = q * t + (-0.142248368f); q = q * t + 0.127414796f; q = q * t;
    const f32x2 s = (v * v) * (-0.72134752044f);
    f32x2 e; e.x = __builtin_amdgcn_exp2f(s.x); e.y = __builtin_amdgcn_exp2f(s.y);
    const f32x2 m = v * (q * e), r = v - m;
    f32x2 o; o.x = v.x < 0.f ? m.x : r.x; o.y = v.y < 0.f ? m.y : r.y; return o;
}

template <int ACT  > struct EpiBf16 {
    static constexpr bool PERM = true, AFTER_DRAIN = false; static_assert(ACT == 0 || ACT == 1, "EpiBf16: ACT is 0 (none) or 1 (gelu_pk)");
    bf16_t* O; int ldc; const float* bias; int split_cols; size_t split_stride; float scale0;
    __device__ __forceinline__ void operator()(const f32x4 (&acc)[2][2][4][2], const Unit& u, int wr, int wc, int fr, int fq) const {
        const int row0 = u.pm * BM + wr * 64 + fr; int colt = u.pn * BM; bf16_t* base = O;
        float sc = 1.f; if (split_cols) { const int t = colt / split_cols; base += (size_t)t * split_stride; colt -= t * split_cols; if (t == 0) sc = scale0; }
        const int col0 = colt + wc * 32 + 8 * fq, bcol0 = u.pn * BM + wc * 32 + 8 * fq;
        f32x4 bv[2][2];
#pragma unroll
        for (int bj = 0; bj < 2; ++bj)
#pragma unroll
            for (int n = 0; n < 2; ++n) bv[bj][n] = bias ? *(const f32x4*)(bias + bcol0 + bj * HALF + 4 * n) : (f32x4){0.f, 0.f, 0.f, 0.f};
#pragma unroll
        for (int ai = 0; ai < 2; ++ai)
#pragma unroll
            for (int m = 0; m < 4; ++m) { bf16_t* rowp = base + (size_t)(row0 + ai * HALF + m * 16) * ldc + col0;
#pragma unroll
                for (int bj = 0; bj < 2; ++bj) { f32x4 v0 = acc[ai][bj][m][0] + bv[bj][0], v1 = acc[ai][bj][m][1] + bv[bj][1];
                    if (ACT == 1) { f32x2 a = gelu_pk((f32x2){v0[0], v0[1]}), b = gelu_pk((f32x2){v0[2], v0[3]}), c = gelu_pk((f32x2){v1[0], v1[1]}), d = gelu_pk((f32x2){v1[2], v1[3]});
                        v0 = (f32x4){a.x, a.y, b.x, b.y}; v1 = (f32x4){c.x, c.y, d.x, d.y}; }
                    v0 = v0 * sc; v1 = v1 * sc; u32x4 w; w.x = cvt_pk_bf16(v0[0], v0[1]); w.y = cvt_pk_bf16(v0[2], v0[3]); w.z = cvt_pk_bf16(v1[0], v1[1]); w.w = cvt_pk_bf16(v1[2], v1[3]);
                    *(u32x4*)(rowp + bj * HALF) = w; } }
    }
};

struct StaticOrder {
    int nM, nN, nwg, G, c;
    __host__ __device__ void init(int M, int N, int G_, int c_) { nM = M / BM; nN = N / BM; nwg = nM * nN; G = G_; c = c_; }
    __host__ __device__ bool next(int i, Unit& u) const {
        const long L = (long)i * G + c; if (L >= nwg) return false;
        int wgid = (int)L; { const int q = nwg / NXCD, r = nwg % NXCD, xcd = wgid % NXCD, off = wgid / NXCD; wgid = (xcd < r ? xcd * (q + 1) : r * (q + 1) + (xcd - r) * q) + off; }
        const int nig = WGM * nN, gid = wgid / nig, fm = gid * WGM, gsz = (nM - fm) < WGM ? (nM - fm) : WGM;
        u.pm = fm + ((wgid % nig) % gsz); u.pn = (wgid % nig) / gsz; return true;
    }
    __device__ __forceinline__ void a_ready(const Unit&) const {}
    __device__ __forceinline__ void done(const Unit&) const {}
};
struct EpiF32 {
    static constexpr bool PERM = false, AFTER_DRAIN = false;
    float* O; int ldc;
    __device__ __forceinline__ void operator()(const f32x4 (&acc)[2][2][4][2], const Unit& u, int wr, int wc, int fr, int fq) const {
        const int row0 = u.pm * BM + wr * 64 + fr, col0 = u.pn * BM + wc * 32 + 4 * fq;
#pragma unroll
        for (int ai = 0; ai < 2; ++ai)
#pragma unroll
            for (int m = 0; m < 4; ++m) { float* rowp = O + (size_t)(row0 + ai * HALF + m * 16) * ldc + col0;
#pragma unroll
                for (int bj = 0; bj < 2; ++bj)
#pragma unroll
                    for (int n = 0; n < 2; ++n) *(f32x4*)(rowp + bj * HALF + n * 16) = acc[ai][bj][m][n]; }
    }
};
struct EpiSwiGLU {
    static constexpr bool PERM = true, AFTER_DRAIN = false;
    bf16_t* O;
    __device__ __forceinline__ void operator()(const f32x4 (&acc)[2][2][4][2], const Unit& u, int wr, int wc, int fr, int fq) const {
        const int row0 = u.pm * BM + wr * 64 + fr, col0 = (u.pn & 3) * 128 + wc * 32 + 8 * fq;
#pragma unroll
        for (int ai = 0; ai < 2; ++ai)
#pragma unroll
            for (int m = 0; m < 4; ++m) {
                float v[8];
#pragma unroll
                for (int n = 0; n < 2; ++n)
#pragma unroll
                    for (int e = 0; e < 4; ++e) { const float g = acc[ai][0][m][n][e]; v[4 * n + e] = g * __builtin_amdgcn_rcpf(1.f + __builtin_amdgcn_exp2f(-1.4426950408889634f * g)) * acc[ai][1][m][n][e]; }
                u32x4 w; w.x = cvt_pk_bf16(v[0], v[1]); w.y = cvt_pk_bf16(v[2], v[3]); w.z = cvt_pk_bf16(v[4], v[5]); w.w = cvt_pk_bf16(v[6], v[7]);
                *(u32x4*)(O + (size_t)(row0 + ai * HALF + m * 16) * 512 + col0) = w; }
    }
};
struct EpiScatter {
    static constexpr bool PERM = true, AFTER_DRAIN = false;
    bf16_t* F; const int* slot2pk; const float* rw; int Mtok;
    __device__ __forceinline__ void operator()(const f32x4 (&acc)[2][2][4][2], const Unit& u, int wr, int wc, int fr, int fq) const {
        const int row0 = u.pm * BM + wr * 64 + fr, col0 = (u.pn & 3) * BM + wc * 32 + 8 * fq;
#pragma unroll
        for (int ai = 0; ai < 2; ++ai)
#pragma unroll
            for (int m = 0; m < 4; ++m) {
                const int pk = slot2pk[row0 + ai * HALF + m * 16];
                if (pk >= 0) { const float wgt = rw[pk]; bf16_t* rowp = F + ((size_t)(pk & 1) * Mtok + (pk >> 1)) * 1024 + col0;
#pragma unroll
                    for (int bj = 0; bj < 2; ++bj) { const f32x4 v0 = acc[ai][bj][m][0] * wgt, v1 = acc[ai][bj][m][1] * wgt;
                        u32x4 w; w.x = cvt_pk_bf16(v0[0], v0[1]); w.y = cvt_pk_bf16(v0[2], v0[3]); w.z = cvt_pk_bf16(v1[0], v1[1]); w.w = cvt_pk_bf16(v1[2], v1[3]);
                        *(u32x4*)(rowp + bj * HALF) = w; } } }
    }
};
struct LatentOrder4 {
    int G, c;
    __device__ bool next(int i, Unit& u) const {
        const int L = i * G + c; if (L >= 256) return false;
        const int x = L & 7, j = L >> 3, pi = x * 8 + (j >> 2);
        u.pm = pi + 1 + (pi >= 32 ? 1 : 0); u.pn = j & 3; u.aux0 = 0; u.aux1 = 0; return true;
    }
    __device__ __forceinline__ void a_ready(const Unit&) const {}
    __device__ __forceinline__ void done(const Unit&) const {}
};
struct G1Order {
    int G, c; bool deferred;
    __device__ bool next(int i, Unit& u) const {
        u.aux0 = 0; u.aux1 = 0;
        if (deferred) { if (i > 0 || c >= 82) return false; if (c < 66) { u.pm = c; u.pn = 8; } else { u.pm = c - 66; u.pn = 0; } return true; }
        const int L = i * G + c; if (L >= 512) return false;
        const int n = (L & ~255) + (L & 7) * 32 + ((L & 255) >> 3);
        if (n < 462) { u.pm = n / 7; u.pn = 1 + n % 7; } else { u.pm = 16 + (n - 462); u.pn = 0; }
        return true;
    }
    __device__ __forceinline__ void a_ready(const Unit&) const {}
    __device__ __forceinline__ void done(const Unit&) const {}
};
struct MoeGatherA {
    static constexpr bool GATHER = true; const PG8_LAS int* map;
    __device__ __forceinline__ int row(int ui, int r) const { const int pk = map[ui * 256 + r]; return pk >= 0 ? (pk >> 1) : 0; }
};
struct MoeOrderL {
    const PG8_LAS int* cnt; int G, c;
    __device__ bool next(int i, Unit& u) const {
        const int L = i * G + c, rt = L >> 2;
        int acc = 0, e = -1;
#pragma unroll
        for (int j = 0; j < 16; ++j) { const int nt = (cnt[j] + 255) >> 8; if (e < 0 && rt < acc + nt) e = j; acc += nt; }
        if (e < 0) return false;
        u.pm = rt; u.pn = e * 4 + (L & 3); u.aux0 = e; u.aux1 = 0; return true;
    }
    __device__ __forceinline__ void a_ready(const Unit&) const {}
    __device__ __forceinline__ void done(const Unit&) const {}
};
struct MoeOrder {
    const unsigned* cnt; int G, c;
    __device__ bool next(int i, Unit& u) const {
        const int L = i * G + c, rt = L >> 2;
        int acc = 0, e = -1;
#pragma unroll
        for (int j = 0; j < 16; ++j) { const int nt = ((int)cnt[j] + 255) >> 8; if (e < 0 && rt < acc + nt) e = j; acc += nt; }
        if (e < 0) return false;
        u.pm = rt; u.pn = e * 4 + (L & 3); u.aux0 = e; u.aux1 = 0; return true;
    }
    __device__ __forceinline__ void a_ready(const Unit&) const {}
    __device__ __forceinline__ void done(const Unit&) const {}
};
struct DenseA { static constexpr bool GATHER = false; __device__ __forceinline__ int row(int, int) const { return 0; } };
template <class Epi, class Sched, bool ALIGN_EPI = false, bool SP2 = false, class AG = DenseA>
__device__ __forceinline__ void gemm_phase(PG8_LAS unsigned char* lds, const Gemm g, const Sched& S, const Epi& E, const int tid, const AG& G = AG()) {
    static_assert(!AG::GATHER || SP2, "the gather policy is wired into the SP2 loop only");
    const int wid = __builtin_amdgcn_readfirstlane(tid >> 6), lane = tid & 63, wr = wid >> 2, wc = wid & 3, fr = lane & 15, fq = lane >> 4;
    const int K = g.K, nt = K / BK;
    unsigned voffA[2], voffB[2]; int RA[2], CA[2];
#pragma unroll
    for (int i = 0; i < 2; ++i) { int R, C; stage_rc(tid * 16 + i * 8192, R, C); const int Rb = Epi::PERM ? ((R & ~31) + perm32(R & 31)) : R;
        voffA[i] = (unsigned)(R * K + C) * 2u; voffB[i] = (unsigned)(Rb * K + C) * 2u; RA[i] = R; CA[i] = C; }
    const size_t kstep = (size_t)(BK * 2);
    const size_t hstep = (size_t)HALF * K * 2;
    const size_t tstep = 2 * hstep;
    const unsigned ldsw = (unsigned)wid * 1024u;
    const int aoff = lds_byte(wr * 64 + fr, fq * 8), boff = lds_byte(wc * 32 + fr, fq * 8);
#define PG8_SA(b, h) (((b) * 2 + (h)) * HTB)
#define PG8_SB(b, h) ((4 + (b) * 2 + (h)) * HTB)
#define PG8_STAGE(bufoff, gbase, voff) do { _Pragma("unroll") for (int _i = 0; _i < 2; ++_i) \
        __builtin_amdgcn_global_load_lds((const unsigned*)((const char*)(gbase) + (voff)[_i]), (PG8_LAS unsigned*)(lds + (bufoff) + ldsw + _i * 8192), 16, 0, 0); } while (0)
#define PG8_LDA(dst, b, h) do { _Pragma("unroll") for (int m = 0; m < 4; ++m) _Pragma("unroll") for (int k = 0; k < 2; ++k) dst[m][k] = *(const PG8_LAS bf16x8*)(lds + PG8_SA(b, h) + aoff + m * 2048 + k * 1024); } while (0)
#define PG8_LDB(dst, b, h) do { _Pragma("unroll") for (int n = 0; n < 2; ++n) _Pragma("unroll") for (int k = 0; k < 2; ++k) dst[n][k] = *(const PG8_LAS bf16x8*)(lds + PG8_SB(b, h) + boff + n * 2048 + k * 1024); } while (0)
#define PG8_MMA(ai, bj, At, Bt) do { __builtin_amdgcn_s_setprio(1); _Pragma("unroll") for (int m = 0; m < 4; ++m) _Pragma("unroll") for (int n = 0; n < 2; ++n) _Pragma("unroll") for (int k = 0; k < 2; ++k) \
        acc[ai][bj][m][n] = __builtin_amdgcn_mfma_f32_16x16x32_bf16(Bt[n][k], At[m][k], acc[ai][bj][m][n], 0, 0, 0); __builtin_amdgcn_s_setprio(0); } while (0)
#define PG8_WAIT_V(n) asm volatile("s_waitcnt vmcnt(" #n ")" ::: "memory")
#define PG8_WAIT_L(n) asm volatile("s_waitcnt lgkmcnt(" #n ")" ::: "memory")
#define PG8_BAR __builtin_amdgcn_s_barrier()
#define PG8_SCHED __builtin_amdgcn_sched_barrier(0)
    Unit cur, nxt; int ui = 0;
    if (!S.next(0, cur)) return;
    f32x4 acc[2][2][4][2];
#pragma unroll
    for (int a = 0; a < 2; ++a)
#pragma unroll
        for (int b = 0; b < 2; ++b)
#pragma unroll
            for (int m = 0; m < 4; ++m)
#pragma unroll
                for (int n = 0; n < 2; ++n) acc[a][b][m][n] = (f32x4){0.f, 0.f, 0.f, 0.f};
    bf16x8 At[4][2], B0[2][2], B1[2][2];
    const char* cA = AG::GATHER ? (const char*)g.A : (const char*)g.A + (size_t)cur.pm * tstep; const char* cB = (const char*)g.Bt + (size_t)cur.pn * tstep;
    unsigned vc[2][2], vn[2][2];
#pragma unroll
    for (int h = 0; h < 2; ++h)
#pragma unroll
        for (int i = 0; i < 2; ++i) { vc[h][i] = AG::GATHER ? (unsigned)(G.row(0, h * HALF + RA[i]) * K + CA[i]) * 2u : voffA[i] + (unsigned)(h * hstep); vn[h][i] = vc[h][i]; }
    S.a_ready(cur);
    if constexpr (SP2) {
        PG8_STAGE(PG8_SB(0, 0), cB, voffB); PG8_STAGE(PG8_SB(0, 1), cB + hstep, voffB); PG8_STAGE(PG8_SA(0, 0), cA, vc[0]); PG8_STAGE(PG8_SA(0, 1), cA, vc[1]);
        if (wr == 1) PG8_BAR;
        PG8_WAIT_V(2); PG8_BAR;
        PG8_STAGE(PG8_SB(1, 0), cB + kstep, voffB); PG8_STAGE(PG8_SA(1, 0), cA + kstep, vc[0]); PG8_STAGE(PG8_SB(1, 1), cB + hstep + kstep, voffB);
        PG8_WAIT_V(6); PG8_BAR;
    } else {
        PG8_STAGE(PG8_SB(0, 0), cB, voffB); PG8_STAGE(PG8_SA(0, 0), cA, voffA); PG8_STAGE(PG8_SB(0, 1), cB + hstep, voffB); PG8_STAGE(PG8_SA(0, 1), cA + hstep, voffA);
        if (wr == 1) PG8_BAR;
        PG8_WAIT_V(4); PG8_BAR;
        PG8_STAGE(PG8_SB(1, 0), cB + kstep, voffB); PG8_STAGE(PG8_SA(1, 0), cA + kstep, voffA); PG8_STAGE(PG8_SB(1, 1), cB + hstep + kstep, voffB);
        PG8_WAIT_V(6); PG8_BAR;
    }
    for (;;) {
        const bool has_next = S.next(ui + 1, nxt);
        const char* nA = AG::GATHER ? cA : (has_next ? (const char*)g.A + (size_t)nxt.pm * tstep : cA); const char* nB = has_next ? (const char*)g.Bt + (size_t)nxt.pn * tstep : cB;
        if (AG::GATHER && has_next) {
#pragma unroll
            for (int h = 0; h < 2; ++h)
#pragma unroll
                for (int i = 0; i < 2; ++i) vn[h][i] = (unsigned)(G.row(ui + 1, h * HALF + RA[i]) * K + CA[i]) * 2u;
        }
        for (int t = 0; t < nt; t += 2) {
            const bool last = (t == nt - 2);
            const char* a1 = cA + (size_t)(t + 1) * kstep;
            const char* a2 = last ? nA : cA + (size_t)(t + 2) * kstep; const char* b2 = last ? nB : cB + (size_t)(t + 2) * kstep;
            const char* a3 = a2 + kstep; const char* b3 = b2 + kstep;
            if (last && has_next) S.a_ready(nxt);
            unsigned v2[2][2];
#pragma unroll
            for (int h = 0; h < 2; ++h)
#pragma unroll
                for (int i = 0; i < 2; ++i) v2[h][i] = last ? vn[h][i] : vc[h][i];
            if constexpr (SP2) {
            PG8_LDB(B0, 0, 0); PG8_LDB(B1, 0, 1); PG8_SCHED; PG8_LDA(At, 0, 0); PG8_STAGE(PG8_SA(1, 1), a1, vc[1]);
            PG8_WAIT_V(8); PG8_WAIT_L(0); PG8_BAR; PG8_MMA(0, 0, At, B0); PG8_MMA(0, 1, At, B1); PG8_BAR; PG8_SCHED;
            PG8_LDA(At, 0, 1); PG8_STAGE(PG8_SB(0, 0), b2, voffB); PG8_STAGE(PG8_SB(0, 1), b2 + hstep, voffB); PG8_STAGE(PG8_SA(0, 0), a2, v2[0]);
            PG8_WAIT_V(8); PG8_WAIT_L(0); PG8_BAR; PG8_MMA(1, 0, At, B0); PG8_MMA(1, 1, At, B1); PG8_BAR; PG8_SCHED;
            PG8_LDB(B0, 1, 0); PG8_LDB(B1, 1, 1); PG8_SCHED; PG8_LDA(At, 1, 0); PG8_STAGE(PG8_SA(0, 1), a2, v2[1]);
            PG8_WAIT_V(8); PG8_WAIT_L(0); PG8_BAR; PG8_MMA(0, 0, At, B0); PG8_MMA(0, 1, At, B1); PG8_BAR; PG8_SCHED;
            PG8_LDA(At, 1, 1); PG8_STAGE(PG8_SB(1, 0), b3, voffB); PG8_STAGE(PG8_SB(1, 1), b3 + hstep, voffB); PG8_STAGE(PG8_SA(1, 0), a3, v2[0]);
            PG8_WAIT_V(8); PG8_WAIT_L(0); PG8_BAR; PG8_MMA(1, 0, At, B0); PG8_MMA(1, 1, At, B1); PG8_BAR; PG8_SCHED;
            } else {
            PG8_LDB(B0, 0, 0); PG8_SCHED; PG8_LDA(At, 0, 0); PG8_STAGE(PG8_SA(1, 1), a1 + hstep, voffA);
            PG8_WAIT_L(8); PG8_BAR; PG8_WAIT_L(0); PG8_MMA(0, 0, At, B0); PG8_BAR; PG8_SCHED;
            PG8_LDB(B1, 0, 1); PG8_STAGE(PG8_SB(0, 0), b2, voffB);
            PG8_BAR; PG8_WAIT_L(0); PG8_MMA(0, 1, At, B1); PG8_BAR;
            PG8_LDA(At, 0, 1); PG8_STAGE(PG8_SA(0, 0), a2, voffA);
            PG8_BAR; PG8_WAIT_L(0); PG8_MMA(1, 0, At, B0); PG8_BAR; PG8_SCHED;
            PG8_STAGE(PG8_SB(0, 1), b2 + hstep, voffB);
            PG8_WAIT_V(6); PG8_BAR; PG8_MMA(1, 1, At, B1); PG8_BAR;
            PG8_LDB(B0, 1, 0); PG8_SCHED; PG8_LDA(At, 1, 0); PG8_STAGE(PG8_SA(0, 1), a2 + hstep, voffA);
            PG8_WAIT_L(8); PG8_BAR; PG8_WAIT_L(0); PG8_MMA(0, 0, At, B0); PG8_BAR; PG8_SCHED;
            PG8_LDB(B1, 1, 1); PG8_STAGE(PG8_SB(1, 0), b3, voffB);
            PG8_BAR; PG8_WAIT_L(0); PG8_MMA(0, 1, At, B1); PG8_BAR;
            PG8_LDA(At, 1, 1); PG8_STAGE(PG8_SA(1, 0), a3, voffA);
            PG8_BAR; PG8_WAIT_L(0); PG8_MMA(1, 0, At, B0); PG8_BAR; PG8_SCHED;
            PG8_STAGE(PG8_SB(1, 1), b3 + hstep, voffB);
            PG8_WAIT_V(6); PG8_BAR; PG8_MMA(1, 1, At, B1); PG8_BAR;
            }
        }
        if constexpr (ALIGN_EPI) { if (wr == 0) PG8_BAR; }
        if constexpr (!Epi::AFTER_DRAIN) { E(acc, cur, wr, wc, fr, fq); S.done(cur); }
        if (!has_next) break;
#pragma unroll
        for (int a = 0; a < 2; ++a)
#pragma unroll
            for (int b = 0; b < 2; ++b)
#pragma unroll
                for (int m = 0; m < 4; ++m)
#pragma unroll
                    for (int n = 0; n < 2; ++n) acc[a][b][m][n] = (f32x4){0.f, 0.f, 0.f, 0.f};
        cur = nxt; cA = nA; cB = nB; ++ui;
#pragma unroll
        for (int h = 0; h < 2; ++h)
#pragma unroll
            for (int i = 0; i < 2; ++i) vc[h][i] = vn[h][i];
        if constexpr (ALIGN_EPI) { if (wr == 1) PG8_BAR; }
    }
    PG8_WAIT_V(0);
    if constexpr (!ALIGN_EPI) { if (wr == 0) PG8_BAR; }
    PG8_BAR;
    if constexpr (Epi::AFTER_DRAIN) { E.fused(acc, cur, wr, wc, fr, fq, lds, wid, lane); S.done(cur); }
#undef PG8_SA
#undef PG8_SB
#undef PG8_STAGE
#undef PG8_LDA
#undef PG8_LDB
#undef PG8_MMA
#undef PG8_WAIT_V
#undef PG8_WAIT_L
#undef PG8_BAR
#undef PG8_SCHED
}
}

__device__ __forceinline__ void transpose_item(const float* W, int K, int N, bf16_t* WT, int item, LAS float* scr, int lane, int rmode = 0) {
    const int nblk = N / 32, kb = item / nblk, nbk = item % nblk, k0 = 64 * kb, n0 = 32 * nbk;
#pragma unroll 8
    for (int i = 0; i < 32; ++i) { const int kk = 2 * i + (lane >> 5); scr[kk * 33 + (lane & 31)] = W[(size_t)(k0 + kk) * N + n0 + (lane & 31)]; }
    asm volatile("s_waitcnt lgkmcnt(0)" ::: "memory");
    const int cc = lane & 7;
#pragma unroll
    for (int j = 0; j < 4; ++j) { const int n = (lane >> 3) + 8 * j; const LAS float* s = scr + (8 * cc) * 33 + n;
        u32x4 o; o.x = pk2(s[0 * 33], s[1 * 33]); o.y = pk2(s[2 * 33], s[3 * 33]); o.z = pk2(s[4 * 33], s[5 * 33]); o.w = pk2(s[6 * 33], s[7 * 33]);
        const int nn = n0 + n, row = rmode == 0 ? nn : ((nn >> 7) * 256 + (rmode - 1) * 128 + (nn & 127));
        *(u32x4*)(WT + (size_t)row * K + k0 + 8 * cc) = o; }
    asm volatile("s_waitcnt lgkmcnt(0)" ::: "memory");
}
constexpr int CV_IN = 16 * 69, CV_OUT = 16 * 32, CV_E = 16 * 256, CV_Q = 4 * 12, CV_KV = 2 * 16;
constexpr int CV_S = CV_IN + CV_OUT + CV_Q + CV_KV;
constexpr int CV_ALL = CV_S + 3 * CV_E;
__device__ __forceinline__ void convert_weights(const Params& p, const Ctx& c, int l, int lo, int hi, int widx, int nw) {
    LAS float* scr = (LAS float*)(c.lds + c.wave * 16384);
    for (int it = lo + widx; it < hi; it += nw) {
        int r = it;
        if (r < CV_IN) { transpose_item(p.w_in + (size_t)l * D * INW, D, INW, (bf16_t*)(p.ws + WS_WIN) + (size_t)l * INP * D, r, scr, c.lane); continue; } r -= CV_IN;
        if (r < CV_OUT) { transpose_item(p.w_out + (size_t)l * D * D, D, D, (bf16_t*)(p.ws + WS_WOUT) + (size_t)l * D * D, r, scr, c.lane); continue; } r -= CV_OUT;
        if (r < CV_Q) { transpose_item(p.mla_w_q + (size_t)l * 256 * 384, 256, 384, (bf16_t*)(p.ws + WS_WQT) + (size_t)l * 384 * 256, r, scr, c.lane); continue; } r -= CV_Q;
        if (r < CV_KV) { transpose_item(p.mla_w_kv + (size_t)l * 128 * 512, 128, 512, (bf16_t*)(p.ws + WS_WKVT) + (size_t)l * 512 * 128, r, scr, c.lane); continue; } r -= CV_KV;
        if (r < CV_E) { const int e = r / 256; transpose_item(p.exp_w_gate + (size_t)(l * NE + e) * D * DE, D, DE, (bf16_t*)(p.ws + WS_WGU) + (size_t)(l * NE + e) * 1024 * 1024, r % 256, scr, c.lane, 1); continue; } r -= CV_E;
        if (r < CV_E) { const int e = r / 256; transpose_item(p.exp_w_up + (size_t)(l * NE + e) * D * DE, D, DE, (bf16_t*)(p.ws + WS_WGU) + (size_t)(l * NE + e) * 1024 * 1024, r % 256, scr, c.lane, 2); continue; } r -= CV_E;
        { const int e = r / 256; transpose_item(p.exp_w_down + (size_t)(l * NE + e) * DE * D, DE, D, (bf16_t*)(p.ws + WS_WD) + (size_t)(l * NE + e) * 1024 * 512, r % 256, scr, c.lane); }
    }
}
__device__ __forceinline__ void phase_pro(const Params& p, const Ctx& c) {
    convert_weights(p, c, 0, 0, CV_S, c.gw, c.ngw);
    for (int i = c.bid * NTHREADS + c.tid; i < 2 * 2 * 2 * 8 * 64 * 64; i += c.nb * NTHREADS) {
        const int k = i & 63, j = (i >> 6) & 63, n = (i >> 12) & 7, g = (i >> 15) & 1, ld = i >> 16;
        const float* src = g ? p.lru_w_i : p.lru_w_a;
        ((bf16_t*)(p.ws + WS_LRUW))[i] = (bf16_t)f2bf(src[((size_t)(ld * 8 + n) * 64 + k) * 64 + j]);
    }
    for (int i = c.bid * NTHREADS + c.tid; i < 2 * 96 * D / 8; i += c.nb * NTHREADS) {
        const int l = i / (96 * D / 8), r = i % (96 * D / 8);
        *(u32x4*)((bf16_t*)(p.ws + WS_WIN) + (size_t)l * INP * D + (size_t)INW * D + (size_t)r * 8) = (u32x4){0u, 0u, 0u, 0u};
    }
    __syncthreads();
    LAS float* sv = (LAS float*)c.lds;
    LAS float* red = sv + 3 * D;
    for (int i = c.tid; i < 3 * D; i += NTHREADS) { const int r = i >> 10, k = i & 1023; sv[i] = siluf_(r < 2 ? p.c[r * D + k] : p.c_ctx[k]); }
    __syncthreads();
    float* mo = (float*)(p.ws + WS_MODP);
    for (int it = c.bid; it < 2 * 96; it += c.nb) {
        const int l = it / 96, n = (it % 96) * 64 + (c.tid & 63), kg = c.tid >> 6;
        const float* w = p.w_ada + ((size_t)l * D + kg * 128) * 6144 + n;
        float a0 = 0.f, a1 = 0.f, a2 = 0.f;
#pragma unroll 8
        for (int kk = 0; kk < 128; ++kk) { const float wv = w[(size_t)kk * 6144]; const int k = kg * 128 + kk; a0 += sv[k] * wv; a1 += sv[D + k] * wv; a2 += sv[2 * D + k] * wv; }
        red[(kg * 3 + 0) * 64 + (c.tid & 63)] = a0; red[(kg * 3 + 1) * 64 + (c.tid & 63)] = a1; red[(kg * 3 + 2) * 64 + (c.tid & 63)] = a2;
        __syncthreads();
        if (c.tid < 192) { const int r = c.tid >> 6, cc = c.tid & 63; float v = p.b_ada[l * 6144 + (it % 96) * 64 + cc];
#pragma unroll
            for (int g = 0; g < 8; ++g) v += red[(g * 3 + r) * 64 + cc];
            mo[(size_t)(l * 3 + r) * 6144 + (it % 96) * 64 + cc] = v; }
        __syncthreads();
    }
}

__device__ __forceinline__ void phase_n1(const Params& p, const Ctx& c, int l) {
    LAS float* sh = (LAS float*)c.lds;
    LAS float* sc = sh + 3 * D;
    load_mods(p, c, l, 0, sh); load_mods(p, c, l, 1, sc);
    __syncthreads();
    const float* g = p.g_norm + (size_t)(l * 4 + 0) * D;
    bf16_t* H = (bf16_t*)(p.ws + WS_H);
#define N1_LOAD(mm) do { const float* xr_ = (l == 0) ? xin_row(p, mm) : res_row(p, mm); _Pragma("unroll") for (int j = 0; j < 4; ++j) vn[j] = *(const f32x4*)(xr_ + 4 * (c.lane + 64 * j)); } while (0)
    f32x4 vn[4];
    if (c.gw < M) N1_LOAD(c.gw);
#pragma unroll 1
    for (int m = c.gw; m < M; m += c.ngw) {
        const int b = m / LT, t = m - b * LT, r = t < CTX ? 2 : b;
        f32x4 v[4]; float ss = 0.f;
#pragma unroll
        for (int j = 0; j < 4; ++j) { v[j] = vn[j]; ss += v[j].x * v[j].x + v[j].y * v[j].y + v[j].z * v[j].z + v[j].w * v[j].w; }
        if (m + c.ngw < M) N1_LOAD(m + c.ngw);
        const float rstd = rsqrtf(wave_sum(ss) * (1.f / D) + 1e-6f);
#pragma unroll
        for (int j = 0; j < 4; ++j) {
            const int n = 4 * (c.lane + 64 * j);
            const f32x4 gg = *(const f32x4*)(g + n);
            float o[4];
#pragma unroll
            for (int e = 0; e < 4; ++e) o[e] = v[j][e] * rstd * gg[e] * (1.f + sc[r * D + n + e]) + sh[r * D + n + e];
            u32x2 w; w.x = pk2(o[0], o[1]); w.y = pk2(o[2], o[3]);
            *(u32x2*)(H + (size_t)m * D + n) = w;
        }
    }
}

template <int NJ, class Op>
__device__ __forceinline__ void wave_gemm_tile(const Op& op, int r0, int c0, int K, int lane) {
    const int fr = lane & 15, fq = lane >> 4;
    const bf16_t* ap[4]; const bf16_t* bp[NJ];
#pragma unroll
    for (int i = 0; i < 4; ++i) ap[i] = op.arow(r0 + 16 * i + fr) + 8 * fq;
#pragma unroll
    for (int j = 0; j < NJ; ++j) bp[j] = op.brow(c0 + 16 * j + fr) + 8 * fq;
    f32x4 acc[4][NJ];
#pragma unroll
    for (int i = 0; i < 4; ++i)
#pragma unroll
        for (int j = 0; j < NJ; ++j) acc[i][j] = (f32x4){0.f, 0.f, 0.f, 0.f};
    for (int k0 = 0; k0 < K; k0 += 32) {
        bf16x8 a[4], b[NJ];
#pragma unroll
        for (int i = 0; i < 4; ++i) a[i] = *(const bf16x8*)(ap[i] + k0);
#pragma unroll
        for (int j = 0; j < NJ; ++j) b[j] = *(const bf16x8*)(bp[j] + k0);
#pragma unroll
        for (int i = 0; i < 4; ++i)
#pragma unroll
            for (int j = 0; j < NJ; ++j) acc[i][j] = __builtin_amdgcn_mfma_f32_16x16x32_bf16(a[i], b[j], acc[i][j], 0, 0, 0);
    }
#pragma unroll
    for (int i = 0; i < 4; ++i)
#pragma unroll
        for (int j = 0; j < NJ; ++j)
#pragma unroll
            for (int e = 0; e < 4; ++e) op.store(r0 + 16 * i + 4 * fq + e, c0 + 16 * j + fr, acc[i][j][e]);
}

__device__ __forceinline__ void phase_g1(const Params& p, const Ctx& c, int l, bool deferred) {
    pg8::Gemm g{(const bf16_t*)(p.ws + WS_H), (const bf16_t*)(p.ws + WS_WIN) + (size_t)l * INP * D, M, INP, D};
    pg8::EpiBf16<0> E{(bf16_t*)(p.ws + WS_P), INP, nullptr, 0, 0, 1.f};
    if (c.nb == 256) { pg8::G1Order S{c.nb, c.bid, deferred}; pg8::gemm_phase<pg8::EpiBf16<0>, pg8::G1Order, true, true>(c.lds, g, S, E, c.tid); }
    else if (!deferred) { pg8::StaticOrder S; S.init(M, INP, c.nb, c.bid); pg8::gemm_phase<pg8::EpiBf16<0>, pg8::StaticOrder, true, true>(c.lds, g, S, E, c.tid); }
}
__device__ __forceinline__ void phase_o1(const Params& p, const Ctx& c, int l, bool last) {
    pg8::Gemm g{(const bf16_t*)(p.ws + WS_Y), (const bf16_t*)(p.ws + WS_WOUT) + (size_t)l * D * D, M, D, D};
    pg8::EpiBf16<0> E{(bf16_t*)(p.ws + WS_P), D, nullptr, 0, 0, 1.f};
    if (last) { pg8::LatentOrder4 S{c.nb, c.bid}; pg8::gemm_phase<pg8::EpiBf16<0>, pg8::LatentOrder4, true, true>(c.lds, g, S, E, c.tid); }
    else { pg8::StaticOrder S; S.init(M, D, c.nb, c.bid); pg8::gemm_phase<pg8::EpiBf16<0>, pg8::StaticOrder, true, true>(c.lds, g, S, E, c.tid);
        constexpr int FULL = (M / 256) * (D / 256) - 256;
        if (c.nb == 256 && c.bid >= FULL) { __syncthreads(); convert_weights(p, c, 0, CV_S, CV_ALL, (c.bid - FULL) * NWAVES + c.wave, (256 - FULL) * NWAVES); }
        else if (c.nb != 256) { __syncthreads(); convert_weights(p, c, 0, CV_S, CV_ALL, c.gw, c.ngw); } }
}

__device__ __forceinline__ void rope_cs(int fi, int pos, float& cs, float& sn) {
    const float ang = (float)pos * __builtin_amdgcn_exp2f(-(float)fi * 1.6609640474436813f); cs = __cosf(ang); sn = __sinf(ang); }
struct C1W { bf16x8 q[3][8]; };
__device__ __forceinline__ void c1_load_q(const Params& p, const Ctx& c, int l, C1W& W) {
    const bf16_t* WqT = (const bf16_t*)(p.ws + WS_WQT) + (size_t)l * 384 * 256; const int fr = c.lane & 15, fq = c.lane >> 4;
#pragma unroll
    for (int i = 0; i < 3; ++i)
#pragma unroll
        for (int ks = 0; ks < 8; ++ks) W.q[i][ks] = *(const bf16x8*)(WqT + (size_t)(48 * c.wave + 16 * i + fr) * 256 + ks * 32 + fq * 8);
}
template <int VAR = 0>
__device__ __forceinline__ void c1_compute(const Params& p, const Ctx& c, int l, const C1W& W, int b, int t0, LAS const unsigned char* aq, LAS const unsigned char* akv) {
    constexpr int PQ = 528, PKV = 272, ROWS = 66, RT = 5;
    bf16_t* Q = (bf16_t*)(p.ws + WS_Q); bf16_t* Kb = (bf16_t*)(p.ws + WS_K); bf16_t* Vb = (bf16_t*)(p.ws + WS_V);
    const bf16_t* WkvT = (const bf16_t*)(p.ws + WS_WKVT) + (size_t)l * 512 * 128;
    const int fr = c.lane & 15, fq = c.lane >> 4, w = c.wave, h = w >> 1;
    bf16x8 bkv[4][4];
    {
        f32x4 acc[3][RT];
#pragma unroll
        for (int i = 0; i < 3; ++i)
#pragma unroll
            for (int rt = 0; rt < RT; ++rt) acc[i][rt] = (f32x4){0.f, 0.f, 0.f, 0.f};
#pragma unroll
        for (int ks = 0; ks < 8; ++ks) {
            bf16x8 a[RT];
#pragma unroll
            for (int rt = 0; rt < RT; ++rt) a[rt] = *(LAS const bf16x8*)(aq + (rt * 16 + fr) * PQ + (ks * 32 + fq * 8) * 2);
#pragma unroll
            for (int i = 0; i < 3; ++i)
#pragma unroll
                for (int rt = 0; rt < RT; ++rt) { if (VAR & 2) { asm volatile("" :: "v"(a[rt]), "v"(W.q[i][ks])); } else acc[i][rt] = __builtin_amdgcn_mfma_f32_16x16x32_bf16(a[rt], W.q[i][ks], acc[i][rt], 0, 0, 0); }
        }
        __builtin_amdgcn_sched_barrier(0);
#pragma unroll
        for (int i = 0; i < 3; ++i) {
            const int d = (w & 1) * 48 + 16 * i + fr;
            const bool rope_tile = (w & 1) && i >= 1;
#pragma unroll
            for (int rt = 0; rt < RT; ++rt)
#pragma unroll
                for (int e = 0; e < 4; ++e) { const int r = 16 * rt + 4 * fq + e, t = t0 + r; float v = acc[i][rt][e];
                    if (rope_tile) { const float pv = dpp_f<0x128>(v);
                        if (t >= CTX) { const int sidx = t - CTX, pos = (i == 2) ? (sidx % GW) : (sidx / GW); float cs, sn; rope_cs(fr & 7, pos, cs, sn); v = fr < 8 ? v * cs - pv * sn : v * cs + pv * sn; } }
                    if (VAR & 1) { asm volatile("" :: "v"(v)); } else if (r < ROWS) Q[((size_t)(b * 4 + h) * LT + t) * 96 + d] = (bf16_t)f2bf(v * 0.14724444602590306f); }
        }
    }
    __builtin_amdgcn_sched_barrier(0);
#pragma unroll
    for (int i = 0; i < 4; ++i)
#pragma unroll
        for (int ks = 0; ks < 4; ++ks) bkv[i][ks] = *(const bf16x8*)(WkvT + (size_t)(64 * w + 16 * i + fr) * 128 + ks * 32 + fq * 8);
    {
        f32x4 acc[4][RT];
#pragma unroll
        for (int i = 0; i < 4; ++i)
#pragma unroll
            for (int rt = 0; rt < RT; ++rt) acc[i][rt] = (f32x4){0.f, 0.f, 0.f, 0.f};
#pragma unroll
        for (int ks = 0; ks < 4; ++ks) {
            bf16x8 a[RT];
#pragma unroll
            for (int rt = 0; rt < RT; ++rt) a[rt] = *(LAS const bf16x8*)(akv + (rt * 16 + fr) * PKV + (ks * 32 + fq * 8) * 2);
#pragma unroll
            for (int i = 0; i < 4; ++i)
#pragma unroll
                for (int rt = 0; rt < RT; ++rt) { if (VAR & 2) { asm volatile("" :: "v"(a[rt]), "v"(bkv[i][ks])); } else acc[i][rt] = __builtin_amdgcn_mfma_f32_16x16x32_bf16(a[rt], bkv[i][ks], acc[i][rt], 0, 0, 0); }
        }
#pragma unroll
        for (int i = 0; i < 4; ++i)
#pragma unroll
            for (int rt = 0; rt < RT; ++rt)
#pragma unroll
                for (int e = 0; e < 4; ++e) { const int r = 16 * rt + 4 * fq + e, t = t0 + r, d = 16 * i + fr; const bf16_t v = (bf16_t)f2bf(acc[i][rt][e]);
                    if (VAR & 1) { asm volatile("" :: "v"(v)); } else if (r < ROWS) { if (w & 1) Vb[((size_t)(b * 4 + h) * LT + t) * 64 + d] = v; else Kb[((size_t)(b * 4 + h) * LT + t) * 96 + d] = v; } }
    }
}
template <int VAR = 0>
__device__ __forceinline__ void phase_c1(const Params& p, const Ctx& c, int l) {
    constexpr int PQ = 528, PKV = 272, ROWS = 66;
    LAS unsigned char* aq = c.lds; LAS unsigned char* akv = c.lds + 80 * PQ;
    const bf16_t* P = (const bf16_t*)(p.ws + WS_P); bf16_t* Kb = (bf16_t*)(p.ws + WS_K);
    for (int g = c.bid; g < M / ROWS; g += c.nb) {
        const int m0 = g * ROWS, b = m0 / LT, t0 = m0 - b * LT;
        C1W W; c1_load_q(p, c, l, W);
        __syncthreads();
#pragma unroll 1
        for (int it = 0; it < 3; ++it) {
            const int r = it * 32 + (c.tid >> 4), q16 = c.tid & 15;
            if (r >= 80 || (VAR & 4)) continue;
            const bool real = r < ROWS; const int rr = real ? r : 0;
            const bf16_t* pr = P + (size_t)(m0 + rr) * INP;
            const u32x4 c0 = *(const u32x4*)(pr + OFF_CQ + q16 * 16), c1 = *(const u32x4*)(pr + OFF_CQ + q16 * 16 + 8), k0 = *(const u32x4*)(pr + OFF_CKV + q16 * 8);
            const unsigned krw = *(const unsigned*)(pr + OFF_KR + q16 * 2);
            float cv[16], kv[8];
            cv[0] = lo_bf(c0.x); cv[1] = hi_bf(c0.x); cv[2] = lo_bf(c0.y); cv[3] = hi_bf(c0.y); cv[4] = lo_bf(c0.z); cv[5] = hi_bf(c0.z); cv[6] = lo_bf(c0.w); cv[7] = hi_bf(c0.w);
            cv[8] = lo_bf(c1.x); cv[9] = hi_bf(c1.x); cv[10] = lo_bf(c1.y); cv[11] = hi_bf(c1.y); cv[12] = lo_bf(c1.z); cv[13] = hi_bf(c1.z); cv[14] = lo_bf(c1.w); cv[15] = hi_bf(c1.w);
            kv[0] = lo_bf(k0.x); kv[1] = hi_bf(k0.x); kv[2] = lo_bf(k0.y); kv[3] = hi_bf(k0.y); kv[4] = lo_bf(k0.z); kv[5] = hi_bf(k0.z); kv[6] = lo_bf(k0.w); kv[7] = hi_bf(k0.w);
            float s1 = 0.f, s2 = 0.f;
#pragma unroll
            for (int i = 0; i < 16; ++i) s1 += cv[i] * cv[i];
#pragma unroll
            for (int i = 0; i < 8; ++i) s2 += kv[i] * kv[i];
            s1 = row16_sum(s1); s2 = row16_sum(s2);
            const float r1 = real ? rsqrtf(s1 * (1.f / 256.f) + 1e-6f) : 0.f, r2 = real ? rsqrtf(s2 * (1.f / 128.f) + 1e-6f) : 0.f;
            const float* gq = p.mla_g_q + l * 256 + q16 * 16; const float* gk = p.mla_g_kv + l * 128 + q16 * 8;
            u32x4 o0, o1, o2;
            o0.x = pk2(cv[0] * r1 * gq[0], cv[1] * r1 * gq[1]); o0.y = pk2(cv[2] * r1 * gq[2], cv[3] * r1 * gq[3]); o0.z = pk2(cv[4] * r1 * gq[4], cv[5] * r1 * gq[5]); o0.w = pk2(cv[6] * r1 * gq[6], cv[7] * r1 * gq[7]);
            o1.x = pk2(cv[8] * r1 * gq[8], cv[9] * r1 * gq[9]); o1.y = pk2(cv[10] * r1 * gq[10], cv[11] * r1 * gq[11]); o1.z = pk2(cv[12] * r1 * gq[12], cv[13] * r1 * gq[13]); o1.w = pk2(cv[14] * r1 * gq[14], cv[15] * r1 * gq[15]);
            o2.x = pk2(kv[0] * r2 * gk[0], kv[1] * r2 * gk[1]); o2.y = pk2(kv[2] * r2 * gk[2], kv[3] * r2 * gk[3]); o2.z = pk2(kv[4] * r2 * gk[4], kv[5] * r2 * gk[5]); o2.w = pk2(kv[6] * r2 * gk[6], kv[7] * r2 * gk[7]);
            *(LAS u32x4*)(aq + r * PQ + q16 * 32) = o0; *(LAS u32x4*)(aq + r * PQ + q16 * 32 + 16) = o1; *(LAS u32x4*)(akv + r * PKV + q16 * 16) = o2;
            float z0 = lo_bf(krw), z1 = hi_bf(krw);
            const float y0 = __shfl_xor(z0, 4), y1 = __shfl_xor(z1, 4);
            const int t = t0 + r;
            if (t >= CTX) { const int sidx = t - CTX, pos = (q16 >> 3) ? (sidx % GW) : (sidx / GW); const int li0 = (2 * q16) & 15; const bool first = li0 < 8;
                float cs, sn; rope_cs(li0 & 7, pos, cs, sn); z0 = first ? z0 * cs - y0 * sn : z0 * cs + y0 * sn;
                rope_cs((li0 + 1) & 7, pos, cs, sn); z1 = first ? z1 * cs - y1 * sn : z1 * cs + y1 * sn; }
            const unsigned kw = pk2(z0, z1);
            if (real) {
#pragma unroll
                for (int h = 0; h < 4; ++h) *(unsigned*)(Kb + ((size_t)(b * 4 + h) * LT + t) * 96 + 64 + 2 * q16) = kw; }
        }
        __syncthreads();
        c1_compute<VAR>(p, c, l, W, b, t0, aq, akv);
    }
}

namespace lru {
typedef float f32x16 __attribute__((ext_vector_type(16)));
constexpr int PITCH = 1040;
__device__ __forceinline__ void load_uc(const Params& p, const Ctx& c, int l, int b, int ch, LAS unsigned char* ucb) {
    const int chn = c.tid, t0 = ch * CH, seq_lo = (ch < NCH_CTX) ? 0 : CTX, seq_hi = (ch < NCH_CTX) ? CTX : LT;
    const bf16_t* Pb = (const bf16_t*)(p.ws + WS_P) + (size_t)(b * LT) * INP + OFF_U + chn;
    const float w0 = p.conv_w[(l * 4 + 0) * LRU_W + chn], w1 = p.conv_w[(l * 4 + 1) * LRU_W + chn], w2 = p.conv_w[(l * 4 + 2) * LRU_W + chn], w3 = p.conv_w[(l * 4 + 3) * LRU_W + chn];
    const float cb = p.conv_b[l * LRU_W + chn];
    float u[CH + 3];
#pragma unroll
    for (int i = 0; i < CH + 3; ++i) { const int t = t0 - 1 + i, tc = min(max(t, seq_lo), seq_hi - 1); u[i] = bf2f(Pb[(size_t)tc * INP]); }
    if (t0 == seq_lo) u[0] = 0.f;
    if (t0 + CH == seq_hi) { u[CH + 1] = 0.f; u[CH + 2] = 0.f; }
#pragma unroll
    for (int i = 0; i < CH; ++i) *(LAS bf16_t*)(ucb + i * PITCH + chn * 2) = (bf16_t)f2bf(u[i] * w0 + u[i + 1] * w1 + u[i + 2] * w2 + u[i + 3] * w3 + cb);
}
struct WF { bf16x8 a[4], i[4]; };
__device__ __forceinline__ WF load_w(const Params& p, int l, int d, int n, int ct, int r32, int hi) {
    const bf16_t* wa = (const bf16_t*)(p.ws + WS_LRUW) + ((size_t)((((l * 2 + d) * 2 + 0) * 8 + n) * 64 + ct * 32 + r32)) * 64 + hi * 8;
    const bf16_t* wi = wa + (size_t)8 * 64 * 64;
    WF w;
#pragma unroll
    for (int ks = 0; ks < 4; ++ks) { w.a[ks] = *(const bf16x8*)(wa + ks * 16); w.i[ks] = *(const bf16x8*)(wi + ks * 16); }
    return w;
}
__device__ __forceinline__ void gates_mm(const WF& w, const bf16x8 (&af)[4], f32x16& za, f32x16& zi) {
    za = f32x16{}; zi = f32x16{};
#pragma unroll
    for (int ks = 0; ks < 4; ++ks) { za = __builtin_amdgcn_mfma_f32_32x32x16_bf16(af[ks], w.a[ks], za, 0, 0, 0); zi = __builtin_amdgcn_mfma_f32_32x32x16_bf16(af[ks], w.i[ks], zi, 0, 0, 0); }
}
__device__ __forceinline__ void gates_ew(const f32x16& za, const f32x16& zi, float bias_a, float bias_i, float lam, const float (&ucv)[16], float (&a)[16], float (&x)[16]) {
    const float ee = __builtin_amdgcn_exp2f(-1.4426950408889634f * lam);
    const float sp = ee * (1.f + ee * (-0.5f + ee * (0.33333333f - 0.25f * ee)));
#pragma unroll
    for (int r = 0; r < 16; ++r) { const float la = -8.f * sigmoidf_(za[r] + bias_a) * sp, y = 2.f * la;
        const float g2 = -y * (1.f + y * (0.5f + y * (0.16666667f + y * (0.041666667f + y * 0.0083333333f))));
        a[r] = __builtin_amdgcn_exp2f(1.4426950408889634f * la); x[r] = __builtin_amdgcn_sqrtf(g2) * sigmoidf_(zi[r] + bias_i) * ucv[r]; }
}
template <bool HS>
__device__ __forceinline__ float scan32(const float (&a)[16], const float (&x)[16], int d, int hi, float h0, float (&hs)[16], float& ap) {
    float As[4], Xs[4];
#pragma unroll
    for (int g = 0; g < 4; ++g) { float A = 1.f, X = 0.f;
#pragma unroll
        for (int e4 = 0; e4 < 4; ++e4) { const int r = 4 * g + (d == 0 ? e4 : 3 - e4); X = a[r] * X + x[r]; A *= a[r]; }
        As[g] = A; Xs[g] = X; }
    float Alo[4], Ahi[4], Xlo[4], Xhi[4];
#pragma unroll
    for (int g = 0; g < 4; ++g) {
        auto ra = __builtin_amdgcn_permlane32_swap(__float_as_uint(As[g]), __float_as_uint(As[g]), false, false);
        auto rx = __builtin_amdgcn_permlane32_swap(__float_as_uint(Xs[g]), __float_as_uint(Xs[g]), false, false);
        Alo[g] = __uint_as_float(ra[0]); Ahi[g] = __uint_as_float(ra[1]); Xlo[g] = __uint_as_float(rx[0]); Xhi[g] = __uint_as_float(rx[1]); }
    float h = h0, hin[4]; ap = 1.f;
#pragma unroll
    for (int s8 = 0; s8 < 8; ++s8) { const int sg = d == 0 ? s8 : 7 - s8, g = sg >> 1; const bool up = (sg & 1) != 0;
        const float A = up ? Ahi[g] : Alo[g], X = up ? Xhi[g] : Xlo[g];
        if (up == (hi != 0)) hin[g] = h;
        h = A * h + X; ap *= A; }
    if (HS) {
#pragma unroll
        for (int g = 0; g < 4; ++g) { float hh = hin[g];
#pragma unroll
            for (int e4 = 0; e4 < 4; ++e4) { const int r = 4 * g + (d == 0 ? e4 : 3 - e4); hh = a[r] * hh + x[r]; hs[r] = hh; } }
    }
    return h;
}
template <int MODE>
__device__ __forceinline__ void chunk(const Params& p, const Ctx& c, int l, int b, int ch, LAS const unsigned char* ucb, WF w) {
    const int n = c.wave, r32 = c.lane & 31, hi = c.lane >> 5;
    bf16x8 af[4];
#pragma unroll
    for (int ks = 0; ks < 4; ++ks) af[ks] = *(LAS const bf16x8*)(ucb + r32 * PITCH + (n * 64 + ks * 16 + hi * 8) * 2);
    constexpr int D0 = MODE == 0 ? 0 : 1, D1 = 1 - D0;
#pragma unroll 1
    for (int ct = 0; ct < 2; ++ct) {
        const int chn = n * 64 + ct * 32 + r32;
        float ucv[16], hr[16], a[16], x[16], ap; f32x16 za, zi;
#pragma unroll
        for (int r = 0; r < 16; ++r) ucv[r] = bf2f(*(LAS const bf16_t*)(ucb + (8 * (r >> 2) + 4 * hi + (r & 3)) * PITCH + chn * 2));
        float c0 = 0.f, c1 = 0.f;
        if (MODE == 1) { const float* cr = (const float*)(p.ws + WS_CARRY);
            c1 = cr[((size_t)((b * 2 + 1) * NCH + ch)) * LRU_W + chn]; c0 = cr[((size_t)((b * 2 + 0) * NCH + ch)) * LRU_W + chn]; }
        { const float bias_a = p.lru_b_a[(l * 2 + D0) * LRU_W + chn], bias_i = p.lru_b_i[(l * 2 + D0) * LRU_W + chn], lam = p.lru_lam[(l * 2 + D0) * LRU_W + chn];
          gates_mm(w, af, za, zi);
          w = load_w(p, l, D1, n, ct, r32, hi);
          __builtin_amdgcn_sched_barrier(0);
          gates_ew(za, zi, bias_a, bias_i, lam, ucv, a, x); }
        if (MODE == 0) { const float he = scan32<false>(a, x, D0, hi, 0.f, hr, ap);
            if (hi == 0) { float* ag = (float*)(p.ws + WS_AGG) + 2 * (((size_t)((b * 2 + D0) * NCH + ch)) * LRU_W + chn); ag[0] = ap; ag[1] = he; } }
        else (void)scan32<true>(a, x, D0, hi, c1, hr, ap);
        __builtin_amdgcn_sched_barrier(0);
        unsigned short gv[16];
        if (MODE == 1) {
            const char* gp = (const char*)((const bf16_t*)(p.ws + WS_P) + ((size_t)b * LT + ch * CH) * INP + OFF_G + n * 64 + ct * 32);
            const unsigned go = (unsigned)((4 * hi * INP + r32) * 2);
#pragma unroll
            for (int r = 0; r < 16; ++r) gv[r] = *(const bf16_t*)(gp + (size_t)(8 * (r >> 2) + (r & 3)) * INP * 2 + go);
        }
        { const float bias_a = p.lru_b_a[(l * 2 + D1) * LRU_W + chn], bias_i = p.lru_b_i[(l * 2 + D1) * LRU_W + chn], lam = p.lru_lam[(l * 2 + D1) * LRU_W + chn];
          gates_mm(w, af, za, zi);
          if (ct == 0) w = load_w(p, l, D0, n, 1, r32, hi);
          __builtin_amdgcn_sched_barrier(0);
          gates_ew(za, zi, bias_a, bias_i, lam, ucv, a, x); }
        if (MODE == 0) { float hs[16]; const float he = scan32<false>(a, x, D1, hi, 0.f, hs, ap);
            if (hi == 0) { float* ag = (float*)(p.ws + WS_AGG) + 2 * (((size_t)((b * 2 + D1) * NCH + ch)) * LRU_W + chn); ag[0] = ap; ag[1] = he; } }
        else {
            float hs[16];
            (void)scan32<true>(a, x, D1, hi, c0, hs, ap);
            char* yp = (char*)((bf16_t*)(p.ws + WS_Y) + ((size_t)b * LT + ch * CH) * D + 256 + n * 64 + ct * 32);
            const unsigned yo = (unsigned)((4 * hi * D + r32) * 2);
#pragma unroll
            for (int r = 0; r < 16; ++r) *(bf16_t*)(yp + (size_t)(8 * (r >> 2) + (r & 3)) * D * 2 + yo) = (bf16_t)f2bf((hr[r] + hs[r]) * gelu_tanh(bf2f(gv[r])));
        }
        __builtin_amdgcn_sched_barrier(0);
    }
}
}
__device__ __forceinline__ void phase_c2(const Params& p, const Ctx& c, int l) {
    constexpr int ND = 82;
    const bool split = c.nb == 256;
    if (split && c.bid < ND) { phase_g1(p, c, l, true); __syncthreads(); }
    else if (!split) { phase_g1(p, c, l, true); __syncthreads(); }
    const int first = split ? (c.bid < ND ? c.bid : ND + (c.bid - ND)) : c.bid;
    const int stride = split ? (c.bid < ND ? NB * NCH : c.nb - ND) : c.nb;
    for (int it = first; it < NB * NCH; it += stride) {
        const int b = it / NCH, ch = it % NCH;
        const lru::WF w0 = lru::load_w(p, l, 0, c.wave, 0, c.lane & 31, c.lane >> 5);
        __syncthreads();
        lru::load_uc(p, c, l, b, ch, c.lds);
        __syncthreads();
        lru::chunk<0>(p, c, l, b, ch, c.lds, w0);
    }
}
__device__ __forceinline__ void phase_c3(const Params& p, const Ctx& c) {
    LAS float* sA = (LAS float*)c.lds; LAS float* sE = sA + 512;
    const float* ag = (const float*)(p.ws + WS_AGG); float* cr = (float*)(p.ws + WS_CARRY);
    for (int u = c.nb - 1 - c.bid; u < 32; u += c.nb) {
        const int b = u >> 4, d = (u >> 3) & 1, chn = (u & 7) * 64 + c.lane, seg = c.wave;
        float aa[33], ee[33];
#pragma unroll
        for (int k = 0; k < 33; ++k) { const int s = seg * 33 + k, ch = d == 0 ? s : (s < NCH_CTX ? NCH_CTX - 1 - s : NCH - 1 - (s - NCH_CTX));
            const size_t idx = ((size_t)((b * 2 + d) * NCH + ch)) * LRU_W + chn; const f32x2 v = *(const f32x2*)(ag + 2 * idx); aa[k] = v.x; ee[k] = v.y; }
        float A = 1.f, E = 0.f;
#pragma unroll
        for (int k = 0; k < 33; ++k) { E = aa[k] * E + ee[k]; A *= aa[k]; }
        __syncthreads();
        sA[seg * 64 + c.lane] = A; sE[seg * 64 + c.lane] = E;
        __syncthreads();
        float st = 0.f;
        for (int s2 = 0; s2 < seg; ++s2) st = sA[s2 * 64 + c.lane] * st + sE[s2 * 64 + c.lane];
#pragma unroll
        for (int k = 0; k < 33; ++k) { const int s = seg * 33 + k, ch = d == 0 ? s : (s < NCH_CTX ? NCH_CTX - 1 - s : NCH - 1 - (s - NCH_CTX));
            const size_t idx = ((size_t)((b * 2 + d) * NCH + ch)) * LRU_W + chn; cr[idx] = st; st = aa[k] * st + ee[k]; }
    }
}
__device__ __forceinline__ void phase_c4(const Params& p, const Ctx& c, int l, bool last) {
    for (int k = 0; k * c.nb < NB * NCH; ++k) {
        const int it = (k < 2 || c.nb != 256) ? k * c.nb + c.bid : k * c.nb + (c.nb - 1 - c.bid);
        if (it >= NB * NCH) continue;
        const int b = it / NCH, ch = it % NCH;
        if (last && ch < NCH_CTX) continue;
        const lru::WF w0 = lru::load_w(p, l, 1, c.wave, 0, c.lane & 31, c.lane >> 5);
        __syncthreads();
        lru::load_uc(p, c, l, b, ch, c.lds);
        __syncthreads();
        lru::chunk<1>(p, c, l, b, ch, c.lds, w0);
    }
}

namespace mla {
typedef float f32x16 __attribute__((ext_vector_type(16)));
typedef short s16x4 __attribute__((ext_vector_type(4)));
constexpr int DQ = 96, DV = 64, KVB = 64;
constexpr float SCALE = 0.10206207261596575f, THR = 8.f;
constexpr int SHM_V = KVB * DV * 2  , SHM_K = KVB * 256  , SHM_ATTN = 3 * SHM_V + 3 * SHM_K + NWAVES * 64 * 4;
#define KSWZ(row, colB) ((row) * 256 + ((colB) ^ (((row) & 15) << 4)))
#define SBAR() __builtin_amdgcn_sched_barrier(0)
__device__ __forceinline__ int crow(int r, int hi) { return (r & 3) + 8 * (r >> 2) + 4 * hi; }
__device__ __forceinline__ unsigned cvtpk(float lo, float hi) { return ::pk2(lo, hi); }
__device__ __forceinline__ void finishSM(f32x16& p0, f32x16& p1, float alpha, float& l_reg, bf16x8& pa0, bf16x8& pa1, bf16x8& pa2, bf16x8& pa3) {
#pragma unroll
    for (int r = 0; r < 16; ++r) p1[r] = __builtin_amdgcn_exp2f(p1[r]);
    float ps, ps0 = 0, ps1 = 0, ps2 = 0, ps3 = 0;
#pragma unroll
    for (int r = 0; r < 16; r += 2) { ps0 += p0[r]; ps1 += p0[r + 1]; ps2 += p1[r]; ps3 += p1[r + 1]; }
    ps = (ps0 + ps1) + (ps2 + ps3);
    { auto rr = __builtin_amdgcn_permlane32_swap(__float_as_uint(ps), __float_as_uint(ps), false, false);
      ps = __uint_as_float(rr[0]) + __uint_as_float(rr[1]); }
    l_reg = l_reg * alpha + ps;
#define PK4(P, BASE, OUT) do { unsigned a0 = cvtpk(P[BASE + 0], P[BASE + 1]), a1 = cvtpk(P[BASE + 2], P[BASE + 3]);   \
    unsigned b0 = cvtpk(P[BASE + 4], P[BASE + 5]), b1 = cvtpk(P[BASE + 6], P[BASE + 7]);                              \
    auto r0 = __builtin_amdgcn_permlane32_swap(a0, b0, false, false); auto r1 = __builtin_amdgcn_permlane32_swap(a1, b1, false, false); \
    u32x4 w = {r0[0], r1[0], r0[1], r1[1]}; OUT = *reinterpret_cast<bf16x8*>(&w); } while (0)
    PK4(p0, 0, pa0); PK4(p0, 8, pa1); PK4(p1, 0, pa2); PK4(p1, 8, pa3);
#undef PK4
}
template <int VAR = 0>
__device__ __forceinline__ void qkt(f32x16& p0, f32x16& p1, LAS const unsigned char* Ks, const bf16x8* qr, int r32, int hi, float m_reg) {
#pragma unroll
    for (int r = 0; r < 16; ++r) { p0[r] = -m_reg; p1[r] = -m_reg; }
#pragma unroll
    for (int d0 = 0; d0 < DQ / 16; ++d0) { const int cb = (d0 * 16 + hi * 8) * 2;
        const bf16x8 b0 = *(LAS const bf16x8*)(Ks + KSWZ(r32, cb));
        const bf16x8 b1 = *(LAS const bf16x8*)(Ks + KSWZ(32 + r32, cb));
        if (VAR & 2) { asm volatile("" :: "v"(b0), "v"(b1)); }
        else { p0 = __builtin_amdgcn_mfma_f32_32x32x16_bf16(b0, qr[d0], p0, 0, 0, 0);
               p1 = __builtin_amdgcn_mfma_f32_32x32x16_bf16(b1, qr[d0], p1, 0, 0, 0); } }
}
__device__ __forceinline__ int v_st(int k, int cc) { const int kk = (k & ~0xC) | ((k & 4) << 1) | ((k & 8) >> 1); return ((kk >> 3) * 2 + (cc >> 5)) * 512 + ((kk & 7) * 32 + (cc & 31)) * 2; }
__device__ __forceinline__ int v_rd_base(int lane) { return ((lane & 3) << 3) | (((lane >> 2) & 3) << 6) | (((lane >> 4) & 1) << 5) | (((lane >> 5) & 1) << 8); }
constexpr int v_rd_off(int d0, int ks, int half) { return d0 * 512 + ks * 2048 + half * 1024; }
template <int OFF> __device__ __forceinline__ s16x4 tr_read(int vb) { return __builtin_amdgcn_ds_read_tr16_b64_v4i16((LAS s16x4*)(uintptr_t)(unsigned)(vb + OFF)); }
template <int D0, int VAR = 0> __device__ __forceinline__ void pv_one(f32x16& od, int vb, bf16x8 pa0, bf16x8 pa1, bf16x8 pa2, bf16x8 pa3) {
    const s16x4 l0 = tr_read<v_rd_off(D0, 0, 0)>(vb), h0 = tr_read<v_rd_off(D0, 0, 1)>(vb), l1 = tr_read<v_rd_off(D0, 1, 0)>(vb), h1 = tr_read<v_rd_off(D0, 1, 1)>(vb);
    const s16x4 l2 = tr_read<v_rd_off(D0, 2, 0)>(vb), h2 = tr_read<v_rd_off(D0, 2, 1)>(vb), l3 = tr_read<v_rd_off(D0, 3, 0)>(vb), h3 = tr_read<v_rd_off(D0, 3, 1)>(vb);
#define PKV(L, H) (bf16x8){L[0], L[1], L[2], L[3], H[0], H[1], H[2], H[3]}
    if (VAR & 2) { asm volatile("" :: "v"(l0), "v"(h0), "v"(l1), "v"(h1), "v"(l2), "v"(h2), "v"(l3), "v"(h3), "v"(pa0), "v"(pa1), "v"(pa2), "v"(pa3)); return; }
    od = __builtin_amdgcn_mfma_f32_32x32x16_bf16(pa0, PKV(l0, h0), od, 0, 0, 0);
    od = __builtin_amdgcn_mfma_f32_32x32x16_bf16(pa1, PKV(l1, h1), od, 0, 0, 0);
    od = __builtin_amdgcn_mfma_f32_32x32x16_bf16(pa2, PKV(l2, h2), od, 0, 0, 0);
    od = __builtin_amdgcn_mfma_f32_32x32x16_bf16(pa3, PKV(l3, h3), od, 0, 0, 0);
#undef PKV
}
template <int VAR = 0> __device__ __forceinline__ void pv_all(f32x16* o, int vb, bf16x8 pa0, bf16x8 pa1, bf16x8 pa2, bf16x8 pa3) { pv_one<0, VAR>(o[0], vb, pa0, pa1, pa2, pa3); pv_one<1, VAR>(o[1], vb, pa0, pa1, pa2, pa3); }

constexpr float THR2 = THR * 1.4426950408889634f;
__device__ __forceinline__ void decideSM(f32x16& p0, f32x16& p1, float& m_reg, float& alpha) {
    float pmax = p0[0], pmx1 = p1[0];
#pragma unroll
    for (int r = 1; r < 16; ++r) { pmax = fmaxf(pmax, p0[r]); pmx1 = fmaxf(pmx1, p1[r]); }
    pmax = fmaxf(pmax, pmx1);
    { auto rr = __builtin_amdgcn_permlane32_swap(__float_as_uint(pmax), __float_as_uint(pmax), false, false);
      pmax = fmaxf(__uint_as_float(rr[0]), __uint_as_float(rr[1])); }
    if (__builtin_expect(__all(pmax <= THR2), 1)) { alpha = 1.f; }
    else { const float d = fmaxf(pmax, 0.f);
        alpha = __builtin_amdgcn_exp2f(-d); m_reg += d;
#pragma unroll
        for (int r = 0; r < 16; ++r) { p0[r] -= d; p1[r] -= d; } }
}
__device__ __forceinline__ void scaleexp(f32x16& p0, f32x16& p1) {
#pragma unroll
    for (int r = 0; r < 16; ++r) p0[r] = __builtin_amdgcn_exp2f(p0[r]);
}
template <int VAR = 0>
__device__ __forceinline__ void pv_sm(f32x16* o, int vb, bf16x8 pa0, bf16x8 pa1, bf16x8 pa2, bf16x8 pa3, f32x16& q0, f32x16& q1) {
    pv_one<0, VAR>(o[0], vb, pa0, pa1, pa2, pa3);
    if (!(VAR & 1)) {
#pragma unroll
        for (int r = 0; r < 16; ++r) q0[r] = __builtin_amdgcn_exp2f(q0[r]); }
    pv_one<1, VAR>(o[1], vb, pa0, pa1, pa2, pa3);
}
__device__ __forceinline__ void fake_finish(const f32x16& p0, const f32x16& p1, bf16x8& pa0, bf16x8& pa1, bf16x8& pa2, bf16x8& pa3) {
    u32x4 w0 = {__float_as_uint(p0[0]), __float_as_uint(p0[1]), __float_as_uint(p0[2]), __float_as_uint(p0[3])}; pa0 = *reinterpret_cast<bf16x8*>(&w0);
    u32x4 w1 = {__float_as_uint(p0[4]), __float_as_uint(p0[5]), __float_as_uint(p0[6]), __float_as_uint(p0[7])}; pa1 = *reinterpret_cast<bf16x8*>(&w1);
    u32x4 w2 = {__float_as_uint(p1[0]), __float_as_uint(p1[1]), __float_as_uint(p1[2]), __float_as_uint(p1[3])}; pa2 = *reinterpret_cast<bf16x8*>(&w2);
    u32x4 w3 = {__float_as_uint(p1[4]), __float_as_uint(p1[5]), __float_as_uint(p1[6]), __float_as_uint(p1[7])}; pa3 = *reinterpret_cast<bf16x8*>(&w3);
}

template <int VAR = 0>
__device__ __forceinline__ void attn_unit(const bf16_t* __restrict__ Qb, const bf16_t* __restrict__ Kh, const bf16_t* __restrict__ Vh, bf16_t* __restrict__ Ob, int seq, LAS unsigned char* lds, int tid) {
    const int wid = tid >> 6, lane = tid & 63, r32 = lane & 31, hi = lane >> 5;
    LAS unsigned char* V_lds = lds; LAS unsigned char* K_lds = lds + 3 * SHM_V;
    LAS float* wsf = (LAS float*)(lds + 3 * SHM_V + 3 * SHM_K) + wid * 64; LAS float* li_l = wsf; LAS float* al_l = wsf + 32;
    float m_reg = 0.f, l_reg = 0; f32x16 o[2] = {}; bf16x8 qr[6];
    const bf16_t* Qw = Qb + (size_t)(wid * 32 + r32) * DQ + hi * 8;
#pragma unroll
    for (int d0 = 0; d0 < 6; ++d0) qr[d0] = *(const bf16x8*)(Qw + d0 * 16);
    const int vrow = tid >> 3, vcol = (tid & 7) * 8, vst = v_st(vrow, vcol);
    const int k0row = tid / 12, k0ch = tid % 12, k1row = (512 + tid) / 12, k1ch = (512 + tid) % 12;
    const int kst0 = KSWZ(k0row, k0ch * 16), kst1 = KSWZ(k1row, k1ch * 16);
    const bool has1 = tid < 256;
    const int vb0 = (int)(uintptr_t)V_lds + v_rd_base(lane);
    unsigned vsrc, ksrc[2];
    { const int ov = wid * 1024 + lane * 16, sbt = ov >> 9, kk = (sbt >> 1) * 8 + ((ov >> 6) & 7), k = (kk & ~0xC) | ((kk & 4) << 1) | ((kk & 8) >> 1), cc = (sbt & 1) * 32 + ((ov >> 4) & 3) * 8;
      vsrc = (unsigned)(k * DV + cc) * 2u;
#pragma unroll
      for (int i = 0; i < 2; ++i) { const int ok = wid * 2048 + i * 1024 + lane * 16, row = ok >> 8, slot = (ok >> 4) & 15, ch = slot ^ (row & 15); ksrc[i] = (unsigned)(row * DQ + (ch < 12 ? ch : 0) * 8) * 2u; } }
#define SLOAD(i, kk) do { } while (0)
#define SWRITE(b, i) do { } while (0)
#define DMA(b, kk) do { if (VAR & 4) break; \
    __builtin_amdgcn_global_load_lds((const unsigned*)((const char*)(Vh + (size_t)(kk) * DV) + vsrc), (LAS unsigned*)(V_lds + (b) * SHM_V + wid * 1024), 16, 0, 0); \
    __builtin_amdgcn_global_load_lds((const unsigned*)((const char*)(Kh + (size_t)(kk) * DQ) + ksrc[0]), (LAS unsigned*)(K_lds + (b) * SHM_K + wid * 2048), 16, 0, 0); \
    __builtin_amdgcn_global_load_lds((const unsigned*)((const char*)(Kh + (size_t)(kk) * DQ) + ksrc[1]), (LAS unsigned*)(K_lds + (b) * SHM_K + wid * 2048 + 1024), 16, 0, 0); } while (0)
#define RESC(a) do { if (__any((a) < 1.f)) { if (hi == 0) al_l[r32] = (a); asm volatile("s_waitcnt lgkmcnt(0)" ::: "memory"); \
    _Pragma("unroll") for (int d = 0; d < 2; ++d) _Pragma("unroll") for (int r = 0; r < 16; ++r) o[d][r] *= al_l[crow(r, hi)]; } } while (0)
    f32x16 pA0, pA1, pB0, pB1; float alA, alB; bf16x8 pa0, pa1, pa2, pa3; const int NT = seq / KVB;
    DMA(0, 0); DMA(1, KVB); __syncthreads();
    qkt<VAR>(pA0, pA1, K_lds, qr, r32, hi, m_reg); if (VAR & 1) { alA = 1.f; } else { decideSM(pA0, pA1, m_reg, alA); scaleexp(pA0, pA1); }
    int bq = 1, bp = 0, bw = 2;
    constexpr bool ordB = false;
#define FIN(P0, P1, AL) do { if (VAR & 1) fake_finish(P0, P1, pa0, pa1, pa2, pa3); else finishSM(P0, P1, AL, l_reg, pa0, pa1, pa2, pa3); } while (0)
#define DEC(P0, P1, MC, AL) do { if (VAR & 1) { AL = 1.f; } else decideSM(P0, P1, m_reg, AL); } while (0)
#define STEP(PX0, PX1, ALX, PY0, PY1, ALY, LOADSTMT, WSLOT) do { \
        if (!ordB) { LOADSTMT; qkt<VAR>(PX0, PX1, K_lds + bq * SHM_K, qr, r32, hi, m_reg); FIN(PY0, PY1, ALY); \
            DEC(PX0, PX1, 0, ALX); \
            pv_sm<VAR>(o, vb0 + bp * SHM_V, pa0, pa1, pa2, pa3, PX0, PX1); } \
        else { SBAR(); FIN(PY0, PY1, ALY); SBAR(); \
            pv_all<VAR>(o, vb0 + bp * SHM_V, pa0, pa1, pa2, pa3); SBAR(); \
            LOADSTMT; qkt<VAR>(PX0, PX1, K_lds + bq * SHM_K, qr, r32, hi, m_reg); SBAR(); \
            DEC(PX0, PX1, 0, ALX); if (!(VAR & 1)) scaleexp(PX0, PX1); SBAR(); } \
        SWRITE(bw, WSLOT); RESC(ALX); if (!(VAR & 8)) __syncthreads(); \
        { const int t3 = bp; bp = bq; bq = bw; bw = t3; } } while (0)
    for (int t = 1; t + 1 < NT; t += 2) {
        STEP(pB0, pB1, alB, pA0, pA1, alA, DMA(bw, (t + 1) * KVB), 0);
        STEP(pA0, pA1, alA, pB0, pB1, alB, DMA(bw, (t + 2) * KVB), 1);
    }
#undef STEP
    qkt<VAR>(pB0, pB1, K_lds + bq * SHM_K, qr, r32, hi, m_reg);
    if (VAR & 1) fake_finish(pA0, pA1, pa0, pa1, pa2, pa3); else finishSM(pA0, pA1, alA, l_reg, pa0, pa1, pa2, pa3);
    if (VAR & 1) { alB = 1.f; } else decideSM(pB0, pB1, m_reg, alB);
    pv_sm<VAR>(o, vb0 + bp * SHM_V, pa0, pa1, pa2, pa3, pB0, pB1);
    RESC(alB);
    if (VAR & 1) fake_finish(pB0, pB1, pa0, pa1, pa2, pa3); else finishSM(pB0, pB1, alB, l_reg, pa0, pa1, pa2, pa3);
    pv_all<VAR>(o, vb0 + bq * SHM_V, pa0, pa1, pa2, pa3);
    if (hi == 0) li_l[r32] = l_reg;
    asm volatile("s_waitcnt lgkmcnt(0)" ::: "memory");
    float rli[16];
#pragma unroll
    for (int r = 0; r < 16; ++r) rli[r] = __builtin_amdgcn_rcpf(li_l[crow(r, hi)]);
    bf16_t* Ow = Ob + (size_t)(wid * 32) * D;
#pragma unroll
    for (int r = 0; r < 16; ++r) { const int orow = crow(r, hi);
#pragma unroll
        for (int d0 = 0; d0 < 2; ++d0) Ow[(size_t)orow * D + d0 * 32 + r32] = (bf16_t)f2bf(o[d0][r] * rli[r]); }
    __syncthreads();
#undef SLOAD
#undef SWRITE
#undef DMA
#undef RESC
#undef FIN
#undef DEC
}
#undef KSWZ
#undef SBAR
}
namespace nab {
using mla::f32x16;
constexpr int SHM_V = 8192, SHM_K = 16384, RING = 3 * (SHM_V + SHM_K);
constexpr int LDS_NEED = RING + NWAVES * 256 + 2048;
constexpr float SCALE = 0.125f, C = SCALE * 1.4426950408889634f;
#define KSWZ(row, colB) ((row) * 256 + ((colB) ^ (((row) & 15) << 4)))
#define SBAR() __builtin_amdgcn_sched_barrier(0)
__device__ __forceinline__ void qkt64(f32x16& p0, f32x16& p1, LAS const unsigned char* Ks, const bf16x8* qr, int r32, int hi, float m_reg) {
#pragma unroll
    for (int r = 0; r < 16; ++r) { p0[r] = -m_reg; p1[r] = -m_reg; }
#pragma unroll
    for (int d0 = 0; d0 < 4; ++d0) { const int cb = (d0 * 16 + hi * 8) * 2;
        const bf16x8 b0 = *(LAS const bf16x8*)(Ks + KSWZ(r32, cb));
        const bf16x8 b1 = *(LAS const bf16x8*)(Ks + KSWZ(32 + r32, cb));
        p0 = __builtin_amdgcn_mfma_f32_32x32x16_bf16(b0, qr[d0], p0, 0, 0, 0);
        p1 = __builtin_amdgcn_mfma_f32_32x32x16_bf16(b1, qr[d0], p1, 0, 0, 0); }
}
__device__ __forceinline__ void unit(const bf16_t* __restrict__ Pb, int h, bool lat, int r0, LAS const float* rp, bf16_t* __restrict__ Yb, LAS unsigned char* lds, int tid) {
    const int wid = __builtin_amdgcn_readfirstlane(tid >> 6), lane = tid & 63, r32 = lane & 31, hi = lane >> 5;
    LAS unsigned char* V_lds = lds; LAS unsigned char* K_lds = lds + 3 * SHM_V;
    LAS float* wsf = (LAS float*)(lds + RING) + wid * 64; LAS float* li_l = wsf; LAS float* al_l = wsf + 32;
    const int r = r0 + (wid >> 1), qc = (wid & 1) * 32 + r32, cs = min(max(qc - 8, 0), 48);
    const int qtok = lat ? CTX + r * GW + qc : wid * 32 + r32;
    const int rs_me = min(max(r - 4, 0), 120), rs_min = min(max(r0 - 4, 0), 120), nrows = lat ? (min(max(r0 + 3 - 4, 0), 120) + 8 - rs_min) : 0;
    const int NT = (4 + nrows + 1) & ~1;
    float m_reg = 0.f, l_reg = 0; f32x16 o[2] = {}; bf16x8 qr[4];
    { const bf16_t* Qw = Pb + (size_t)qtok * INP + OFF_QA + h * 64 + hi * 8;
#pragma unroll
      for (int d0 = 0; d0 < 4; ++d0) { const u32x4 w = *(const u32x4*)(Qw + d0 * 16);
          u32x4 o4; o4.x = pk2(lo_bf(w.x) * C, hi_bf(w.x) * C); o4.y = pk2(lo_bf(w.y) * C, hi_bf(w.y) * C); o4.z = pk2(lo_bf(w.z) * C, hi_bf(w.z) * C); o4.w = pk2(lo_bf(w.w) * C, hi_bf(w.w) * C);
          qr[d0] = *reinterpret_cast<bf16x8*>(&o4); } }
    const int srow = tid >> 3, sch = tid & 7, vst = mla::v_st(srow, sch * 8), kst = KSWZ(srow, sch * 16);
    const unsigned svo = (unsigned)((srow * INP + h * 64 + sch * 8) * 2);
    const int vb0 = (int)(uintptr_t)V_lds + mla::v_rd_base(lane);
    struct { bf16x8 v, k; } sr_[2];
#define TOK0(t) ((t) < 4 ? (t) * 64 : CTX + min(rs_min + (t) - 4, 127) * GW)
#define SLOAD(i, t) do { const char* kb = (const char*)(Pb + (size_t)TOK0(t) * INP); sr_[i].k = *(const bf16x8*)(kb + svo + OFF_KA * 2); sr_[i].v = *(const bf16x8*)(kb + svo + OFF_VA * 2); } while (0)
#define SWRITE(b, i) do { *(LAS bf16x8*)(V_lds + (b) * SHM_V + vst) = sr_[i].v; *(LAS bf16x8*)(K_lds + (b) * SHM_K + kst) = sr_[i].k; } while (0)
#define RESC(a) do { if (__any((a) < 1.f)) { if (hi == 0) al_l[r32] = (a); asm volatile("s_waitcnt lgkmcnt(0)" ::: "memory"); \
    _Pragma("unroll") for (int d = 0; d < 2; ++d) _Pragma("unroll") for (int rr = 0; rr < 16; ++rr) o[d][rr] *= al_l[mla::crow(rr, hi)]; } } while (0)
#define MASK(P0, P1, t) do { if ((t) >= 4) { const int kr = rs_min + (t) - 4; \
        if ((unsigned)(kr - rs_me) < 8u) { int qcl = qc; asm volatile("" : "+v"(qcl)); const int csl = min(max(qcl - 8, 0), 48); \
            LAS const float* rl_ = rp + (kr - r + 7) * 32 + (4 * hi - qcl + 15); const int rel = 4 * hi - csl; \
            _Pragma("unroll") for (int rr = 0; rr < 16; ++rr) { const int k0c = mla::crow(rr, 0); \
                P0[rr] = ((unsigned)(rel + k0c) < 16u) ? P0[rr] + rl_[k0c] : -1e30f; \
                P1[rr] = ((unsigned)(rel + k0c + 32) < 16u) ? P1[rr] + rl_[k0c + 32] : -1e30f; } } \
        else { _Pragma("unroll") for (int rr = 0; rr < 16; ++rr) { P0[rr] = -1e30f; P1[rr] = -1e30f; } } } } while (0)
    f32x16 pA0, pA1, pB0, pB1; float alA, alB; bf16x8 pa0, pa1, pa2, pa3;
    SLOAD(0, 0); SLOAD(1, 1); SWRITE(0, 0); SWRITE(1, 1); __syncthreads();
    SLOAD(0, 2);
    qkt64(pA0, pA1, K_lds, qr, r32, hi, m_reg); mla::decideSM(pA0, pA1, m_reg, alA); mla::scaleexp(pA0, pA1);
    int bq = 1, bp = 0, bw = 2;
#define STEP(PX0, PX1, ALX, PY0, PY1, ALY, t, LOADSTMT, WSLOT) do { \
        qkt64(PX0, PX1, K_lds + bq * SHM_K, qr, r32, hi, m_reg); mla::finishSM(PY0, PY1, ALY, l_reg, pa0, pa1, pa2, pa3); \
        LOADSTMT; MASK(PX0, PX1, t); mla::decideSM(PX0, PX1, m_reg, ALX); \
        mla::pv_sm<0>(o, vb0 + bp * SHM_V, pa0, pa1, pa2, pa3, PX0, PX1); \
        SWRITE(bw, WSLOT); RESC(ALX); __syncthreads(); \
        { const int t3 = bp; bp = bq; bq = bw; bw = t3; } } while (0)
    for (int t = 1; t + 1 < NT; t += 2) {
        STEP(pB0, pB1, alB, pA0, pA1, alA, t, SLOAD(1, t + 2), 0);
        STEP(pA0, pA1, alA, pB0, pB1, alB, t + 1, if (t + 3 < NT) SLOAD(0, t + 3), 1);
    }
#undef STEP
    qkt64(pB0, pB1, K_lds + bq * SHM_K, qr, r32, hi, m_reg);
    mla::finishSM(pA0, pA1, alA, l_reg, pa0, pa1, pa2, pa3);
    MASK(pB0, pB1, NT - 1); mla::decideSM(pB0, pB1, m_reg, alB);
    mla::pv_sm<0>(o, vb0 + bp * SHM_V, pa0, pa1, pa2, pa3, pB0, pB1);
    RESC(alB);
    mla::finishSM(pB0, pB1, alB, l_reg, pa0, pa1, pa2, pa3);
    mla::pv_all<0>(o, vb0 + bq * SHM_V, pa0, pa1, pa2, pa3);
    if (hi == 0) li_l[r32] = l_reg;
    asm volatile("s_waitcnt lgkmcnt(0)" ::: "memory");
    const int qtok0 = lat ? CTX + r * GW + (wid & 1) * 32 : wid * 32;
    bf16_t* Ow = Yb + (size_t)qtok0 * D + h * 64;
#pragma unroll
    for (int rr = 0; rr < 16; ++rr) { const int orow = mla::crow(rr, hi); const float rl = __builtin_amdgcn_rcpf(li_l[orow]);
#pragma unroll
        for (int d0 = 0; d0 < 2; ++d0) Ow[(size_t)orow * D + d0 * 32 + r32] = (bf16_t)f2bf(o[d0][rr] * rl); }
    __syncthreads();
#undef TOK0
#undef SLOAD
#undef SWRITE
#undef RESC
#undef MASK
}
#undef KSWZ
#undef SBAR
}
__device__ __forceinline__ void phase_a1b(const Params& p, const Ctx& c, int l, bool last) {
    const bf16_t* P = (const bf16_t*)(p.ws + WS_P); bf16_t* Y = (bf16_t*)(p.ws + WS_Y);
    LAS float* rp = (LAS float*)(c.lds + nab::RING + NWAVES * 256);
    const int n_units = 256 + (last ? 0 : 8);
    for (int u = c.bid; u < n_units; u += c.nb) {
        const int bh = u & 7, b = bh >> 2, h = bh & 3; const bool lat = u < 256;
        __syncthreads();
        if (lat) { const float* rpb = p.na_rpb + (size_t)((l * 4 + h) * 15) * 31;
            for (int i = c.tid; i < 15 * 32; i += NTHREADS) { const int dr = i >> 5, dc = i & 31; rp[i] = dc < 31 ? rpb[dr * 31 + dc] * 1.4426950408889634f : 0.f; } }
        __syncthreads();
        nab::unit(P + (size_t)(b * LT) * INP, h, lat, lat ? (u >> 3) * 4 : 0, rp, Y + (size_t)(b * LT) * D, c.lds, c.tid);
    }
}

template <int VAR = 0>
__device__ __forceinline__ void phase_a2(const Params& p, const Ctx& c, bool last) {
    const bf16_t* Q = (const bf16_t*)(p.ws + WS_Q); const bf16_t* Kb = (const bf16_t*)(p.ws + WS_K); const bf16_t* Vb = (const bf16_t*)(p.ws + WS_V);
    bf16_t* Y = (bf16_t*)(p.ws + WS_Y);
    const int n_units = 256 + (last ? 0 : 8);
    for (int u = c.bid; u < n_units; u += c.nb) {
        const int bh = u & 7, b = bh >> 2, h = bh & 3;
        const int t0 = u < 256 ? CTX + (u >> 3) * 256 : 0, seq = u < 256 ? LT : CTX;
        const size_t hb = (size_t)(b * 4 + h) * LT;
        mla::attn_unit<VAR>(Q + (hb + t0) * 96, Kb + hb * 96, Vb + hb * 64, Y + (size_t)(b * LT + t0) * D + 768 + h * 64, seq, c.lds, c.tid);
    }
}

__device__ __forceinline__ void phase_o2(const Params& p, const Ctx& c, int l, bool last) {
    LAS float* gt = (LAS float*)c.lds;
    LAS float* sh = gt + 3 * D;
    LAS float* sc = sh + 3 * D;
    LAS int* lcnt = (LAS int*)(sc + 3 * D);
    load_mods(p, c, l, 2, gt); load_mods(p, c, l, 3, sh); load_mods(p, c, l, 4, sc);
    if (c.tid < NE) lcnt[c.tid] = 0;
    LAS float* rwl = (LAS float*)(c.lds + 40960);
    for (int i = c.tid; i < D * 4; i += NTHREADS) { const int n = i >> 2, q4 = i & 3; *(LAS f32x4*)(rwl + ((n & 3) * 256 + (n >> 2)) * 20 + 4 * q4) = *(const f32x4*)(p.router_w + (size_t)n * 16 + 4 * q4); }
    LAS float* g1 = (LAS float*)(c.lds + 122880); LAS float* g2 = g1 + D;
    for (int i = c.tid; i < D; i += NTHREADS) { g1[i] = p.g_norm[(size_t)(l * 4 + 1) * D + i]; g2[i] = p.g_norm[(size_t)(l * 4 + 2) * D + i]; }
    __syncthreads();
    const bf16_t* YO = (const bf16_t*)(p.ws + WS_P); bf16_t* H = (bf16_t*)(p.ws + WS_H);
    int* RE = (int*)(p.ws + WS_RE); float* RW = (float*)(p.ws + WS_RW);
    const int nrow = last ? NB * S : M;
#define O2_ROW(i) (last ? ((i) / S) * LT + CTX + ((i) % S) : (i))
#define O2_LOAD(i) do { const int m_ = O2_ROW(i); const bf16_t* yr_ = YO + (size_t)m_ * D; const float* xr_ = (l == 0) ? xin_row(p, m_) : res_row(p, m_); \
        _Pragma("unroll") for (int j = 0; j < 4; ++j) { ywn[j] = *(const u32x2*)((const char*)yr_ + (unsigned)(8 * (c.lane + 64 * j))); xvn[j] = *(const f32x4*)((const char*)xr_ + (unsigned)(16 * (c.lane + 64 * j))); } } while (0)
    u32x2 ywn[4]; f32x4 xvn[4];
    if (c.gw < nrow) O2_LOAD(c.gw);
#pragma unroll 1
    for (int ri = c.gw; ri < nrow; ri += c.ngw) {
        const int m = O2_ROW(ri);
        const int b = m / LT, t = m - b * LT, r = t < CTX ? 2 : b;
        float* xo = res_row(p, m);
        f32x4 y[4], xv[4]; float ss = 0.f;
#pragma unroll
        for (int j = 0; j < 4; ++j) { y[j] = (f32x4){lo_bf(ywn[j].x), hi_bf(ywn[j].x), lo_bf(ywn[j].y), hi_bf(ywn[j].y)}; xv[j] = xvn[j];
            ss += y[j].x * y[j].x + y[j].y * y[j].y + y[j].z * y[j].z + y[j].w * y[j].w; }
        if (ri + c.ngw < nrow) O2_LOAD(ri + c.ngw);
        const float rstd = rsqrtf(wave_sum(ss) * (1.f / D) + 1e-6f);
        float s2 = 0.f;
#pragma unroll
        for (int j = 0; j < 4; ++j) { const int n = 4 * (c.lane + 64 * j); const f32x4 gg = *(LAS const f32x4*)(g1 + n);
#pragma unroll
            for (int e = 0; e < 4; ++e) { xv[j][e] += gt[r * D + n + e] * (y[j][e] * rstd * gg[e]); s2 += xv[j][e] * xv[j][e]; }
            *(f32x4*)((char*)xo + (unsigned)(n * 4)) = xv[j]; }
        const float rstd2 = rsqrtf(wave_sum(s2) * (1.f / D) + 1e-6f);
        float lg[16];
#pragma unroll
        for (int e = 0; e < 16; ++e) lg[e] = 0.f;
#pragma unroll
        for (int j = 0; j < 4; ++j) { const int n = 4 * (c.lane + 64 * j); const f32x4 gg = *(LAS const f32x4*)(g2 + n);
            float o[4];
#pragma unroll
            for (int e = 0; e < 4; ++e) { o[e] = xv[j][e] * rstd2 * gg[e] * (1.f + sc[r * D + n + e]) + sh[r * D + n + e];
                LAS const f32x4* rw = (LAS const f32x4*)(rwl + (e * 256 + c.lane + 64 * j) * 20);
#pragma unroll
                for (int q4 = 0; q4 < 4; ++q4) { const f32x4 w = rw[q4]; lg[4 * q4] += o[e] * w.x; lg[4 * q4 + 1] += o[e] * w.y; lg[4 * q4 + 2] += o[e] * w.z; lg[4 * q4 + 3] += o[e] * w.w; } }
            u32x2 w; w.x = pk2(o[0], o[1]); w.y = pk2(o[2], o[3]);
            *(u32x2*)(H + (size_t)m * D + n) = w; }
        float aff[16], sel[16];
#pragma unroll
        for (int e = 0; e < 16; ++e) { aff[e] = sigmoidf_(wave_sum(lg[e])); sel[e] = aff[e] + p.router_b[e]; }
        float bv = -INFINITY, ba0 = 0.f, ba1 = 0.f; int bi0 = 0, bi1 = 0;
#pragma unroll
        for (int g = 0; g < 4; ++g) {
            float m1 = sel[4 * g], a1 = aff[4 * g]; int i0 = 0;
#pragma unroll
            for (int i = 1; i < 4; ++i) if (sel[4 * g + i] > m1) { m1 = sel[4 * g + i]; a1 = aff[4 * g + i]; i0 = i; }
            float m2 = -INFINITY, a2 = 0.f; int i1 = 0;
#pragma unroll
            for (int i = 0; i < 4; ++i) if (i != i0 && sel[4 * g + i] > m2) { m2 = sel[4 * g + i]; a2 = aff[4 * g + i]; i1 = i; }
            const float gs = m1 + m2;
            if (gs > bv) { bv = gs; bi0 = 4 * g + i0; bi1 = 4 * g + i1; ba0 = a1; ba1 = a2; }
        }
        if (c.lane == 0) {
            const float inv = 1.f / (ba0 + ba1);
            const int lp0 = __hip_atomic_fetch_add(lcnt + bi0, 1, __ATOMIC_RELAXED, __HIP_MEMORY_SCOPE_WORKGROUP);
            const int lp1 = __hip_atomic_fetch_add(lcnt + bi1, 1, __ATOMIC_RELAXED, __HIP_MEMORY_SCOPE_WORKGROUP);
            RE[2 * m] = bi0 + 16 * lp0; RE[2 * m + 1] = bi1 + 16 * lp1; RW[2 * m] = ba0 * inv; RW[2 * m + 1] = ba1 * inv;
        }
    }
    __syncthreads();
    if (c.tid < NE) ((int*)(p.ws + WS_PERM))[c.bid * NE + c.tid] = lcnt[c.tid];
}

__device__ __forceinline__ void phase_r2(const Params& p, const Ctx& c, int l, bool last) {
    LAS int* cntT = (LAS int*)c.lds;
    LAS int* map = (LAS int*)(c.lds + 131072); LAS int* nE = map + 768; LAS int* ebase = nE + NE;
    const int* BC = (const int*)(p.ws + WS_PERM); const int* RE = (const int*)(p.ws + WS_RE);
    for (int i = c.tid; i < c.nb * NE; i += NTHREADS) cntT[i] = BC[i];
    for (int i = c.tid; i < 768; i += NTHREADS) map[i] = -1;
    __syncthreads();
    if (c.tid < NE) { int acc = 0; for (int b2 = 0; b2 < c.nb; ++b2) { const int v = cntT[b2 * NE + c.tid]; cntT[b2 * NE + c.tid] = acc; acc += v; } nE[c.tid] = acc; }
    __syncthreads();
    if (c.tid < NE) { int acc = 0; for (int e = 0; e < c.tid; ++e) acc += (nE[e] + 255) >> 8; ebase[c.tid] = acc * 256;
        if (c.bid == 0) ((unsigned*)(p.ws + WS_CTL))[CW_CNT + l * 64 + c.tid] = (unsigned)nE[c.tid]; }
    __syncthreads();
    const int rt0 = c.bid >> 2, rt1 = (c.nb + c.bid) >> 2, rt2 = (2 * c.nb + c.bid) >> 2, ngw = c.nb * NWAVES;
    for (int m = c.tid; m < M; m += NTHREADS) {
        const int b = m / LT, t = m - b * LT;
        if (last && t < CTX) continue;
        const int blk = ((last ? b * S + (t - CTX) : m) % ngw) >> 3;
#pragma unroll
        for (int k = 0; k < 2; ++k) { const int info = RE[2 * m + k], e = info & 15, pos = ebase[e] + cntT[blk * NE + e] + (info >> 4), rt = pos >> 8;
            if (rt == rt0) map[pos & 255] = 2 * m + k; else if (rt == rt1) map[256 + (pos & 255)] = 2 * m + k; else if (rt == rt2) map[512 + (pos & 255)] = 2 * m + k; }
    }
    __syncthreads();
    if ((c.bid & 3) == 0) { int tot = 0; for (int e = 0; e < NE; ++e) tot += (nE[e] + 255) >> 8;
        int* S2P = (int*)(p.ws + WS_S2P);
        for (int i = c.tid; i < 768; i += NTHREADS) { const int rt = (i < 256) ? rt0 : (i < 512 ? rt1 : rt2); if (rt < tot) S2P[rt * 256 + (i & 255)] = map[i]; } }
    pg8::Gemm g{(const bf16_t*)(p.ws + WS_H), (const bf16_t*)(p.ws + WS_WGU) + (size_t)l * NE * 1024 * 1024, 0, 0, D};
    pg8::MoeOrderL S{nE, c.nb, c.bid};
    pg8::EpiSwiGLU E{(bf16_t*)(p.ws + WS_Q)};
    pg8::MoeGatherA GA{map};
    pg8::gemm_phase<pg8::EpiSwiGLU, pg8::MoeOrderL, true, true, pg8::MoeGatherA>(c.lds, g, S, E, c.tid, GA);
    if (l == 0) {
        int tot = 0; for (int e = 0; e < NE; ++e) tot += (nE[e] + 255) >> 8;
        const int nfull = min(max(4 * tot - 2 * c.nb, 0), c.nb);
        __syncthreads();
        if (c.bid >= nfull) convert_weights(p, c, 1, 0, CV_ALL, (c.bid - nfull) * NWAVES + c.wave, (c.nb - nfull) * NWAVES);
        else if (nfull == c.nb) convert_weights(p, c, 1, 0, CV_ALL, c.gw, c.ngw);
    }
}
__device__ __forceinline__ void phase_r3(const Params& p, const Ctx& c, int l) {
    pg8::Gemm g{(const bf16_t*)(p.ws + WS_Q), (const bf16_t*)(p.ws + WS_WD) + (size_t)l * NE * 1024 * 512, 0, 0, DE};
    pg8::MoeOrder S{(const unsigned*)(p.ws + WS_CTL) + CW_CNT + l * 64, c.nb, c.bid};
    pg8::EpiScatter E{(bf16_t*)(p.ws + WS_P), (const int*)(p.ws + WS_S2P), (const float*)(p.ws + WS_RW), M};
    pg8::gemm_phase<pg8::EpiScatter, pg8::MoeOrder, true, true>(c.lds, g, S, E, c.tid);
}

__device__ __forceinline__ void phase_f(const Params& p, const Ctx& c, int l, bool last) {
    LAS float* gt = (LAS float*)c.lds; LAS float* sh = gt + 3 * D; LAS float* sc = sh + 3 * D;
    load_mods(p, c, l, 5, gt);
    if (!last) { load_mods(p, c, l + 1, 0, sh); load_mods(p, c, l + 1, 1, sc); }
    __syncthreads();
    const float* g0n = p.g_norm + (size_t)((l + 1) * 4 + 0) * D; bf16_t* H = (bf16_t*)(p.ws + WS_H);
    const float* g3 = p.g_norm + (size_t)(l * 4 + 3) * D;
    const bf16_t* F0 = (const bf16_t*)(p.ws + WS_P); const bf16_t* F1 = F0 + (size_t)M * D;
    const int nrow = last ? NB * S : M;
#define F_ROW(i) (last ? ((i) / S) * LT + CTX + ((i) % S) : (i))
#define F_LOAD(i) do { const int m_ = F_ROW(i); const float* xr_ = res_row(p, m_); \
        _Pragma("unroll") for (int j = 0; j < 4; ++j) { const int n_ = 4 * (c.lane + 64 * j); fan[j] = *(const u32x2*)(F0 + (size_t)m_ * D + n_); fbn[j] = *(const u32x2*)(F1 + (size_t)m_ * D + n_); xn[j] = *(const f32x4*)(xr_ + n_); } } while (0)
    u32x2 fan[4], fbn[4]; f32x4 xn[4];
    if (c.gw < nrow) F_LOAD(c.gw);
#pragma unroll 1
    for (int ri = c.gw; ri < nrow; ri += c.ngw) {
        const int m = F_ROW(ri);
        const int b = m / LT, t = m - b * LT, r = t < CTX ? 2 : b;
        float* xr = res_row(p, m);
        float f[16]; float ss = 0.f; f32x4 xc[4];
#pragma unroll
        for (int j = 0; j < 4; ++j) {
            const u32x2 a = fan[j], bb = fbn[j]; xc[j] = xn[j];
            f[4 * j] = lo_bf(a.x) + lo_bf(bb.x); f[4 * j + 1] = hi_bf(a.x) + hi_bf(bb.x); f[4 * j + 2] = lo_bf(a.y) + lo_bf(bb.y); f[4 * j + 3] = hi_bf(a.y) + hi_bf(bb.y);
#pragma unroll
            for (int e = 0; e < 4; ++e) ss += f[4 * j + e] * f[4 * j + e]; }
        if (ri + c.ngw < nrow) F_LOAD(ri + c.ngw);
        const float rstd = rsqrtf(wave_sum(ss) * (1.f / D) + 1e-6f);
        float s2 = 0.f;
#pragma unroll
        for (int j = 0; j < 4; ++j) { const int n = 4 * (c.lane + 64 * j); const f32x4 gg = *(const f32x4*)(g3 + n); f32x4 xv = xc[j];
#pragma unroll
            for (int e = 0; e < 4; ++e) { xv[e] += gt[r * D + n + e] * (f[4 * j + e] * rstd * gg[e]); f[4 * j + e] = xv[e]; s2 += xv[e] * xv[e]; }
            *(f32x4*)(xr + n) = xv; }
        if (!last) {
            const float rstd2 = rsqrtf(wave_sum(s2) * (1.f / D) + 1e-6f);
#pragma unroll
            for (int j = 0; j < 4; ++j) { const int n = 4 * (c.lane + 64 * j); const f32x4 gg = *(const f32x4*)(g0n + n); float o[4];
#pragma unroll
                for (int e = 0; e < 4; ++e) o[e] = f[4 * j + e] * rstd2 * gg[e] * (1.f + sc[r * D + n + e]) + sh[r * D + n + e];
                u32x2 w; w.x = pk2(o[0], o[1]); w.y = pk2(o[2], o[3]);
                *(u32x2*)(H + (size_t)m * D + n) = w; }
        }
    }
}

__device__ __forceinline__ int lane_id() { int l; asm volatile("v_mbcnt_lo_u32_b32 %0, -1, 0\n\tv_mbcnt_hi_u32_b32 %0, -1, %0" : "=v"(l)); return l; }
__global__ void __launch_bounds__(NTHREADS, 2) fwd_kernel(Params p_unused) {
    extern __shared__ __attribute__((aligned(16))) unsigned char lds_raw[];
    const int wave = __builtin_amdgcn_readfirstlane((int)threadIdx.x >> 6);
    LAS unsigned char* lds = (LAS unsigned char*)lds_raw;
    volatile LAS unsigned* misc = (volatile LAS unsigned*)(lds + LDS_BYTES - 64);
#define TID() (wave * 64 + lane_id())
#define GP_(T, i) (T*)(__attribute__((address_space(1))) T*)kp_[i]
#define KARG(q) const __attribute__((address_space(4))) unsigned long long* kp_ = (const __attribute__((address_space(4))) unsigned long long*)__builtin_amdgcn_kernarg_segment_ptr(); asm volatile("" : "+s"(kp_)); \
    Params q; q.x = GP_(const float, 0); q.c = GP_(const float, 1); q.ctx = GP_(const float, 2); q.c_ctx = GP_(const float, 3); q.w_ada = GP_(const float, 4); q.b_ada = GP_(const float, 5); \
    q.g_norm = GP_(const float, 6); q.w_in = GP_(const float, 7); q.w_out = GP_(const float, 8); q.na_rpb = GP_(const float, 9); q.conv_w = GP_(const float, 10); q.conv_b = GP_(const float, 11); \
    q.lru_w_a = GP_(const float, 12); q.lru_b_a = GP_(const float, 13); q.lru_w_i = GP_(const float, 14); q.lru_b_i = GP_(const float, 15); q.lru_lam = GP_(const float, 16); q.mla_g_q = GP_(const float, 17); \
    q.mla_w_q = GP_(const float, 18); q.mla_g_kv = GP_(const float, 19); q.mla_w_kv = GP_(const float, 20); q.router_w = GP_(const float, 21); q.router_b = GP_(const float, 22); \
    q.exp_w_gate = GP_(const float, 23); q.exp_w_up = GP_(const float, 24); q.exp_w_down = GP_(const float, 25); q.out = GP_(float, 26); q.ws = GP_(unsigned char, 27); q.ph_lo = 0; q.ph_hi = 0
    { const int t = TID(); if (t < 16) misc[t] = 0u; }
    __syncthreads();
    { KARG(q); (void)xcd_barrier_post((unsigned*)(q.ws + WS_CTL) + CW_BAR, misc, TID()); }
#define GBAR() do { KARG(q); XcdBarrier b_; b_.bar = (unsigned*)(q.ws + WS_CTL) + CW_BAR; b_.x = xb_xcc_id(); b_.st = misc; xcd_barrier(b_, TID()); } while (0)
#ifndef PROBE_MASK
#define PROBE_MASK 0
#endif
#ifndef PROBE_VAR
#define PROBE_VAR 0
#endif
#ifndef PROBE_C1
#define PROBE_C1 0
#endif
#define RP(bit, stmt) do { stmt; if ((PROBE_MASK >> (bit)) & 1) { GBAR(); stmt; } } while (0)
#define PH(call) do { KARG(q); Ctx cc; cc.lds = lds; cc.wave = wave; cc.lane = lane_id(); cc.tid = wave * 64 + cc.lane; \
        cc.bid = blockIdx.x; cc.nb = gridDim.x; cc.gw = cc.bid * NWAVES + wave; cc.ngw = cc.nb * NWAVES; call; } while (0)
    RP(0, PH(phase_pro(q, cc))); GBAR();
#define LAYER(l, last) do { \
        if ((l) == 0) { RP(1, PH(phase_n1(q, cc, l))); GBAR(); } \
        RP(2, PH(phase_g1(q, cc, l, false))); GBAR(); \
        RP(4, PH(phase_c2(q, cc, l))); GBAR(); \
        RP(6, PH(phase_c3(q, cc))); __syncthreads(); if (PROBE_C1) { PH(phase_c1<PROBE_C1>(q, cc, l)); GBAR(); } RP(3, PH(phase_c1(q, cc, l))); __syncthreads(); RP(5, PH(phase_a1b(q, cc, l, last))); GBAR(); \
        RP(7, PH(phase_c4(q, cc, l, last))); __syncthreads(); if (PROBE_VAR) { PH(phase_a2<PROBE_VAR>(q, cc, last)); GBAR(); } RP(8, PH(phase_a2(q, cc, last))); GBAR(); \
        RP(9, PH(phase_o1(q, cc, l, last))); GBAR(); \
        PH(phase_o2(q, cc, l, last)); if (((PROBE_MASK >> 13) & 1) && (l) == 0) { GBAR(); PH(phase_o2(q, cc, l, last)); } GBAR(); \
        RP(11, PH(phase_r2(q, cc, l, last))); GBAR(); \
        RP(12, PH(phase_r3(q, cc, l))); GBAR(); \
        PH(phase_f(q, cc, l, last)); } while (0)
    LAYER(0, false); GBAR();
    LAYER(1, true);
#undef LAYER
#undef PH
#undef RP
#undef GBAR
#undef TID
#undef KARG
#undef GP_
}

#ifdef DBG_PHASE
__global__ void __launch_bounds__(NTHREADS, 2) dbg_kernel(Params p, int l) {
    extern __shared__ __attribute__((aligned(16))) unsigned char lds_raw[];
    Ctx cc; cc.lds = (LAS unsigned char*)lds_raw; cc.wave = __builtin_amdgcn_readfirstlane((int)threadIdx.x >> 6); cc.lane = threadIdx.x & 63; cc.tid = threadIdx.x;
    cc.bid = blockIdx.x; cc.nb = gridDim.x; cc.gw = cc.bid * NWAVES + cc.wave; cc.ngw = cc.nb * NWAVES;
    DBG_PHASE;
}
#endif
#define MAIN_KERNEL fwd_kernel

extern "C" void kernel_launch(void* const* d_in, const int* in_sizes, int n_in, void* d_out, int out_size, void* d_ws, size_t ws_size, hipStream_t stream) {
    static int grid = 0;
    if (grid == 0) {
        if (n_in != 26 || out_size != NB * S * D || ws_size < WS_END) { fprintf(stderr, "kernel_launch: unexpected shapes (n_in %d out %d ws %zu)\n", n_in, out_size, ws_size); grid = -1; return; }
        int dev = 0, cus = 0, per_cu = 0;
        hipGetDevice(&dev);
        hipDeviceGetAttribute(&cus, hipDeviceAttributeMultiprocessorCount, dev);
        hipFuncSetAttribute((const void*)fwd_kernel, hipFuncAttributeMaxDynamicSharedMemorySize, LDS_BYTES);
        hipOccupancyMaxActiveBlocksPerMultiprocessor(&per_cu, (const void*)MAIN_KERNEL, NTHREADS, LDS_BYTES);
        (void)hipGetLastError();
        if (per_cu < 1) { fprintf(stderr, "kernel_launch: occupancy query says %d blocks per CU\n", per_cu); grid = -1; return; }
        if (cus < 256) { fprintf(stderr, "kernel_launch: this build's unit orders assume a 256-workgroup grid (one per CU of a 256-CU device); the device reports %d CUs\n", cus); grid = -1; return; }
        grid = 256;
    }
    if (grid < 0) return;
    hipMemsetAsync((char*)d_ws + WS_CTL, 0, CTL_BYTES, stream);
    Params p{};
    const float** pp = (const float**)&p;
    for (int i = 0; i < 26; ++i) pp[i] = (const float*)d_in[i];
    p.out = (float*)d_out; p.ws = (unsigned char*)d_ws;
    void* args[] = {&p};
    hipLaunchCooperativeKernel((const void*)fwd_kernel, dim3(grid), dim3(NTHREADS), args, LDS_BYTES, stream);
}
```

```cpp
#include <hip/hip_runtime.h>
#include <cstdio>
#include <cstdint>


#define LAS __attribute__((address_space(3)))
typedef unsigned short bf16_t;
typedef short bf16x8 __attribute__((ext_vector_type(8)));
typedef float f32x4 __attribute__((ext_vector_type(4)));
typedef float f32x2 __attribute__((ext_vector_type(2)));
typedef unsigned u32x4 __attribute__((ext_vector_type(4)));
typedef unsigned u32x2 __attribute__((ext_vector_type(2)));

constexpr int D = 1024, NB = 2, S = 8192, CTX = 256, LT = CTX + S, M = NB * LT;
constexpr int GW = 64;
constexpr int INW = 2208, INP = 2304;
constexpr int OFF_QA = 0, OFF_KA = 256, OFF_VA = 512, OFF_U = 768, OFF_G = 1280, OFF_CQ = 1792, OFF_CKV = 2048, OFF_KR = 2176;
constexpr int LRU_W = 512;
constexpr int CH = 32, NCH = LT / CH, NCH_CTX = CTX / CH;
constexpr int NE = 16, DE = 512;
constexpr int NTHREADS = 512, NWAVES = 8;
constexpr int LDS_BYTES = 147456;

constexpr size_t MiB = 1u << 20;
constexpr size_t WS_CTL = 0, CTL_BYTES = 1 * MiB;
constexpr size_t WS_MODP = 1 * MiB;
constexpr size_t WS_WIN = 4 * MiB;
constexpr size_t WS_WOUT = 13 * MiB;
constexpr size_t WS_WGU = 17 * MiB;
constexpr size_t WS_WD = 81 * MiB;
constexpr size_t WS_XC = 113 * MiB;
constexpr size_t WS_RE = 115 * MiB;
constexpr size_t WS_RW = WS_RE + 256 * 1024;
constexpr size_t WS_PERM = WS_RW + 256 * 1024;
constexpr size_t WS_S2P = 117 * MiB;
constexpr size_t WS_LRUW = 117 * MiB + 512 * 1024;
constexpr size_t WS_WQT = 118 * MiB;
constexpr size_t WS_WKVT = 118 * MiB + 512 * 1024;
constexpr size_t WS_AGG = 119 * MiB;
constexpr size_t WS_CARRY = 1 * MiB + 256 * 1024;
constexpr size_t WS_XB = 301 * MiB;
constexpr size_t WS_H = 125 * MiB;
constexpr size_t WS_P = 158 * MiB;
constexpr size_t WS_Q = 233 * MiB;
constexpr size_t WS_K = 246 * MiB;
constexpr size_t WS_V = 259 * MiB;
constexpr size_t WS_Y = 268 * MiB;
constexpr size_t WS_END = 333 * MiB;
constexpr int CW_CNT = 64;
constexpr int CW_BAR = 4096;

__device__ __forceinline__ float bf2f(bf16_t v) { return __uint_as_float(((unsigned)v) << 16); }
typedef __bf16 bf16x2_hw __attribute__((ext_vector_type(2)));
typedef float f32x2_hw __attribute__((ext_vector_type(2)));
__device__ __forceinline__ unsigned pk2(float lo, float hi) { const f32x2_hw v = {lo, hi}; return __builtin_bit_cast(unsigned, __builtin_convertvector(v, bf16x2_hw)); }
__device__ __forceinline__ unsigned f2bf(float f) { return pk2(f, 0.f) & 0xffffu; }
__device__ __forceinline__ float lo_bf(unsigned w) { return __uint_as_float(w << 16); }
__device__ __forceinline__ float hi_bf(unsigned w) { return __uint_as_float(w & 0xffff0000u); }
template <int CTRL> __device__ __forceinline__ float dpp_f(float v) { return __builtin_bit_cast(float, __builtin_amdgcn_update_dpp(0, __builtin_bit_cast(int, v), CTRL, 0xF, 0xF, true)); }
__device__ __forceinline__ float row16_sum(float v) {
    v += dpp_f<0xB1>(v);
    v += dpp_f<0x4E>(v);
    v += dpp_f<0x141>(v);
    v += dpp_f<0x140>(v);
    return v;
}
__device__ __forceinline__ float wave_sum(float v) {
    v = row16_sum(v);
    { auto r = __builtin_amdgcn_permlane16_swap(__float_as_uint(v), __float_as_uint(v), false, false); v = __uint_as_float(r[0]) + __uint_as_float(r[1]); }
    { auto r = __builtin_amdgcn_permlane32_swap(__float_as_uint(v), __float_as_uint(v), false, false); v = __uint_as_float(r[0]) + __uint_as_float(r[1]); }
    return v;
}
__device__ __forceinline__ float sigmoidf_(float x) { return __builtin_amdgcn_rcpf(1.f + __builtin_amdgcn_exp2f(-1.4426950408889634f * x)); }
__device__ __forceinline__ float siluf_(float x) { return x * sigmoidf_(x); }
__device__ __forceinline__ float gelu_tanh(float x) { return x * sigmoidf_(1.5957691216057308f * (x + 0.044715f * x * x * x)); }

struct Params {
    const float *x, *c, *ctx, *c_ctx, *w_ada, *b_ada, *g_norm, *w_in, *w_out, *na_rpb, *conv_w, *conv_b,
        *lru_w_a, *lru_b_a, *lru_w_i, *lru_b_i, *lru_lam, *mla_g_q, *mla_w_q, *mla_g_kv, *mla_w_kv,
        *router_w, *router_b, *exp_w_gate, *exp_w_up, *exp_w_down;
    float* out; unsigned char* ws; int ph_lo, ph_hi;
};

struct Ctx {
    int tid, lane, wave, bid, nb, gw, ngw;
    LAS unsigned char* lds;
};

__device__ __forceinline__ const float* xin_row(const Params& p, int m) {
    const int b = m / LT, t = m - b * LT;
    return t < CTX ? p.ctx + (size_t)(b * CTX + t) * D : p.x + (size_t)(b * S + t - CTX) * D;
}
__device__ __forceinline__ float* xc_row(const Params& p, int m) { const int b = m / LT, t = m - b * LT; return (float*)(p.ws + WS_XC) + (size_t)(b * CTX + t) * D; }
__device__ __forceinline__ bf16_t* xb_row(const Params& p, int m) { const int b = m / LT, t = m - b * LT; return (bf16_t*)(p.ws + WS_XB) + (size_t)(b * S + t - CTX) * D; }
__device__ __forceinline__ float* out_row(const Params& p, int m) { const int b = m / LT, t = m - b * LT; return p.out + (size_t)(b * S + t - CTX) * D; }
__device__ __forceinline__ f32x4 bf4(u32x2 w) { return (f32x4){lo_bf(w.x), hi_bf(w.x), lo_bf(w.y), hi_bf(w.y)}; }
__device__ __forceinline__ u32x2 pk4(f32x4 v) { u32x2 w; w.x = pk2(v.x, v.y); w.y = pk2(v.z, v.w); return w; }
__device__ __forceinline__ void load_mods(const Params& p, const Ctx& c, int l, int j, LAS float* dst) {
    const float* mp = (const float*)(p.ws + WS_MODP);
    for (int idx = c.tid; idx < 3 * D; idx += NTHREADS) {
        const int r = idx >> 10, n = idx & 1023;
        dst[idx] = mp[(size_t)(l * 3 + r) * 6144 + j * D + n];
    }
}

#define XB_TMO      128
#define XB_XCNT(j)  (256  + 64 * (j))
#define XB_XSUB(j)  (1280 + 64 * (j))
#define XB_XGEN(j)  (2304 + 64 * (j))
#define XB_TOP      3328
#define XB_TOPGEN   3392
#define XCD_BAR_WORDS 3456
#define XB_SPIN_CAP (1u << 18)
__device__ __forceinline__ unsigned xb_ld(unsigned* p)              { return __hip_atomic_load(p, __ATOMIC_RELAXED, __HIP_MEMORY_SCOPE_AGENT); }
__device__ __forceinline__ unsigned xb_add(unsigned* p, unsigned v) { return __hip_atomic_fetch_add(p, v, __ATOMIC_RELAXED, __HIP_MEMORY_SCOPE_AGENT); }
__device__ __forceinline__ unsigned xb_xcc_id() { return (unsigned)__builtin_amdgcn_s_getreg((3 << 11) | 20) & 0xFu; }
#define XB_SPIN(cond, bar) do { unsigned _sp = 0; while (cond) { __builtin_amdgcn_s_sleep(1); \
    if ((++_sp & 255u) == 0u) { if (xb_ld(&(bar)[XB_TMO])) break; if (_sp > XB_SPIN_CAP) { atomicAdd(&(bar)[XB_TMO], 1u); break; } } } } while (0)
struct XcdBarrier { unsigned* bar; unsigned x; volatile LAS unsigned* st; };
__device__ __forceinline__ XcdBarrier xcd_barrier_post(unsigned* bar, volatile LAS unsigned* st, int tid) {
    XcdBarrier b; b.bar = bar; b.x = xb_xcc_id(); b.st = st;
    if (tid == 0) (void)xb_add(&bar[XB_XCNT(b.x)], 1u);
    return b;
}
__device__ __forceinline__ void xcd_barrier_complete(unsigned* bar, unsigned x, unsigned& nloc, unsigned& nx) {
    const unsigned G = gridDim.x * gridDim.y * gridDim.z;
    unsigned sum, cnt, mine, sp = 0u;
    for (;;) {
        sum = 0u; cnt = 0u; mine = 0u;
#pragma unroll
        for (unsigned j = 0; j < 16; ++j) { const unsigned c = xb_ld(&bar[XB_XCNT(j)]); sum += c; cnt += (c > 0u) ? 1u : 0u; mine = (j == x) ? c : mine; }
        if (sum == G) break;
        __builtin_amdgcn_s_sleep(1);
        if ((++sp & 255u) == 0u) { if (xb_ld(&bar[XB_TMO])) break; if (sp > XB_SPIN_CAP) { atomicAdd(&bar[XB_TMO], 1u); break; } }
    }
    nloc = mine > 0u ? mine : 1u; nx = cnt > 0u ? cnt : 1u;
}
__device__ __forceinline__ void xcd_barrier(const XcdBarrier& b, int tid) {
    asm volatile("s_waitcnt vmcnt(0)" ::: "memory");
    __syncthreads();
    if (tid == 0) {
        unsigned* bar = b.bar;
        __builtin_amdgcn_s_waitcnt(0);
        unsigned nloc = b.st[0], nx = b.st[1];
        if (nloc == 0u) { xcd_barrier_complete(bar, b.x, nloc, nx); b.st[0] = nloc; b.st[1] = nx; }
        const unsigned old = xb_add(&bar[XB_XSUB(b.x)], 1u);
        const unsigned gen = old / nloc;
        if (old + 1u == (gen + 1u) * nloc) {
            __builtin_amdgcn_fence(__ATOMIC_RELEASE, "agent");
            asm volatile("s_waitcnt vmcnt(0)" ::: "memory");
            const unsigned og = xb_add(&bar[XB_TOP], 1u);
            const unsigned tg = og / nx;
            if (og + 1u == (tg + 1u) * nx) xb_add(&bar[XB_TOPGEN], 1u);
            else XB_SPIN(xb_ld(&bar[XB_TOPGEN]) == tg, bar);
            __builtin_amdgcn_fence(__ATOMIC_ACQUIRE, "agent");
            xb_add(&bar[XB_XGEN(b.x)], 1u);
            asm volatile("s_waitcnt vmcnt(0)" ::: "memory");
        } else {
            XB_SPIN(xb_ld(&bar[XB_XGEN(b.x)]) == gen, bar);
            __builtin_amdgcn_fence(__ATOMIC_ACQUIRE, "agent");
            asm volatile("s_waitcnt vmcnt(0)" ::: "memory");
        }
    }
    __syncthreads();
}


namespace pg8 {
#define PG8_LAS __attribute__((address_space(3)))
typedef unsigned short bf16_t;
typedef short bf16x8 __attribute__((ext_vector_type(8)));
typedef float f32x4 __attribute__((ext_vector_type(4)));
typedef unsigned u32x4 __attribute__((ext_vector_type(4)));
constexpr int BM = 256, BK = 64, HALF = 128, HTB = HALF * BK * 2  , STAGE_BYTES = 8 * HTB, NXCD = 8, WGM = 8;

__host__ __device__ __forceinline__ int lds_byte(int r, int c) { const int st = (r >> 4) * 2 + (c >> 5), rr = r & 15, cc = c & 31, ob = rr * 64 + cc * 2; return st * 1024 + (ob ^ (((ob >> 9) & 1) << 5)); }
__host__ __device__ __forceinline__ void stage_rc(int b, int& R, int& C) { const int st = b / 1024, sb = b % 1024, swz = sb ^ (((sb >> 9) & 1) << 5); R = (st >> 1) * 16 + swz / 64; C = (st & 1) * 32 + (swz % 64) / 2; }
__host__ __device__ __forceinline__ int perm32(int rho) { const int n = rho >> 4, i = rho & 15; return 8 * (i >> 2) + 4 * n + (i & 3); }

struct Unit { int pm, pn, aux0, aux1; };
struct Gemm { const bf16_t* A; const bf16_t* Bt; int M, N, K; };
__device__ __forceinline__ unsigned cvt_pk_bf16(float lo, float hi) { return ::pk2(lo, hi); }
typedef float f32x2 __attribute__((ext_vector_type(2)));
__device__ __forceinline__ f32x2 gelu_pk(f32x2 v) {
    const f32x2 av = __builtin_elementwise_abs(v), d = av * 0.2316418882f + 1.0f;
    f32x2 t; t.x = __builtin_amdgcn_rcpf(d.x); t.y = __builtin_amdgcn_rcpf(d.y);
    f32x2 q = t * 0.5307027145f + (-0.7265760135f); q = q * t + 0.7107068705f; q = q * t + (-0.142248368f); q = q * t + 0.127414796f; q = q * t;
    const f32x2 s = (v * v) * (-0.72134752044f);
    f32x2 e; e.x = __builtin_amdgcn_exp2f(s.x); e.y = __builtin_amdgcn_exp2f(s.y);
    const f32x2 m = v * (q * e), r = v - m;
    f32x2 o; o.x = v.x < 0.f ? m.x : r.x; o.y = v.y < 0.f ? m.y : r.y; return o;
}

template <int ACT  > struct EpiBf16 {
    static constexpr bool PERM = true, AFTER_DRAIN = false; static_assert(ACT == 0 || ACT == 1, "EpiBf16: ACT is 0 (none) or 1 (gelu_pk)");
    bf16_t* O; int ldc; const float* bias; int split_cols; size_t split_stride; float scale0;
    __device__ __forceinline__ void operator()(const f32x4 (&acc)[2][2][4][2], const Unit& u, int wr, int wc, int fr, int fq) const {
        const int row0 = u.pm * BM + wr * 64 + fr; int colt = u.pn * BM; bf16_t* base = O;
        float sc = 1.f; if (split_cols) { const int t = colt / split_cols; base += (size_t)t * split_stride; colt -= t * split_cols; if (t == 0) sc = scale0; }
        const int col0 = colt + wc * 32 + 8 * fq, bcol0 = u.pn * BM + wc * 32 + 8 * fq;
        f32x4 bv[2][2];
#pragma unroll
        for (int bj = 0; bj < 2; ++bj)
#pragma unroll
            for (int n = 0; n < 2; ++n) bv[bj][n] = bias ? *(const f32x4*)(bias + bcol0 + bj * HALF + 4 * n) : (f32x4){0.f, 0.f, 0.f, 0.f};
#pragma unroll
        for (int ai = 0; ai < 2; ++ai)
#pragma unroll
            for (int m = 0; m < 4; ++m) { bf16_t* rowp = base + (size_t)(row0 + ai * HALF + m * 16) * ldc + col0;
#pragma unroll
                for (int bj = 0; bj < 2; ++bj) { f32x4 v0 = acc[ai][bj][m][0] + bv[bj][0], v1 = acc[ai][bj][m][1] + bv[bj][1];
                    if (ACT == 1) { f32x2 a = gelu_pk((f32x2){v0[0], v0[1]}), b = gelu_pk((f32x2){v0[2], v0[3]}), c = gelu_pk((f32x2){v1[0], v1[1]}), d = gelu_pk((f32x2){v1[2], v1[3]});
                        v0 = (f32x4){a.x, a.y, b.x, b.y}; v1 = (f32x4){c.x, c.y, d.x, d.y}; }
                    v0 = v0 * sc; v1 = v1 * sc; u32x4 w; w.x = cvt_pk_bf16(v0[0], v0[1]); w.y = cvt_pk_bf16(v0[2], v0[3]); w.z = cvt_pk_bf16(v1[0], v1[1]); w.w = cvt_pk_bf16(v1[2], v1[3]);
                    *(u32x4*)(rowp + bj * HALF) = w; } }
    }
};

struct StaticOrder {
    int nM, nN, nwg, G, c;
    __host__ __device__ void init(int M, int N, int G_, int c_) { nM = M / BM; nN = N / BM; nwg = nM * nN; G = G_; c = c_; }
    __host__ __device__ bool next(int i, Unit& u) const {
        const long L = (long)i * G + c; if (L >= nwg) return false;
        int wgid = (int)L; { const int q = nwg / NXCD, r = nwg % NXCD, xcd = wgid % NXCD, off = wgid / NXCD; wgid = (xcd < r ? xcd * (q + 1) : r * (q + 1) + (xcd - r) * q) + off; }
        const int nig = WGM * nN, gid = wgid / nig, fm = gid * WGM, gsz = (nM - fm) < WGM ? (nM - fm) : WGM;
        u.pm = fm + ((wgid % nig) % gsz); u.pn = (wgid % nig) / gsz; return true;
    }
    __device__ __forceinline__ void a_ready(const Unit&) const {}
    __device__ __forceinline__ void done(const Unit&) const {}
};
struct EpiF32 {
    static constexpr bool PERM = false, AFTER_DRAIN = false;
    float* O; int ldc;
    __device__ __forceinline__ void operator()(const f32x4 (&acc)[2][2][4][2], const Unit& u, int wr, int wc, int fr, int fq) const {
        const int row0 = u.pm * BM + wr * 64 + fr, col0 = u.pn * BM + wc * 32 + 4 * fq;
#pragma unroll
        for (int ai = 0; ai < 2; ++ai)
#pragma unroll
            for (int m = 0; m < 4; ++m) { float* rowp = O + (size_t)(row0 + ai * HALF + m * 16) * ldc + col0;
#pragma unroll
                for (int bj = 0; bj < 2; ++bj)
#pragma unroll
                    for (int n = 0; n < 2; ++n) *(f32x4*)(rowp + bj * HALF + n * 16) = acc[ai][bj][m][n]; }
    }
};
struct EpiSwiGLU {
    static constexpr bool PERM = true, AFTER_DRAIN = false;
    bf16_t* O;
    __device__ __forceinline__ void operator()(const f32x4 (&acc)[2][2][4][2], const Unit& u, int wr, int wc, int fr, int fq) const {
        const int row0 = u.pm * BM + wr * 64 + fr, col0 = (u.pn & 3) * 128 + wc * 32 + 8 * fq;
#pragma unroll
        for (int ai = 0; ai < 2; ++ai)
#pragma unroll
            for (int m = 0; m < 4; ++m) {
                float v[8];
#pragma unroll
                for (int n = 0; n < 2; ++n)
#pragma unroll
                    for (int e = 0; e < 4; ++e) { const float g = acc[ai][0][m][n][e]; v[4 * n + e] = g * __builtin_amdgcn_rcpf(1.f + __builtin_amdgcn_exp2f(-1.4426950408889634f * g)) * acc[ai][1][m][n][e]; }
                u32x4 w; w.x = cvt_pk_bf16(v[0], v[1]); w.y = cvt_pk_bf16(v[2], v[3]); w.z = cvt_pk_bf16(v[4], v[5]); w.w = cvt_pk_bf16(v[6], v[7]);
                *(u32x4*)(O + (size_t)(row0 + ai * HALF + m * 16) * 512 + col0) = w; }
    }
};
struct EpiScatter {
    static constexpr bool PERM = true, AFTER_DRAIN = false;
    bf16_t* F; const int* slot2pk; const float* rw; int Mtok;
    __device__ __forceinline__ void operator()(const f32x4 (&acc)[2][2][4][2], const Unit& u, int wr, int wc, int fr, int fq) const {
        const int row0 = u.pm * BM + wr * 64 + fr, col0 = (u.pn & 3) * BM + wc * 32 + 8 * fq;
#pragma unroll
        for (int ai = 0; ai < 2; ++ai)
#pragma unroll
            for (int m = 0; m < 4; ++m) {
                const int pk = slot2pk[row0 + ai * HALF + m * 16];
                if (pk >= 0) { const float wgt = rw[pk]; bf16_t* rowp = F + ((size_t)(pk & 1) * Mtok + (pk >> 1)) * 1024 + col0;
#pragma unroll
                    for (int bj = 0; bj < 2; ++bj) { const f32x4 v0 = acc[ai][bj][m][0] * wgt, v1 = acc[ai][bj][m][1] * wgt;
                        u32x4 w; w.x = cvt_pk_bf16(v0[0], v0[1]); w.y = cvt_pk_bf16(v0[2], v0[3]); w.z = cvt_pk_bf16(v1[0], v1[1]); w.w = cvt_pk_bf16(v1[2], v1[3]);
                        *(u32x4*)(rowp + bj * HALF) = w; } } }
    }
};
struct LatentOrder4 {
    int G, c;
    __device__ bool next(int i, Unit& u) const {
        const int L = i * G + c; if (L >= 256) return false;
        const int x = L & 7, j = L >> 3, pi = x * 8 + (j >> 2);
        u.pm = pi + 1 + (pi >= 32 ? 1 : 0); u.pn = j & 3; u.aux0 = 0; u.aux1 = 0; return true;
    }
    __device__ __forceinline__ void a_ready(const Unit&) const {}
    __device__ __forceinline__ void done(const Unit&) const {}
};
struct G1Order {
    int G, c; bool deferred;
    __device__ bool next(int i, Unit& u) const {
        u.aux0 = 0; u.aux1 = 0;
        if (deferred) { if (i > 0 || c >= 82) return false; if (c < 66) { u.pm = c; u.pn = 8; } else { u.pm = c - 66; u.pn = 0; } return true; }
        const int L = i * G + c; if (L >= 512) return false;
        const int n = (L & ~255) + (L & 7) * 32 + ((L & 255) >> 3);
        if (n < 462) { u.pm = n / 7; u.pn = 1 + n % 7; } else { u.pm = 16 + (n - 462); u.pn = 0; }
        return true;
    }
    __device__ __forceinline__ void a_ready(const Unit&) const {}
    __device__ __forceinline__ void done(const Unit&) const {}
};
struct MoeGatherA {
    static constexpr bool GATHER = true; const PG8_LAS int* map;
    __device__ __forceinline__ int row(int ui, int r) const { const int pk = map[ui * 256 + r]; return pk >= 0 ? (pk >> 1) : 0; }
};
struct MoeOrderL {
    const PG8_LAS int* cnt; int G, c;
    __device__ bool next(int i, Unit& u) const {
        const int L = i * G + c, rt = L >> 2;
        int acc = 0, e = -1;
#pragma unroll
        for (int j = 0; j < 16; ++j) { const int nt = (cnt[j] + 255) >> 8; if (e < 0 && rt < acc + nt) e = j; acc += nt; }
        if (e < 0) return false;
        u.pm = rt; u.pn = e * 4 + (L & 3); u.aux0 = e; u.aux1 = 0; return true;
    }
    __device__ __forceinline__ void a_ready(const Unit&) const {}
    __device__ __forceinline__ void done(const Unit&) const {}
};
struct MoeOrder {
    const unsigned* cnt; int G, c;
    __device__ bool next(int i, Unit& u) const {
        const int L = i * G + c, rt = L >> 2;
        int acc = 0, e = -1;
#pragma unroll
        for (int j = 0; j < 16; ++j) { const int nt = ((int)cnt[j] + 255) >> 8; if (e < 0 && rt < acc + nt) e = j; acc += nt; }
        if (e < 0) return false;
        u.pm = rt; u.pn = e * 4 + (L & 3); u.aux0 = e; u.aux1 = 0; return true;
    }
    __device__ __forceinline__ void a_ready(const Unit&) const {}
    __device__ __forceinline__ void done(const Unit&) const {}
};
struct DenseA { static constexpr bool GATHER = false; __device__ __forceinline__ int row(int, int) const { return 0; } };
template <class Epi, class Sched, bool ALIGN_EPI = false, bool SP2 = false, class AG = DenseA>
__device__ __forceinline__ void gemm_phase(PG8_LAS unsigned char* lds, const Gemm g, const Sched& S, const Epi& E, const int tid, const AG& G = AG()) {
    static_assert(!AG::GATHER || SP2, "the gather policy is wired into the SP2 loop only");
    const int wid = __builtin_amdgcn_readfirstlane(tid >> 6), lane = tid & 63, wr = wid >> 2, wc = wid & 3, fr = lane & 15, fq = lane >> 4;
    const int K = g.K, nt = K / BK;
    unsigned voffA[2], voffB[2]; int RA[2], CA[2];
#pragma unroll
    for (int i = 0; i < 2; ++i) { int R, C; stage_rc(tid * 16 + i * 8192, R, C); const int Rb = Epi::PERM ? ((R & ~31) + perm32(R & 31)) : R;
        voffA[i] = (unsigned)(R * K + C) * 2u; voffB[i] = (unsigned)(Rb * K + C) * 2u; RA[i] = R; CA[i] = C; }
    const size_t kstep = (size_t)(BK * 2);
    const size_t hstep = (size_t)HALF * K * 2;
    const size_t tstep = 2 * hstep;
    const unsigned ldsw = (unsigned)wid * 1024u;
    const int aoff = lds_byte(wr * 64 + fr, fq * 8), boff = lds_byte(wc * 32 + fr, fq * 8);
#define PG8_SA(b, h) (((b) * 2 + (h)) * HTB)
#define PG8_SB(b, h) ((4 + (b) * 2 + (h)) * HTB)
#define PG8_STAGE(bufoff, gbase, voff) do { _Pragma("unroll") for (int _i = 0; _i < 2; ++_i) \
        __builtin_amdgcn_global_load_lds((const unsigned*)((const char*)(gbase) + (voff)[_i]), (PG8_LAS unsigned*)(lds + (bufoff) + ldsw + _i * 8192), 16, 0, 0); } while (0)
#define PG8_LDA(dst, b, h) do { _Pragma("unroll") for (int m = 0; m < 4; ++m) _Pragma("unroll") for (int k = 0; k < 2; ++k) dst[m][k] = *(const PG8_LAS bf16x8*)(lds + PG8_SA(b, h) + aoff + m * 2048 + k * 1024); } while (0)
#define PG8_LDB(dst, b, h) do { _Pragma("unroll") for (int n = 0; n < 2; ++n) _Pragma("unroll") for (int k = 0; k < 2; ++k) dst[n][k] = *(const PG8_LAS bf16x8*)(lds + PG8_SB(b, h) + boff + n * 2048 + k * 1024); } while (0)
#define PG8_MMA(ai, bj, At, Bt) do { __builtin_amdgcn_s_setprio(1); _Pragma("unroll") for (int m = 0; m < 4; ++m) _Pragma("unroll") for (int n = 0; n < 2; ++n) _Pragma("unroll") for (int k = 0; k < 2; ++k) \
        acc[ai][bj][m][n] = __builtin_amdgcn_mfma_f32_16x16x32_bf16(Bt[n][k], At[m][k], acc[ai][bj][m][n], 0, 0, 0); __builtin_amdgcn_s_setprio(0); } while (0)
#define PG8_WAIT_V(n) asm volatile("s_waitcnt vmcnt(" #n ")" ::: "memory")
#define PG8_WAIT_L(n) asm volatile("s_waitcnt lgkmcnt(" #n ")" ::: "memory")
#define PG8_BAR __builtin_amdgcn_s_barrier()
#define PG8_SCHED __builtin_amdgcn_sched_barrier(0)
    Unit cur, nxt; int ui = 0;
    if (!S.next(0, cur)) return;
    f32x4 acc[2][2][4][2];
#pragma unroll
    for (int a = 0; a < 2; ++a)
#pragma unroll
        for (int b = 0; b < 2; ++b)
#pragma unroll
            for (int m = 0; m < 4; ++m)
#pragma unroll
                for (int n = 0; n < 2; ++n) acc[a][b][m][n] = (f32x4){0.f, 0.f, 0.f, 0.f};
    bf16x8 At[4][2], B0[2][2], B1[2][2];
    const char* cA = AG::GATHER ? (const char*)g.A : (const char*)g.A + (size_t)cur.pm * tstep; const char* cB = (const char*)g.Bt + (size_t)cur.pn * tstep;
    unsigned vc[2][2], vn[2][2];
#pragma unroll
    for (int h = 0; h < 2; ++h)
#pragma unroll
        for (int i = 0; i < 2; ++i) { vc[h][i] = AG::GATHER ? (unsigned)(G.row(0, h * HALF + RA[i]) * K + CA[i]) * 2u : voffA[i] + (unsigned)(h * hstep); vn[h][i] = vc[h][i]; }
    S.a_ready(cur);
    if constexpr (SP2) {
        PG8_STAGE(PG8_SB(0, 0), cB, voffB); PG8_STAGE(PG8_SB(0, 1), cB + hstep, voffB); PG8_STAGE(PG8_SA(0, 0), cA, vc[0]); PG8_STAGE(PG8_SA(0, 1), cA, vc[1]);
        if (wr == 1) PG8_BAR;
        PG8_WAIT_V(2); PG8_BAR;
        PG8_STAGE(PG8_SB(1, 0), cB + kstep, voffB); PG8_STAGE(PG8_SA(1, 0), cA + kstep, vc[0]); PG8_STAGE(PG8_SB(1, 1), cB + hstep + kstep, voffB);
        PG8_WAIT_V(6); PG8_BAR;
    } else {
        PG8_STAGE(PG8_SB(0, 0), cB, voffB); PG8_STAGE(PG8_SA(0, 0), cA, voffA); PG8_STAGE(PG8_SB(0, 1), cB + hstep, voffB); PG8_STAGE(PG8_SA(0, 1), cA + hstep, voffA);
        if (wr == 1) PG8_BAR;
        PG8_WAIT_V(4); PG8_BAR;
        PG8_STAGE(PG8_SB(1, 0), cB + kstep, voffB); PG8_STAGE(PG8_SA(1, 0), cA + kstep, voffA); PG8_STAGE(PG8_SB(1, 1), cB + hstep + kstep, voffB);
        PG8_WAIT_V(6); PG8_BAR;
    }
    for (;;) {
        const bool has_next = S.next(ui + 1, nxt);
        const char* nA = AG::GATHER ? cA : (has_next ? (const char*)g.A + (size_t)nxt.pm * tstep : cA); const char* nB = has_next ? (const char*)g.Bt + (size_t)nxt.pn * tstep : cB;
        if (AG::GATHER && has_next) {
#pragma unroll
            for (int h = 0; h < 2; ++h)
#pragma unroll
                for (int i = 0; i < 2; ++i) vn[h][i] = (unsigned)(G.row(ui + 1, h * HALF + RA[i]) * K + CA[i]) * 2u;
        }
        for (int t = 0; t < nt; t += 2) {
            const bool last = (t == nt - 2);
            const char* a1 = cA + (size_t)(t + 1) * kstep;
            const char* a2 = last ? nA : cA + (size_t)(t + 2) * kstep; const char* b2 = last ? nB : cB + (size_t)(t + 2) * kstep;
            const char* a3 = a2 + kstep; const char* b3 = b2 + kstep;
            if (last && has_next) S.a_ready(nxt);
            unsigned v2[2][2];
#pragma unroll
            for (int h = 0; h < 2; ++h)
#pragma unroll
                for (int i = 0; i < 2; ++i) v2[h][i] = last ? vn[h][i] : vc[h][i];
            if constexpr (SP2) {
            PG8_LDB(B0, 0, 0); PG8_LDB(B1, 0, 1); PG8_SCHED; PG8_LDA(At, 0, 0); PG8_STAGE(PG8_SA(1, 1), a1, vc[1]);
            PG8_WAIT_V(8); PG8_WAIT_L(0); PG8_BAR; PG8_MMA(0, 0, At, B0); PG8_MMA(0, 1, At, B1); PG8_BAR; PG8_SCHED;
            PG8_LDA(At, 0, 1); PG8_STAGE(PG8_SB(0, 0), b2, voffB); PG8_STAGE(PG8_SB(0, 1), b2 + hstep, voffB); PG8_STAGE(PG8_SA(0, 0), a2, v2[0]);
            PG8_WAIT_V(8); PG8_WAIT_L(0); PG8_BAR; PG8_MMA(1, 0, At, B0); PG8_MMA(1, 1, At, B1); PG8_BAR; PG8_SCHED;
            PG8_LDB(B0, 1, 0); PG8_LDB(B1, 1, 1); PG8_SCHED; PG8_LDA(At, 1, 0); PG8_STAGE(PG8_SA(0, 1), a2, v2[1]);
            PG8_WAIT_V(8); PG8_WAIT_L(0); PG8_BAR; PG8_MMA(0, 0, At, B0); PG8_MMA(0, 1, At, B1); PG8_BAR; PG8_SCHED;
            PG8_LDA(At, 1, 1); PG8_STAGE(PG8_SB(1, 0), b3, voffB); PG8_STAGE(PG8_SB(1, 1), b3 + hstep, voffB); PG8_STAGE(PG8_SA(1, 0), a3, v2[0]);
            PG8_WAIT_V(8); PG8_WAIT_L(0); PG8_BAR; PG8_MMA(1, 0, At, B0); PG8_MMA(1, 1, At, B1); PG8_BAR; PG8_SCHED;
            } else {
            PG8_LDB(B0, 0, 0); PG8_SCHED; PG8_LDA(At, 0, 0); PG8_STAGE(PG8_SA(1, 1), a1 + hstep, voffA);
            PG8_WAIT_L(8); PG8_BAR; PG8_WAIT_L(0); PG8_MMA(0, 0, At, B0); PG8_BAR; PG8_SCHED;
            PG8_LDB(B1, 0, 1); PG8_STAGE(PG8_SB(0, 0), b2, voffB);
            PG8_BAR; PG8_WAIT_L(0); PG8_MMA(0, 1, At, B1); PG8_BAR;
            PG8_LDA(At, 0, 1); PG8_STAGE(PG8_SA(0, 0), a2, voffA);
            PG8_BAR; PG8_WAIT_L(0); PG8_MMA(1, 0, At, B0); PG8_BAR; PG8_SCHED;
            PG8_STAGE(PG8_SB(0, 1), b2 + hstep, voffB);
            PG8_WAIT_V(6); PG8_BAR; PG8_MMA(1, 1, At, B1); PG8_BAR;
            PG8_LDB(B0, 1, 0); PG8_SCHED; PG8_LDA(At, 1, 0); PG8_STAGE(PG8_SA(0, 1), a2 + hstep, voffA);
            PG8_WAIT_L(8); PG8_BAR; PG8_WAIT_L(0); PG8_MMA(0, 0, At, B0); PG8_BAR; PG8_SCHED;
            PG8_LDB(B1, 1, 1); PG8_STAGE(PG8_SB(1, 0), b3, voffB);
            PG8_BAR; PG8_WAIT_L(0); PG8_MMA(0, 1, At, B1); PG8_BAR;
            PG8_LDA(At, 1, 1); PG8_STAGE(PG8_SA(1, 0), a3, voffA);
            PG8_BAR; PG8_WAIT_L(0); PG8_MMA(1, 0, At, B0); PG8_BAR; PG8_SCHED;
            PG8_STAGE(PG8_SB(1, 1), b3 + hstep, voffB);
            PG8_WAIT_V(6); PG8_BAR; PG8_MMA(1, 1, At, B1); PG8_BAR;
            }
        }
        if constexpr (ALIGN_EPI) { if (wr == 0) PG8_BAR; }
        if constexpr (!Epi::AFTER_DRAIN) { E(acc, cur, wr, wc, fr, fq); S.done(cur); }
        if (!has_next) break;
#pragma unroll
        for (int a = 0; a < 2; ++a)
#pragma unroll
            for (int b = 0; b < 2; ++b)
#pragma unroll
                for (int m = 0; m < 4; ++m)
#pragma unroll
                    for (int n = 0; n < 2; ++n) acc[a][b][m][n] = (f32x4){0.f, 0.f, 0.f, 0.f};
        cur = nxt; cA = nA; cB = nB; ++ui;
#pragma unroll
        for (int h = 0; h < 2; ++h)
#pragma unroll
            for (int i = 0; i < 2; ++i) vc[h][i] = vn[h][i];
        if constexpr (ALIGN_EPI) { if (wr == 1) PG8_BAR; }
    }
    PG8_WAIT_V(0);
    if constexpr (!ALIGN_EPI) { if (wr == 0) PG8_BAR; }
    PG8_BAR;
    if constexpr (Epi::AFTER_DRAIN) { E.fused(acc, cur, wr, wc, fr, fq, lds, wid, lane); S.done(cur); }
#undef PG8_SA
#undef PG8_SB
#undef PG8_STAGE
#undef PG8_LDA
#undef PG8_LDB
#undef PG8_MMA
#undef PG8_WAIT_V
#undef PG8_WAIT_L
#undef PG8_BAR
#undef PG8_SCHED
}
}

__device__ __forceinline__ void transpose_item(const float* W, int K, int N, bf16_t* WT, int item, LAS float* scr, int lane, int rmode = 0) {
    const int nblk = N / 32, kb = item / nblk, nbk = item % nblk, k0 = 64 * kb, n0 = 32 * nbk;
#pragma unroll 8
    for (int i = 0; i < 32; ++i) { const int kk = 2 * i + (lane >> 5); scr[kk * 33 + (lane & 31)] = W[(size_t)(k0 + kk) * N + n0 + (lane & 31)]; }
    asm volatile("s_waitcnt lgkmcnt(0)" ::: "memory");
    const int cc = lane & 7;
#pragma unroll
    for (int j = 0; j < 4; ++j) { const int n = (lane >> 3) + 8 * j; const LAS float* s = scr + (8 * cc) * 33 + n;
        u32x4 o; o.x = pk2(s[0 * 33], s[1 * 33]); o.y = pk2(s[2 * 33], s[3 * 33]); o.z = pk2(s[4 * 33], s[5 * 33]); o.w = pk2(s[6 * 33], s[7 * 33]);
        const int nn = n0 + n, row = rmode == 0 ? nn : ((nn >> 7) * 256 + (rmode - 1) * 128 + (nn & 127));
        *(u32x4*)(WT + (size_t)row * K + k0 + 8 * cc) = o; }
    asm volatile("s_waitcnt lgkmcnt(0)" ::: "memory");
}
constexpr int CV_IN = 16 * 69, CV_OUT = 16 * 32, CV_E = 16 * 256, CV_Q = 4 * 12, CV_KV = 2 * 16;
constexpr int CV_S = CV_IN + CV_OUT + CV_Q + CV_KV;
constexpr int CV_ALL = CV_S + 3 * CV_E;
__device__ __forceinline__ void convert_weights(const Params& p, const Ctx& c, int l, int lo, int hi, int widx, int nw) {
    LAS float* scr = (LAS float*)(c.lds + c.wave * 16384);
    for (int it = lo + widx; it < hi; it += nw) {
        int r = it;
        if (r < CV_IN) { transpose_item(p.w_in + (size_t)l * D * INW, D, INW, (bf16_t*)(p.ws + WS_WIN) + (size_t)l * INP * D, r, scr, c.lane); continue; } r -= CV_IN;
        if (r < CV_OUT) { transpose_item(p.w_out + (size_t)l * D * D, D, D, (bf16_t*)(p.ws + WS_WOUT) + (size_t)l * D * D, r, scr, c.lane); continue; } r -= CV_OUT;
        if (r < CV_Q) { transpose_item(p.mla_w_q + (size_t)l * 256 * 384, 256, 384, (bf16_t*)(p.ws + WS_WQT) + (size_t)l * 384 * 256, r, scr, c.lane); continue; } r -= CV_Q;
        if (r < CV_KV) { transpose_item(p.mla_w_kv + (size_t)l * 128 * 512, 128, 512, (bf16_t*)(p.ws + WS_WKVT) + (size_t)l * 512 * 128, r, scr, c.lane); continue; } r -= CV_KV;
        if (r < CV_E) { const int e = r / 256; transpose_item(p.exp_w_gate + (size_t)(l * NE + e) * D * DE, D, DE, (bf16_t*)(p.ws + WS_WGU) + (size_t)(l * NE + e) * 1024 * 1024, r % 256, scr, c.lane, 1); continue; } r -= CV_E;
        if (r < CV_E) { const int e = r / 256; transpose_item(p.exp_w_up + (size_t)(l * NE + e) * D * DE, D, DE, (bf16_t*)(p.ws + WS_WGU) + (size_t)(l * NE + e) * 1024 * 1024, r % 256, scr, c.lane, 2); continue; } r -= CV_E;
        { const int e = r / 256; transpose_item(p.exp_w_down + (size_t)(l * NE + e) * DE * D, DE, D, (bf16_t*)(p.ws + WS_WD) + (size_t)(l * NE + e) * 1024 * 512, r % 256, scr, c.lane); }
    }
}
__device__ __forceinline__ void phase_pro(const Params& p, const Ctx& c) {
    convert_weights(p, c, 0, 0, CV_S, c.gw, c.ngw);
    for (int i = c.bid * NTHREADS + c.tid; i < 2 * 2 * 2 * 8 * 64 * 64; i += c.nb * NTHREADS) {
        const int k = i & 63, j = (i >> 6) & 63, n = (i >> 12) & 7, g = (i >> 15) & 1, ld = i >> 16;
        const float* src = g ? p.lru_w_i : p.lru_w_a;
        ((bf16_t*)(p.ws + WS_LRUW))[i] = (bf16_t)f2bf(src[((size_t)(ld * 8 + n) * 64 + k) * 64 + j]);
    }
    for (int i = c.bid * NTHREADS + c.tid; i < 2 * 96 * D / 8; i += c.nb * NTHREADS) {
        const int l = i / (96 * D / 8), r = i % (96 * D / 8);
        *(u32x4*)((bf16_t*)(p.ws + WS_WIN) + (size_t)l * INP * D + (size_t)INW * D + (size_t)r * 8) = (u32x4){0u, 0u, 0u, 0u};
    }
    __syncthreads();
    LAS float* sv = (LAS float*)c.lds;
    LAS float* red = sv + 3 * D;
    for (int i = c.tid; i < 3 * D; i += NTHREADS) { const int r = i >> 10, k = i & 1023; sv[i] = siluf_(r < 2 ? p.c[r * D + k] : p.c_ctx[k]); }
    __syncthreads();
    float* mo = (float*)(p.ws + WS_MODP);
    for (int it = c.bid; it < 2 * 96; it += c.nb) {
        const int l = it / 96, n = (it % 96) * 64 + (c.tid & 63), kg = c.tid >> 6;
        const float* w = p.w_ada + ((size_t)l * D + kg * 128) * 6144 + n;
        float a0 = 0.f, a1 = 0.f, a2 = 0.f;
#pragma unroll 8
        for (int kk = 0; kk < 128; ++kk) { const float wv = w[(size_t)kk * 6144]; const int k = kg * 128 + kk; a0 += sv[k] * wv; a1 += sv[D + k] * wv; a2 += sv[2 * D + k] * wv; }
        red[(kg * 3 + 0) * 64 + (c.tid & 63)] = a0; red[(kg * 3 + 1) * 64 + (c.tid & 63)] = a1; red[(kg * 3 + 2) * 64 + (c.tid & 63)] = a2;
        __syncthreads();
        if (c.tid < 192) { const int r = c.tid >> 6, cc = c.tid & 63; float v = p.b_ada[l * 6144 + (it % 96) * 64 + cc];
#pragma unroll
            for (int g = 0; g < 8; ++g) v += red[(g * 3 + r) * 64 + cc];
            mo[(size_t)(l * 3 + r) * 6144 + (it % 96) * 64 + cc] = v; }
        __syncthreads();
    }
}

__device__ __forceinline__ void phase_n1(const Params& p, const Ctx& c, int l) {
    LAS float* sh = (LAS float*)c.lds;
    LAS float* sc = sh + 3 * D;
    load_mods(p, c, l, 0, sh); load_mods(p, c, l, 1, sc);
    __syncthreads();
    const float* g = p.g_norm + (size_t)(l * 4 + 0) * D;
    bf16_t* H = (bf16_t*)(p.ws + WS_H);
#define N1_LOAD(mm) do { const float* xr_ = xin_row(p, mm);        _Pragma("unroll") for (int j = 0; j < 4; ++j) vn[j] = *(const f32x4*)(xr_ + 4 * (c.lane + 64 * j)); } while (0)
    f32x4 vn[4];
    if (c.gw < M) N1_LOAD(c.gw);
#pragma unroll 1
    for (int m = c.gw; m < M; m += c.ngw) {
        const int b = m / LT, t = m - b * LT, r = t < CTX ? 2 : b;
        f32x4 v[4]; float ss = 0.f;
#pragma unroll
        for (int j = 0; j < 4; ++j) { v[j] = vn[j]; ss += v[j].x * v[j].x + v[j].y * v[j].y + v[j].z * v[j].z + v[j].w * v[j].w; }
        if (m + c.ngw < M) N1_LOAD(m + c.ngw);
        const float rstd = rsqrtf(wave_sum(ss) * (1.f / D) + 1e-6f);
#pragma unroll
        for (int j = 0; j < 4; ++j) {
            const int n = 4 * (c.lane + 64 * j);
            const f32x4 gg = *(const f32x4*)(g + n);
            float o[4];
#pragma unroll
            for (int e = 0; e < 4; ++e) o[e] = v[j][e] * rstd * gg[e] * (1.f + sc[r * D + n + e]) + sh[r * D + n + e];
            u32x2 w; w.x = pk2(o[0], o[1]); w.y = pk2(o[2], o[3]);
            *(u32x2*)(H + (size_t)m * D + n) = w;
        }
    }
}

template <int NJ, class Op>
__device__ __forceinline__ void wave_gemm_tile(const Op& op, int r0, int c0, int K, int lane) {
    const int fr = lane & 15, fq = lane >> 4;
    const bf16_t* ap[4]; const bf16_t* bp[NJ];
#pragma unroll
    for (int i = 0; i < 4; ++i) ap[i] = op.arow(r0 + 16 * i + fr) + 8 * fq;
#pragma unroll
    for (int j = 0; j < NJ; ++j) bp[j] = op.brow(c0 + 16 * j + fr) + 8 * fq;
    f32x4 acc[4][NJ];
#pragma unroll
    for (int i = 0; i < 4; ++i)
#pragma unroll
        for (int j = 0; j < NJ; ++j) acc[i][j] = (f32x4){0.f, 0.f, 0.f, 0.f};
    for (int k0 = 0; k0 < K; k0 += 32) {
        bf16x8 a[4], b[NJ];
#pragma unroll
        for (int i = 0; i < 4; ++i) a[i] = *(const bf16x8*)(ap[i] + k0);
#pragma unroll
        for (int j = 0; j < NJ; ++j) b[j] = *(const bf16x8*)(bp[j] + k0);
#pragma unroll
        for (int i = 0; i < 4; ++i)
#pragma unroll
            for (int j = 0; j < NJ; ++j) acc[i][j] = __builtin_amdgcn_mfma_f32_16x16x32_bf16(a[i], b[j], acc[i][j], 0, 0, 0);
    }
#pragma unroll
    for (int i = 0; i < 4; ++i)
#pragma unroll
        for (int j = 0; j < NJ; ++j)
#pragma unroll
            for (int e = 0; e < 4; ++e) op.store(r0 + 16 * i + 4 * fq + e, c0 + 16 * j + fr, acc[i][j][e]);
}

__device__ __forceinline__ void phase_g1(const Params& p, const Ctx& c, int l, bool deferred) {
    pg8::Gemm g{(const bf16_t*)(p.ws + WS_H), (const bf16_t*)(p.ws + WS_WIN) + (size_t)l * INP * D, M, INP, D};
    pg8::EpiBf16<0> E{(bf16_t*)(p.ws + WS_P), INP, nullptr, 0, 0, 1.f};
    if (c.nb == 256) { pg8::G1Order S{c.nb, c.bid, deferred}; pg8::gemm_phase<pg8::EpiBf16<0>, pg8::G1Order, true, true>(c.lds, g, S, E, c.tid); }
    else if (!deferred) { pg8::StaticOrder S; S.init(M, INP, c.nb, c.bid); pg8::gemm_phase<pg8::EpiBf16<0>, pg8::StaticOrder, true, true>(c.lds, g, S, E, c.tid); }
}
__device__ __forceinline__ void phase_o1(const Params& p, const Ctx& c, int l, bool last) {
    pg8::Gemm g{(const bf16_t*)(p.ws + WS_Y), (const bf16_t*)(p.ws + WS_WOUT) + (size_t)l * D * D, M, D, D};
    pg8::EpiBf16<0> E{(bf16_t*)(p.ws + WS_P), D, nullptr, 0, 0, 1.f};
    if (last) { pg8::LatentOrder4 S{c.nb, c.bid}; pg8::gemm_phase<pg8::EpiBf16<0>, pg8::LatentOrder4, true, true>(c.lds, g, S, E, c.tid); }
    else { pg8::StaticOrder S; S.init(M, D, c.nb, c.bid); pg8::gemm_phase<pg8::EpiBf16<0>, pg8::StaticOrder, true, true>(c.lds, g, S, E, c.tid);
        constexpr int FULL = (M / 256) * (D / 256) - 256;
        if (c.nb == 256 && c.bid >= FULL) { __syncthreads(); convert_weights(p, c, 0, CV_S, CV_ALL, (c.bid - FULL) * NWAVES + c.wave, (256 - FULL) * NWAVES); }
        else if (c.nb != 256) { __syncthreads(); convert_weights(p, c, 0, CV_S, CV_ALL, c.gw, c.ngw); } }
}

__device__ __forceinline__ void rope_cs(int fi, int pos, float& cs, float& sn) {
    const float ang = (float)pos * __builtin_amdgcn_exp2f(-(float)fi * 1.6609640474436813f); cs = __cosf(ang); sn = __sinf(ang); }
struct C1W { bf16x8 q[3][8]; };
__device__ __forceinline__ void c1_load_q(const Params& p, const Ctx& c, int l, C1W& W) {
    const bf16_t* WqT = (const bf16_t*)(p.ws + WS_WQT) + (size_t)l * 384 * 256; const int fr = c.lane & 15, fq = c.lane >> 4;
#pragma unroll
    for (int i = 0; i < 3; ++i)
#pragma unroll
        for (int ks = 0; ks < 8; ++ks) W.q[i][ks] = *(const bf16x8*)(WqT + (size_t)(48 * c.wave + 16 * i + fr) * 256 + ks * 32 + fq * 8);
}
template <int VAR = 0>
__device__ __forceinline__ void c1_compute(const Params& p, const Ctx& c, int l, const C1W& W, int b, int t0, LAS const unsigned char* aq, LAS const unsigned char* akv) {
    constexpr int PQ = 528, PKV = 272, ROWS = 66, RT = 5;
    bf16_t* Q = (bf16_t*)(p.ws + WS_Q); bf16_t* Kb = (bf16_t*)(p.ws + WS_K); bf16_t* Vb = (bf16_t*)(p.ws + WS_V);
    const bf16_t* WkvT = (const bf16_t*)(p.ws + WS_WKVT) + (size_t)l * 512 * 128;
    const int fr = c.lane & 15, fq = c.lane >> 4, w = c.wave, h = w >> 1;
    bf16x8 bkv[4][4];
    {
        f32x4 acc[3][RT];
#pragma unroll
        for (int i = 0; i < 3; ++i)
#pragma unroll
            for (int rt = 0; rt < RT; ++rt) acc[i][rt] = (f32x4){0.f, 0.f, 0.f, 0.f};
#pragma unroll
        for (int ks = 0; ks < 8; ++ks) {
            bf16x8 a[RT];
#pragma unroll
            for (int rt = 0; rt < RT; ++rt) a[rt] = *(LAS const bf16x8*)(aq + (rt * 16 + fr) * PQ + (ks * 32 + fq * 8) * 2);
#pragma unroll
            for (int i = 0; i < 3; ++i)
#pragma unroll
                for (int rt = 0; rt < RT; ++rt) { if (VAR & 2) { asm volatile("" :: "v"(a[rt]), "v"(W.q[i][ks])); } else acc[i][rt] = __builtin_amdgcn_mfma_f32_16x16x32_bf16(a[rt], W.q[i][ks], acc[i][rt], 0, 0, 0); }
        }
        __builtin_amdgcn_sched_barrier(0);
#pragma unroll
        for (int i = 0; i < 3; ++i) {
            const int d = (w & 1) * 48 + 16 * i + fr;
            const bool rope_tile = (w & 1) && i >= 1;
#pragma unroll
            for (int rt = 0; rt < RT; ++rt)
#pragma unroll
                for (int e = 0; e < 4; ++e) { const int r = 16 * rt + 4 * fq + e, t = t0 + r; float v = acc[i][rt][e];
                    if (rope_tile) { const float pv = dpp_f<0x128>(v);
                        if (t >= CTX) { const int sidx = t - CTX, pos = (i == 2) ? (sidx % GW) : (sidx / GW); float cs, sn; rope_cs(fr & 7, pos, cs, sn); v = fr < 8 ? v * cs - pv * sn : v * cs + pv * sn; } }
                    if (VAR & 1) { asm volatile("" :: "v"(v)); } else if (r < ROWS) Q[((size_t)(b * 4 + h) * LT + t) * 96 + d] = (bf16_t)f2bf(v * 0.14724444602590306f); }
        }
    }
    __builtin_amdgcn_sched_barrier(0);
#pragma unroll
    for (int i = 0; i < 4; ++i)
#pragma unroll
        for (int ks = 0; ks < 4; ++ks) bkv[i][ks] = *(const bf16x8*)(WkvT + (size_t)(64 * w + 16 * i + fr) * 128 + ks * 32 + fq * 8);
    {
        f32x4 acc[4][RT];
#pragma unroll
        for (int i = 0; i < 4; ++i)
#pragma unroll
            for (int rt = 0; rt < RT; ++rt) acc[i][rt] = (f32x4){0.f, 0.f, 0.f, 0.f};
#pragma unroll
        for (int ks = 0; ks < 4; ++ks) {
            bf16x8 a[RT];
#pragma unroll
            for (int rt = 0; rt < RT; ++rt) a[rt] = *(LAS const bf16x8*)(akv + (rt * 16 + fr) * PKV + (ks * 32 + fq * 8) * 2);
#pragma unroll
            for (int i = 0; i < 4; ++i)
#pragma unroll
                for (int rt = 0; rt < RT; ++rt) { if (VAR & 2) { asm volatile("" :: "v"(a[rt]), "v"(bkv[i][ks])); } else acc[i][rt] = __builtin_amdgcn_mfma_f32_16x16x32_bf16(a[rt], bkv[i][ks], acc[i][rt], 0, 0, 0); }
        }
#pragma unroll
        for (int i = 0; i < 4; ++i)
#pragma unroll
            for (int rt = 0; rt < RT; ++rt)
#pragma unroll
                for (int e = 0; e < 4; ++e) { const int r = 16 * rt + 4 * fq + e, t = t0 + r, d = 16 * i + fr; const bf16_t v = (bf16_t)f2bf(acc[i][rt][e]);
                    if (VAR & 1) { asm volatile("" :: "v"(v)); } else if (r < ROWS) { if (w & 1) Vb[((size_t)(b * 4 + h) * LT + t) * 64 + d] = v; else Kb[((size_t)(b * 4 + h) * LT + t) * 96 + d] = v; } }
    }
}
template <int VAR = 0>
__device__ __forceinline__ void phase_c1(const Params& p, const Ctx& c, int l) {
    constexpr int PQ = 528, PKV = 272, ROWS = 66;
    LAS unsigned char* aq = c.lds; LAS unsigned char* akv = c.lds + 80 * PQ;
    const bf16_t* P = (const bf16_t*)(p.ws + WS_P); bf16_t* Kb = (bf16_t*)(p.ws + WS_K);
    for (int g = c.bid; g < M / ROWS; g += c.nb) {
        const int m0 = g * ROWS, b = m0 / LT, t0 = m0 - b * LT;
        C1W W; c1_load_q(p, c, l, W);
        __syncthreads();
#pragma unroll 1
        for (int it = 0; it < 3; ++it) {
            const int r = it * 32 + (c.tid >> 4), q16 = c.tid & 15;
            if (r >= 80 || (VAR & 4)) continue;
            const bool real = r < ROWS; const int rr = real ? r : 0;
            const bf16_t* pr = P + (size_t)(m0 + rr) * INP;
            const u32x4 c0 = *(const u32x4*)(pr + OFF_CQ + q16 * 16), c1 = *(const u32x4*)(pr + OFF_CQ + q16 * 16 + 8), k0 = *(const u32x4*)(pr + OFF_CKV + q16 * 8);
            const unsigned krw = *(const unsigned*)(pr + OFF_KR + q16 * 2);
            float cv[16], kv[8];
            cv[0] = lo_bf(c0.x); cv[1] = hi_bf(c0.x); cv[2] = lo_bf(c0.y); cv[3] = hi_bf(c0.y); cv[4] = lo_bf(c0.z); cv[5] = hi_bf(c0.z); cv[6] = lo_bf(c0.w); cv[7] = hi_bf(c0.w);
            cv[8] = lo_bf(c1.x); cv[9] = hi_bf(c1.x); cv[10] = lo_bf(c1.y); cv[11] = hi_bf(c1.y); cv[12] = lo_bf(c1.z); cv[13] = hi_bf(c1.z); cv[14] = lo_bf(c1.w); cv[15] = hi_bf(c1.w);
            kv[0] = lo_bf(k0.x); kv[1] = hi_bf(k0.x); kv[2] = lo_bf(k0.y); kv[3] = hi_bf(k0.y); kv[4] = lo_bf(k0.z); kv[5] = hi_bf(k0.z); kv[6] = lo_bf(k0.w); kv[7] = hi_bf(k0.w);
            float s1 = 0.f, s2 = 0.f;
#pragma unroll
            for (int i = 0; i < 16; ++i) s1 += cv[i] * cv[i];
#pragma unroll
            for (int i = 0; i < 8; ++i) s2 += kv[i] * kv[i];
            s1 = row16_sum(s1); s2 = row16_sum(s2);
            const float r1 = real ? rsqrtf(s1 * (1.f / 256.f) + 1e-6f) : 0.f, r2 = real ? rsqrtf(s2 * (1.f / 128.f) + 1e-6f) : 0.f;
            const float* gq = p.mla_g_q + l * 256 + q16 * 16; const float* gk = p.mla_g_kv + l * 128 + q16 * 8;
            u32x4 o0, o1, o2;
            o0.x = pk2(cv[0] * r1 * gq[0], cv[1] * r1 * gq[1]); o0.y = pk2(cv[2] * r1 * gq[2], cv[3] * r1 * gq[3]); o0.z = pk2(cv[4] * r1 * gq[4], cv[5] * r1 * gq[5]); o0.w = pk2(cv[6] * r1 * gq[6], cv[7] * r1 * gq[7]);
            o1.x = pk2(cv[8] * r1 * gq[8], cv[9] * r1 * gq[9]); o1.y = pk2(cv[10] * r1 * gq[10], cv[11] * r1 * gq[11]); o1.z = pk2(cv[12] * r1 * gq[12], cv[13] * r1 * gq[13]); o1.w = pk2(cv[14] * r1 * gq[14], cv[15] * r1 * gq[15]);
            o2.x = pk2(kv[0] * r2 * gk[0], kv[1] * r2 * gk[1]); o2.y = pk2(kv[2] * r2 * gk[2], kv[3] * r2 * gk[3]); o2.z = pk2(kv[4] * r2 * gk[4], kv[5] * r2 * gk[5]); o2.w = pk2(kv[6] * r2 * gk[6], kv[7] * r2 * gk[7]);
            *(LAS u32x4*)(aq + r * PQ + q16 * 32) = o0; *(LAS u32x4*)(aq + r * PQ + q16 * 32 + 16) = o1; *(LAS u32x4*)(akv + r * PKV + q16 * 16) = o2;
            float z0 = lo_bf(krw), z1 = hi_bf(krw);
            const float y0 = __shfl_xor(z0, 4), y1 = __shfl_xor(z1, 4);
            const int t = t0 + r;
            if (t >= CTX) { const int sidx = t - CTX, pos = (q16 >> 3) ? (sidx % GW) : (sidx / GW); const int li0 = (2 * q16) & 15; const bool first = li0 < 8;
                float cs, sn; rope_cs(li0 & 7, pos, cs, sn); z0 = first ? z0 * cs - y0 * sn : z0 * cs + y0 * sn;
                rope_cs((li0 + 1) & 7, pos, cs, sn); z1 = first ? z1 * cs - y1 * sn : z1 * cs + y1 * sn; }
            const unsigned kw = pk2(z0, z1);
            if (real) {
#pragma unroll
                for (int h = 0; h < 4; ++h) *(unsigned*)(Kb + ((size_t)(b * 4 + h) * LT + t) * 96 + 64 + 2 * q16) = kw; }
        }
        __syncthreads();
        c1_compute<VAR>(p, c, l, W, b, t0, aq, akv);
    }
}

namespace lru {
typedef float f32x16 __attribute__((ext_vector_type(16)));
constexpr int PITCH = 1040;
__device__ __forceinline__ void load_uc(const Params& p, const Ctx& c, int l, int b, int ch, LAS unsigned char* ucb) {
    const int chn = c.tid, t0 = ch * CH, seq_lo = (ch < NCH_CTX) ? 0 : CTX, seq_hi = (ch < NCH_CTX) ? CTX : LT;
    const bf16_t* Pb = (const bf16_t*)(p.ws + WS_P) + (size_t)(b * LT) * INP + OFF_U + chn;
    const float w0 = p.conv_w[(l * 4 + 0) * LRU_W + chn], w1 = p.conv_w[(l * 4 + 1) * LRU_W + chn], w2 = p.conv_w[(l * 4 + 2) * LRU_W + chn], w3 = p.conv_w[(l * 4 + 3) * LRU_W + chn];
    const float cb = p.conv_b[l * LRU_W + chn];
    float u[CH + 3];
#pragma unroll
    for (int i = 0; i < CH + 3; ++i) { const int t = t0 - 1 + i, tc = min(max(t, seq_lo), seq_hi - 1); u[i] = bf2f(Pb[(size_t)tc * INP]); }
    if (t0 == seq_lo) u[0] = 0.f;
    if (t0 + CH == seq_hi) { u[CH + 1] = 0.f; u[CH + 2] = 0.f; }
#pragma unroll
    for (int i = 0; i < CH; ++i) *(LAS bf16_t*)(ucb + i * PITCH + chn * 2) = (bf16_t)f2bf(u[i] * w0 + u[i + 1] * w1 + u[i + 2] * w2 + u[i + 3] * w3 + cb);
}
struct WF { bf16x8 a[4], i[4]; };
__device__ __forceinline__ WF load_w(const Params& p, int l, int d, int n, int ct, int r32, int hi) {
    const bf16_t* wa = (const bf16_t*)(p.ws + WS_LRUW) + ((size_t)((((l * 2 + d) * 2 + 0) * 8 + n) * 64 + ct * 32 + r32)) * 64 + hi * 8;
    const bf16_t* wi = wa + (size_t)8 * 64 * 64;
    WF w;
#pragma unroll
    for (int ks = 0; ks < 4; ++ks) { w.a[ks] = *(const bf16x8*)(wa + ks * 16); w.i[ks] = *(const bf16x8*)(wi + ks * 16); }
    return w;
}
__device__ __forceinline__ void gates_mm(const WF& w, const bf16x8 (&af)[4], f32x16& za, f32x16& zi) {
    za = f32x16{}; zi = f32x16{};
#pragma unroll
    for (int ks = 0; ks < 4; ++ks) { za = __builtin_amdgcn_mfma_f32_32x32x16_bf16(af[ks], w.a[ks], za, 0, 0, 0); zi = __builtin_amdgcn_mfma_f32_32x32x16_bf16(af[ks], w.i[ks], zi, 0, 0, 0); }
}
__device__ __forceinline__ void gates_ew(const f32x16& za, const f32x16& zi, float bias_a, float bias_i, float lam, const float (&ucv)[16], float (&a)[16], float (&x)[16]) {
    const float ee = __builtin_amdgcn_exp2f(-1.4426950408889634f * lam);
    const float sp = ee * (1.f + ee * (-0.5f + ee * (0.33333333f - 0.25f * ee)));
#pragma unroll
    for (int r = 0; r < 16; ++r) { const float la = -8.f * sigmoidf_(za[r] + bias_a) * sp, y = 2.f * la;
        const float g2 = -y * (1.f + y * (0.5f + y * (0.16666667f + y * (0.041666667f + y * 0.0083333333f))));
        a[r] = __builtin_amdgcn_exp2f(1.4426950408889634f * la); x[r] = __builtin_amdgcn_sqrtf(g2) * sigmoidf_(zi[r] + bias_i) * ucv[r]; }
}
template <bool HS>
__device__ __forceinline__ float scan32(const float (&a)[16], const float (&x)[16], int d, int hi, float h0, float (&hs)[16], float& ap) {
    float As[4], Xs[4];
#pragma unroll
    for (int g = 0; g < 4; ++g) { float A = 1.f, X = 0.f;
#pragma unroll
        for (int e4 = 0; e4 < 4; ++e4) { const int r = 4 * g + (d == 0 ? e4 : 3 - e4); X = a[r] * X + x[r]; A *= a[r]; }
        As[g] = A; Xs[g] = X; }
    float Alo[4], Ahi[4], Xlo[4], Xhi[4];
#pragma unroll
    for (int g = 0; g < 4; ++g) {
        auto ra = __builtin_amdgcn_permlane32_swap(__float_as_uint(As[g]), __float_as_uint(As[g]), false, false);
        auto rx = __builtin_amdgcn_permlane32_swap(__float_as_uint(Xs[g]), __float_as_uint(Xs[g]), false, false);
        Alo[g] = __uint_as_float(ra[0]); Ahi[g] = __uint_as_float(ra[1]); Xlo[g] = __uint_as_float(rx[0]); Xhi[g] = __uint_as_float(rx[1]); }
    float h = h0, hin[4]; ap = 1.f;
#pragma unroll
    for (int s8 = 0; s8 < 8; ++s8) { const int sg = d == 0 ? s8 : 7 - s8, g = sg >> 1; const bool up = (sg & 1) != 0;
        const float A = up ? Ahi[g] : Alo[g], X = up ? Xhi[g] : Xlo[g];
        if (up == (hi != 0)) hin[g] = h;
        h = A * h + X; ap *= A; }
    if (HS) {
#pragma unroll
        for (int g = 0; g < 4; ++g) { float hh = hin[g];
#pragma unroll
            for (int e4 = 0; e4 < 4; ++e4) { const int r = 4 * g + (d == 0 ? e4 : 3 - e4); hh = a[r] * hh + x[r]; hs[r] = hh; } }
    }
    return h;
}
template <int MODE>
__device__ __forceinline__ void chunk(const Params& p, const Ctx& c, int l, int b, int ch, LAS const unsigned char* ucb, WF w) {
    const int n = c.wave, r32 = c.lane & 31, hi = c.lane >> 5;
    bf16x8 af[4];
#pragma unroll
    for (int ks = 0; ks < 4; ++ks) af[ks] = *(LAS const bf16x8*)(ucb + r32 * PITCH + (n * 64 + ks * 16 + hi * 8) * 2);
    constexpr int D0 = MODE == 0 ? 0 : 1, D1 = 1 - D0;
#pragma unroll 1
    for (int ct = 0; ct < 2; ++ct) {
        const int chn = n * 64 + ct * 32 + r32;
        float ucv[16], hr[16], a[16], x[16], ap; f32x16 za, zi;
#pragma unroll
        for (int r = 0; r < 16; ++r) ucv[r] = bf2f(*(LAS const bf16_t*)(ucb + (8 * (r >> 2) + 4 * hi + (r & 3)) * PITCH + chn * 2));
        float c0 = 0.f, c1 = 0.f;
        if (MODE == 1) { const float* cr = (const float*)(p.ws + WS_CARRY);
            c1 = cr[((size_t)((b * 2 + 1) * NCH + ch)) * LRU_W + chn]; c0 = cr[((size_t)((b * 2 + 0) * NCH + ch)) * LRU_W + chn]; }
        { const float bias_a = p.lru_b_a[(l * 2 + D0) * LRU_W + chn], bias_i = p.lru_b_i[(l * 2 + D0) * LRU_W + chn], lam = p.lru_lam[(l * 2 + D0) * LRU_W + chn];
          gates_mm(w, af, za, zi);
          w = load_w(p, l, D1, n, ct, r32, hi);
          __builtin_amdgcn_sched_barrier(0);
          gates_ew(za, zi, bias_a, bias_i, lam, ucv, a, x); }
        if (MODE == 0) { const float he = scan32<false>(a, x, D0, hi, 0.f, hr, ap);
            if (hi == 0) { float* ag = (float*)(p.ws + WS_AGG) + 2 * (((size_t)((b * 2 + D0) * NCH + ch)) * LRU_W + chn); ag[0] = ap; ag[1] = he; } }
        else (void)scan32<true>(a, x, D0, hi, c1, hr, ap);
        __builtin_amdgcn_sched_barrier(0);
        unsigned short gv[16];
        if (MODE == 1) {
            const char* gp = (const char*)((const bf16_t*)(p.ws + WS_P) + ((size_t)b * LT + ch * CH) * INP + OFF_G + n * 64 + ct * 32);
            const unsigned go = (unsigned)((4 * hi * INP + r32) * 2);
#pragma unroll
            for (int r = 0; r < 16; ++r) gv[r] = *(const bf16_t*)(gp + (size_t)(8 * (r >> 2) + (r & 3)) * INP * 2 + go);
        }
        { const float bias_a = p.lru_b_a[(l * 2 + D1) * LRU_W + chn], bias_i = p.lru_b_i[(l * 2 + D1) * LRU_W + chn], lam = p.lru_lam[(l * 2 + D1) * LRU_W + chn];
          gates_mm(w, af, za, zi);
          if (ct == 0) w = load_w(p, l, D0, n, 1, r32, hi);
          __builtin_amdgcn_sched_barrier(0);
          gates_ew(za, zi, bias_a, bias_i, lam, ucv, a, x); }
        if (MODE == 0) { float hs[16]; const float he = scan32<false>(a, x, D1, hi, 0.f, hs, ap);
            if (hi == 0) { float* ag = (float*)(p.ws + WS_AGG) + 2 * (((size_t)((b * 2 + D1) * NCH + ch)) * LRU_W + chn); ag[0] = ap; ag[1] = he; } }
        else {
            float hs[16];
            (void)scan32<true>(a, x, D1, hi, c0, hs, ap);
            char* yp = (char*)((bf16_t*)(p.ws + WS_Y) + ((size_t)b * LT + ch * CH) * D + 256 + n * 64 + ct * 32);
            const unsigned yo = (unsigned)((4 * hi * D + r32) * 2);
#pragma unroll
            for (int r = 0; r < 16; ++r) *(bf16_t*)(yp + (size_t)(8 * (r >> 2) + (r & 3)) * D * 2 + yo) = (bf16_t)f2bf((hr[r] + hs[r]) * gelu_tanh(bf2f(gv[r])));
        }
        __builtin_amdgcn_sched_barrier(0);
    }
}
}
__device__ __forceinline__ void phase_c2(const Params& p, const Ctx& c, int l) {
    constexpr int ND = 82;
    const bool split = c.nb == 256;
    if (split && c.bid < ND) { phase_g1(p, c, l, true); __syncthreads(); }
    else if (!split) { phase_g1(p, c, l, true); __syncthreads(); }
    const int first = split ? (c.bid < ND ? c.bid : ND + (c.bid - ND)) : c.bid;
    const int stride = split ? (c.bid < ND ? NB * NCH : c.nb - ND) : c.nb;
    for (int it = first; it < NB * NCH; it += stride) {
        const int b = it / NCH, ch = it % NCH;
        const lru::WF w0 = lru::load_w(p, l, 0, c.wave, 0, c.lane & 31, c.lane >> 5);
        __syncthreads();
        lru::load_uc(p, c, l, b, ch, c.lds);
        __syncthreads();
        lru::chunk<0>(p, c, l, b, ch, c.lds, w0);
    }
}
__device__ __forceinline__ void phase_c3(const Params& p, const Ctx& c) {
    LAS float* sA = (LAS float*)c.lds; LAS float* sE = sA + 512;
    const float* ag = (const float*)(p.ws + WS_AGG); float* cr = (float*)(p.ws + WS_CARRY);
    for (int u = c.nb - 1 - c.bid; u < 32; u += c.nb) {
        const int b = u >> 4, d = (u >> 3) & 1, chn = (u & 7) * 64 + c.lane, seg = c.wave;
        float aa[33], ee[33];
#pragma unroll
        for (int k = 0; k < 33; ++k) { const int s = seg * 33 + k, ch = d == 0 ? s : (s < NCH_CTX ? NCH_CTX - 1 - s : NCH - 1 - (s - NCH_CTX));
            const size_t idx = ((size_t)((b * 2 + d) * NCH + ch)) * LRU_W + chn; const f32x2 v = *(const f32x2*)(ag + 2 * idx); aa[k] = v.x; ee[k] = v.y; }
        float A = 1.f, E = 0.f;
#pragma unroll
        for (int k = 0; k < 33; ++k) { E = aa[k] * E + ee[k]; A *= aa[k]; }
        __syncthreads();
        sA[seg * 64 + c.lane] = A; sE[seg * 64 + c.lane] = E;
        __syncthreads();
        float st = 0.f;
        for (int s2 = 0; s2 < seg; ++s2) st = sA[s2 * 64 + c.lane] * st + sE[s2 * 64 + c.lane];
#pragma unroll
        for (int k = 0; k < 33; ++k) { const int s = seg * 33 + k, ch = d == 0 ? s : (s < NCH_CTX ? NCH_CTX - 1 - s : NCH - 1 - (s - NCH_CTX));
            const size_t idx = ((size_t)((b * 2 + d) * NCH + ch)) * LRU_W + chn; cr[idx] = st; st = aa[k] * st + ee[k]; }
    }
}
__device__ __forceinline__ void phase_c4(const Params& p, const Ctx& c, int l, bool last) {
    for (int k = 0; k * c.nb < NB * NCH; ++k) {
        const int it = (k < 2 || c.nb != 256) ? k * c.nb + c.bid : k * c.nb + (c.nb - 1 - c.bid);
        if (it >= NB * NCH) continue;
        const int b = it / NCH, ch = it % NCH;
        if (last && ch < NCH_CTX) continue;
        const lru::WF w0 = lru::load_w(p, l, 1, c.wave, 0, c.lane & 31, c.lane >> 5);
        __syncthreads();
        lru::load_uc(p, c, l, b, ch, c.lds);
        __syncthreads();
        lru::chunk<1>(p, c, l, b, ch, c.lds, w0);
    }
}

namespace mla {
typedef float f32x16 __attribute__((ext_vector_type(16)));
typedef short s16x4 __attribute__((ext_vector_type(4)));
constexpr int DQ = 96, DV = 64, KVB = 64;
constexpr float SCALE = 0.10206207261596575f, THR = 8.f;
constexpr int SHM_V = KVB * DV * 2  , SHM_K = KVB * 256  , SHM_ATTN = 3 * SHM_V + 3 * SHM_K + NWAVES * 64 * 4;
#define KSWZ(row, colB) ((row) * 256 + ((colB) ^ (((row) & 15) << 4)))
#define SBAR() __builtin_amdgcn_sched_barrier(0)
__device__ __forceinline__ int crow(int r, int hi) { return (r & 3) + 8 * (r >> 2) + 4 * hi; }
__device__ __forceinline__ unsigned cvtpk(float lo, float hi) { return ::pk2(lo, hi); }
__device__ __forceinline__ void finishSM(f32x16& p0, f32x16& p1, float alpha, float& l_reg, bf16x8& pa0, bf16x8& pa1, bf16x8& pa2, bf16x8& pa3) {
#pragma unroll
    for (int r = 0; r < 16; ++r) p1[r] = __builtin_amdgcn_exp2f(p1[r]);
    float ps, ps0 = 0, ps1 = 0, ps2 = 0, ps3 = 0;
#pragma unroll
    for (int r = 0; r < 16; r += 2) { ps0 += p0[r]; ps1 += p0[r + 1]; ps2 += p1[r]; ps3 += p1[r + 1]; }
    ps = (ps0 + ps1) + (ps2 + ps3);
    { auto rr = __builtin_amdgcn_permlane32_swap(__float_as_uint(ps), __float_as_uint(ps), false, false);
      ps = __uint_as_float(rr[0]) + __uint_as_float(rr[1]); }
    l_reg = l_reg * alpha + ps;
#define PK4(P, BASE, OUT) do { unsigned a0 = cvtpk(P[BASE + 0], P[BASE + 1]), a1 = cvtpk(P[BASE + 2], P[BASE + 3]);   \
    unsigned b0 = cvtpk(P[BASE + 4], P[BASE + 5]), b1 = cvtpk(P[BASE + 6], P[BASE + 7]);                              \
    auto r0 = __builtin_amdgcn_permlane32_swap(a0, b0, false, false); auto r1 = __builtin_amdgcn_permlane32_swap(a1, b1, false, false); \
    u32x4 w = {r0[0], r1[0], r0[1], r1[1]}; OUT = *reinterpret_cast<bf16x8*>(&w); } while (0)
    PK4(p0, 0, pa0); PK4(p0, 8, pa1); PK4(p1, 0, pa2); PK4(p1, 8, pa3);
#undef PK4
}
template <int VAR = 0>
__device__ __forceinline__ void qkt(f32x16& p0, f32x16& p1, LAS const unsigned char* Ks, const bf16x8* qr, int r32, int hi, float m_reg) {
#pragma unroll
    for (int r = 0; r < 16; ++r) { p0[r] = -m_reg; p1[r] = -m_reg; }
#pragma unroll
    for (int d0 = 0; d0 < DQ / 16; ++d0) { const int cb = (d0 * 16 + hi * 8) * 2;
        const bf16x8 b0 = *(LAS const bf16x8*)(Ks + KSWZ(r32, cb));
        const bf16x8 b1 = *(LAS const bf16x8*)(Ks + KSWZ(32 + r32, cb));
        if (VAR & 2) { asm volatile("" :: "v"(b0), "v"(b1)); }
        else { p0 = __builtin_amdgcn_mfma_f32_32x32x16_bf16(b0, qr[d0], p0, 0, 0, 0);
               p1 = __builtin_amdgcn_mfma_f32_32x32x16_bf16(b1, qr[d0], p1, 0, 0, 0); } }
}
__device__ __forceinline__ int v_st(int k, int cc) { const int kk = (k & ~0xC) | ((k & 4) << 1) | ((k & 8) >> 1); return ((kk >> 3) * 2 + (cc >> 5)) * 512 + ((kk & 7) * 32 + (cc & 31)) * 2; }
__device__ __forceinline__ int v_rd_base(int lane) { return ((lane & 3) << 3) | (((lane >> 2) & 3) << 6) | (((lane >> 4) & 1) << 5) | (((lane >> 5) & 1) << 8); }
constexpr int v_rd_off(int d0, int ks, int half) { return d0 * 512 + ks * 2048 + half * 1024; }
template <int OFF> __device__ __forceinline__ s16x4 tr_read(int vb) { return __builtin_amdgcn_ds_read_tr16_b64_v4i16((LAS s16x4*)(uintptr_t)(unsigned)(vb + OFF)); }
template <int D0, int VAR = 0> __device__ __forceinline__ void pv_one(f32x16& od, int vb, bf16x8 pa0, bf16x8 pa1, bf16x8 pa2, bf16x8 pa3) {
    const s16x4 l0 = tr_read<v_rd_off(D0, 0, 0)>(vb), h0 = tr_read<v_rd_off(D0, 0, 1)>(vb), l1 = tr_read<v_rd_off(D0, 1, 0)>(vb), h1 = tr_read<v_rd_off(D0, 1, 1)>(vb);
    const s16x4 l2 = tr_read<v_rd_off(D0, 2, 0)>(vb), h2 = tr_read<v_rd_off(D0, 2, 1)>(vb), l3 = tr_read<v_rd_off(D0, 3, 0)>(vb), h3 = tr_read<v_rd_off(D0, 3, 1)>(vb);
#define PKV(L, H) (bf16x8){L[0], L[1], L[2], L[3], H[0], H[1], H[2], H[3]}
    if (VAR & 2) { asm volatile("" :: "v"(l0), "v"(h0), "v"(l1), "v"(h1), "v"(l2), "v"(h2), "v"(l3), "v"(h3), "v"(pa0), "v"(pa1), "v"(pa2), "v"(pa3)); return; }
    od = __builtin_amdgcn_mfma_f32_32x32x16_bf16(pa0, PKV(l0, h0), od, 0, 0, 0);
    od = __builtin_amdgcn_mfma_f32_32x32x16_bf16(pa1, PKV(l1, h1), od, 0, 0, 0);
    od = __builtin_amdgcn_mfma_f32_32x32x16_bf16(pa2, PKV(l2, h2), od, 0, 0, 0);
    od = __builtin_amdgcn_mfma_f32_32x32x16_bf16(pa3, PKV(l3, h3), od, 0, 0, 0);
#undef PKV
}
template <int VAR = 0> __device__ __forceinline__ void pv_all(f32x16* o, int vb, bf16x8 pa0, bf16x8 pa1, bf16x8 pa2, bf16x8 pa3) { pv_one<0, VAR>(o[0], vb, pa0, pa1, pa2, pa3); pv_one<1, VAR>(o[1], vb, pa0, pa1, pa2, pa3); }

constexpr float THR2 = THR * 1.4426950408889634f;
__device__ __forceinline__ void decideSM(f32x16& p0, f32x16& p1, float& m_reg, float& alpha) {
    float pmax = p0[0], pmx1 = p1[0];
#pragma unroll
    for (int r = 1; r < 16; ++r) { pmax = fmaxf(pmax, p0[r]); pmx1 = fmaxf(pmx1, p1[r]); }
    pmax = fmaxf(pmax, pmx1);
    { auto rr = __builtin_amdgcn_permlane32_swap(__float_as_uint(pmax), __float_as_uint(pmax), false, false);
      pmax = fmaxf(__uint_as_float(rr[0]), __uint_as_float(rr[1])); }
    if (__builtin_expect(__all(pmax <= THR2), 1)) { alpha = 1.f; }
    else { const float d = fmaxf(pmax, 0.f);
        alpha = __builtin_amdgcn_exp2f(-d); m_reg += d;
#pragma unroll
        for (int r = 0; r < 16; ++r) { p0[r] -= d; p1[r] -= d; } }
}
__device__ __forceinline__ void scaleexp(f32x16& p0, f32x16& p1) {
#pragma unroll
    for (int r = 0; r < 16; ++r) p0[r] = __builtin_amdgcn_exp2f(p0[r]);
}
template <int VAR = 0>
__device__ __forceinline__ void pv_sm(f32x16* o, int vb, bf16x8 pa0, bf16x8 pa1, bf16x8 pa2, bf16x8 pa3, f32x16& q0, f32x16& q1) {
    pv_one<0, VAR>(o[0], vb, pa0, pa1, pa2, pa3);
    if (!(VAR & 1)) {
#pragma unroll
        for (int r = 0; r < 16; ++r) q0[r] = __builtin_amdgcn_exp2f(q0[r]); }
    pv_one<1, VAR>(o[1], vb, pa0, pa1, pa2, pa3);
}
__device__ __forceinline__ void fake_finish(const f32x16& p0, const f32x16& p1, bf16x8& pa0, bf16x8& pa1, bf16x8& pa2, bf16x8& pa3) {
    u32x4 w0 = {__float_as_uint(p0[0]), __float_as_uint(p0[1]), __float_as_uint(p0[2]), __float_as_uint(p0[3])}; pa0 = *reinterpret_cast<bf16x8*>(&w0);
    u32x4 w1 = {__float_as_uint(p0[4]), __float_as_uint(p0[5]), __float_as_uint(p0[6]), __float_as_uint(p0[7])}; pa1 = *reinterpret_cast<bf16x8*>(&w1);
    u32x4 w2 = {__float_as_uint(p1[0]), __float_as_uint(p1[1]), __float_as_uint(p1[2]), __float_as_uint(p1[3])}; pa2 = *reinterpret_cast<bf16x8*>(&w2);
    u32x4 w3 = {__float_as_uint(p1[4]), __float_as_uint(p1[5]), __float_as_uint(p1[6]), __float_as_uint(p1[7])}; pa3 = *reinterpret_cast<bf16x8*>(&w3);
}

template <int VAR = 0>
__device__ __forceinline__ void attn_unit(const bf16_t* __restrict__ Qb, const bf16_t* __restrict__ Kh, const bf16_t* __restrict__ Vh, bf16_t* __restrict__ Ob, int seq, LAS unsigned char* lds, int tid) {
    const int wid = tid >> 6, lane = tid & 63, r32 = lane & 31, hi = lane >> 5;
    LAS unsigned char* V_lds = lds; LAS unsigned char* K_lds = lds + 3 * SHM_V;
    LAS float* wsf = (LAS float*)(lds + 3 * SHM_V + 3 * SHM_K) + wid * 64; LAS float* li_l = wsf; LAS float* al_l = wsf + 32;
    float m_reg = 0.f, l_reg = 0; f32x16 o[2] = {}; bf16x8 qr[6];
    const bf16_t* Qw = Qb + (size_t)(wid * 32 + r32) * DQ + hi * 8;
#pragma unroll
    for (int d0 = 0; d0 < 6; ++d0) qr[d0] = *(const bf16x8*)(Qw + d0 * 16);
    const int vrow = tid >> 3, vcol = (tid & 7) * 8, vst = v_st(vrow, vcol);
    const int k0row = tid / 12, k0ch = tid % 12, k1row = (512 + tid) / 12, k1ch = (512 + tid) % 12;
    const int kst0 = KSWZ(k0row, k0ch * 16), kst1 = KSWZ(k1row, k1ch * 16);
    const bool has1 = tid < 256;
    const int vb0 = (int)(uintptr_t)V_lds + v_rd_base(lane);
    unsigned vsrc, ksrc[2];
    { const int ov = wid * 1024 + lane * 16, sbt = ov >> 9, kk = (sbt >> 1) * 8 + ((ov >> 6) & 7), k = (kk & ~0xC) | ((kk & 4) << 1) | ((kk & 8) >> 1), cc = (sbt & 1) * 32 + ((ov >> 4) & 3) * 8;
      vsrc = (unsigned)(k * DV + cc) * 2u;
#pragma unroll
      for (int i = 0; i < 2; ++i) { const int ok = wid * 2048 + i * 1024 + lane * 16, row = ok >> 8, slot = (ok >> 4) & 15, ch = slot ^ (row & 15); ksrc[i] = (unsigned)(row * DQ + (ch < 12 ? ch : 0) * 8) * 2u; } }
#define SLOAD(i, kk) do { } while (0)
#define SWRITE(b, i) do { } while (0)
#define DMA(b, kk) do { if (VAR & 4) break; \
    __builtin_amdgcn_global_load_lds((const unsigned*)((const char*)(Vh + (size_t)(kk) * DV) + vsrc), (LAS unsigned*)(V_lds + (b) * SHM_V + wid * 1024), 16, 0, 0); \
    __builtin_amdgcn_global_load_lds((const unsigned*)((const char*)(Kh + (size_t)(kk) * DQ) + ksrc[0]), (LAS unsigned*)(K_lds + (b) * SHM_K + wid * 2048), 16, 0, 0); \
    __builtin_amdgcn_global_load_lds((const unsigned*)((const char*)(Kh + (size_t)(kk) * DQ) + ksrc[1]), (LAS unsigned*)(K_lds + (b) * SHM_K + wid * 2048 + 1024), 16, 0, 0); } while (0)
#define RESC(a) do { if (__any((a) < 1.f)) { if (hi == 0) al_l[r32] = (a); asm volatile("s_waitcnt lgkmcnt(0)" ::: "memory"); \
    _Pragma("unroll") for (int d = 0; d < 2; ++d) _Pragma("unroll") for (int r = 0; r < 16; ++r) o[d][r] *= al_l[crow(r, hi)]; } } while (0)
    f32x16 pA0, pA1, pB0, pB1; float alA, alB; bf16x8 pa0, pa1, pa2, pa3; const int NT = seq / KVB;
    DMA(0, 0); DMA(1, KVB); __syncthreads();
    qkt<VAR>(pA0, pA1, K_lds, qr, r32, hi, m_reg); if (VAR & 1) { alA = 1.f; } else { decideSM(pA0, pA1, m_reg, alA); scaleexp(pA0, pA1); }
    int bq = 1, bp = 0, bw = 2;
    constexpr bool ordB = false;
#define FIN(P0, P1, AL) do { if (VAR & 1) fake_finish(P0, P1, pa0, pa1, pa2, pa3); else finishSM(P0, P1, AL, l_reg, pa0, pa1, pa2, pa3); } while (0)
#define DEC(P0, P1, MC, AL) do { if (VAR & 1) { AL = 1.f; } else decideSM(P0, P1, m_reg, AL); } while (0)
#define STEP(PX0, PX1, ALX, PY0, PY1, ALY, LOADSTMT, WSLOT) do { \
        if (!ordB) { LOADSTMT; qkt<VAR>(PX0, PX1, K_lds + bq * SHM_K, qr, r32, hi, m_reg); FIN(PY0, PY1, ALY); \
            DEC(PX0, PX1, 0, ALX); \
            pv_sm<VAR>(o, vb0 + bp * SHM_V, pa0, pa1, pa2, pa3, PX0, PX1); } \
        else { SBAR(); FIN(PY0, PY1, ALY); SBAR(); \
            pv_all<VAR>(o, vb0 + bp * SHM_V, pa0, pa1, pa2, pa3); SBAR(); \
            LOADSTMT; qkt<VAR>(PX0, PX1, K_lds + bq * SHM_K, qr, r32, hi, m_reg); SBAR(); \
            DEC(PX0, PX1, 0, ALX); if (!(VAR & 1)) scaleexp(PX0, PX1); SBAR(); } \
        SWRITE(bw, WSLOT); RESC(ALX); if (!(VAR & 8)) __syncthreads(); \
        { const int t3 = bp; bp = bq; bq = bw; bw = t3; } } while (0)
    for (int t = 1; t + 1 < NT; t += 2) {
        STEP(pB0, pB1, alB, pA0, pA1, alA, DMA(bw, (t + 1) * KVB), 0);
        STEP(pA0, pA1, alA, pB0, pB1, alB, DMA(bw, (t + 2) * KVB), 1);
    }
#undef STEP
    qkt<VAR>(pB0, pB1, K_lds + bq * SHM_K, qr, r32, hi, m_reg);
    if (VAR & 1) fake_finish(pA0, pA1, pa0, pa1, pa2, pa3); else finishSM(pA0, pA1, alA, l_reg, pa0, pa1, pa2, pa3);
    if (VAR & 1) { alB = 1.f; } else decideSM(pB0, pB1, m_reg, alB);
    pv_sm<VAR>(o, vb0 + bp * SHM_V, pa0, pa1, pa2, pa3, pB0, pB1);
    RESC(alB);
    if (VAR & 1) fake_finish(pB0, pB1, pa0, pa1, pa2, pa3); else finishSM(pB0, pB1, alB, l_reg, pa0, pa1, pa2, pa3);
    pv_all<VAR>(o, vb0 + bq * SHM_V, pa0, pa1, pa2, pa3);
    if (hi == 0) li_l[r32] = l_reg;
    asm volatile("s_waitcnt lgkmcnt(0)" ::: "memory");
    float rli[16];
#pragma unroll
    for (int r = 0; r < 16; ++r) rli[r] = __builtin_amdgcn_rcpf(li_l[crow(r, hi)]);
    bf16_t* Ow = Ob + (size_t)(wid * 32) * D;
#pragma unroll
    for (int r = 0; r < 16; ++r) { const int orow = crow(r, hi);
#pragma unroll
        for (int d0 = 0; d0 < 2; ++d0) Ow[(size_t)orow * D + d0 * 32 + r32] = (bf16_t)f2bf(o[d0][r] * rli[r]); }
    __syncthreads();
#undef SLOAD
#undef SWRITE
#undef DMA
#undef RESC
#undef FIN
#undef DEC
}
#undef KSWZ
#undef SBAR
}
namespace nab {
using mla::f32x16;
constexpr int SHM_V = 8192, SHM_K = 16384, RING = 3 * (SHM_V + SHM_K);
constexpr int LDS_NEED = RING + NWAVES * 256 + 2048;
constexpr float SCALE = 0.125f, C = SCALE * 1.4426950408889634f;
#define KSWZ(row, colB) ((row) * 256 + ((colB) ^ (((row) & 15) << 4)))
#define SBAR() __builtin_amdgcn_sched_barrier(0)
__device__ __forceinline__ void qkt64(f32x16& p0, f32x16& p1, LAS const unsigned char* Ks, const bf16x8* qr, int r32, int hi, float m_reg) {
#pragma unroll
    for (int r = 0; r < 16; ++r) { p0[r] = -m_reg; p1[r] = -m_reg; }
#pragma unroll
    for (int d0 = 0; d0 < 4; ++d0) { const int cb = (d0 * 16 + hi * 8) * 2;
        const bf16x8 b0 = *(LAS const bf16x8*)(Ks + KSWZ(r32, cb));
        const bf16x8 b1 = *(LAS const bf16x8*)(Ks + KSWZ(32 + r32, cb));
        p0 = __builtin_amdgcn_mfma_f32_32x32x16_bf16(b0, qr[d0], p0, 0, 0, 0);
        p1 = __builtin_amdgcn_mfma_f32_32x32x16_bf16(b1, qr[d0], p1, 0, 0, 0); }
}
__device__ __forceinline__ void unit(const bf16_t* __restrict__ Pb, int h, bool lat, int r0, LAS const float* rp, bf16_t* __restrict__ Yb, LAS unsigned char* lds, int tid) {
    const int wid = __builtin_amdgcn_readfirstlane(tid >> 6), lane = tid & 63, r32 = lane & 31, hi = lane >> 5;
    LAS unsigned char* V_lds = lds; LAS unsigned char* K_lds = lds + 3 * SHM_V;
    LAS float* wsf = (LAS float*)(lds + RING) + wid * 64; LAS float* li_l = wsf; LAS float* al_l = wsf + 32;
    const int r = r0 + (wid >> 1), qc = (wid & 1) * 32 + r32, cs = min(max(qc - 8, 0), 48);
    const int qtok = lat ? CTX + r * GW + qc : wid * 32 + r32;
    const int rs_me = min(max(r - 4, 0), 120), rs_min = min(max(r0 - 4, 0), 120), nrows = lat ? (min(max(r0 + 3 - 4, 0), 120) + 8 - rs_min) : 0;
    const int NT = (4 + nrows + 1) & ~1;
    float m_reg = 0.f, l_reg = 0; f32x16 o[2] = {}; bf16x8 qr[4];
    { const bf16_t* Qw = Pb + (size_t)qtok * INP + OFF_QA + h * 64 + hi * 8;
#pragma unroll
      for (int d0 = 0; d0 < 4; ++d0) { const u32x4 w = *(const u32x4*)(Qw + d0 * 16);
          u32x4 o4; o4.x = pk2(lo_bf(w.x) * C, hi_bf(w.x) * C); o4.y = pk2(lo_bf(w.y) * C, hi_bf(w.y) * C); o4.z = pk2(lo_bf(w.z) * C, hi_bf(w.z) * C); o4.w = pk2(lo_bf(w.w) * C, hi_bf(w.w) * C);
          qr[d0] = *reinterpret_cast<bf16x8*>(&o4); } }
    const int srow = tid >> 3, sch = tid & 7, vst = mla::v_st(srow, sch * 8), kst = KSWZ(srow, sch * 16);
    const unsigned svo = (unsigned)((srow * INP + h * 64 + sch * 8) * 2);
    const int vb0 = (int)(uintptr_t)V_lds + mla::v_rd_base(lane);
    struct { bf16x8 v, k; } sr_[2];
#define TOK0(t) ((t) < 4 ? (t) * 64 : CTX + min(rs_min + (t) - 4, 127) * GW)
#define SLOAD(i, t) do { const char* kb = (const char*)(Pb + (size_t)TOK0(t) * INP); sr_[i].k = *(const bf16x8*)(kb + svo + OFF_KA * 2); sr_[i].v = *(const bf16x8*)(kb + svo + OFF_VA * 2); } while (0)
#define SWRITE(b, i) do { *(LAS bf16x8*)(V_lds + (b) * SHM_V + vst) = sr_[i].v; *(LAS bf16x8*)(K_lds + (b) * SHM_K + kst) = sr_[i].k; } while (0)
#define RESC(a) do { if (__any((a) < 1.f)) { if (hi == 0) al_l[r32] = (a); asm volatile("s_waitcnt lgkmcnt(0)" ::: "memory"); \
    _Pragma("unroll") for (int d = 0; d < 2; ++d) _Pragma("unroll") for (int rr = 0; rr < 16; ++rr) o[d][rr] *= al_l[mla::crow(rr, hi)]; } } while (0)
#define MASK(P0, P1, t) do { if ((t) >= 4) { const int kr = rs_min + (t) - 4; \
        if ((unsigned)(kr - rs_me) < 8u) { int qcl = qc; asm volatile("" : "+v"(qcl)); const int csl = min(max(qcl - 8, 0), 48); \
            LAS const float* rl_ = rp + (kr - r + 7) * 32 + (4 * hi - qcl + 15); const int rel = 4 * hi - csl; \
            _Pragma("unroll") for (int rr = 0; rr < 16; ++rr) { const int k0c = mla::crow(rr, 0); \
                P0[rr] = ((unsigned)(rel + k0c) < 16u) ? P0[rr] + rl_[k0c] : -1e30f; \
                P1[rr] = ((unsigned)(rel + k0c + 32) < 16u) ? P1[rr] + rl_[k0c + 32] : -1e30f; } } \
        else { _Pragma("unroll") for (int rr = 0; rr < 16; ++rr) { P0[rr] = -1e30f; P1[rr] = -1e30f; } } } } while (0)
    f32x16 pA0, pA1, pB0, pB1; float alA, alB; bf16x8 pa0, pa1, pa2, pa3;
    SLOAD(0, 0); SLOAD(1, 1); SWRITE(0, 0); SWRITE(1, 1); __syncthreads();
    SLOAD(0, 2);
    qkt64(pA0, pA1, K_lds, qr, r32, hi, m_reg); mla::decideSM(pA0, pA1, m_reg, alA); mla::scaleexp(pA0, pA1);
    int bq = 1, bp = 0, bw = 2;
#define STEP(PX0, PX1, ALX, PY0, PY1, ALY, t, LOADSTMT, WSLOT) do { \
        qkt64(PX0, PX1, K_lds + bq * SHM_K, qr, r32, hi, m_reg); mla::finishSM(PY0, PY1, ALY, l_reg, pa0, pa1, pa2, pa3); \
        LOADSTMT; MASK(PX0, PX1, t); mla::decideSM(PX0, PX1, m_reg, ALX); \
        mla::pv_sm<0>(o, vb0 + bp * SHM_V, pa0, pa1, pa2, pa3, PX0, PX1); \
        SWRITE(bw, WSLOT); RESC(ALX); __syncthreads(); \
        { const int t3 = bp; bp = bq; bq = bw; bw = t3; } } while (0)
    for (int t = 1; t + 1 < NT; t += 2) {
        STEP(pB0, pB1, alB, pA0, pA1, alA, t, SLOAD(1, t + 2), 0);
        STEP(pA0, pA1, alA, pB0, pB1, alB, t + 1, if (t + 3 < NT) SLOAD(0, t + 3), 1);
    }
#undef STEP
    qkt64(pB0, pB1, K_lds + bq * SHM_K, qr, r32, hi, m_reg);
    mla::finishSM(pA0, pA1, alA, l_reg, pa0, pa1, pa2, pa3);
    MASK(pB0, pB1, NT - 1); mla::decideSM(pB0, pB1, m_reg, alB);
    mla::pv_sm<0>(o, vb0 + bp * SHM_V, pa0, pa1, pa2, pa3, pB0, pB1);
    RESC(alB);
    mla::finishSM(pB0, pB1, alB, l_reg, pa0, pa1, pa2, pa3);
    mla::pv_all<0>(o, vb0 + bq * SHM_V, pa0, pa1, pa2, pa3);
    if (hi == 0) li_l[r32] = l_reg;
    asm volatile("s_waitcnt lgkmcnt(0)" ::: "memory");
    const int qtok0 = lat ? CTX + r * GW + (wid & 1) * 32 : wid * 32;
    bf16_t* Ow = Yb + (size_t)qtok0 * D + h * 64;
#pragma unroll
    for (int rr = 0; rr < 16; ++rr) { const int orow = mla::crow(rr, hi); const float rl = __builtin_amdgcn_rcpf(li_l[orow]);
#pragma unroll
        for (int d0 = 0; d0 < 2; ++d0) Ow[(size_t)orow * D + d0 * 32 + r32] = (bf16_t)f2bf(o[d0][rr] * rl); }
    __syncthreads();
#undef TOK0
#undef SLOAD
#undef SWRITE
#undef RESC
#undef MASK
}
#undef KSWZ
#undef SBAR
}
__device__ __forceinline__ void phase_a1b(const Params& p, const Ctx& c, int l, bool last) {
    const bf16_t* P = (const bf16_t*)(p.ws + WS_P); bf16_t* Y = (bf16_t*)(p.ws + WS_Y);
    LAS float* rp = (LAS float*)(c.lds + nab::RING + NWAVES * 256);
    const int n_units = 256 + (last ? 0 : 8);
    for (int u = c.bid; u < n_units; u += c.nb) {
        const int bh = u & 7, b = bh >> 2, h = bh & 3; const bool lat = u < 256;
        __syncthreads();
        if (lat) { const float* rpb = p.na_rpb + (size_t)((l * 4 + h) * 15) * 31;
            for (int i = c.tid; i < 15 * 32; i += NTHREADS) { const int dr = i >> 5, dc = i & 31; rp[i] = dc < 31 ? rpb[dr * 31 + dc] * 1.4426950408889634f : 0.f; } }
        __syncthreads();
        nab::unit(P + (size_t)(b * LT) * INP, h, lat, lat ? (u >> 3) * 4 : 0, rp, Y + (size_t)(b * LT) * D, c.lds, c.tid);
    }
}

template <int VAR = 0>
__device__ __forceinline__ void phase_a2(const Params& p, const Ctx& c, bool last) {
    const bf16_t* Q = (const bf16_t*)(p.ws + WS_Q); const bf16_t* Kb = (const bf16_t*)(p.ws + WS_K); const bf16_t* Vb = (const bf16_t*)(p.ws + WS_V);
    bf16_t* Y = (bf16_t*)(p.ws + WS_Y);
    const int n_units = 256 + (last ? 0 : 8);
    for (int u = c.bid; u < n_units; u += c.nb) {
        const int bh = u & 7, b = bh >> 2, h = bh & 3;
        const int t0 = u < 256 ? CTX + (u >> 3) * 256 : 0, seq = u < 256 ? LT : CTX;
        const size_t hb = (size_t)(b * 4 + h) * LT;
        mla::attn_unit<VAR>(Q + (hb + t0) * 96, Kb + hb * 96, Vb + hb * 64, Y + (size_t)(b * LT + t0) * D + 768 + h * 64, seq, c.lds, c.tid);
    }
}

__device__ __forceinline__ void phase_o2(const Params& p, const Ctx& c, int l, bool last) {
    LAS float* gt = (LAS float*)c.lds;
    LAS float* sh = gt + 3 * D;
    LAS float* sc = sh + 3 * D;
    LAS int* lcnt = (LAS int*)(sc + 3 * D);
    load_mods(p, c, l, 2, gt); load_mods(p, c, l, 3, sh); load_mods(p, c, l, 4, sc);
    if (c.tid < NE) lcnt[c.tid] = 0;
    LAS float* rwl = (LAS float*)(c.lds + 40960);
    for (int i = c.tid; i < D * 4; i += NTHREADS) { const int n = i >> 2, q4 = i & 3; *(LAS f32x4*)(rwl + ((n & 3) * 256 + (n >> 2)) * 20 + 4 * q4) = *(const f32x4*)(p.router_w + (size_t)n * 16 + 4 * q4); }
    LAS float* g1 = (LAS float*)(c.lds + 122880); LAS float* g2 = g1 + D;
    for (int i = c.tid; i < D; i += NTHREADS) { g1[i] = p.g_norm[(size_t)(l * 4 + 1) * D + i]; g2[i] = p.g_norm[(size_t)(l * 4 + 2) * D + i]; }
    __syncthreads();
    const bf16_t* YO = (const bf16_t*)(p.ws + WS_P); bf16_t* H = (bf16_t*)(p.ws + WS_H);
    int* RE = (int*)(p.ws + WS_RE); float* RW = (float*)(p.ws + WS_RW);
    const int nrow = last ? NB * S : M;
#define O2_ROW(i) (last ? ((i) / S) * LT + CTX + ((i) % S) : (i))
#define O2_LOAD(i) do { const int m_ = O2_ROW(i); const bf16_t* yr_ = YO + (size_t)m_ * D; \
        _Pragma("unroll") for (int j = 0; j < 4; ++j) ywn[j] = *(const u32x2*)((const char*)yr_ + (unsigned)(8 * (c.lane + 64 * j))); \
        if (l == 0) { const float* xr_ = xin_row(p, m_); _Pragma("unroll") for (int j = 0; j < 4; ++j) xvn[j] = *(const f32x4*)((const char*)xr_ + (unsigned)(16 * (c.lane + 64 * j))); } \
        else { const bf16_t* xr_ = xb_row(p, m_); _Pragma("unroll") for (int j = 0; j < 4; ++j) xbn[j] = *(const u32x2*)((const char*)xr_ + (unsigned)(8 * (c.lane + 64 * j))); } } while (0)
    u32x2 ywn[4], xbn[4]; f32x4 xvn[4];
    if (c.gw < nrow) O2_LOAD(c.gw);
#pragma unroll 1
    for (int ri = c.gw; ri < nrow; ri += c.ngw) {
        const int m = O2_ROW(ri);
        const int b = m / LT, t = m - b * LT, r = t < CTX ? 2 : b;
        f32x4 y[4], xv[4]; float ss = 0.f;
#pragma unroll
        for (int j = 0; j < 4; ++j) { y[j] = bf4(ywn[j]); xv[j] = (l == 0) ? xvn[j] : bf4(xbn[j]);
            ss += y[j].x * y[j].x + y[j].y * y[j].y + y[j].z * y[j].z + y[j].w * y[j].w; }
        if (ri + c.ngw < nrow) O2_LOAD(ri + c.ngw);
        const float rstd = rsqrtf(wave_sum(ss) * (1.f / D) + 1e-6f);
        float s2 = 0.f;
#pragma unroll
        for (int j = 0; j < 4; ++j) { const int n = 4 * (c.lane + 64 * j); const f32x4 gg = *(LAS const f32x4*)(g1 + n);
#pragma unroll
            for (int e = 0; e < 4; ++e) { xv[j][e] += gt[r * D + n + e] * (y[j][e] * rstd * gg[e]); s2 += xv[j][e] * xv[j][e]; }
            if (t < CTX) *(f32x4*)((char*)xc_row(p, m) + (unsigned)(n * 4)) = xv[j]; else *(u32x2*)((char*)xb_row(p, m) + (unsigned)(n * 2)) = pk4(xv[j]); }
        const float rstd2 = rsqrtf(wave_sum(s2) * (1.f / D) + 1e-6f);
        float lg[16];
#pragma unroll
        for (int e = 0; e < 16; ++e) lg[e] = 0.f;
#pragma unroll
        for (int j = 0; j < 4; ++j) { const int n = 4 * (c.lane + 64 * j); const f32x4 gg = *(LAS const f32x4*)(g2 + n);
            float o[4];
#pragma unroll
            for (int e = 0; e < 4; ++e) { o[e] = xv[j][e] * rstd2 * gg[e] * (1.f + sc[r * D + n + e]) + sh[r * D + n + e];
                LAS const f32x4* rw = (LAS const f32x4*)(rwl + (e * 256 + c.lane + 64 * j) * 20);
#pragma unroll
                for (int q4 = 0; q4 < 4; ++q4) { const f32x4 w = rw[q4]; lg[4 * q4] += o[e] * w.x; lg[4 * q4 + 1] += o[e] * w.y; lg[4 * q4 + 2] += o[e] * w.z; lg[4 * q4 + 3] += o[e] * w.w; } }
            u32x2 w; w.x = pk2(o[0], o[1]); w.y = pk2(o[2], o[3]);
            *(u32x2*)(H + (size_t)m * D + n) = w; }
        float aff[16], sel[16];
#pragma unroll
        for (int e = 0; e < 16; ++e) { aff[e] = sigmoidf_(wave_sum(lg[e])); sel[e] = aff[e] + p.router_b[e]; }
        float bv = -INFINITY, ba0 = 0.f, ba1 = 0.f; int bi0 = 0, bi1 = 0;
#pragma unroll
        for (int g = 0; g < 4; ++g) {
            float m1 = sel[4 * g], a1 = aff[4 * g]; int i0 = 0;
#pragma unroll
            for (int i = 1; i < 4; ++i) if (sel[4 * g + i] > m1) { m1 = sel[4 * g + i]; a1 = aff[4 * g + i]; i0 = i; }
            float m2 = -INFINITY, a2 = 0.f; int i1 = 0;
#pragma unroll
            for (int i = 0; i < 4; ++i) if (i != i0 && sel[4 * g + i] > m2) { m2 = sel[4 * g + i]; a2 = aff[4 * g + i]; i1 = i; }
            const float gs = m1 + m2;
            if (gs > bv) { bv = gs; bi0 = 4 * g + i0; bi1 = 4 * g + i1; ba0 = a1; ba1 = a2; }
        }
        if (c.lane == 0) {
            const float inv = 1.f / (ba0 + ba1);
            const int lp0 = __hip_atomic_fetch_add(lcnt + bi0, 1, __ATOMIC_RELAXED, __HIP_MEMORY_SCOPE_WORKGROUP);
            const int lp1 = __hip_atomic_fetch_add(lcnt + bi1, 1, __ATOMIC_RELAXED, __HIP_MEMORY_SCOPE_WORKGROUP);
            RE[2 * m] = bi0 + 16 * lp0; RE[2 * m + 1] = bi1 + 16 * lp1; RW[2 * m] = ba0 * inv; RW[2 * m + 1] = ba1 * inv;
        }
    }
    __syncthreads();
    if (c.tid < NE) ((int*)(p.ws + WS_PERM))[c.bid * NE + c.tid] = lcnt[c.tid];
}

__device__ __forceinline__ void phase_r2(const Params& p, const Ctx& c, int l, bool last) {
    LAS int* cntT = (LAS int*)c.lds;
    LAS int* map = (LAS int*)(c.lds + 131072); LAS int* nE = map + 768; LAS int* ebase = nE + NE;
    const int* BC = (const int*)(p.ws + WS_PERM); const int* RE = (const int*)(p.ws + WS_RE);
    for (int i = c.tid; i < c.nb * NE; i += NTHREADS) cntT[i] = BC[i];
    for (int i = c.tid; i < 768; i += NTHREADS) map[i] = -1;
    __syncthreads();
    if (c.tid < NE) { int acc = 0; for (int b2 = 0; b2 < c.nb; ++b2) { const int v = cntT[b2 * NE + c.tid]; cntT[b2 * NE + c.tid] = acc; acc += v; } nE[c.tid] = acc; }
    __syncthreads();
    if (c.tid < NE) { int acc = 0; for (int e = 0; e < c.tid; ++e) acc += (nE[e] + 255) >> 8; ebase[c.tid] = acc * 256;
        if (c.bid == 0) ((unsigned*)(p.ws + WS_CTL))[CW_CNT + l * 64 + c.tid] = (unsigned)nE[c.tid]; }
    __syncthreads();
    const int rt0 = c.bid >> 2, rt1 = (c.nb + c.bid) >> 2, rt2 = (2 * c.nb + c.bid) >> 2, ngw = c.nb * NWAVES;
    for (int m = c.tid; m < M; m += NTHREADS) {
        const int b = m / LT, t = m - b * LT;
        if (last && t < CTX) continue;
        const int blk = ((last ? b * S + (t - CTX) : m) % ngw) >> 3;
#pragma unroll
        for (int k = 0; k < 2; ++k) { const int info = RE[2 * m + k], e = info & 15, pos = ebase[e] + cntT[blk * NE + e] + (info >> 4), rt = pos >> 8;
            if (rt == rt0) map[pos & 255] = 2 * m + k; else if (rt == rt1) map[256 + (pos & 255)] = 2 * m + k; else if (rt == rt2) map[512 + (pos & 255)] = 2 * m + k; }
    }
    __syncthreads();
    if ((c.bid & 3) == 0) { int tot = 0; for (int e = 0; e < NE; ++e) tot += (nE[e] + 255) >> 8;
        int* S2P = (int*)(p.ws + WS_S2P);
        for (int i = c.tid; i < 768; i += NTHREADS) { const int rt = (i < 256) ? rt0 : (i < 512 ? rt1 : rt2); if (rt < tot) S2P[rt * 256 + (i & 255)] = map[i]; } }
    pg8::Gemm g{(const bf16_t*)(p.ws + WS_H), (const bf16_t*)(p.ws + WS_WGU) + (size_t)l * NE * 1024 * 1024, 0, 0, D};
    pg8::MoeOrderL S{nE, c.nb, c.bid};
    pg8::EpiSwiGLU E{(bf16_t*)(p.ws + WS_Q)};
    pg8::MoeGatherA GA{map};
    pg8::gemm_phase<pg8::EpiSwiGLU, pg8::MoeOrderL, true, true, pg8::MoeGatherA>(c.lds, g, S, E, c.tid, GA);
    if (l == 0) {
        int tot = 0; for (int e = 0; e < NE; ++e) tot += (nE[e] + 255) >> 8;
        const int nfull = min(max(4 * tot - 2 * c.nb, 0), c.nb);
        __syncthreads();
        if (c.bid >= nfull) convert_weights(p, c, 1, 0, CV_ALL, (c.bid - nfull) * NWAVES + c.wave, (c.nb - nfull) * NWAVES);
        else if (nfull == c.nb) convert_weights(p, c, 1, 0, CV_ALL, c.gw, c.ngw);
    }
}
__device__ __forceinline__ void phase_r3(const Params& p, const Ctx& c, int l) {
    pg8::Gemm g{(const bf16_t*)(p.ws + WS_Q), (const bf16_t*)(p.ws + WS_WD) + (size_t)l * NE * 1024 * 512, 0, 0, DE};
    pg8::MoeOrder S{(const unsigned*)(p.ws + WS_CTL) + CW_CNT + l * 64, c.nb, c.bid};
    pg8::EpiScatter E{(bf16_t*)(p.ws + WS_P), (const int*)(p.ws + WS_S2P), (const float*)(p.ws + WS_RW), M};
    pg8::gemm_phase<pg8::EpiScatter, pg8::MoeOrder, true, true>(c.lds, g, S, E, c.tid);
}

__device__ __forceinline__ void phase_f(const Params& p, const Ctx& c, int l, bool last) {
    LAS float* gt = (LAS float*)c.lds; LAS float* sh = gt + 3 * D; LAS float* sc = sh + 3 * D;
    load_mods(p, c, l, 5, gt);
    if (!last) { load_mods(p, c, l + 1, 0, sh); load_mods(p, c, l + 1, 1, sc); }
    __syncthreads();
    const float* g0n = p.g_norm + (size_t)((l + 1) * 4 + 0) * D; bf16_t* H = (bf16_t*)(p.ws + WS_H);
    const float* g3 = p.g_norm + (size_t)(l * 4 + 3) * D;
    const bf16_t* F0 = (const bf16_t*)(p.ws + WS_P); const bf16_t* F1 = F0 + (size_t)M * D;
    const int nrow = last ? NB * S : M;
#define F_ROW(i) (last ? ((i) / S) * LT + CTX + ((i) % S) : (i))
#define F_LOAD(i) do { const int m_ = F_ROW(i); const bool cx_ = (m_ % LT) < CTX; \
        _Pragma("unroll") for (int j = 0; j < 4; ++j) { const int n_ = 4 * (c.lane + 64 * j); fan[j] = *(const u32x2*)(F0 + (size_t)m_ * D + n_); fbn[j] = *(const u32x2*)(F1 + (size_t)m_ * D + n_); } \
        if (cx_) { const float* xr_ = xc_row(p, m_); _Pragma("unroll") for (int j = 0; j < 4; ++j) xn[j] = *(const f32x4*)(xr_ + 4 * (c.lane + 64 * j)); } \
        else { const bf16_t* xr_ = xb_row(p, m_); _Pragma("unroll") for (int j = 0; j < 4; ++j) xbn[j] = *(const u32x2*)(xr_ + 4 * (c.lane + 64 * j)); } } while (0)
    u32x2 fan[4], fbn[4], xbn[4]; f32x4 xn[4];
    if (c.gw < nrow) F_LOAD(c.gw);
#pragma unroll 1
    for (int ri = c.gw; ri < nrow; ri += c.ngw) {
        const int m = F_ROW(ri);
        const int b = m / LT, t = m - b * LT, r = t < CTX ? 2 : b;
        float f[16]; float ss = 0.f; f32x4 xc[4];
#pragma unroll
        for (int j = 0; j < 4; ++j) {
            const u32x2 a = fan[j], bb = fbn[j]; xc[j] = (t < CTX) ? xn[j] : bf4(xbn[j]);
            f[4 * j] = lo_bf(a.x) + lo_bf(bb.x); f[4 * j + 1] = hi_bf(a.x) + hi_bf(bb.x); f[4 * j + 2] = lo_bf(a.y) + lo_bf(bb.y); f[4 * j + 3] = hi_bf(a.y) + hi_bf(bb.y);
#pragma unroll
            for (int e = 0; e < 4; ++e) ss += f[4 * j + e] * f[4 * j + e]; }
        if (ri + c.ngw < nrow) F_LOAD(ri + c.ngw);
        const float rstd = rsqrtf(wave_sum(ss) * (1.f / D) + 1e-6f);
        float s2 = 0.f;
#pragma unroll
        for (int j = 0; j < 4; ++j) { const int n = 4 * (c.lane + 64 * j); const f32x4 gg = *(const f32x4*)(g3 + n); f32x4 xv = xc[j];
#pragma unroll
            for (int e = 0; e < 4; ++e) { xv[e] += gt[r * D + n + e] * (f[4 * j + e] * rstd * gg[e]); f[4 * j + e] = xv[e]; s2 += xv[e] * xv[e]; }
            if (last) *(f32x4*)(out_row(p, m) + n) = xv; else if (t < CTX) *(f32x4*)(xc_row(p, m) + n) = xv; else *(u32x2*)(xb_row(p, m) + n) = pk4(xv); }
        if (!last) {
            const float rstd2 = rsqrtf(wave_sum(s2) * (1.f / D) + 1e-6f);
#pragma unroll
            for (int j = 0; j < 4; ++j) { const int n = 4 * (c.lane + 64 * j); const f32x4 gg = *(const f32x4*)(g0n + n); float o[4];
#pragma unroll
                for (int e = 0; e < 4; ++e) o[e] = f[4 * j + e] * rstd2 * gg[e] * (1.f + sc[r * D + n + e]) + sh[r * D + n + e];
                u32x2 w; w.x = pk2(o[0], o[1]); w.y = pk2(o[2], o[3]);
                *(u32x2*)(H + (size_t)m * D + n) = w; }
        }
    }
}

__device__ __forceinline__ int lane_id() { int l; asm volatile("v_mbcnt_lo_u32_b32 %0, -1, 0\n\tv_mbcnt_hi_u32_b32 %0, -1, %0" : "=v"(l)); return l; }
__global__ void __launch_bounds__(NTHREADS, 2) fwd_kernel(Params p_unused) {
    extern __shared__ __attribute__((aligned(16))) unsigned char lds_raw[];
    const int wave = __builtin_amdgcn_readfirstlane((int)threadIdx.x >> 6);
    LAS unsigned char* lds = (LAS unsigned char*)lds_raw;
    volatile LAS unsigned* misc = (volatile LAS unsigned*)(lds + LDS_BYTES - 64);
#define TID() (wave * 64 + lane_id())
#define GP_(T, i) (T*)(__attribute__((address_space(1))) T*)kp_[i]
#define KARG(q) const __attribute__((address_space(4))) unsigned long long* kp_ = (const __attribute__((address_space(4))) unsigned long long*)__builtin_amdgcn_kernarg_segment_ptr(); asm volatile("" : "+s"(kp_)); \
    Params q; q.x = GP_(const float, 0); q.c = GP_(const float, 1); q.ctx = GP_(const float, 2); q.c_ctx = GP_(const float, 3); q.w_ada = GP_(const float, 4); q.b_ada = GP_(const float, 5); \
    q.g_norm = GP_(const float, 6); q.w_in = GP_(const float, 7); q.w_out = GP_(const float, 8); q.na_rpb = GP_(const float, 9); q.conv_w = GP_(const float, 10); q.conv_b = GP_(const float, 11); \
    q.lru_w_a = GP_(const float, 12); q.lru_b_a = GP_(const float, 13); q.lru_w_i = GP_(const float, 14); q.lru_b_i = GP_(const float, 15); q.lru_lam = GP_(const float, 16); q.mla_g_q = GP_(const float, 17); \
    q.mla_w_q = GP_(const float, 18); q.mla_g_kv = GP_(const float, 19); q.mla_w_kv = GP_(const float, 20); q.router_w = GP_(const float, 21); q.router_b = GP_(const float, 22); \
    q.exp_w_gate = GP_(const float, 23); q.exp_w_up = GP_(const float, 24); q.exp_w_down = GP_(const float, 25); q.out = GP_(float, 26); q.ws = GP_(unsigned char, 27); q.ph_lo = 0; q.ph_hi = 0
    { const int t = TID(); if (t < 16) misc[t] = 0u; }
    __syncthreads();
    { KARG(q); (void)xcd_barrier_post((unsigned*)(q.ws + WS_CTL) + CW_BAR, misc, TID()); }
#define GBAR() do { KARG(q); XcdBarrier b_; b_.bar = (unsigned*)(q.ws + WS_CTL) + CW_BAR; b_.x = xb_xcc_id(); b_.st = misc; xcd_barrier(b_, TID()); } while (0)
#ifndef PROBE_MASK
#define PROBE_MASK 0
#endif
#ifndef PROBE_VAR
#define PROBE_VAR 0
#endif
#ifndef PROBE_C1
#define PROBE_C1 0
#endif
#define RP(bit, stmt) do { stmt; if ((PROBE_MASK >> (bit)) & 1) { GBAR(); stmt; } } while (0)
#define PH(call) do { KARG(q); Ctx cc; cc.lds = lds; cc.wave = wave; cc.lane = lane_id(); cc.tid = wave * 64 + cc.lane; \
        cc.bid = blockIdx.x; cc.nb = gridDim.x; cc.gw = cc.bid * NWAVES + wave; cc.ngw = cc.nb * NWAVES; call; } while (0)
    RP(0, PH(phase_pro(q, cc))); GBAR();
#define LAYER(l, last) do { \
        if ((l) == 0) { RP(1, PH(phase_n1(q, cc, l))); GBAR(); } \
        RP(2, PH(phase_g1(q, cc, l, false))); GBAR(); \
        RP(4, PH(phase_c2(q, cc, l))); GBAR(); \
        RP(6, PH(phase_c3(q, cc))); __syncthreads(); if (PROBE_C1) { PH(phase_c1<PROBE_C1>(q, cc, l)); GBAR(); } RP(3, PH(phase_c1(q, cc, l))); __syncthreads(); RP(5, PH(phase_a1b(q, cc, l, last))); GBAR(); \
        RP(7, PH(phase_c4(q, cc, l, last))); __syncthreads(); if (PROBE_VAR) { PH(phase_a2<PROBE_VAR>(q, cc, last)); GBAR(); } RP(8, PH(phase_a2(q, cc, last))); GBAR(); \
        RP(9, PH(phase_o1(q, cc, l, last))); GBAR(); \
        PH(phase_o2(q, cc, l, last)); if (((PROBE_MASK >> 13) & 1) && (l) == 0) { GBAR(); PH(phase_o2(q, cc, l, last)); } GBAR(); \
        RP(11, PH(phase_r2(q, cc, l, last))); GBAR(); \
        RP(12, PH(phase_r3(q, cc, l))); GBAR(); \
        PH(phase_f(q, cc, l, last)); } while (0)
    LAYER(0, false); GBAR();
    LAYER(1, true);
#undef LAYER
#undef PH
#undef RP
#undef GBAR
#undef TID
#undef KARG
#undef GP_
}

#ifdef DBG_PHASE
__global__ void __launch_bounds__(NTHREADS, 2) dbg_kernel(Params p, int l) {
    extern __shared__ __attribute__((aligned(16))) unsigned char lds_raw[];
    Ctx cc; cc.lds = (LAS unsigned char*)lds_raw; cc.wave = __builtin_amdgcn_readfirstlane((int)threadIdx.x >> 6); cc.lane = threadIdx.x & 63; cc.tid = threadIdx.x;
    cc.bid = blockIdx.x; cc.nb = gridDim.x; cc.gw = cc.bid * NWAVES + cc.wave; cc.ngw = cc.nb * NWAVES;
    DBG_PHASE;
}
#endif
#define MAIN_KERNEL fwd_kernel

extern "C" void kernel_launch(void* const* d_in, const int* in_sizes, int n_in, void* d_out, int out_size, void* d_ws, size_t ws_size, hipStream_t stream) {
    static int grid = 0;
    if (grid == 0) {
        if (n_in != 26 || out_size != NB * S * D || ws_size < WS_END) { fprintf(stderr, "kernel_launch: unexpected shapes (n_in %d out %d ws %zu)\n", n_in, out_size, ws_size); grid = -1; return; }
        int dev = 0, cus = 0, per_cu = 0;
        hipGetDevice(&dev);
        hipDeviceGetAttribute(&cus, hipDeviceAttributeMultiprocessorCount, dev);
        hipFuncSetAttribute((const void*)fwd_kernel, hipFuncAttributeMaxDynamicSharedMemorySize, LDS_BYTES);
        hipOccupancyMaxActiveBlocksPerMultiprocessor(&per_cu, (const void*)MAIN_KERNEL, NTHREADS, LDS_BYTES);
        (void)hipGetLastError();
        if (per_cu < 1) { fprintf(stderr, "kernel_launch: occupancy query says %d blocks per CU\n", per_cu); grid = -1; return; }
        if (cus < 256) { fprintf(stderr, "kernel_launch: this build's unit orders assume a 256-workgroup grid (one per CU of a 256-CU device); the device reports %d CUs\n", cus); grid = -1; return; }
        grid = 256;
    }
    if (grid < 0) return;
    hipMemsetAsync((char*)d_ws + WS_CTL, 0, CTL_BYTES, stream);
    Params p{};
    const float** pp = (const float**)&p;
    for (int i = 0; i < 26; ++i) pp[i] = (const float*)d_in[i];
    p.out = (float*)d_out; p.ws = (unsigned char*)d_ws;
    void* args[] = {&p};
    hipLaunchCooperativeKernel((const void*)fwd_kernel, dim3(grid), dim3(NTHREADS), args, LDS_BYTES, stream);
}
```

```cpp
#include <hip/hip_runtime.h>
#include <cstdio>
#include <cstdint>


#define LAS __attribute__((address_space(3)))
typedef unsigned short bf16_t;
typedef short bf16x8 __attribute__((ext_vector_type(8)));
typedef float f32x4 __attribute__((ext_vector_type(4)));
typedef float f32x2 __attribute__((ext_vector_type(2)));
typedef unsigned u32x4 __attribute__((ext_vector_type(4)));
typedef unsigned u32x2 __attribute__((ext_vector_type(2)));

constexpr int D = 1024, NB = 2, S = 8192, CTX = 256, LT = CTX + S, M = NB * LT;
constexpr int GW = 64;
constexpr int INW = 2208, INP = 2304;
constexpr int OFF_QA = 0, OFF_KA = 256, OFF_VA = 512, OFF_U = 768, OFF_G = 1280, OFF_CQ = 1792, OFF_CKV = 2048, OFF_KR = 2176;
constexpr int LRU_W = 512;
constexpr int CH = 32, NCH = LT / CH, NCH_CTX = CTX / CH;
constexpr int NE = 16, DE = 512;
constexpr int NTHREADS = 512, NWAVES = 8;
constexpr int LDS_BYTES = 147456;

constexpr size_t MiB = 1u << 20;
constexpr size_t WS_CTL = 0, CTL_BYTES = 1 * MiB;
constexpr size_t WS_MODP = 1 * MiB;
constexpr size_t WS_WIN = 4 * MiB;
constexpr size_t WS_WOUT = 13 * MiB;
constexpr size_t WS_WGU = 17 * MiB;
constexpr size_t WS_WD = 81 * MiB;
constexpr size_t WS_XC = 113 * MiB;
constexpr size_t WS_RE = 115 * MiB;
constexpr size_t WS_RW = WS_RE + 256 * 1024;
constexpr size_t WS_PERM = WS_RW + 256 * 1024;
constexpr size_t WS_S2P = 117 * MiB;
constexpr size_t WS_LRUW = 117 * MiB + 512 * 1024;
constexpr size_t WS_WQT = 118 * MiB;
constexpr size_t WS_WKVT = 118 * MiB + 512 * 1024;
constexpr size_t WS_AGG = 119 * MiB;
constexpr size_t WS_CARRY = 1 * MiB + 256 * 1024;
constexpr size_t WS_XB = 301 * MiB;
constexpr size_t WS_H = 125 * MiB;
constexpr size_t WS_P = 158 * MiB;
constexpr size_t WS_Q = 233 * MiB;
constexpr size_t WS_K = 246 * MiB;
constexpr size_t WS_V = 259 * MiB;
constexpr size_t WS_Y = 268 * MiB;
constexpr size_t WS_END = 333 * MiB;
constexpr int CW_CNT = 64;
constexpr int CW_BAR = 4096;

__device__ __forceinline__ float bf2f(bf16_t v) { return __uint_as_float(((unsigned)v) << 16); }
typedef __bf16 bf16x2_hw __attribute__((ext_vector_type(2)));
typedef float f32x2_hw __attribute__((ext_vector_type(2)));
__device__ __forceinline__ unsigned pk2(float lo, float hi) { const f32x2_hw v = {lo, hi}; return __builtin_bit_cast(unsigned, __builtin_convertvector(v, bf16x2_hw)); }
__device__ __forceinline__ unsigned f2bf(float f) { return pk2(f, 0.f) & 0xffffu; }
__device__ __forceinline__ float lo_bf(unsigned w) { return __uint_as_float(w << 16); }
__device__ __forceinline__ float hi_bf(unsigned w) { return __uint_as_float(w & 0xffff0000u); }
template <int CTRL> __device__ __forceinline__ float dpp_f(float v) { return __builtin_bit_cast(float, __builtin_amdgcn_update_dpp(0, __builtin_bit_cast(int, v), CTRL, 0xF, 0xF, true)); }
__device__ __forceinline__ float row16_sum(float v) {
    v += dpp_f<0xB1>(v);
    v += dpp_f<0x4E>(v);
    v += dpp_f<0x141>(v);
    v += dpp_f<0x140>(v);
    return v;
}
__device__ __forceinline__ float wave_sum(float v) {
    v = row16_sum(v);
    { auto r = __builtin_amdgcn_permlane16_swap(__float_as_uint(v), __float_as_uint(v), false, false); v = __uint_as_float(r[0]) + __uint_as_float(r[1]); }
    { auto r = __builtin_amdgcn_permlane32_swap(__float_as_uint(v), __float_as_uint(v), false, false); v = __uint_as_float(r[0]) + __uint_as_float(r[1]); }
    return v;
}
__device__ __forceinline__ float sigmoidf_(float x) { return __builtin_amdgcn_rcpf(1.f + __builtin_amdgcn_exp2f(-1.4426950408889634f * x)); }
__device__ __forceinline__ float siluf_(float x) { return x * sigmoidf_(x); }
__device__ __forceinline__ float gelu_tanh(float x) { return x * sigmoidf_(1.5957691216057308f * (x + 0.044715f * x * x * x)); }

struct Params {
    const float *x, *c, *ctx, *c_ctx, *w_ada, *b_ada, *g_norm, *w_in, *w_out, *na_rpb, *conv_w, *conv_b,
        *lru_w_a, *lru_b_a, *lru_w_i, *lru_b_i, *lru_lam, *mla_g_q, *mla_w_q, *mla_g_kv, *mla_w_kv,
        *router_w, *router_b, *exp_w_gate, *exp_w_up, *exp_w_down;
    float* out; unsigned char* ws; int ph_lo, ph_hi;
};

struct Ctx {
    int tid, lane, wave, bid, nb, gw, ngw;
    LAS unsigned char* lds;
};

__device__ __forceinline__ const float* xin_row(const Params& p, int m) {
    const int b = m / LT, t = m - b * LT;
    return t < CTX ? p.ctx + (size_t)(b * CTX + t) * D : p.x + (size_t)(b * S + t - CTX) * D;
}
__device__ __forceinline__ float* xc_row(const Params& p, int m) { const int b = m / LT, t = m - b * LT; return (float*)(p.ws + WS_XC) + (size_t)(b * CTX + t) * D; }
__device__ __forceinline__ bf16_t* xb_row(const Params& p, int m) { const int b = m / LT, t = m - b * LT; return (bf16_t*)(p.ws + WS_XB) + (size_t)(b * S + t - CTX) * D; }
__device__ __forceinline__ float* out_row(const Params& p, int m) { const int b = m / LT, t = m - b * LT; return p.out + (size_t)(b * S + t - CTX) * D; }
__device__ __forceinline__ f32x4 bf4(u32x2 w) { return (f32x4){lo_bf(w.x), hi_bf(w.x), lo_bf(w.y), hi_bf(w.y)}; }
__device__ __forceinline__ u32x2 pk4(f32x4 v) { u32x2 w; w.x = pk2(v.x, v.y); w.y = pk2(v.z, v.w); return w; }
__device__ __forceinline__ void load_mods(const Params& p, const Ctx& c, int l, int j, LAS float* dst) {
    const float* mp = (const float*)(p.ws + WS_MODP);
    for (int idx = c.tid; idx < 3 * D; idx += NTHREADS) {
        const int r = idx >> 10, n = idx & 1023;
        dst[idx] = mp[(size_t)(l * 3 + r) * 6144 + j * D + n];
    }
}

#define XB_TMO      128
#define XB_XCNT(j)  (256  + 64 * (j))
#define XB_XSUB(j)  (1280 + 64 * (j))
#define XB_XGEN(j)  (2304 + 64 * (j))
#define XB_TOP      3328
#define XB_TOPGEN   3392
#define XCD_BAR_WORDS 3456
#define XB_SPIN_CAP (1u << 18)
__device__ __forceinline__ unsigned xb_ld(unsigned* p)              { return __hip_atomic_load(p, __ATOMIC_RELAXED, __HIP_MEMORY_SCOPE_AGENT); }
__device__ __forceinline__ unsigned xb_add(unsigned* p, unsigned v) { return __hip_atomic_fetch_add(p, v, __ATOMIC_RELAXED, __HIP_MEMORY_SCOPE_AGENT); }
__device__ __forceinline__ unsigned xb_xcc_id() { return (unsigned)__builtin_amdgcn_s_getreg((3 << 11) | 20) & 0xFu; }
#define XB_SPIN(cond, bar) do { unsigned _sp = 0; while (cond) { __builtin_amdgcn_s_sleep(1); \
    if ((++_sp & 255u) == 0u) { if (xb_ld(&(bar)[XB_TMO])) break; if (_sp > XB_SPIN_CAP) { atomicAdd(&(bar)[XB_TMO], 1u); break; } } } } while (0)
struct XcdBarrier { unsigned* bar; unsigned x; volatile LAS unsigned* st; };
__device__ __forceinline__ XcdBarrier xcd_barrier_post(unsigned* bar, volatile LAS unsigned* st, int tid) {
    XcdBarrier b; b.bar = bar; b.x = xb_xcc_id(); b.st = st;
    if (tid == 0) (void)xb_add(&bar[XB_XCNT(b.x)], 1u);
    return b;
}
__device__ __forceinline__ void xcd_barrier_complete(unsigned* bar, unsigned x, unsigned& nloc, unsigned& nx) {
    const unsigned G = gridDim.x * gridDim.y * gridDim.z;
    unsigned sum, cnt, mine, sp = 0u;
    for (;;) {
        sum = 0u; cnt = 0u; mine = 0u;
#pragma unroll
        for (unsigned j = 0; j < 16; ++j) { const unsigned c = xb_ld(&bar[XB_XCNT(j)]); sum += c; cnt += (c > 0u) ? 1u : 0u; mine = (j == x) ? c : mine; }
        if (sum == G) break;
        __builtin_amdgcn_s_sleep(1);
        if ((++sp & 255u) == 0u) { if (xb_ld(&bar[XB_TMO])) break; if (sp > XB_SPIN_CAP) { atomicAdd(&bar[XB_TMO], 1u); break; } }
    }
    nloc = mine > 0u ? mine : 1u; nx = cnt > 0u ? cnt : 1u;
}
__device__ __forceinline__ void xcd_barrier(const XcdBarrier& b, int tid) {
    asm volatile("s_waitcnt vmcnt(0)" ::: "memory");
    __syncthreads();
    if (tid == 0) {
        unsigned* bar = b.bar;
        __builtin_amdgcn_s_waitcnt(0);
        unsigned nloc = b.st[0], nx = b.st[1];
        if (nloc == 0u) { xcd_barrier_complete(bar, b.x, nloc, nx); b.st[0] = nloc; b.st[1] = nx; }
        const unsigned old = xb_add(&bar[XB_XSUB(b.x)], 1u);
        const unsigned gen = old / nloc;
        if (old + 1u == (gen + 1u) * nloc) {
            __builtin_amdgcn_fence(__ATOMIC_RELEASE, "agent");
            asm volatile("s_waitcnt vmcnt(0)" ::: "memory");
            const unsigned og = xb_add(&bar[XB_TOP], 1u);
            const unsigned tg = og / nx;
            if (og + 1u == (tg + 1u) * nx) xb_add(&bar[XB_TOPGEN], 1u);
            else XB_SPIN(xb_ld(&bar[XB_TOPGEN]) == tg, bar);
            __builtin_amdgcn_fence(__ATOMIC_ACQUIRE, "agent");
            xb_add(&bar[XB_XGEN(b.x)], 1u);
            asm volatile("s_waitcnt vmcnt(0)" ::: "memory");
        } else {
            XB_SPIN(xb_ld(&bar[XB_XGEN(b.x)]) == gen, bar);
            __builtin_amdgcn_fence(__ATOMIC_ACQUIRE, "agent");
            asm volatile("s_waitcnt vmcnt(0)" ::: "memory");
        }
    }
    __syncthreads();
}


namespace pg8 {
#define PG8_LAS __attribute__((address_space(3)))
typedef unsigned short bf16_t;
typedef short bf16x8 __attribute__((ext_vector_type(8)));
typedef float f32x4 __attribute__((ext_vector_type(4)));
typedef unsigned u32x4 __attribute__((ext_vector_type(4)));
constexpr int BM = 256, BK = 64, HALF = 128, HTB = HALF * BK * 2  , STAGE_BYTES = 8 * HTB, NXCD = 8, WGM = 8;

__host__ __device__ __forceinline__ int lds_byte(int r, int c) { const int st = (r >> 4) * 2 + (c >> 5), rr = r & 15, cc = c & 31, ob = rr * 64 + cc * 2; return st * 1024 + (ob ^ (((ob >> 9) & 1) << 5)); }
__host__ __device__ __forceinline__ void stage_rc(int b, int& R, int& C) { const int st = b / 1024, sb = b % 1024, swz = sb ^ (((sb >> 9) & 1) << 5); R = (st >> 1) * 16 + swz / 64; C = (st & 1) * 32 + (swz % 64) / 2; }
__host__ __device__ __forceinline__ int perm32(int rho) { const int n = rho >> 4, i = rho & 15; return 8 * (i >> 2) + 4 * n + (i & 3); }

struct Unit { int pm, pn, aux0, aux1; };
struct Gemm { const bf16_t* A; const bf16_t* Bt; int M, N, K; };
__device__ __forceinline__ unsigned cvt_pk_bf16(float lo, float hi) { return ::pk2(lo, hi); }
typedef float f32x2 __attribute__((ext_vector_type(2)));
__device__ __forceinline__ f32x2 gelu_pk(f32x2 v) {
    const f32x2 av = __builtin_elementwise_abs(v), d = av * 0.2316418882f + 1.0f;
    f32x2 t; t.x = __builtin_amdgcn_rcpf(d.x); t.y = __builtin_amdgcn_rcpf(d.y);
    f32x2 q = t * 0.5307027145f + (-0.7265760135f); q = q * t + 0.7107068705f; q = q * t + (-0.142248368f); q = q * t + 0.127414796f; q = q * t;
    const f32x2 s = (v * v) * (-0.72134752044f);
    f32x2 e; e.x = __builtin_amdgcn_exp2f(s.x); e.y = __builtin_amdgcn_exp2f(s.y);
    const f32x2 m = v * (q * e), r = v - m;
    f32x2 o; o.x = v.x < 0.f ? m.x : r.x; o.y = v.y < 0.f ? m.y : r.y; return o;
}

template <int ACT  > struct EpiBf16 {
    static constexpr bool PERM = true, AFTER_DRAIN = false; static_assert(ACT == 0 || ACT == 1, "EpiBf16: ACT is 0 (none) or 1 (gelu_pk)");
    bf16_t* O; int ldc; const float* bias; int split_cols; size_t split_stride; float scale0;
    __device__ __forceinline__ void operator()(const f32x4 (&acc)[2][2][4][2], const Unit& u, int wr, int wc, int fr, int fq) const {
        const int row0 = u.pm * BM + wr * 64 + fr; int colt = u.pn * BM; bf16_t* base = O;
        float sc = 1.f; if (split_cols) { const int t = colt / split_cols; base += (size_t)t * split_stride; colt -= t * split_cols; if (t == 0) sc = scale0; }
        const int col0 = colt + wc * 32 + 8 * fq, bcol0 = u.pn * BM + wc * 32 + 8 * fq;
        f32x4 bv[2][2];
#pragma unroll
        for (int bj = 0; bj < 2; ++bj)
#pragma unroll
            for (int n = 0; n < 2; ++n) bv[bj][n] = bias ? *(const f32x4*)(bias + bcol0 + bj * HALF + 4 * n) : (f32x4){0.f, 0.f, 0.f, 0.f};
#pragma unroll
        for (int ai = 0; ai < 2; ++ai)
#pragma unroll
            for (int m = 0; m < 4; ++m) { bf16_t* rowp = base + (size_t)(row0 + ai * HALF + m * 16) * ldc + col0;
#pragma unroll
                for (int bj = 0; bj < 2; ++bj) { f32x4 v0 = acc[ai][bj][m][0] + bv[bj][0], v1 = acc[ai][bj][m][1] + bv[bj][1];
                    if (ACT == 1) { f32x2 a = gelu_pk((f32x2){v0[0], v0[1]}), b = gelu_pk((f32x2){v0[2], v0[3]}), c = gelu_pk((f32x2){v1[0], v1[1]}), d = gelu_pk((f32x2){v1[2], v1[3]});
                        v0 = (f32x4){a.x, a.y, b.x, b.y}; v1 = (f32x4){c.x, c.y, d.x, d.y}; }
                    v0 = v0 * sc; v1 = v1 * sc; u32x4 w; w.x = cvt_pk_bf16(v0[0], v0[1]); w.y = cvt_pk_bf16(v0[2], v0[3]); w.z = cvt_pk_bf16(v1[0], v1[1]); w.w = cvt_pk_bf16(v1[2], v1[3]);
                    *(u32x4*)(rowp + bj * HALF) = w; } }
    }
};

struct StaticOrder {
    int nM, nN, nwg, G, c;
    __host__ __device__ void init(int M, int N, int G_, int c_) { nM = M / BM; nN = N / BM; nwg = nM * nN; G = G_; c = c_; }
    __host__ __device__ bool next(int i, Unit& u) const {
        const long L = (long)i * G + c; if (L >= nwg) return false;
        int wgid = (int)L; { const int q = nwg / NXCD, r = nwg % NXCD, xcd = wgid % NXCD, off = wgid / NXCD; wgid = (xcd < r ? xcd * (q + 1) : r * (q + 1) + (xcd - r) * q) + off; }
        const int nig = WGM * nN, gid = wgid / nig, fm = gid * WGM, gsz = (nM - fm) < WGM ? (nM - fm) : WGM;
        u.pm = fm + ((wgid % nig) % gsz); u.pn = (wgid % nig) / gsz; return true;
    }
    __device__ __forceinline__ void a_ready(const Unit&) const {}
    __device__ __forceinline__ void done(const Unit&) const {}
};
struct EpiF32 {
    static constexpr bool PERM = false, AFTER_DRAIN = false;
    float* O; int ldc;
    __device__ __forceinline__ void operator()(const f32x4 (&acc)[2][2][4][2], const Unit& u, int wr, int wc, int fr, int fq) const {
        const int row0 = u.pm * BM + wr * 64 + fr, col0 = u.pn * BM + wc * 32 + 4 * fq;
#pragma unroll
        for (int ai = 0; ai < 2; ++ai)
#pragma unroll
            for (int m = 0; m < 4; ++m) { float* rowp = O + (size_t)(row0 + ai * HALF + m * 16) * ldc + col0;
#pragma unroll
                for (int bj = 0; bj < 2; ++bj)
#pragma unroll
                    for (int n = 0; n < 2; ++n) *(f32x4*)(rowp + bj * HALF + n * 16) = acc[ai][bj][m][n]; }
    }
};
struct EpiSwiGLU {
    static constexpr bool PERM = true, AFTER_DRAIN = false;
    bf16_t* O;
    __device__ __forceinline__ void operator()(const f32x4 (&acc)[2][2][4][2], const Unit& u, int wr, int wc, int fr, int fq) const {
        const int row0 = u.pm * BM + wr * 64 + fr, col0 = (u.pn & 3) * 128 + wc * 32 + 8 * fq;
#pragma unroll
        for (int ai = 0; ai < 2; ++ai)
#pragma unroll
            for (int m = 0; m < 4; ++m) {
                float v[8];
#pragma unroll
                for (int n = 0; n < 2; ++n)
#pragma unroll
                    for (int e = 0; e < 4; ++e) { const float g = acc[ai][0][m][n][e]; v[4 * n + e] = g * __builtin_amdgcn_rcpf(1.f + __builtin_amdgcn_exp2f(-1.4426950408889634f * g)) * acc[ai][1][m][n][e]; }
                u32x4 w; w.x = cvt_pk_bf16(v[0], v[1]); w.y = cvt_pk_bf16(v[2], v[3]); w.z = cvt_pk_bf16(v[4], v[5]); w.w = cvt_pk_bf16(v[6], v[7]);
                *(u32x4*)(O + (size_t)(row0 + ai * HALF + m * 16) * 512 + col0) = w; }
    }
};
struct EpiScatter {
    static constexpr bool PERM = true, AFTER_DRAIN = false;
    bf16_t* F; const int* slot2pk; const float* rw; int Mtok;
    __device__ __forceinline__ void operator()(const f32x4 (&acc)[2][2][4][2], const Unit& u, int wr, int wc, int fr, int fq) const {
        const int row0 = u.pm * BM + wr * 64 + fr, col0 = (u.pn & 3) * BM + wc * 32 + 8 * fq;
#pragma unroll
        for (int ai = 0; ai < 2; ++ai)
#pragma unroll
            for (int m = 0; m < 4; ++m) {
                const int pk = slot2pk[row0 + ai * HALF + m * 16];
                if (pk >= 0) { const float wgt = rw[pk]; bf16_t* rowp = F + ((size_t)(pk & 1) * Mtok + (pk >> 1)) * 1024 + col0;
#pragma unroll
                    for (int bj = 0; bj < 2; ++bj) { const f32x4 v0 = acc[ai][bj][m][0] * wgt, v1 = acc[ai][bj][m][1] * wgt;
                        u32x4 w; w.x = cvt_pk_bf16(v0[0], v0[1]); w.y = cvt_pk_bf16(v0[2], v0[3]); w.z = cvt_pk_bf16(v1[0], v1[1]); w.w = cvt_pk_bf16(v1[2], v1[3]);
                        *(u32x4*)(rowp + bj * HALF) = w; } } }
    }
};
struct LatentOrder4 {
    int G, c;
    __device__ bool next(int i, Unit& u) const {
        const int L = i * G + c; if (L >= 256) return false;
        const int x = L & 7, j = L >> 3, pi = x * 8 + (j >> 2);
        u.pm = pi + 1 + (pi >= 32 ? 1 : 0); u.pn = j & 3; u.aux0 = 0; u.aux1 = 0; return true;
    }
    __device__ __forceinline__ void a_ready(const Unit&) const {}
    __device__ __forceinline__ void done(const Unit&) const {}
};
struct G1Order {
    int G, c; bool deferred;
    __device__ bool next(int i, Unit& u) const {
        u.aux0 = 0; u.aux1 = 0;
        if (deferred) { if (i > 0 || c >= 82) return false; if (c < 66) { u.pm = c; u.pn = 8; } else { u.pm = c - 66; u.pn = 0; } return true; }
        const int L = i * G + c; if (L >= 512) return false;
        const int n = (L & ~255) + (L & 7) * 32 + ((L & 255) >> 3);
        if (n < 462) { u.pm = n / 7; u.pn = 1 + n % 7; } else { u.pm = 16 + (n - 462); u.pn = 0; }
        return true;
    }
    __device__ __forceinline__ void a_ready(const Unit&) const {}
    __device__ __forceinline__ void done(const Unit&) const {}
};
struct MoeGatherA {
    static constexpr bool GATHER = true; const PG8_LAS int* map;
    __device__ __forceinline__ int row(int ui, int r) const { const int pk = map[ui * 256 + r]; return pk >= 0 ? (pk >> 1) : 0; }
};
struct MoeOrderL {
    const PG8_LAS int* cnt; int G, c;
    __device__ bool next(int i, Unit& u) const {
        const int L = i * G + c, rt = L >> 2;
        int acc = 0, e = -1;
#pragma unroll
        for (int j = 0; j < 16; ++j) { const int nt = (cnt[j] + 255) >> 8; if (e < 0 && rt < acc + nt) e = j; acc += nt; }
        if (e < 0) return false;
        u.pm = rt; u.pn = e * 4 + (L & 3); u.aux0 = e; u.aux1 = 0; return true;
    }
    __device__ __forceinline__ void a_ready(const Unit&) const {}
    __device__ __forceinline__ void done(const Unit&) const {}
};
struct MoeOrder {
    const unsigned* cnt; int G, c;
    __device__ bool next(int i, Unit& u) const {
        const int L = i * G + c, rt = L >> 2;
        int acc = 0, e = -1;
#pragma unroll
        for (int j = 0; j < 16; ++j) { const int nt = ((int)cnt[j] + 255) >> 8; if (e < 0 && rt < acc + nt) e = j; acc += nt; }
        if (e < 0) return false;
        u.pm = rt; u.pn = e * 4 + (L & 3); u.aux0 = e; u.aux1 = 0; return true;
    }
    __device__ __forceinline__ void a_ready(const Unit&) const {}
    __device__ __forceinline__ void done(const Unit&) const {}
};
struct DenseA { static constexpr bool GATHER = false; __device__ __forceinline__ int row(int, int) const { return 0; } };
template <class Epi, class Sched, bool ALIGN_EPI = false, bool SP2 = false, class AG = DenseA>
__device__ __forceinline__ void gemm_phase(PG8_LAS unsigned char* lds, const Gemm g, const Sched& S, const Epi& E, const int tid, const AG& G = AG()) {
    static_assert(!AG::GATHER || SP2, "the gather policy is wired into the SP2 loop only");
    const int wid = __builtin_amdgcn_readfirstlane(tid >> 6), lane = tid & 63, wr = wid >> 2, wc = wid & 3, fr = lane & 15, fq = lane >> 4;
    const int K = g.K, nt = K / BK;
    unsigned voffA[2], voffB[2]; int RA[2], CA[2];
#pragma unroll
    for (int i = 0; i < 2; ++i) { int R, C; stage_rc(tid * 16 + i * 8192, R, C); const int Rb = Epi::PERM ? ((R & ~31) + perm32(R & 31)) : R;
        voffA[i] = (unsigned)(R * K + C) * 2u; voffB[i] = (unsigned)(Rb * K + C) * 2u; RA[i] = R; CA[i] = C; }
    const size_t kstep = (size_t)(BK * 2);
    const size_t hstep = (size_t)HALF * K * 2;
    const size_t tstep = 2 * hstep;
    const unsigned ldsw = (unsigned)wid * 1024u;
    const int aoff = lds_byte(wr * 64 + fr, fq * 8), boff = lds_byte(wc * 32 + fr, fq * 8);
#define PG8_SA(b, h) (((b) * 2 + (h)) * HTB)
#define PG8_SB(b, h) ((4 + (b) * 2 + (h)) * HTB)
#define PG8_STAGE(bufoff, gbase, voff) do { _Pragma("unroll") for (int _i = 0; _i < 2; ++_i) \
        __builtin_amdgcn_global_load_lds((const unsigned*)((const char*)(gbase) + (voff)[_i]), (PG8_LAS unsigned*)(lds + (bufoff) + ldsw + _i * 8192), 16, 0, 0); } while (0)
#define PG8_LDA(dst, b, h) do { _Pragma("unroll") for (int m = 0; m < 4; ++m) _Pragma("unroll") for (int k = 0; k < 2; ++k) dst[m][k] = *(const PG8_LAS bf16x8*)(lds + PG8_SA(b, h) + aoff + m * 2048 + k * 1024); } while (0)
#define PG8_LDB(dst, b, h) do { _Pragma("unroll") for (int n = 0; n < 2; ++n) _Pragma("unroll") for (int k = 0; k < 2; ++k) dst[n][k] = *(const PG8_LAS bf16x8*)(lds + PG8_SB(b, h) + boff + n * 2048 + k * 1024); } while (0)
#define PG8_MMA(ai, bj, At, Bt) do { __builtin_amdgcn_s_setprio(1); _Pragma("unroll") for (int m = 0; m < 4; ++m) _Pragma("unroll") for (int n = 0; n < 2; ++n) _Pragma("unroll") for (int k = 0; k < 2; ++k) \
        acc[ai][bj][m][n] = __builtin_amdgcn_mfma_f32_16x16x32_bf16(Bt[n][k], At[m][k], acc[ai][bj][m][n], 0, 0, 0); __builtin_amdgcn_s_setprio(0); } while (0)
#define PG8_WAIT_V(n) asm volatile("s_waitcnt vmcnt(" #n ")" ::: "memory")
#define PG8_WAIT_L(n) asm volatile("s_waitcnt lgkmcnt(" #n ")" ::: "memory")
#define PG8_BAR __builtin_amdgcn_s_barrier()
#define PG8_SCHED __builtin_amdgcn_sched_barrier(0)
    Unit cur, nxt; int ui = 0;
    if (!S.next(0, cur)) return;
    f32x4 acc[2][2][4][2];
#pragma unroll
    for (int a = 0; a < 2; ++a)
#pragma unroll
        for (int b = 0; b < 2; ++b)
#pragma unroll
            for (int m = 0; m < 4; ++m)
#pragma unroll
                for (int n = 0; n < 2; ++n) acc[a][b][m][n] = (f32x4){0.f, 0.f, 0.f, 0.f};
    bf16x8 At[4][2], B0[2][2], B1[2][2];
    const char* cA = AG::GATHER ? (const char*)g.A : (const char*)g.A + (size_t)cur.pm * tstep; const char* cB = (const char*)g.Bt + (size_t)cur.pn * tstep;
    unsigned vc[2][2], vn[2][2];
#pragma unroll
    for (int h = 0; h < 2; ++h)
#pragma unroll
        for (int i = 0; i < 2; ++i) { vc[h][i] = AG::GATHER ? (unsigned)(G.row(0, h * HALF + RA[i]) * K + CA[i]) * 2u : voffA[i] + (unsigned)(h * hstep); vn[h][i] = vc[h][i]; }
    S.a_ready(cur);
    if constexpr (SP2) {
        PG8_STAGE(PG8_SB(0, 0), cB, voffB); PG8_STAGE(PG8_SB(0, 1), cB + hstep, voffB); PG8_STAGE(PG8_SA(0, 0), cA, vc[0]); PG8_STAGE(PG8_SA(0, 1), cA, vc[1]);
        if (wr == 1) PG8_BAR;
        PG8_WAIT_V(2); PG8_BAR;
        PG8_STAGE(PG8_SB(1, 0), cB + kstep, voffB); PG8_STAGE(PG8_SA(1, 0), cA + kstep, vc[0]); PG8_STAGE(PG8_SB(1, 1), cB + hstep + kstep, voffB);
        PG8_WAIT_V(6); PG8_BAR;
    } else {
        PG8_STAGE(PG8_SB(0, 0), cB, voffB); PG8_STAGE(PG8_SA(0, 0), cA, voffA); PG8_STAGE(PG8_SB(0, 1), cB + hstep, voffB); PG8_STAGE(PG8_SA(0, 1), cA + hstep, voffA);
        if (wr == 1) PG8_BAR;
        PG8_WAIT_V(4); PG8_BAR;
        PG8_STAGE(PG8_SB(1, 0), cB + kstep, voffB); PG8_STAGE(PG8_SA(1, 0), cA + kstep, voffA); PG8_STAGE(PG8_SB(1, 1), cB + hstep + kstep, voffB);
        PG8_WAIT_V(6); PG8_BAR;
    }
    for (;;) {
        const bool has_next = S.next(ui + 1, nxt);
        const char* nA = AG::GATHER ? cA : (has_next ? (const char*)g.A + (size_t)nxt.pm * tstep : cA); const char* nB = has_next ? (const char*)g.Bt + (size_t)nxt.pn * tstep : cB;
        if (AG::GATHER && has_next) {
#pragma unroll
            for (int h = 0; h < 2; ++h)
#pragma unroll
                for (int i = 0; i < 2; ++i) vn[h][i] = (unsigned)(G.row(ui + 1, h * HALF + RA[i]) * K + CA[i]) * 2u;
        }
        for (int t = 0; t < nt; t += 2) {
            const bool last = (t == nt - 2);
            const char* a1 = cA + (size_t)(t + 1) * kstep;
            const char* a2 = last ? nA : cA + (size_t)(t + 2) * kstep; const char* b2 = last ? nB : cB + (size_t)(t + 2) * kstep;
            const char* a3 = a2 + kstep; const char* b3 = b2 + kstep;
            if (last && has_next) S.a_ready(nxt);
            unsigned v2[2][2];
#pragma unroll
            for (int h = 0; h < 2; ++h)
#pragma unroll
                for (int i = 0; i < 2; ++i) v2[h][i] = last ? vn[h][i] : vc[h][i];
            if constexpr (SP2) {
            PG8_LDB(B0, 0, 0); PG8_LDB(B1, 0, 1); PG8_SCHED; PG8_LDA(At, 0, 0); PG8_STAGE(PG8_SA(1, 1), a1, vc[1]);
            PG8_WAIT_V(8); PG8_WAIT_L(0); PG8_BAR; PG8_MMA(0, 0, At, B0); PG8_MMA(0, 1, At, B1); PG8_BAR; PG8_SCHED;
            PG8_LDA(At, 0, 1); PG8_STAGE(PG8_SB(0, 0), b2, voffB); PG8_STAGE(PG8_SB(0, 1), b2 + hstep, voffB); PG8_STAGE(PG8_SA(0, 0), a2, v2[0]);
            PG8_WAIT_V(8); PG8_WAIT_L(0); PG8_BAR; PG8_MMA(1, 0, At, B0); PG8_MMA(1, 1, At, B1); PG8_BAR; PG8_SCHED;
            PG8_LDB(B0, 1, 0); PG8_LDB(B1, 1, 1); PG8_SCHED; PG8_LDA(At, 1, 0); PG8_STAGE(PG8_SA(0, 1), a2, v2[1]);
            PG8_WAIT_V(8); PG8_WAIT_L(0); PG8_BAR; PG8_MMA(0, 0, At, B0); PG8_MMA(0, 1, At, B1); PG8_BAR; PG8_SCHED;
            PG8_LDA(At, 1, 1); PG8_STAGE(PG8_SB(1, 0), b3, voffB); PG8_STAGE(PG8_SB(1, 1), b3 + hstep, voffB); PG8_STAGE(PG8_SA(1, 0), a3, v2[0]);
            PG8_WAIT_V(8); PG8_WAIT_L(0); PG8_BAR; PG8_MMA(1, 0, At, B0); PG8_MMA(1, 1, At, B1); PG8_BAR; PG8_SCHED;
            } else {
            PG8_LDB(B0, 0, 0); PG8_SCHED; PG8_LDA(At, 0, 0); PG8_STAGE(PG8_SA(1, 1), a1 + hstep, voffA);
            PG8_WAIT_L(8); PG8_BAR; PG8_WAIT_L(0); PG8_MMA(0, 0, At, B0); PG8_BAR; PG8_SCHED;
            PG8_LDB(B1, 0, 1); PG8_STAGE(PG8_SB(0, 0), b2, voffB);
            PG8_BAR; PG8_WAIT_L(0); PG8_MMA(0, 1, At, B1); PG8_BAR;
            PG8_LDA(At, 0, 1); PG8_STAGE(PG8_SA(0, 0), a2, voffA);
            PG8_BAR; PG8_WAIT_L(0); PG8_MMA(1, 0, At, B0); PG8_BAR; PG8_SCHED;
            PG8_STAGE(PG8_SB(0, 1), b2 + hstep, voffB);
            PG8_WAIT_V(6); PG8_BAR; PG8_MMA(1, 1, At, B1); PG8_BAR;
            PG8_LDB(B0, 1, 0); PG8_SCHED; PG8_LDA(At, 1, 0); PG8_STAGE(PG8_SA(0, 1), a2 + hstep, voffA);
            PG8_WAIT_L(8); PG8_BAR; PG8_WAIT_L(0); PG8_MMA(0, 0, At, B0); PG8_BAR; PG8_SCHED;
            PG8_LDB(B1, 1, 1); PG8_STAGE(PG8_SB(1, 0), b3, voffB);
            PG8_BAR; PG8_WAIT_L(0); PG8_MMA(0, 1, At, B1); PG8_BAR;
            PG8_LDA(At, 1, 1); PG8_STAGE(PG8_SA(1, 0), a3, voffA);
            PG8_BAR; PG8_WAIT_L(0); PG8_MMA(1, 0, At, B0); PG8_BAR; PG8_SCHED;
            PG8_STAGE(PG8_SB(1, 1), b3 + hstep, voffB);
            PG8_WAIT_V(6); PG8_BAR; PG8_MMA(1, 1, At, B1); PG8_BAR;
            }
        }
        if constexpr (ALIGN_EPI) { if (wr == 0) PG8_BAR; }
        if constexpr (!Epi::AFTER_DRAIN) { E(acc, cur, wr, wc, fr, fq); S.done(cur); }
        if (!has_next) break;
#pragma unroll
        for (int a = 0; a < 2; ++a)
#pragma unroll
            for (int b = 0; b < 2; ++b)
#pragma unroll
                for (int m = 0; m < 4; ++m)
#pragma unroll
                    for (int n = 0; n < 2; ++n) acc[a][b][m][n] = (f32x4){0.f, 0.f, 0.f, 0.f};
        cur = nxt; cA = nA; cB = nB; ++ui;
#pragma unroll
        for (int h = 0; h < 2; ++h)
#pragma unroll
            for (int i = 0; i < 2; ++i) vc[h][i] = vn[h][i];
        if constexpr (ALIGN_EPI) { if (wr == 1) PG8_BAR; }
    }
    PG8_WAIT_V(0);
    if constexpr (!ALIGN_EPI) { if (wr == 0) PG8_BAR; }
    PG8_BAR;
    if constexpr (Epi::AFTER_DRAIN) { E.fused(acc, cur, wr, wc, fr, fq, lds, wid, lane); S.done(cur); }
#undef PG8_SA
#undef PG8_SB
#undef PG8_STAGE
#undef PG8_LDA
#undef PG8_LDB
#undef PG8_MMA
#undef PG8_WAIT_V
#undef PG8_WAIT_L
#undef PG8_BAR
#undef PG8_SCHED
}
}

__device__ __forceinline__ void transpose_item(const float* W, int K, int N, bf16_t* WT, int item, LAS float* scr, int lane, int rmode = 0) {
    const int nblk = N / 32, kb = item / nblk, nbk = item % nblk, k0 = 64 * kb, n0 = 32 * nbk;
#pragma unroll 8
    for (int i = 0; i < 32; ++i) { const int kk = 2 * i + (lane >> 5); scr[kk * 33 + (lane & 31)] = W[(size_t)(k0 + kk) * N + n0 + (lane & 31)]; }
    asm volatile("s_waitcnt lgkmcnt(0)" ::: "memory");
    const int cc = lane & 7;
#pragma unroll
    for (int j = 0; j < 4; ++j) { const int n = (lane >> 3) + 8 * j; const LAS float* s = scr + (8 * cc) * 33 + n;
        u32x4 o; o.x = pk2(s[0 * 33], s[1 * 33]); o.y = pk2(s[2 * 33], s[3 * 33]); o.z = pk2(s[4 * 33], s[5 * 33]); o.w = pk2(s[6 * 33], s[7 * 33]);
        const int nn = n0 + n, row = rmode == 0 ? nn : ((nn >> 7) * 256 + (rmode - 1) * 128 + (nn & 127));
        *(u32x4*)(WT + (size_t)row * K + k0 + 8 * cc) = o; }
    asm volatile("s_waitcnt lgkmcnt(0)" ::: "memory");
}
constexpr int CV_IN = 16 * 69, CV_OUT = 16 * 32, CV_E = 16 * 256, CV_Q = 4 * 12, CV_KV = 2 * 16;
constexpr int CV_S = CV_IN + CV_OUT + CV_Q + CV_KV;
constexpr int CV_ALL = CV_S + 3 * CV_E;
__device__ __forceinline__ void convert_weights(const Params& p, const Ctx& c, int l, int lo, int hi, int widx, int nw) {
    LAS float* scr = (LAS float*)(c.lds + c.wave * 16384);
    for (int it = lo + widx; it < hi; it += nw) {
        int r = it;
        if (r < CV_IN) { transpose_item(p.w_in + (size_t)l * D * INW, D, INW, (bf16_t*)(p.ws + WS_WIN) + (size_t)l * INP * D, r, scr, c.lane); continue; } r -= CV_IN;
        if (r < CV_OUT) { transpose_item(p.w_out + (size_t)l * D * D, D, D, (bf16_t*)(p.ws + WS_WOUT) + (size_t)l * D * D, r, scr, c.lane); continue; } r -= CV_OUT;
        if (r < CV_Q) { transpose_item(p.mla_w_q + (size_t)l * 256 * 384, 256, 384, (bf16_t*)(p.ws + WS_WQT) + (size_t)l * 384 * 256, r, scr, c.lane); continue; } r -= CV_Q;
        if (r < CV_KV) { transpose_item(p.mla_w_kv + (size_t)l * 128 * 512, 128, 512, (bf16_t*)(p.ws + WS_WKVT) + (size_t)l * 512 * 128, r, scr, c.lane); continue; } r -= CV_KV;
        if (r < CV_E) { const int e = r / 256; transpose_item(p.exp_w_gate + (size_t)(l * NE + e) * D * DE, D, DE, (bf16_t*)(p.ws + WS_WGU) + (size_t)(l * NE + e) * 1024 * 1024, r % 256, scr, c.lane, 1); continue; } r -= CV_E;
        if (r < CV_E) { const int e = r / 256; transpose_item(p.exp_w_up + (size_t)(l * NE + e) * D * DE, D, DE, (bf16_t*)(p.ws + WS_WGU) + (size_t)(l * NE + e) * 1024 * 1024, r % 256, scr, c.lane, 2); continue; } r -= CV_E;
        { const int e = r / 256; transpose_item(p.exp_w_down + (size_t)(l * NE + e) * DE * D, DE, D, (bf16_t*)(p.ws + WS_WD) + (size_t)(l * NE + e) * 1024 * 512, r % 256, scr, c.lane); }
    }
}
__device__ __forceinline__ void phase_pro(const Params& p, const Ctx& c) {
    convert_weights(p, c, 0, 0, CV_S, c.gw, c.ngw);
    for (int i = c.bid * NTHREADS + c.tid; i < 2 * 2 * 2 * 8 * 64 * 64; i += c.nb * NTHREADS) {
        const int k = i & 63, j = (i >> 6) & 63, n = (i >> 12) & 7, g = (i >> 15) & 1, ld = i >> 16;
        const float* src = g ? p.lru_w_i : p.lru_w_a;
        ((bf16_t*)(p.ws + WS_LRUW))[i] = (bf16_t)f2bf(src[((size_t)(ld * 8 + n) * 64 + k) * 64 + j]);
    }
    for (int i = c.bid * NTHREADS + c.tid; i < 2 * 96 * D / 8; i += c.nb * NTHREADS) {
        const int l = i / (96 * D / 8), r = i % (96 * D / 8);
        *(u32x4*)((bf16_t*)(p.ws + WS_WIN) + (size_t)l * INP * D + (size_t)INW * D + (size_t)r * 8) = (u32x4){0u, 0u, 0u, 0u};
    }
    __syncthreads();
    LAS float* sv = (LAS float*)c.lds;
    LAS float* red = sv + 3 * D;
    for (int i = c.tid; i < 3 * D; i += NTHREADS) { const int r = i >> 10, k = i & 1023; sv[i] = siluf_(r < 2 ? p.c[r * D + k] : p.c_ctx[k]); }
    __syncthreads();
    float* mo = (float*)(p.ws + WS_MODP);
    for (int it = c.bid; it < 2 * 96; it += c.nb) {
        const int l = it / 96, n = (it % 96) * 64 + (c.tid & 63), kg = c.tid >> 6;
        const float* w = p.w_ada + ((size_t)l * D + kg * 128) * 6144 + n;
        float a0 = 0.f, a1 = 0.f, a2 = 0.f;
#pragma unroll 8
        for (int kk = 0; kk < 128; ++kk) { const float wv = w[(size_t)kk * 6144]; const int k = kg * 128 + kk; a0 += sv[k] * wv; a1 += sv[D + k] * wv; a2 += sv[2 * D + k] * wv; }
        red[(kg * 3 + 0) * 64 + (c.tid & 63)] = a0; red[(kg * 3 + 1) * 64 + (c.tid & 63)] = a1; red[(kg * 3 + 2) * 64 + (c.tid & 63)] = a2;
        __syncthreads();
        if (c.tid < 192) { const int r = c.tid >> 6, cc = c.tid & 63; float v = p.b_ada[l * 6144 + (it % 96) * 64 + cc];
#pragma unroll
            for (int g = 0; g < 8; ++g) v += red[(g * 3 + r) * 64 + cc];
            mo[(size_t)(l * 3 + r) * 6144 + (it % 96) * 64 + cc] = v; }
        __syncthreads();
    }
}

__device__ __forceinline__ void phase_n1(const Params& p, const Ctx& c, int l) {
    LAS float* sh = (LAS float*)c.lds;
    LAS float* sc = sh + 3 * D;
    load_mods(p, c, l, 0, sh); load_mods(p, c, l, 1, sc);
    __syncthreads();
    const float* g = p.g_norm + (size_t)(l * 4 + 0) * D;
    bf16_t* H = (bf16_t*)(p.ws + WS_H);
#define N1_LOAD(mm) do { const float* xr_ = xin_row(p, mm);        _Pragma("unroll") for (int j = 0; j < 4; ++j) vn[j] = *(const f32x4*)(xr_ + 4 * (c.lane + 64 * j)); } while (0)
    f32x4 vn[4];
    if (c.gw < M) N1_LOAD(c.gw);
#pragma unroll 1
    for (int m = c.gw; m < M; m += c.ngw) {
        const int b = m / LT, t = m - b * LT, r = t < CTX ? 2 : b;
        f32x4 v[4]; float ss = 0.f;
#pragma unroll
        for (int j = 0; j < 4; ++j) { v[j] = vn[j]; ss += v[j].x * v[j].x + v[j].y * v[j].y + v[j].z * v[j].z + v[j].w * v[j].w; }
        if (m + c.ngw < M) N1_LOAD(m + c.ngw);
        const float rstd = rsqrtf(wave_sum(ss) * (1.f / D) + 1e-6f);
#pragma unroll
        for (int j = 0; j < 4; ++j) {
            const int n = 4 * (c.lane + 64 * j);
            const f32x4 gg = *(const f32x4*)(g + n);
            float o[4];
#pragma unroll
            for (int e = 0; e < 4; ++e) o[e] = v[j][e] * rstd * gg[e] * (1.f + sc[r * D + n + e]) + sh[r * D + n + e];
            u32x2 w; w.x = pk2(o[0], o[1]); w.y = pk2(o[2], o[3]);
            *(u32x2*)(H + (size_t)m * D + n) = w;
        }
    }
}

template <int NJ, class Op>
__device__ __forceinline__ void wave_gemm_tile(const Op& op, int r0, int c0, int K, int lane) {
    const int fr = lane & 15, fq = lane >> 4;
    const bf16_t* ap[4]; const bf16_t* bp[NJ];
#pragma unroll
    for (int i = 0; i < 4; ++i) ap[i] = op.arow(r0 + 16 * i + fr) + 8 * fq;
#pragma unroll
    for (int j = 0; j < NJ; ++j) bp[j] = op.brow(c0 + 16 * j + fr) + 8 * fq;
    f32x4 acc[4][NJ];
#pragma unroll
    for (int i = 0; i < 4; ++i)
#pragma unroll
        for (int j = 0; j < NJ; ++j) acc[i][j] = (f32x4){0.f, 0.f, 0.f, 0.f};
    for (int k0 = 0; k0 < K; k0 += 32) {
        bf16x8 a[4], b[NJ];
#pragma unroll
        for (int i = 0; i < 4; ++i) a[i] = *(const bf16x8*)(ap[i] + k0);
#pragma unroll
        for (int j = 0; j < NJ; ++j) b[j] = *(const bf16x8*)(bp[j] + k0);
#pragma unroll
        for (int i = 0; i < 4; ++i)
#pragma unroll
            for (int j = 0; j < NJ; ++j) acc[i][j] = __builtin_amdgcn_mfma_f32_16x16x32_bf16(a[i], b[j], acc[i][j], 0, 0, 0);
    }
#pragma unroll
    for (int i = 0; i < 4; ++i)
#pragma unroll
        for (int j = 0; j < NJ; ++j)
#pragma unroll
            for (int e = 0; e < 4; ++e) op.store(r0 + 16 * i + 4 * fq + e, c0 + 16 * j + fr, acc[i][j][e]);
}

__device__ __forceinline__ void phase_g1(const Params& p, const Ctx& c, int l, bool deferred) {
    pg8::Gemm g{(const bf16_t*)(p.ws + WS_H), (const bf16_t*)(p.ws + WS_WIN) + (size_t)l * INP * D, M, INP, D};
    pg8::EpiBf16<0> E{(bf16_t*)(p.ws + WS_P), INP, nullptr, 0, 0, 1.f};
    if (c.nb == 256) { pg8::G1Order S{c.nb, c.bid, deferred}; pg8::gemm_phase<pg8::EpiBf16<0>, pg8::G1Order, true, true>(c.lds, g, S, E, c.tid); }
    else if (!deferred) { pg8::StaticOrder S; S.init(M, INP, c.nb, c.bid); pg8::gemm_phase<pg8::EpiBf16<0>, pg8::StaticOrder, true, true>(c.lds, g, S, E, c.tid); }
}
__device__ __forceinline__ void phase_o1(const Params& p, const Ctx& c, int l, bool last) {
    pg8::Gemm g{(const bf16_t*)(p.ws + WS_Y), (const bf16_t*)(p.ws + WS_WOUT) + (size_t)l * D * D, M, D, D};
    pg8::EpiBf16<0> E{(bf16_t*)(p.ws + WS_P), D, nullptr, 0, 0, 1.f};
    if (last) { pg8::LatentOrder4 S{c.nb, c.bid}; pg8::gemm_phase<pg8::EpiBf16<0>, pg8::LatentOrder4, true, true>(c.lds, g, S, E, c.tid); }
    else { pg8::StaticOrder S; S.init(M, D, c.nb, c.bid); pg8::gemm_phase<pg8::EpiBf16<0>, pg8::StaticOrder, true, true>(c.lds, g, S, E, c.tid);
        constexpr int FULL = (M / 256) * (D / 256) - 256;
        if (c.nb == 256 && c.bid >= FULL) { __syncthreads(); convert_weights(p, c, 0, CV_S, CV_ALL, (c.bid - FULL) * NWAVES + c.wave, (256 - FULL) * NWAVES); }
        else if (c.nb != 256) { __syncthreads(); convert_weights(p, c, 0, CV_S, CV_ALL, c.gw, c.ngw); } }
}

__device__ __forceinline__ void rope_cs(int fi, int pos, float& cs, float& sn) {
    const float ang = (float)pos * __builtin_amdgcn_exp2f(-(float)fi * 1.6609640474436813f); cs = __cosf(ang); sn = __sinf(ang); }
struct C1W { bf16x8 q[3][8]; };
__device__ __forceinline__ void c1_load_q(const Params& p, const Ctx& c, int l, C1W& W) {
    const bf16_t* WqT = (const bf16_t*)(p.ws + WS_WQT) + (size_t)l * 384 * 256; const int fr = c.lane & 15, fq = c.lane >> 4;
#pragma unroll
    for (int i = 0; i < 3; ++i)
#pragma unroll
        for (int ks = 0; ks < 8; ++ks) W.q[i][ks] = *(const bf16x8*)(WqT + (size_t)(48 * c.wave + 16 * i + fr) * 256 + ks * 32 + fq * 8);
}
template <int VAR = 0>
__device__ __forceinline__ void c1_compute(const Params& p, const Ctx& c, int l, const C1W& W, int b, int t0, LAS const unsigned char* aq, LAS const unsigned char* akv) {
    constexpr int PQ = 528, PKV = 272, ROWS = 66, RT = 5;
    bf16_t* Q = (bf16_t*)(p.ws + WS_Q); bf16_t* Kb = (bf16_t*)(p.ws + WS_K); bf16_t* Vb = (bf16_t*)(p.ws + WS_V);
    const bf16_t* WkvT = (const bf16_t*)(p.ws + WS_WKVT) + (size_t)l * 512 * 128;
    const int fr = c.lane & 15, fq = c.lane >> 4, w = c.wave, h = w >> 1;
    bf16x8 bkv[4][4];
    {
        f32x4 acc[3][RT];
#pragma unroll
        for (int i = 0; i < 3; ++i)
#pragma unroll
            for (int rt = 0; rt < RT; ++rt) acc[i][rt] = (f32x4){0.f, 0.f, 0.f, 0.f};
#pragma unroll
        for (int ks = 0; ks < 8; ++ks) {
            bf16x8 a[RT];
#pragma unroll
            for (int rt = 0; rt < RT; ++rt) a[rt] = *(LAS const bf16x8*)(aq + (rt * 16 + fr) * PQ + (ks * 32 + fq * 8) * 2);
#pragma unroll
            for (int i = 0; i < 3; ++i)
#pragma unroll
                for (int rt = 0; rt < RT; ++rt) { if (VAR & 2) { asm volatile("" :: "v"(a[rt]), "v"(W.q[i][ks])); } else acc[i][rt] = __builtin_amdgcn_mfma_f32_16x16x32_bf16(a[rt], W.q[i][ks], acc[i][rt], 0, 0, 0); }
        }
        __builtin_amdgcn_sched_barrier(0);
#pragma unroll
        for (int i = 0; i < 3; ++i) {
            const int d = (w & 1) * 48 + 16 * i + fr;
            const bool rope_tile = (w & 1) && i >= 1;
#pragma unroll
            for (int rt = 0; rt < RT; ++rt)
#pragma unroll
                for (int e = 0; e < 4; ++e) { const int r = 16 * rt + 4 * fq + e, t = t0 + r; float v = acc[i][rt][e];
                    if (rope_tile) { const float pv = dpp_f<0x128>(v);
                        if (t >= CTX) { const int sidx = t - CTX, pos = (i == 2) ? (sidx % GW) : (sidx / GW); float cs, sn; rope_cs(fr & 7, pos, cs, sn); v = fr < 8 ? v * cs - pv * sn : v * cs + pv * sn; } }
                    if (VAR & 1) { asm volatile("" :: "v"(v)); } else if (r < ROWS) Q[((size_t)(b * 4 + h) * LT + t) * 96 + d] = (bf16_t)f2bf(v * 0.14724444602590306f); }
        }
    }
    __builtin_amdgcn_sched_barrier(0);
#pragma unroll
    for (int i = 0; i < 4; ++i)
#pragma unroll
        for (int ks = 0; ks < 4; ++ks) bkv[i][ks] = *(const bf16x8*)(WkvT + (size_t)(64 * w + 16 * i + fr) * 128 + ks * 32 + fq * 8);
    {
        f32x4 acc[4][RT];
#pragma unroll
        for (int i = 0; i < 4; ++i)
#pragma unroll
            for (int rt = 0; rt < RT; ++rt) acc[i][rt] = (f32x4){0.f, 0.f, 0.f, 0.f};
#pragma unroll
        for (int ks = 0; ks < 4; ++ks) {
            bf16x8 a[RT];
#pragma unroll
            for (int rt = 0; rt < RT; ++rt) a[rt] = *(LAS const bf16x8*)(akv + (rt * 16 + fr) * PKV + (ks * 32 + fq * 8) * 2);
#pragma unroll
            for (int i = 0; i < 4; ++i)
#pragma unroll
                for (int rt = 0; rt < RT; ++rt) { if (VAR & 2) { asm volatile("" :: "v"(a[rt]), "v"(bkv[i][ks])); } else acc[i][rt] = __builtin_amdgcn_mfma_f32_16x16x32_bf16(a[rt], bkv[i][ks], acc[i][rt], 0, 0, 0); }
        }
#pragma unroll
        for (int i = 0; i < 4; ++i)
#pragma unroll
            for (int rt = 0; rt < RT; ++rt)
#pragma unroll
                for (int e = 0; e < 4; ++e) { const int r = 16 * rt + 4 * fq + e, t = t0 + r, d = 16 * i + fr; const bf16_t v = (bf16_t)f2bf(acc[i][rt][e]);
                    if (VAR & 1) { asm volatile("" :: "v"(v)); } else if (r < ROWS) { if (w & 1) Vb[((size_t)(b * 4 + h) * LT + t) * 64 + d] = v; else Kb[((size_t)(b * 4 + h) * LT + t) * 96 + d] = v; } }
    }
}
template <int VAR = 0>
__device__ __forceinline__ void phase_c1(const Params& p, const Ctx& c, int l) {
    constexpr int PQ = 528, PKV = 272, ROWS = 66;
    LAS unsigned char* aq = c.lds; LAS unsigned char* akv = c.lds + 80 * PQ;
    const bf16_t* P = (const bf16_t*)(p.ws + WS_P); bf16_t* Kb = (bf16_t*)(p.ws + WS_K);
    for (int g = c.bid; g < M / ROWS; g += c.nb) {
        const int m0 = g * ROWS, b = m0 / LT, t0 = m0 - b * LT;
        C1W W; c1_load_q(p, c, l, W);
        __syncthreads();
#pragma unroll 1
        for (int it = 0; it < 3; ++it) {
            const int r = it * 32 + (c.tid >> 4), q16 = c.tid & 15;
            if (r >= 80 || (VAR & 4)) continue;
            const bool real = r < ROWS; const int rr = real ? r : 0;
            const bf16_t* pr = P + (size_t)(m0 + rr) * INP;
            const u32x4 c0 = *(const u32x4*)(pr + OFF_CQ + q16 * 16), c1 = *(const u32x4*)(pr + OFF_CQ + q16 * 16 + 8), k0 = *(const u32x4*)(pr + OFF_CKV + q16 * 8);
            const unsigned krw = *(const unsigned*)(pr + OFF_KR + q16 * 2);
            float cv[16], kv[8];
            cv[0] = lo_bf(c0.x); cv[1] = hi_bf(c0.x); cv[2] = lo_bf(c0.y); cv[3] = hi_bf(c0.y); cv[4] = lo_bf(c0.z); cv[5] = hi_bf(c0.z); cv[6] = lo_bf(c0.w); cv[7] = hi_bf(c0.w);
            cv[8] = lo_bf(c1.x); cv[9] = hi_bf(c1.x); cv[10] = lo_bf(c1.y); cv[11] = hi_bf(c1.y); cv[12] = lo_bf(c1.z); cv[13] = hi_bf(c1.z); cv[14] = lo_bf(c1.w); cv[15] = hi_bf(c1.w);
            kv[0] = lo_bf(k0.x); kv[1] = hi_bf(k0.x); kv[2] = lo_bf(k0.y); kv[3] = hi_bf(k0.y); kv[4] = lo_bf(k0.z); kv[5] = hi_bf(k0.z); kv[6] = lo_bf(k0.w); kv[7] = hi_bf(k0.w);
            float s1 = 0.f, s2 = 0.f;
#pragma unroll
            for (int i = 0; i < 16; ++i) s1 += cv[i] * cv[i];
#pragma unroll
            for (int i = 0; i < 8; ++i) s2 += kv[i] * kv[i];
            s1 = row16_sum(s1); s2 = row16_sum(s2);
            const float r1 = real ? rsqrtf(s1 * (1.f / 256.f) + 1e-6f) : 0.f, r2 = real ? rsqrtf(s2 * (1.f / 128.f) + 1e-6f) : 0.f;
            const float* gq = p.mla_g_q + l * 256 + q16 * 16; const float* gk = p.mla_g_kv + l * 128 + q16 * 8;
            u32x4 o0, o1, o2;
            o0.x = pk2(cv[0] * r1 * gq[0], cv[1] * r1 * gq[1]); o0.y = pk2(cv[2] * r1 * gq[2], cv[3] * r1 * gq[3]); o0.z = pk2(cv[4] * r1 * gq[4], cv[5] * r1 * gq[5]); o0.w = pk2(cv[6] * r1 * gq[6], cv[7] * r1 * gq[7]);
            o1.x = pk2(cv[8] * r1 * gq[8], cv[9] * r1 * gq[9]); o1.y = pk2(cv[10] * r1 * gq[10], cv[11] * r1 * gq[11]); o1.z = pk2(cv[12] * r1 * gq[12], cv[13] * r1 * gq[13]); o1.w = pk2(cv[14] * r1 * gq[14], cv[15] * r1 * gq[15]);
            o2.x = pk2(kv[0] * r2 * gk[0], kv[1] * r2 * gk[1]); o2.y = pk2(kv[2] * r2 * gk[2], kv[3] * r2 * gk[3]); o2.z = pk2(kv[4] * r2 * gk[4], kv[5] * r2 * gk[5]); o2.w = pk2(kv[6] * r2 * gk[6], kv[7] * r2 * gk[7]);
            *(LAS u32x4*)(aq + r * PQ + q16 * 32) = o0; *(LAS u32x4*)(aq + r * PQ + q16 * 32 + 16) = o1; *(LAS u32x4*)(akv + r * PKV + q16 * 16) = o2;
            float z0 = lo_bf(krw), z1 = hi_bf(krw);
            const float y0 = __shfl_xor(z0, 4), y1 = __shfl_xor(z1, 4);
            const int t = t0 + r;
            if (t >= CTX) { const int sidx = t - CTX, pos = (q16 >> 3) ? (sidx % GW) : (sidx / GW); const int li0 = (2 * q16) & 15; const bool first = li0 < 8;
                float cs, sn; rope_cs(li0 & 7, pos, cs, sn); z0 = first ? z0 * cs - y0 * sn : z0 * cs + y0 * sn;
                rope_cs((li0 + 1) & 7, pos, cs, sn); z1 = first ? z1 * cs - y1 * sn : z1 * cs + y1 * sn; }
            const unsigned kw = pk2(z0, z1);
            if (real) {
#pragma unroll
                for (int h = 0; h < 4; ++h) *(unsigned*)(Kb + ((size_t)(b * 4 + h) * LT + t) * 96 + 64 + 2 * q16) = kw; }
        }
        __syncthreads();
        c1_compute<VAR>(p, c, l, W, b, t0, aq, akv);
    }
}

namespace lru {
typedef float f32x16 __attribute__((ext_vector_type(16)));
constexpr int PITCH = 1040;
__device__ __forceinline__ void load_uc(const Params& p, const Ctx& c, int l, int b, int ch, LAS unsigned char* ucb) {
    const int chn = c.tid, t0 = ch * CH, seq_lo = (ch < NCH_CTX) ? 0 : CTX, seq_hi = (ch < NCH_CTX) ? CTX : LT;
    const bf16_t* Pb = (const bf16_t*)(p.ws + WS_P) + (size_t)(b * LT) * INP + OFF_U + chn;
    const float w0 = p.conv_w[(l * 4 + 0) * LRU_W + chn], w1 = p.conv_w[(l * 4 + 1) * LRU_W + chn], w2 = p.conv_w[(l * 4 + 2) * LRU_W + chn], w3 = p.conv_w[(l * 4 + 3) * LRU_W + chn];
    const float cb = p.conv_b[l * LRU_W + chn];
    float u[CH + 3];
#pragma unroll
    for (int i = 0; i < CH + 3; ++i) { const int t = t0 - 1 + i, tc = min(max(t, seq_lo), seq_hi - 1); u[i] = bf2f(Pb[(size_t)tc * INP]); }
    if (t0 == seq_lo) u[0] = 0.f;
    if (t0 + CH == seq_hi) { u[CH + 1] = 0.f; u[CH + 2] = 0.f; }
#pragma unroll
    for (int i = 0; i < CH; ++i) *(LAS bf16_t*)(ucb + i * PITCH + chn * 2) = (bf16_t)f2bf(u[i] * w0 + u[i + 1] * w1 + u[i + 2] * w2 + u[i + 3] * w3 + cb);
}
struct WF { bf16x8 a[4], i[4]; };
__device__ __forceinline__ WF load_w(const Params& p, int l, int d, int n, int ct, int r32, int hi) {
    const bf16_t* wa = (const bf16_t*)(p.ws + WS_LRUW) + ((size_t)((((l * 2 + d) * 2 + 0) * 8 + n) * 64 + ct * 32 + r32)) * 64 + hi * 8;
    const bf16_t* wi = wa + (size_t)8 * 64 * 64;
    WF w;
#pragma unroll
    for (int ks = 0; ks < 4; ++ks) { w.a[ks] = *(const bf16x8*)(wa + ks * 16); w.i[ks] = *(const bf16x8*)(wi + ks * 16); }
    return w;
}
__device__ __forceinline__ void gates_mm(const WF& w, const bf16x8 (&af)[4], f32x16& za, f32x16& zi) {
    za = f32x16{}; zi = f32x16{};
#pragma unroll
    for (int ks = 0; ks < 4; ++ks) { za = __builtin_amdgcn_mfma_f32_32x32x16_bf16(af[ks], w.a[ks], za, 0, 0, 0); zi = __builtin_amdgcn_mfma_f32_32x32x16_bf16(af[ks], w.i[ks], zi, 0, 0, 0); }
}
__device__ __forceinline__ void gates_ew(const f32x16& za, const f32x16& zi, float bias_a, float bias_i, float lam, const float (&ucv)[16], float (&a)[16], float (&x)[16]) {
    const float ee = __builtin_amdgcn_exp2f(-1.4426950408889634f * lam);
    const float sp = ee * (1.f + ee * (-0.5f + ee * (0.33333333f - 0.25f * ee)));
#pragma unroll
    for (int r = 0; r < 16; ++r) { const float la = -8.f * sigmoidf_(za[r] + bias_a) * sp, y = 2.f * la;
        const float g2 = -y * (1.f + y * (0.5f + y * (0.16666667f + y * (0.041666667f + y * 0.0083333333f))));
        a[r] = __builtin_amdgcn_exp2f(1.4426950408889634f * la); x[r] = __builtin_amdgcn_sqrtf(g2) * sigmoidf_(zi[r] + bias_i) * ucv[r]; }
}
template <bool HS>
__device__ __forceinline__ float scan32(const float (&a)[16], const float (&x)[16], int d, int hi, float h0, float (&hs)[16], float& ap) {
    float As[4], Xs[4];
#pragma unroll
    for (int g = 0; g < 4; ++g) { float A = 1.f, X = 0.f;
#pragma unroll
        for (int e4 = 0; e4 < 4; ++e4) { const int r = 4 * g + (d == 0 ? e4 : 3 - e4); X = a[r] * X + x[r]; A *= a[r]; }
        As[g] = A; Xs[g] = X; }
    float Alo[4], Ahi[4], Xlo[4], Xhi[4];
#pragma unroll
    for (int g = 0; g < 4; ++g) {
        auto ra = __builtin_amdgcn_permlane32_swap(__float_as_uint(As[g]), __float_as_uint(As[g]), false, false);
        auto rx = __builtin_amdgcn_permlane32_swap(__float_as_uint(Xs[g]), __float_as_uint(Xs[g]), false, false);
        Alo[g] = __uint_as_float(ra[0]); Ahi[g] = __uint_as_float(ra[1]); Xlo[g] = __uint_as_float(rx[0]); Xhi[g] = __uint_as_float(rx[1]); }
    float h = h0, hin[4]; ap = 1.f;
#pragma unroll
    for (int s8 = 0; s8 < 8; ++s8) { const int sg = d == 0 ? s8 : 7 - s8, g = sg >> 1; const bool up = (sg & 1) != 0;
        const float A = up ? Ahi[g] : Alo[g], X = up ? Xhi[g] : Xlo[g];
        if (up == (hi != 0)) hin[g] = h;
        h = A * h + X; ap *= A; }
    if (HS) {
#pragma unroll
        for (int g = 0; g < 4; ++g) { float hh = hin[g];
#pragma unroll
            for (int e4 = 0; e4 < 4; ++e4) { const int r = 4 * g + (d == 0 ? e4 : 3 - e4); hh = a[r] * hh + x[r]; hs[r] = hh; } }
    }
    return h;
}
template <int MODE>
__device__ __forceinline__ void chunk(const Params& p, const Ctx& c, int l, int b, int ch, LAS const unsigned char* ucb, WF w) {
    const int n = c.wave, r32 = c.lane & 31, hi = c.lane >> 5;
    bf16x8 af[4];
#pragma unroll
    for (int ks = 0; ks < 4; ++ks) af[ks] = *(LAS const bf16x8*)(ucb + r32 * PITCH + (n * 64 + ks * 16 + hi * 8) * 2);
    constexpr int D0 = MODE == 0 ? 0 : 1, D1 = 1 - D0;
#pragma unroll 1
    for (int ct = 0; ct < 2; ++ct) {
        const int chn = n * 64 + ct * 32 + r32;
        float ucv[16], hr[16], a[16], x[16], ap; f32x16 za, zi;
#pragma unroll
        for (int r = 0; r < 16; ++r) ucv[r] = bf2f(*(LAS const bf16_t*)(ucb + (8 * (r >> 2) + 4 * hi + (r & 3)) * PITCH + chn * 2));
        float c0 = 0.f, c1 = 0.f;
        if (MODE == 1) { const float* cr = (const float*)(p.ws + WS_CARRY);
            c1 = cr[((size_t)((b * 2 + 1) * NCH + ch)) * LRU_W + chn]; c0 = cr[((size_t)((b * 2 + 0) * NCH + ch)) * LRU_W + chn]; }
        { const float bias_a = p.lru_b_a[(l * 2 + D0) * LRU_W + chn], bias_i = p.lru_b_i[(l * 2 + D0) * LRU_W + chn], lam = p.lru_lam[(l * 2 + D0) * LRU_W + chn];
          gates_mm(w, af, za, zi);
          w = load_w(p, l, D1, n, ct, r32, hi);
          __builtin_amdgcn_sched_barrier(0);
          gates_ew(za, zi, bias_a, bias_i, lam, ucv, a, x); }
        if (MODE == 0) { const float he = scan32<false>(a, x, D0, hi, 0.f, hr, ap);
            if (hi == 0) { float* ag = (float*)(p.ws + WS_AGG) + 2 * (((size_t)((b * 2 + D0) * NCH + ch)) * LRU_W + chn); ag[0] = ap; ag[1] = he; } }
        else (void)scan32<true>(a, x, D0, hi, c1, hr, ap);
        __builtin_amdgcn_sched_barrier(0);
        unsigned short gv[16];
        if (MODE == 1) {
            const char* gp = (const char*)((const bf16_t*)(p.ws + WS_P) + ((size_t)b * LT + ch * CH) * INP + OFF_G + n * 64 + ct * 32);
            const unsigned go = (unsigned)((4 * hi * INP + r32) * 2);
#pragma unroll
            for (int r = 0; r < 16; ++r) gv[r] = *(const bf16_t*)(gp + (size_t)(8 * (r >> 2) + (r & 3)) * INP * 2 + go);
        }
        { const float bias_a = p.lru_b_a[(l * 2 + D1) * LRU_W + chn], bias_i = p.lru_b_i[(l * 2 + D1) * LRU_W + chn], lam = p.lru_lam[(l * 2 + D1) * LRU_W + chn];
          gates_mm(w, af, za, zi);
          if (ct == 0) w = load_w(p, l, D0, n, 1, r32, hi);
          __builtin_amdgcn_sched_barrier(0);
          gates_ew(za, zi, bias_a, bias_i, lam, ucv, a, x); }
        if (MODE == 0) { float hs[16]; const float he = scan32<false>(a, x, D1, hi, 0.f, hs, ap);
            if (hi == 0) { float* ag = (float*)(p.ws + WS_AGG) + 2 * (((size_t)((b * 2 + D1) * NCH + ch)) * LRU_W + chn); ag[0] = ap; ag[1] = he; } }
        else {
            float hs[16];
            (void)scan32<true>(a, x, D1, hi, c0, hs, ap);
            char* yp = (char*)((bf16_t*)(p.ws + WS_Y) + ((size_t)b * LT + ch * CH) * D + 256 + n * 64 + ct * 32);
            const unsigned yo = (unsigned)((4 * hi * D + r32) * 2);
#pragma unroll
            for (int r = 0; r < 16; ++r) *(bf16_t*)(yp + (size_t)(8 * (r >> 2) + (r & 3)) * D * 2 + yo) = (bf16_t)f2bf((hr[r] + hs[r]) * gelu_tanh(bf2f(gv[r])));
        }
        __builtin_amdgcn_sched_barrier(0);
    }
}
}
__device__ __forceinline__ void phase_c2(const Params& p, const Ctx& c, int l) {
    constexpr int ND = 82;
    const bool split = c.nb == 256;
    if (split && c.bid < ND) { phase_g1(p, c, l, true); __syncthreads(); }
    else if (!split) { phase_g1(p, c, l, true); __syncthreads(); }
    const int first = split ? (c.bid < ND ? c.bid : ND + (c.bid - ND)) : c.bid;
    const int stride = split ? (c.bid < ND ? NB * NCH : c.nb - ND) : c.nb;
    for (int it = first; it < NB * NCH; it += stride) {
        const int b = it / NCH, ch = it % NCH;
        const lru::WF w0 = lru::load_w(p, l, 0, c.wave, 0, c.lane & 31, c.lane >> 5);
        __syncthreads();
        lru::load_uc(p, c, l, b, ch, c.lds);
        __syncthreads();
        lru::chunk<0>(p, c, l, b, ch, c.lds, w0);
    }
}
__device__ __forceinline__ void phase_c3(const Params& p, const Ctx& c) {
    LAS float* sA = (LAS float*)c.lds; LAS float* sE = sA + 512;
    const float* ag = (const float*)(p.ws + WS_AGG); float* cr = (float*)(p.ws + WS_CARRY);
    for (int u = c.nb - 1 - c.bid; u < 32; u += c.nb) {
        const int b = u >> 4, d = (u >> 3) & 1, chn = (u & 7) * 64 + c.lane, seg = c.wave;
        float aa[33], ee[33];
#pragma unroll
        for (int k = 0; k < 33; ++k) { const int s = seg * 33 + k, ch = d == 0 ? s : (s < NCH_CTX ? NCH_CTX - 1 - s : NCH - 1 - (s - NCH_CTX));
            const size_t idx = ((size_t)((b * 2 + d) * NCH + ch)) * LRU_W + chn; const f32x2 v = *(const f32x2*)(ag + 2 * idx); aa[k] = v.x; ee[k] = v.y; }
        float A = 1.f, E = 0.f;
#pragma unroll
        for (int k = 0; k < 33; ++k) { E = aa[k] * E + ee[k]; A *= aa[k]; }
        __syncthreads();
        sA[seg * 64 + c.lane] = A; sE[seg * 64 + c.lane] = E;
        __syncthreads();
        float st = 0.f;
        for (int s2 = 0; s2 < seg; ++s2) st = sA[s2 * 64 + c.lane] * st + sE[s2 * 64 + c.lane];
#pragma unroll
        for (int k = 0; k < 33; ++k) { const int s = seg * 33 + k, ch = d == 0 ? s : (s < NCH_CTX ? NCH_CTX - 1 - s : NCH - 1 - (s - NCH_CTX));
            const size_t idx = ((size_t)((b * 2 + d) * NCH + ch)) * LRU_W + chn; cr[idx] = st; st = aa[k] * st + ee[k]; }
    }
}
__device__ __forceinline__ void phase_c4(const Params& p, const Ctx& c, int l, bool last) {
    for (int k = 0; k * c.nb < NB * NCH; ++k) {
        const int it = (k < 2 || c.nb != 256) ? k * c.nb + c.bid : k * c.nb + (c.nb - 1 - c.bid);
        if (it >= NB * NCH) continue;
        const int b = it / NCH, ch = it % NCH;
        if (last && ch < NCH_CTX) continue;
        const lru::WF w0 = lru::load_w(p, l, 1, c.wave, 0, c.lane & 31, c.lane >> 5);
        __syncthreads();
        lru::load_uc(p, c, l, b, ch, c.lds);
        __syncthreads();
        lru::chunk<1>(p, c, l, b, ch, c.lds, w0);
    }
}

namespace mla {
typedef float f32x16 __attribute__((ext_vector_type(16)));
typedef short s16x4 __attribute__((ext_vector_type(4)));
constexpr int DQ = 96, DV = 64, KVB = 64;
constexpr float SCALE = 0.10206207261596575f, THR = 8.f;
constexpr int SHM_V = KVB * DV * 2  , SHM_K = KVB * 256  , SHM_ATTN = 3 * SHM_V + 3 * SHM_K + NWAVES * 64 * 4;
#define KSWZ(row, colB) ((row) * 256 + ((colB) ^ (((row) & 15) << 4)))
#define SBAR() __builtin_amdgcn_sched_barrier(0)
__device__ __forceinline__ int crow(int r, int hi) { return (r & 3) + 8 * (r >> 2) + 4 * hi; }
__device__ __forceinline__ unsigned cvtpk(float lo, float hi) { return ::pk2(lo, hi); }
__device__ __forceinline__ void finishSM(f32x16& p0, f32x16& p1, float alpha, float& l_reg, bf16x8& pa0, bf16x8& pa1, bf16x8& pa2, bf16x8& pa3) {
#pragma unroll
    for (int r = 0; r < 16; ++r) p1[r] = __builtin_amdgcn_exp2f(p1[r]);
    float ps, ps0 = 0, ps1 = 0, ps2 = 0, ps3 = 0;
#pragma unroll
    for (int r = 0; r < 16; r += 2) { ps0 += p0[r]; ps1 += p0[r + 1]; ps2 += p1[r]; ps3 += p1[r + 1]; }
    ps = (ps0 + ps1) + (ps2 + ps3);
    { auto rr = __builtin_amdgcn_permlane32_swap(__float_as_uint(ps), __float_as_uint(ps), false, false);
      ps = __uint_as_float(rr[0]) + __uint_as_float(rr[1]); }
    l_reg = l_reg * alpha + ps;
#define PK4(P, BASE, OUT) do { unsigned a0 = cvtpk(P[BASE + 0], P[BASE + 1]), a1 = cvtpk(P[BASE + 2], P[BASE + 3]);   \
    unsigned b0 = cvtpk(P[BASE + 4], P[BASE + 5]), b1 = cvtpk(P[BASE + 6], P[BASE + 7]);                              \
    auto r0 = __builtin_amdgcn_permlane32_swap(a0, b0, false, false); auto r1 = __builtin_amdgcn_permlane32_swap(a1, b1, false, false); \
    u32x4 w = {r0[0], r1[0], r0[1], r1[1]}; OUT = *reinterpret_cast<bf16x8*>(&w); } while (0)
    PK4(p0, 0, pa0); PK4(p0, 8, pa1); PK4(p1, 0, pa2); PK4(p1, 8, pa3);
#undef PK4
}
template <int VAR = 0>
__device__ __forceinline__ void qkt(f32x16& p0, f32x16& p1, LAS const unsigned char* Ks, const bf16x8* qr, int r32, int hi, float m_reg) {
#pragma unroll
    for (int r = 0; r < 16; ++r) { p0[r] = -m_reg; p1[r] = -m_reg; }
#pragma unroll
    for (int d0 = 0; d0 < DQ / 16; ++d0) { const int cb = (d0 * 16 + hi * 8) * 2;
        const bf16x8 b0 = *(LAS const bf16x8*)(Ks + KSWZ(r32, cb));
        const bf16x8 b1 = *(LAS const bf16x8*)(Ks + KSWZ(32 + r32, cb));
        if (VAR & 2) { asm volatile("" :: "v"(b0), "v"(b1)); }
        else { p0 = __builtin_amdgcn_mfma_f32_32x32x16_bf16(b0, qr[d0], p0, 0, 0, 0);
               p1 = __builtin_amdgcn_mfma_f32_32x32x16_bf16(b1, qr[d0], p1, 0, 0, 0); } }
}
__device__ __forceinline__ int v_st(int k, int cc) { const int kk = (k & ~0xC) | ((k & 4) << 1) | ((k & 8) >> 1); return ((kk >> 3) * 2 + (cc >> 5)) * 512 + ((kk & 7) * 32 + (cc & 31)) * 2; }
__device__ __forceinline__ int v_rd_base(int lane) { return ((lane & 3) << 3) | (((lane >> 2) & 3) << 6) | (((lane >> 4) & 1) << 5) | (((lane >> 5) & 1) << 8); }
constexpr int v_rd_off(int d0, int ks, int half) { return d0 * 512 + ks * 2048 + half * 1024; }
template <int OFF> __device__ __forceinline__ s16x4 tr_read(int vb) { return __builtin_amdgcn_ds_read_tr16_b64_v4i16((LAS s16x4*)(uintptr_t)(unsigned)(vb + OFF)); }
template <int D0, int VAR = 0> __device__ __forceinline__ void pv_one(f32x16& od, int vb, bf16x8 pa0, bf16x8 pa1, bf16x8 pa2, bf16x8 pa3) {
    const s16x4 l0 = tr_read<v_rd_off(D0, 0, 0)>(vb), h0 = tr_read<v_rd_off(D0, 0, 1)>(vb), l1 = tr_read<v_rd_off(D0, 1, 0)>(vb), h1 = tr_read<v_rd_off(D0, 1, 1)>(vb);
    const s16x4 l2 = tr_read<v_rd_off(D0, 2, 0)>(vb), h2 = tr_read<v_rd_off(D0, 2, 1)>(vb), l3 = tr_read<v_rd_off(D0, 3, 0)>(vb), h3 = tr_read<v_rd_off(D0, 3, 1)>(vb);
#define PKV(L, H) (bf16x8){L[0], L[1], L[2], L[3], H[0], H[1], H[2], H[3]}
    if (VAR & 2) { asm volatile("" :: "v"(l0), "v"(h0), "v"(l1), "v"(h1), "v"(l2), "v"(h2), "v"(l3), "v"(h3), "v"(pa0), "v"(pa1), "v"(pa2), "v"(pa3)); return; }
    od = __builtin_amdgcn_mfma_f32_32x32x16_bf16(pa0, PKV(l0, h0), od, 0, 0, 0);
    od = __builtin_amdgcn_mfma_f32_32x32x16_bf16(pa1, PKV(l1, h1), od, 0, 0, 0);
    od = __builtin_amdgcn_mfma_f32_32x32x16_bf16(pa2, PKV(l2, h2), od, 0, 0, 0);
    od = __builtin_amdgcn_mfma_f32_32x32x16_bf16(pa3, PKV(l3, h3), od, 0, 0, 0);
#undef PKV
}
template <int VAR = 0> __device__ __forceinline__ void pv_all(f32x16* o, int vb, bf16x8 pa0, bf16x8 pa1, bf16x8 pa2, bf16x8 pa3) { pv_one<0, VAR>(o[0], vb, pa0, pa1, pa2, pa3); pv_one<1, VAR>(o[1], vb, pa0, pa1, pa2, pa3); }

constexpr float THR2 = THR * 1.4426950408889634f;
__device__ __forceinline__ void decideSM(f32x16& p0, f32x16& p1, float& m_reg, float& alpha) {
    float pmax = p0[0], pmx1 = p1[0];
#pragma unroll
    for (int r = 1; r < 16; ++r) { pmax = fmaxf(pmax, p0[r]); pmx1 = fmaxf(pmx1, p1[r]); }
    pmax = fmaxf(pmax, pmx1);
    { auto rr = __builtin_amdgcn_permlane32_swap(__float_as_uint(pmax), __float_as_uint(pmax), false, false);
      pmax = fmaxf(__uint_as_float(rr[0]), __uint_as_float(rr[1])); }
    if (__builtin_expect(__all(pmax <= THR2), 1)) { alpha = 1.f; }
    else { const float d = fmaxf(pmax, 0.f);
        alpha = __builtin_amdgcn_exp2f(-d); m_reg += d;
#pragma unroll
        for (int r = 0; r < 16; ++r) { p0[r] -= d; p1[r] -= d; } }
}
__device__ __forceinline__ void decideSM_first(f32x16& p0, f32x16& p1, float& m_reg, float& alpha) {
    float pmax = p0[0], pmx1 = p1[0];
#pragma unroll
    for (int r = 1; r < 16; ++r) { pmax = fmaxf(pmax, p0[r]); pmx1 = fmaxf(pmx1, p1[r]); }
    pmax = fmaxf(pmax, pmx1);
    { auto rr = __builtin_amdgcn_permlane32_swap(__float_as_uint(pmax), __float_as_uint(pmax), false, false);
      pmax = fmaxf(__uint_as_float(rr[0]), __uint_as_float(rr[1])); }
    alpha = 1.f; m_reg += pmax;
#pragma unroll
    for (int r = 0; r < 16; ++r) { p0[r] -= pmax; p1[r] -= pmax; }
}
__device__ __forceinline__ void scaleexp(f32x16& p0, f32x16& p1) {
#pragma unroll
    for (int r = 0; r < 16; ++r) p0[r] = __builtin_amdgcn_exp2f(p0[r]);
}
template <int VAR = 0>
__device__ __forceinline__ void pv_sm(f32x16* o, int vb, bf16x8 pa0, bf16x8 pa1, bf16x8 pa2, bf16x8 pa3, f32x16& q0, f32x16& q1) {
    pv_one<0, VAR>(o[0], vb, pa0, pa1, pa2, pa3);
    if (!(VAR & 1)) {
#pragma unroll
        for (int r = 0; r < 16; ++r) q0[r] = __builtin_amdgcn_exp2f(q0[r]); }
    pv_one<1, VAR>(o[1], vb, pa0, pa1, pa2, pa3);
}
__device__ __forceinline__ void fake_finish(const f32x16& p0, const f32x16& p1, bf16x8& pa0, bf16x8& pa1, bf16x8& pa2, bf16x8& pa3) {
    u32x4 w0 = {__float_as_uint(p0[0]), __float_as_uint(p0[1]), __float_as_uint(p0[2]), __float_as_uint(p0[3])}; pa0 = *reinterpret_cast<bf16x8*>(&w0);
    u32x4 w1 = {__float_as_uint(p0[4]), __float_as_uint(p0[5]), __float_as_uint(p0[6]), __float_as_uint(p0[7])}; pa1 = *reinterpret_cast<bf16x8*>(&w1);
    u32x4 w2 = {__float_as_uint(p1[0]), __float_as_uint(p1[1]), __float_as_uint(p1[2]), __float_as_uint(p1[3])}; pa2 = *reinterpret_cast<bf16x8*>(&w2);
    u32x4 w3 = {__float_as_uint(p1[4]), __float_as_uint(p1[5]), __float_as_uint(p1[6]), __float_as_uint(p1[7])}; pa3 = *reinterpret_cast<bf16x8*>(&w3);
}

template <int VAR = 0>
__device__ __forceinline__ void attn_unit(const bf16_t* __restrict__ Qb, const bf16_t* __restrict__ Kh, const bf16_t* __restrict__ Vh, bf16_t* __restrict__ Ob, int seq, LAS unsigned char* lds, int tid) {
    const int wid = tid >> 6, lane = tid & 63, r32 = lane & 31, hi = lane >> 5;
    LAS unsigned char* V_lds = lds; LAS unsigned char* K_lds = lds + 3 * SHM_V;
    LAS float* wsf = (LAS float*)(lds + 3 * SHM_V + 3 * SHM_K) + wid * 64; LAS float* li_l = wsf; LAS float* al_l = wsf + 32;
    float m_reg = 0.f, l_reg = 0; f32x16 o[2] = {}; bf16x8 qr[6];
    const bf16_t* Qw = Qb + (size_t)(wid * 32 + r32) * DQ + hi * 8;
#pragma unroll
    for (int d0 = 0; d0 < 6; ++d0) qr[d0] = *(const bf16x8*)(Qw + d0 * 16);
    const int vrow = tid >> 3, vcol = (tid & 7) * 8, vst = v_st(vrow, vcol);
    const int k0row = tid / 12, k0ch = tid % 12, k1row = (512 + tid) / 12, k1ch = (512 + tid) % 12;
    const int kst0 = KSWZ(k0row, k0ch * 16), kst1 = KSWZ(k1row, k1ch * 16);
    const bool has1 = tid < 256;
    const int vb0 = (int)(uintptr_t)V_lds + v_rd_base(lane);
    unsigned vsrc, ksrc[2];
    { const int ov = wid * 1024 + lane * 16, sbt = ov >> 9, kk = (sbt >> 1) * 8 + ((ov >> 6) & 7), k = (kk & ~0xC) | ((kk & 4) << 1) | ((kk & 8) >> 1), cc = (sbt & 1) * 32 + ((ov >> 4) & 3) * 8;
      vsrc = (unsigned)(k * DV + cc) * 2u;
#pragma unroll
      for (int i = 0; i < 2; ++i) { const int ok = wid * 2048 + i * 1024 + lane * 16, row = ok >> 8, slot = (ok >> 4) & 15, ch = slot ^ (row & 15); ksrc[i] = (unsigned)(row * DQ + (ch < 12 ? ch : 0) * 8) * 2u; } }
#define SLOAD(i, kk) do { } while (0)
#define SWRITE(b, i) do { } while (0)
#define DMA(b, kk) do { if (VAR & 4) break; \
    __builtin_amdgcn_global_load_lds((const unsigned*)((const char*)(Vh + (size_t)(kk) * DV) + vsrc), (LAS unsigned*)(V_lds + (b) * SHM_V + wid * 1024), 16, 0, 0); \
    __builtin_amdgcn_global_load_lds((const unsigned*)((const char*)(Kh + (size_t)(kk) * DQ) + ksrc[0]), (LAS unsigned*)(K_lds + (b) * SHM_K + wid * 2048), 16, 0, 0); \
    __builtin_amdgcn_global_load_lds((const unsigned*)((const char*)(Kh + (size_t)(kk) * DQ) + ksrc[1]), (LAS unsigned*)(K_lds + (b) * SHM_K + wid * 2048 + 1024), 16, 0, 0); } while (0)
#define RESC(a) do { if (__any((a) < 1.f)) { if (hi == 0) al_l[r32] = (a); asm volatile("s_waitcnt lgkmcnt(0)" ::: "memory"); \
    _Pragma("unroll") for (int d = 0; d < 2; ++d) _Pragma("unroll") for (int r = 0; r < 16; ++r) o[d][r] *= al_l[crow(r, hi)]; } } while (0)
    f32x16 pA0, pA1, pB0, pB1; float alA, alB; bf16x8 pa0, pa1, pa2, pa3; const int NT = seq / KVB;
    DMA(0, 0); DMA(1, KVB); __syncthreads();
    qkt<VAR>(pA0, pA1, K_lds, qr, r32, hi, m_reg); if (VAR & 1) { alA = 1.f; } else { decideSM_first(pA0, pA1, m_reg, alA); scaleexp(pA0, pA1); }
    int bq = 1, bp = 0, bw = 2;
    constexpr bool ordB = false;
#define FIN(P0, P1, AL) do { if (VAR & 1) fake_finish(P0, P1, pa0, pa1, pa2, pa3); else finishSM(P0, P1, AL, l_reg, pa0, pa1, pa2, pa3); } while (0)
#define DEC(P0, P1, MC, AL) do { if (VAR & 1) { AL = 1.f; } else decideSM(P0, P1, m_reg, AL); } while (0)
#define STEP(PX0, PX1, ALX, PY0, PY1, ALY, LOADSTMT, WSLOT) do { \
        if (!ordB) { LOADSTMT; qkt<VAR>(PX0, PX1, K_lds + bq * SHM_K, qr, r32, hi, m_reg); FIN(PY0, PY1, ALY); \
            DEC(PX0, PX1, 0, ALX); \
            pv_sm<VAR>(o, vb0 + bp * SHM_V, pa0, pa1, pa2, pa3, PX0, PX1); } \
        else { SBAR(); FIN(PY0, PY1, ALY); SBAR(); \
            pv_all<VAR>(o, vb0 + bp * SHM_V, pa0, pa1, pa2, pa3); SBAR(); \
            LOADSTMT; qkt<VAR>(PX0, PX1, K_lds + bq * SHM_K, qr, r32, hi, m_reg); SBAR(); \
            DEC(PX0, PX1, 0, ALX); if (!(VAR & 1)) scaleexp(PX0, PX1); SBAR(); } \
        SWRITE(bw, WSLOT); RESC(ALX); if (!(VAR & 8)) __syncthreads(); \
        { const int t3 = bp; bp = bq; bq = bw; bw = t3; } } while (0)
    for (int t = 1; t + 1 < NT; t += 2) {
        STEP(pB0, pB1, alB, pA0, pA1, alA, DMA(bw, (t + 1) * KVB), 0);
        STEP(pA0, pA1, alA, pB0, pB1, alB, DMA(bw, (t + 2) * KVB), 1);
    }
#undef STEP
    qkt<VAR>(pB0, pB1, K_lds + bq * SHM_K, qr, r32, hi, m_reg);
    if (VAR & 1) fake_finish(pA0, pA1, pa0, pa1, pa2, pa3); else finishSM(pA0, pA1, alA, l_reg, pa0, pa1, pa2, pa3);
    if (VAR & 1) { alB = 1.f; } else decideSM(pB0, pB1, m_reg, alB);
    pv_sm<VAR>(o, vb0 + bp * SHM_V, pa0, pa1, pa2, pa3, pB0, pB1);
    RESC(alB);
    if (VAR & 1) fake_finish(pB0, pB1, pa0, pa1, pa2, pa3); else finishSM(pB0, pB1, alB, l_reg, pa0, pa1, pa2, pa3);
    pv_all<VAR>(o, vb0 + bq * SHM_V, pa0, pa1, pa2, pa3);
    if (hi == 0) li_l[r32] = l_reg;
    asm volatile("s_waitcnt lgkmcnt(0)" ::: "memory");
    float rli[16];
#pragma unroll
    for (int r = 0; r < 16; ++r) rli[r] = __builtin_amdgcn_rcpf(li_l[crow(r, hi)]);
    bf16_t* Ow = Ob + (size_t)(wid * 32) * D;
#pragma unroll
    for (int r = 0; r < 16; ++r) { const int orow = crow(r, hi);
#pragma unroll
        for (int d0 = 0; d0 < 2; ++d0) Ow[(size_t)orow * D + d0 * 32 + r32] = (bf16_t)f2bf(o[d0][r] * rli[r]); }
    __syncthreads();
#undef SLOAD
#undef SWRITE
#undef DMA
#undef RESC
#undef FIN
#undef DEC
}
#undef KSWZ
#undef SBAR
}
namespace nab {
using mla::f32x16;
constexpr int SHM_V = 8192, SHM_K = 16384, RING = 3 * (SHM_V + SHM_K);
constexpr int LDS_NEED = RING + NWAVES * 256 + 2048;
constexpr float SCALE = 0.125f, C = SCALE * 1.4426950408889634f;
#define KSWZ(row, colB) ((row) * 256 + ((colB) ^ (((row) & 15) << 4)))
#define SBAR() __builtin_amdgcn_sched_barrier(0)
__device__ __forceinline__ void qkt64(f32x16& p0, f32x16& p1, LAS const unsigned char* Ks, const bf16x8* qr, int r32, int hi, float m_reg) {
#pragma unroll
    for (int r = 0; r < 16; ++r) { p0[r] = -m_reg; p1[r] = -m_reg; }
#pragma unroll
    for (int d0 = 0; d0 < 4; ++d0) { const int cb = (d0 * 16 + hi * 8) * 2;
        const bf16x8 b0 = *(LAS const bf16x8*)(Ks + KSWZ(r32, cb));
        const bf16x8 b1 = *(LAS const bf16x8*)(Ks + KSWZ(32 + r32, cb));
        p0 = __builtin_amdgcn_mfma_f32_32x32x16_bf16(b0, qr[d0], p0, 0, 0, 0);
        p1 = __builtin_amdgcn_mfma_f32_32x32x16_bf16(b1, qr[d0], p1, 0, 0, 0); }
}
__device__ __forceinline__ void unit(const bf16_t* __restrict__ Pb, int h, bool lat, int r0, LAS const float* rp, bf16_t* __restrict__ Yb, LAS unsigned char* lds, int tid) {
    const int wid = __builtin_amdgcn_readfirstlane(tid >> 6), lane = tid & 63, r32 = lane & 31, hi = lane >> 5;
    LAS unsigned char* V_lds = lds; LAS unsigned char* K_lds = lds + 3 * SHM_V;
    LAS float* wsf = (LAS float*)(lds + RING) + wid * 64; LAS float* li_l = wsf; LAS float* al_l = wsf + 32;
    const int r = r0 + (wid >> 1), qc = (wid & 1) * 32 + r32, cs = min(max(qc - 8, 0), 48);
    const int qtok = lat ? CTX + r * GW + qc : wid * 32 + r32;
    const int rs_me = min(max(r - 4, 0), 120), rs_min = min(max(r0 - 4, 0), 120), nrows = lat ? (min(max(r0 + 3 - 4, 0), 120) + 8 - rs_min) : 0;
    const int NT = (4 + nrows + 1) & ~1;
    float m_reg = 0.f, l_reg = 0; f32x16 o[2] = {}; bf16x8 qr[4];
    { const bf16_t* Qw = Pb + (size_t)qtok * INP + OFF_QA + h * 64 + hi * 8;
#pragma unroll
      for (int d0 = 0; d0 < 4; ++d0) { const u32x4 w = *(const u32x4*)(Qw + d0 * 16);
          u32x4 o4; o4.x = pk2(lo_bf(w.x) * C, hi_bf(w.x) * C); o4.y = pk2(lo_bf(w.y) * C, hi_bf(w.y) * C); o4.z = pk2(lo_bf(w.z) * C, hi_bf(w.z) * C); o4.w = pk2(lo_bf(w.w) * C, hi_bf(w.w) * C);
          qr[d0] = *reinterpret_cast<bf16x8*>(&o4); } }
    const int srow = tid >> 3, sch = tid & 7, vst = mla::v_st(srow, sch * 8), kst = KSWZ(srow, sch * 16);
    const unsigned svo = (unsigned)((srow * INP + h * 64 + sch * 8) * 2);
    const int vb0 = (int)(uintptr_t)V_lds + mla::v_rd_base(lane);
    struct { bf16x8 v, k; } sr_[2];
#define TOK0(t) ((t) < 4 ? (t) * 64 : CTX + min(rs_min + (t) - 4, 127) * GW)
#define SLOAD(i, t) do { const char* kb = (const char*)(Pb + (size_t)TOK0(t) * INP); sr_[i].k = *(const bf16x8*)(kb + svo + OFF_KA * 2); sr_[i].v = *(const bf16x8*)(kb + svo + OFF_VA * 2); } while (0)
#define SWRITE(b, i) do { *(LAS bf16x8*)(V_lds + (b) * SHM_V + vst) = sr_[i].v; *(LAS bf16x8*)(K_lds + (b) * SHM_K + kst) = sr_[i].k; } while (0)
#define RESC(a) do { if (__any((a) < 1.f)) { if (hi == 0) al_l[r32] = (a); asm volatile("s_waitcnt lgkmcnt(0)" ::: "memory"); \
    _Pragma("unroll") for (int d = 0; d < 2; ++d) _Pragma("unroll") for (int rr = 0; rr < 16; ++rr) o[d][rr] *= al_l[mla::crow(rr, hi)]; } } while (0)
#define MASK(P0, P1, t) do { if ((t) >= 4) { const int kr = rs_min + (t) - 4; \
        if ((unsigned)(kr - rs_me) < 8u) { int qcl = qc; asm volatile("" : "+v"(qcl)); const int csl = min(max(qcl - 8, 0), 48); \
            LAS const float* rl_ = rp + (kr - r + 7) * 32 + (4 * hi - qcl + 15); const int rel = 4 * hi - csl; \
            _Pragma("unroll") for (int rr = 0; rr < 16; ++rr) { const int k0c = mla::crow(rr, 0); \
                P0[rr] = ((unsigned)(rel + k0c) < 16u) ? P0[rr] + rl_[k0c] : -1e30f; \
                P1[rr] = ((unsigned)(rel + k0c + 32) < 16u) ? P1[rr] + rl_[k0c + 32] : -1e30f; } } \
        else { _Pragma("unroll") for (int rr = 0; rr < 16; ++rr) { P0[rr] = -1e30f; P1[rr] = -1e30f; } } } } while (0)
    f32x16 pA0, pA1, pB0, pB1; float alA, alB; bf16x8 pa0, pa1, pa2, pa3;
    SLOAD(0, 0); SLOAD(1, 1); SWRITE(0, 0); SWRITE(1, 1); __syncthreads();
    SLOAD(0, 2);
    qkt64(pA0, pA1, K_lds, qr, r32, hi, m_reg); mla::decideSM_first(pA0, pA1, m_reg, alA); mla::scaleexp(pA0, pA1);
    int bq = 1, bp = 0, bw = 2;
#define STEP(PX0, PX1, ALX, PY0, PY1, ALY, t, LOADSTMT, WSLOT) do { \
        qkt64(PX0, PX1, K_lds + bq * SHM_K, qr, r32, hi, m_reg); mla::finishSM(PY0, PY1, ALY, l_reg, pa0, pa1, pa2, pa3); \
        LOADSTMT; MASK(PX0, PX1, t); mla::decideSM(PX0, PX1, m_reg, ALX); \
        mla::pv_sm<0>(o, vb0 + bp * SHM_V, pa0, pa1, pa2, pa3, PX0, PX1); \
        SWRITE(bw, WSLOT); RESC(ALX); __syncthreads(); \
        { const int t3 = bp; bp = bq; bq = bw; bw = t3; } } while (0)
    for (int t = 1; t + 1 < NT; t += 2) {
        STEP(pB0, pB1, alB, pA0, pA1, alA, t, SLOAD(1, t + 2), 0);
        STEP(pA0, pA1, alA, pB0, pB1, alB, t + 1, if (t + 3 < NT) SLOAD(0, t + 3), 1);
    }
#undef STEP
    qkt64(pB0, pB1, K_lds + bq * SHM_K, qr, r32, hi, m_reg);
    mla::finishSM(pA0, pA1, alA, l_reg, pa0, pa1, pa2, pa3);
    MASK(pB0, pB1, NT - 1); mla::decideSM(pB0, pB1, m_reg, alB);
    mla::pv_sm<0>(o, vb0 + bp * SHM_V, pa0, pa1, pa2, pa3, pB0, pB1);
    RESC(alB);
    mla::finishSM(pB0, pB1, alB, l_reg, pa0, pa1, pa2, pa3);
    mla::pv_all<0>(o, vb0 + bq * SHM_V, pa0, pa1, pa2, pa3);
    if (hi == 0) li_l[r32] = l_reg;
    asm volatile("s_waitcnt lgkmcnt(0)" ::: "memory");
    const int qtok0 = lat ? CTX + r * GW + (wid & 1) * 32 : wid * 32;
    bf16_t* Ow = Yb + (size_t)qtok0 * D + h * 64;
#pragma unroll
    for (int rr = 0; rr < 16; ++rr) { const int orow = mla::crow(rr, hi); const float rl = __builtin_amdgcn_rcpf(li_l[orow]);
#pragma unroll
        for (int d0 = 0; d0 < 2; ++d0) Ow[(size_t)orow * D + d0 * 32 + r32] = (bf16_t)f2bf(o[d0][rr] * rl); }
    __syncthreads();
#undef TOK0
#undef SLOAD
#undef SWRITE
#undef RESC
#undef MASK
}
#undef KSWZ
#undef SBAR
}
__device__ __forceinline__ void phase_a1b(const Params& p, const Ctx& c, int l, bool last) {
    const bf16_t* P = (const bf16_t*)(p.ws + WS_P); bf16_t* Y = (bf16_t*)(p.ws + WS_Y);
    LAS float* rp = (LAS float*)(c.lds + nab::RING + NWAVES * 256);
    const int n_units = 256 + (last ? 0 : 8);
    for (int u = c.bid; u < n_units; u += c.nb) {
        const int bh = u & 7, b = bh >> 2, h = bh & 3; const bool lat = u < 256;
        __syncthreads();
        if (lat) { const float* rpb = p.na_rpb + (size_t)((l * 4 + h) * 15) * 31;
            for (int i = c.tid; i < 15 * 32; i += NTHREADS) { const int dr = i >> 5, dc = i & 31; rp[i] = dc < 31 ? rpb[dr * 31 + dc] * 1.4426950408889634f : 0.f; } }
        __syncthreads();
        nab::unit(P + (size_t)(b * LT) * INP, h, lat, lat ? (u >> 3) * 4 : 0, rp, Y + (size_t)(b * LT) * D, c.lds, c.tid);
    }
}

template <int VAR = 0>
__device__ __forceinline__ void phase_a2(const Params& p, const Ctx& c, bool last) {
    const bf16_t* Q = (const bf16_t*)(p.ws + WS_Q); const bf16_t* Kb = (const bf16_t*)(p.ws + WS_K); const bf16_t* Vb = (const bf16_t*)(p.ws + WS_V);
    bf16_t* Y = (bf16_t*)(p.ws + WS_Y);
    const int n_units = 256 + (last ? 0 : 8);
    for (int u = c.bid; u < n_units; u += c.nb) {
        const int bh = u & 7, b = bh >> 2, h = bh & 3;
        const int t0 = u < 256 ? CTX + (u >> 3) * 256 : 0, seq = u < 256 ? LT : CTX;
        const size_t hb = (size_t)(b * 4 + h) * LT;
        mla::attn_unit<VAR>(Q + (hb + t0) * 96, Kb + hb * 96, Vb + hb * 64, Y + (size_t)(b * LT + t0) * D + 768 + h * 64, seq, c.lds, c.tid);
    }
}

__device__ __forceinline__ void phase_o2(const Params& p, const Ctx& c, int l, bool last) {
    LAS float* gt = (LAS float*)c.lds;
    LAS float* sh = gt + 3 * D;
    LAS float* sc = sh + 3 * D;
    LAS int* lcnt = (LAS int*)(sc + 3 * D);
    load_mods(p, c, l, 2, gt); load_mods(p, c, l, 3, sh); load_mods(p, c, l, 4, sc);
    if (c.tid < NE) lcnt[c.tid] = 0;
    LAS float* rwl = (LAS float*)(c.lds + 40960);
    for (int i = c.tid; i < D * 4; i += NTHREADS) { const int n = i >> 2, q4 = i & 3; *(LAS f32x4*)(rwl + ((n & 3) * 256 + (n >> 2)) * 20 + 4 * q4) = *(const f32x4*)(p.router_w + (size_t)n * 16 + 4 * q4); }
    LAS float* g1 = (LAS float*)(c.lds + 122880); LAS float* g2 = g1 + D;
    for (int i = c.tid; i < D; i += NTHREADS) { g1[i] = p.g_norm[(size_t)(l * 4 + 1) * D + i]; g2[i] = p.g_norm[(size_t)(l * 4 + 2) * D + i]; }
    __syncthreads();
    const bf16_t* YO = (const bf16_t*)(p.ws + WS_P); bf16_t* H = (bf16_t*)(p.ws + WS_H);
    int* RE = (int*)(p.ws + WS_RE); float* RW = (float*)(p.ws + WS_RW);
    const int nrow = last ? NB * S : M;
#define O2_ROW(i) (last ? ((i) / S) * LT + CTX + ((i) % S) : (i))
#define O2_LOAD(i) do { const int m_ = O2_ROW(i); const bf16_t* yr_ = YO + (size_t)m_ * D; \
        _Pragma("unroll") for (int j = 0; j < 4; ++j) ywn[j] = *(const u32x2*)((const char*)yr_ + (unsigned)(8 * (c.lane + 64 * j))); \
        if (l == 0) { const float* xr_ = xin_row(p, m_); _Pragma("unroll") for (int j = 0; j < 4; ++j) xvn[j] = *(const f32x4*)((const char*)xr_ + (unsigned)(16 * (c.lane + 64 * j))); } \
        else { const bf16_t* xr_ = xb_row(p, m_); _Pragma("unroll") for (int j = 0; j < 4; ++j) xbn[j] = *(const u32x2*)((const char*)xr_ + (unsigned)(8 * (c.lane + 64 * j))); } } while (0)
    u32x2 ywn[4], xbn[4]; f32x4 xvn[4];
    if (c.gw < nrow) O2_LOAD(c.gw);
#pragma unroll 1
    for (int ri = c.gw; ri < nrow; ri += c.ngw) {
        const int m = O2_ROW(ri);
        const int b = m / LT, t = m - b * LT, r = t < CTX ? 2 : b;
        f32x4 y[4], xv[4]; float ss = 0.f;
#pragma unroll
        for (int j = 0; j < 4; ++j) { y[j] = bf4(ywn[j]); xv[j] = (l == 0) ? xvn[j] : bf4(xbn[j]);
            ss += y[j].x * y[j].x + y[j].y * y[j].y + y[j].z * y[j].z + y[j].w * y[j].w; }
        if (ri + c.ngw < nrow) O2_LOAD(ri + c.ngw);
        const float rstd = rsqrtf(wave_sum(ss) * (1.f / D) + 1e-6f);
        float s2 = 0.f;
#pragma unroll
        for (int j = 0; j < 4; ++j) { const int n = 4 * (c.lane + 64 * j); const f32x4 gg = *(LAS const f32x4*)(g1 + n);
#pragma unroll
            for (int e = 0; e < 4; ++e) { xv[j][e] += gt[r * D + n + e] * (y[j][e] * rstd * gg[e]); s2 += xv[j][e] * xv[j][e]; }
            if (t < CTX) *(f32x4*)((char*)xc_row(p, m) + (unsigned)(n * 4)) = xv[j]; else *(u32x2*)((char*)xb_row(p, m) + (unsigned)(n * 2)) = pk4(xv[j]); }
        const float rstd2 = rsqrtf(wave_sum(s2) * (1.f / D) + 1e-6f);
        float lg[16];
#pragma unroll
        for (int e = 0; e < 16; ++e) lg[e] = 0.f;
#pragma unroll
        for (int j = 0; j < 4; ++j) { const int n = 4 * (c.lane + 64 * j); const f32x4 gg = *(LAS const f32x4*)(g2 + n);
            float o[4];
#pragma unroll
            for (int e = 0; e < 4; ++e) { o[e] = xv[j][e] * rstd2 * gg[e] * (1.f + sc[r * D + n + e]) + sh[r * D + n + e];
                LAS const f32x4* rw = (LAS const f32x4*)(rwl + (e * 256 + c.lane + 64 * j) * 20);
#pragma unroll
                for (int q4 = 0; q4 < 4; ++q4) { const f32x4 w = rw[q4]; lg[4 * q4] += o[e] * w.x; lg[4 * q4 + 1] += o[e] * w.y; lg[4 * q4 + 2] += o[e] * w.z; lg[4 * q4 + 3] += o[e] * w.w; } }
            u32x2 w; w.x = pk2(o[0], o[1]); w.y = pk2(o[2], o[3]);
            *(u32x2*)(H + (size_t)m * D + n) = w; }
        float aff[16], sel[16];
#pragma unroll
        for (int e = 0; e < 16; ++e) { aff[e] = sigmoidf_(wave_sum(lg[e])); sel[e] = aff[e] + p.router_b[e]; }
        float bv = -INFINITY, ba0 = 0.f, ba1 = 0.f; int bi0 = 0, bi1 = 0;
#pragma unroll
        for (int g = 0; g < 4; ++g) {
            float m1 = sel[4 * g], a1 = aff[4 * g]; int i0 = 0;
#pragma unroll
            for (int i = 1; i < 4; ++i) if (sel[4 * g + i] > m1) { m1 = sel[4 * g + i]; a1 = aff[4 * g + i]; i0 = i; }
            float m2 = -INFINITY, a2 = 0.f; int i1 = 0;
#pragma unroll
            for (int i = 0; i < 4; ++i) if (i != i0 && sel[4 * g + i] > m2) { m2 = sel[4 * g + i]; a2 = aff[4 * g + i]; i1 = i; }
            const float gs = m1 + m2;
            if (gs > bv) { bv = gs; bi0 = 4 * g + i0; bi1 = 4 * g + i1; ba0 = a1; ba1 = a2; }
        }
        if (c.lane == 0) {
            const float inv = 1.f / (ba0 + ba1);
            const int lp0 = __hip_atomic_fetch_add(lcnt + bi0, 1, __ATOMIC_RELAXED, __HIP_MEMORY_SCOPE_WORKGROUP);
            const int lp1 = __hip_atomic_fetch_add(lcnt + bi1, 1, __ATOMIC_RELAXED, __HIP_MEMORY_SCOPE_WORKGROUP);
            RE[2 * m] = bi0 + 16 * lp0; RE[2 * m + 1] = bi1 + 16 * lp1; RW[2 * m] = ba0 * inv; RW[2 * m + 1] = ba1 * inv;
        }
    }
    __syncthreads();
    if (c.tid < NE) ((int*)(p.ws + WS_PERM))[c.bid * NE + c.tid] = lcnt[c.tid];
}

__device__ __forceinline__ void phase_r2(const Params& p, const Ctx& c, int l, bool last) {
    LAS int* cntT = (LAS int*)c.lds;
    LAS int* map = (LAS int*)(c.lds + 131072); LAS int* nE = map + 768; LAS int* ebase = nE + NE;
    const int* BC = (const int*)(p.ws + WS_PERM); const int* RE = (const int*)(p.ws + WS_RE);
    for (int i = c.tid; i < c.nb * NE; i += NTHREADS) cntT[i] = BC[i];
    for (int i = c.tid; i < 768; i += NTHREADS) map[i] = -1;
    __syncthreads();
    if (c.tid < NE) { int acc = 0; for (int b2 = 0; b2 < c.nb; ++b2) { const int v = cntT[b2 * NE + c.tid]; cntT[b2 * NE + c.tid] = acc; acc += v; } nE[c.tid] = acc; }
    __syncthreads();
    if (c.tid < NE) { int acc = 0; for (int e = 0; e < c.tid; ++e) acc += (nE[e] + 255) >> 8; ebase[c.tid] = acc * 256;
        if (c.bid == 0) ((unsigned*)(p.ws + WS_CTL))[CW_CNT + l * 64 + c.tid] = (unsigned)nE[c.tid]; }
    __syncthreads();
    const int rt0 = c.bid >> 2, rt1 = (c.nb + c.bid) >> 2, rt2 = (2 * c.nb + c.bid) >> 2, ngw = c.nb * NWAVES;
    for (int m = c.tid; m < M; m += NTHREADS) {
        const int b = m / LT, t = m - b * LT;
        if (last && t < CTX) continue;
        const int blk = ((last ? b * S + (t - CTX) : m) % ngw) >> 3;
#pragma unroll
        for (int k = 0; k < 2; ++k) { const int info = RE[2 * m + k], e = info & 15, pos = ebase[e] + cntT[blk * NE + e] + (info >> 4), rt = pos >> 8;
            if (rt == rt0) map[pos & 255] = 2 * m + k; else if (rt == rt1) map[256 + (pos & 255)] = 2 * m + k; else if (rt == rt2) map[512 + (pos & 255)] = 2 * m + k; }
    }
    __syncthreads();
    if ((c.bid & 3) == 0) { int tot = 0; for (int e = 0; e < NE; ++e) tot += (nE[e] + 255) >> 8;
        int* S2P = (int*)(p.ws + WS_S2P);
        for (int i = c.tid; i < 768; i += NTHREADS) { const int rt = (i < 256) ? rt0 : (i < 512 ? rt1 : rt2); if (rt < tot) S2P[rt * 256 + (i & 255)] = map[i]; } }
    pg8::Gemm g{(const bf16_t*)(p.ws + WS_H), (const bf16_t*)(p.ws + WS_WGU) + (size_t)l * NE * 1024 * 1024, 0, 0, D};
    pg8::MoeOrderL S{nE, c.nb, c.bid};
    pg8::EpiSwiGLU E{(bf16_t*)(p.ws + WS_Q)};
    pg8::MoeGatherA GA{map};
    pg8::gemm_phase<pg8::EpiSwiGLU, pg8::MoeOrderL, true, true, pg8::MoeGatherA>(c.lds, g, S, E, c.tid, GA);
    if (l == 0) {
        int tot = 0; for (int e = 0; e < NE; ++e) tot += (nE[e] + 255) >> 8;
        const int nfull = min(max(4 * tot - 2 * c.nb, 0), c.nb);
        __syncthreads();
        if (c.bid >= nfull) convert_weights(p, c, 1, 0, CV_ALL, (c.bid - nfull) * NWAVES + c.wave, (c.nb - nfull) * NWAVES);
        else if (nfull == c.nb) convert_weights(p, c, 1, 0, CV_ALL, c.gw, c.ngw);
    }
}
__device__ __forceinline__ void phase_r3(const Params& p, const Ctx& c, int l) {
    pg8::Gemm g{(const bf16_t*)(p.ws + WS_Q), (const bf16_t*)(p.ws + WS_WD) + (size_t)l * NE * 1024 * 512, 0, 0, DE};
    pg8::MoeOrder S{(const unsigned*)(p.ws + WS_CTL) + CW_CNT + l * 64, c.nb, c.bid};
    pg8::EpiScatter E{(bf16_t*)(p.ws + WS_P), (const int*)(p.ws + WS_S2P), (const float*)(p.ws + WS_RW), M};
    pg8::gemm_phase<pg8::EpiScatter, pg8::MoeOrder, true, true>(c.lds, g, S, E, c.tid);
}

__device__ __forceinline__ void phase_f(const Params& p, const Ctx& c, int l, bool last) {
    LAS float* gt = (LAS float*)c.lds; LAS float* sh = gt + 3 * D; LAS float* sc = sh + 3 * D;
    load_mods(p, c, l, 5, gt);
    if (!last) { load_mods(p, c, l + 1, 0, sh); load_mods(p, c, l + 1, 1, sc); }
    __syncthreads();
    const float* g0n = p.g_norm + (size_t)((l + 1) * 4 + 0) * D; bf16_t* H = (bf16_t*)(p.ws + WS_H);
    const float* g3 = p.g_norm + (size_t)(l * 4 + 3) * D;
    const bf16_t* F0 = (const bf16_t*)(p.ws + WS_P); const bf16_t* F1 = F0 + (size_t)M * D;
    const int nrow = last ? NB * S : M;
#define F_ROW(i) (last ? ((i) / S) * LT + CTX + ((i) % S) : (i))
#define F_LOAD(i) do { const int m_ = F_ROW(i); const bool cx_ = (m_ % LT) < CTX; \
        _Pragma("unroll") for (int j = 0; j < 4; ++j) { const int n_ = 4 * (c.lane + 64 * j); fan[j] = *(const u32x2*)(F0 + (size_t)m_ * D + n_); fbn[j] = *(const u32x2*)(F1 + (size_t)m_ * D + n_); } \
        if (cx_) { const float* xr_ = xc_row(p, m_); _Pragma("unroll") for (int j = 0; j < 4; ++j) xn[j] = *(const f32x4*)(xr_ + 4 * (c.lane + 64 * j)); } \
        else { const bf16_t* xr_ = xb_row(p, m_); _Pragma("unroll") for (int j = 0; j < 4; ++j) xbn[j] = *(const u32x2*)(xr_ + 4 * (c.lane + 64 * j)); } } while (0)
    u32x2 fan[4], fbn[4], xbn[4]; f32x4 xn[4];
    if (c.gw < nrow) F_LOAD(c.gw);
#pragma unroll 1
    for (int ri = c.gw; ri < nrow; ri += c.ngw) {
        const int m = F_ROW(ri);
        const int b = m / LT, t = m - b * LT, r = t < CTX ? 2 : b;
        float f[16]; float ss = 0.f; f32x4 xc[4];
#pragma unroll
        for (int j = 0; j < 4; ++j) {
            const u32x2 a = fan[j], bb = fbn[j]; xc[j] = (t < CTX) ? xn[j] : bf4(xbn[j]);
            f[4 * j] = lo_bf(a.x) + lo_bf(bb.x); f[4 * j + 1] = hi_bf(a.x) + hi_bf(bb.x); f[4 * j + 2] = lo_bf(a.y) + lo_bf(bb.y); f[4 * j + 3] = hi_bf(a.y) + hi_bf(bb.y);
#pragma unroll
            for (int e = 0; e < 4; ++e) ss += f[4 * j + e] * f[4 * j + e]; }
        if (ri + c.ngw < nrow) F_LOAD(ri + c.ngw);
        const float rstd = rsqrtf(wave_sum(ss) * (1.f / D) + 1e-6f);
        float s2 = 0.f;
#pragma unroll
        for (int j = 0; j < 4; ++j) { const int n = 4 * (c.lane + 64 * j); const f32x4 gg = *(const f32x4*)(g3 + n); f32x4 xv = xc[j];
#pragma unroll
            for (int e = 0; e < 4; ++e) { xv[e] += gt[r * D + n + e] * (f[4 * j + e] * rstd * gg[e]); f[4 * j + e] = xv[e]; s2 += xv[e] * xv[e]; }
            if (last) *(f32x4*)(out_row(p, m) + n) = xv; else if (t < CTX) *(f32x4*)(xc_row(p, m) + n) = xv; else *(u32x2*)(xb_row(p, m) + n) = pk4(xv); }
        if (!last) {
            const float rstd2 = rsqrtf(wave_sum(s2) * (1.f / D) + 1e-6f);
#pragma unroll
            for (int j = 0; j < 4; ++j) { const int n = 4 * (c.lane + 64 * j); const f32x4 gg = *(const f32x4*)(g0n + n); float o[4];
#pragma unroll
                for (int e = 0; e < 4; ++e) o[e] = f[4 * j + e] * rstd2 * gg[e] * (1.f + sc[r * D + n + e]) + sh[r * D + n + e];
                u32x2 w; w.x = pk2(o[0], o[1]); w.y = pk2(o[2], o[3]);
                *(u32x2*)(H + (size_t)m * D + n) = w; }
        }
    }
}

__device__ __forceinline__ int lane_id() { int l; asm volatile("v_mbcnt_lo_u32_b32 %0, -1, 0\n\tv_mbcnt_hi_u32_b32 %0, -1, %0" : "=v"(l)); return l; }
__global__ void __launch_bounds__(NTHREADS, 2) fwd_kernel(Params p_unused) {
    extern __shared__ __attribute__((aligned(16))) unsigned char lds_raw[];
    const int wave = __builtin_amdgcn_readfirstlane((int)threadIdx.x >> 6);
    LAS unsigned char* lds = (LAS unsigned char*)lds_raw;
    volatile LAS unsigned* misc = (volatile LAS unsigned*)(lds + LDS_BYTES - 64);
#define TID() (wave * 64 + lane_id())
#define GP_(T, i) (T*)(__attribute__((address_space(1))) T*)kp_[i]
#define KARG(q) const __attribute__((address_space(4))) unsigned long long* kp_ = (const __attribute__((address_space(4))) unsigned long long*)__builtin_amdgcn_kernarg_segment_ptr(); asm volatile("" : "+s"(kp_)); \
    Params q; q.x = GP_(const float, 0); q.c = GP_(const float, 1); q.ctx = GP_(const float, 2); q.c_ctx = GP_(const float, 3); q.w_ada = GP_(const float, 4); q.b_ada = GP_(const float, 5); \
    q.g_norm = GP_(const float, 6); q.w_in = GP_(const float, 7); q.w_out = GP_(const float, 8); q.na_rpb = GP_(const float, 9); q.conv_w = GP_(const float, 10); q.conv_b = GP_(const float, 11); \
    q.lru_w_a = GP_(const float, 12); q.lru_b_a = GP_(const float, 13); q.lru_w_i = GP_(const float, 14); q.lru_b_i = GP_(const float, 15); q.lru_lam = GP_(const float, 16); q.mla_g_q = GP_(const float, 17); \
    q.mla_w_q = GP_(const float, 18); q.mla_g_kv = GP_(const float, 19); q.mla_w_kv = GP_(const float, 20); q.router_w = GP_(const float, 21); q.router_b = GP_(const float, 22); \
    q.exp_w_gate = GP_(const float, 23); q.exp_w_up = GP_(const float, 24); q.exp_w_down = GP_(const float, 25); q.out = GP_(float, 26); q.ws = GP_(unsigned char, 27); q.ph_lo = 0; q.ph_hi = 0
    { const int t = TID(); if (t < 16) misc[t] = 0u; }
    __syncthreads();
    { KARG(q); (void)xcd_barrier_post((unsigned*)(q.ws + WS_CTL) + CW_BAR, misc, TID()); }
#define GBAR() do { KARG(q); XcdBarrier b_; b_.bar = (unsigned*)(q.ws + WS_CTL) + CW_BAR; b_.x = xb_xcc_id(); b_.st = misc; xcd_barrier(b_, TID()); } while (0)
#ifndef PROBE_MASK
#define PROBE_MASK 0
#endif
#ifndef PROBE_VAR
#define PROBE_VAR 0
#endif
#ifndef PROBE_C1
#define PROBE_C1 0
#endif
#define RP(bit, stmt) do { stmt; if ((PROBE_MASK >> (bit)) & 1) { GBAR(); stmt; } } while (0)
#define PH(call) do { KARG(q); Ctx cc; cc.lds = lds; cc.wave = wave; cc.lane = lane_id(); cc.tid = wave * 64 + cc.lane; \
        cc.bid = blockIdx.x; cc.nb = gridDim.x; cc.gw = cc.bid * NWAVES + wave; cc.ngw = cc.nb * NWAVES; call; } while (0)
    RP(0, PH(phase_pro(q, cc))); GBAR();
#define LAYER(l, last) do { \
        if ((l) == 0) { RP(1, PH(phase_n1(q, cc, l))); GBAR(); } \
        RP(2, PH(phase_g1(q, cc, l, false))); GBAR(); \
        RP(4, PH(phase_c2(q, cc, l))); GBAR(); \
        RP(6, PH(phase_c3(q, cc))); __syncthreads(); if (PROBE_C1) { PH(phase_c1<PROBE_C1>(q, cc, l)); GBAR(); } RP(3, PH(phase_c1(q, cc, l))); __syncthreads(); RP(5, PH(phase_a1b(q, cc, l, last))); GBAR(); \
        RP(7, PH(phase_c4(q, cc, l, last))); __syncthreads(); if (PROBE_VAR) { PH(phase_a2<PROBE_VAR>(q, cc, last)); GBAR(); } RP(8, PH(phase_a2(q, cc, last))); GBAR(); \
        RP(9, PH(phase_o1(q, cc, l, last))); GBAR(); \
        PH(phase_o2(q, cc, l, last)); if (((PROBE_MASK >> 13) & 1) && (l) == 0) { GBAR(); PH(phase_o2(q, cc, l, last)); } GBAR(); \
        RP(11, PH(phase_r2(q, cc, l, last))); GBAR(); \
        RP(12, PH(phase_r3(q, cc, l))); GBAR(); \
        PH(phase_f(q, cc, l, last)); } while (0)
    LAYER(0, false); GBAR();
    LAYER(1, true);
#undef LAYER
#undef PH
#undef RP
#undef GBAR
#undef TID
#undef KARG
#undef GP_
}

#ifdef DBG_PHASE
__global__ void __launch_bounds__(NTHREADS, 2) dbg_kernel(Params p, int l) {
    extern __shared__ __attribute__((aligned(16))) unsigned char lds_raw[];
    Ctx cc; cc.lds = (LAS unsigned char*)lds_raw; cc.wave = __builtin_amdgcn_readfirstlane((int)threadIdx.x >> 6); cc.lane = threadIdx.x & 63; cc.tid = threadIdx.x;
    cc.bid = blockIdx.x; cc.nb = gridDim.x; cc.gw = cc.bid * NWAVES + cc.wave; cc.ngw = cc.nb * NWAVES;
    DBG_PHASE;
}
#endif
#define MAIN_KERNEL fwd_kernel

extern "C" void kernel_launch(void* const* d_in, const int* in_sizes, int n_in, void* d_out, int out_size, void* d_ws, size_t ws_size, hipStream_t stream) {
    static int grid = 0;
    if (grid == 0) {
        if (n_in != 26 || out_size != NB * S * D || ws_size < WS_END) { fprintf(stderr, "kernel_launch: unexpected shapes (n_in %d out %d ws %zu)\n", n_in, out_size, ws_size); grid = -1; return; }
        int dev = 0, cus = 0, per_cu = 0;
        hipGetDevice(&dev);
        hipDeviceGetAttribute(&cus, hipDeviceAttributeMultiprocessorCount, dev);
        hipFuncSetAttribute((const void*)fwd_kernel, hipFuncAttributeMaxDynamicSharedMemorySize, LDS_BYTES);
        hipOccupancyMaxActiveBlocksPerMultiprocessor(&per_cu, (const void*)MAIN_KERNEL, NTHREADS, LDS_BYTES);
        (void)hipGetLastError();
        if (per_cu < 1) { fprintf(stderr, "kernel_launch: occupancy query says %d blocks per CU\n", per_cu); grid = -1; return; }
        if (cus < 256) { fprintf(stderr, "kernel_launch: this build's unit orders assume a 256-workgroup grid (one per CU of a 256-CU device); the device reports %d CUs\n", cus); grid = -1; return; }
        grid = 256;
    }
    if (grid < 0) return;
    hipMemsetAsync((char*)d_ws + WS_CTL, 0, CTL_BYTES, stream);
    Params p{};
    const float** pp = (const float**)&p;
    for (int i = 0; i < 26; ++i) pp[i] = (const float*)d_in[i];
    p.out = (float*)d_out; p.ws = (unsigned char*)d_ws;
    void* args[] = {&p};
    hipLaunchCooperativeKernel((const void*)fwd_kernel, dim3(grid), dim3(NTHREADS), args, LDS_BYTES, stream);
}
```

```cpp
#include <hip/hip_runtime.h>
#include <cstdio>
#include <cstdint>


#define LAS __attribute__((address_space(3)))
typedef unsigned short bf16_t;
typedef short bf16x8 __attribute__((ext_vector_type(8)));
typedef float f32x4 __attribute__((ext_vector_type(4)));
typedef float f32x2 __attribute__((ext_vector_type(2)));
typedef unsigned u32x4 __attribute__((ext_vector_type(4)));
typedef unsigned u32x2 __attribute__((ext_vector_type(2)));

constexpr int D = 1024, NB = 2, S = 8192, CTX = 256, LT = CTX + S, M = NB * LT;
constexpr int GW = 64;
constexpr int INW = 2208, INP = 2304;
constexpr int OFF_QA = 0, OFF_KA = 256, OFF_VA = 512, OFF_U = 768, OFF_G = 1280, OFF_CQ = 1792, OFF_CKV = 2048, OFF_KR = 2176;
constexpr int LRU_W = 512;
constexpr int CH = 32, NCH = LT / CH, NCH_CTX = CTX / CH;
constexpr int NE = 16, DE = 512;
constexpr int NTHREADS = 512, NWAVES = 8;
constexpr int LDS_BYTES = 147456;

constexpr size_t MiB = 1u << 20;
constexpr size_t WS_CTL = 0, CTL_BYTES = 1 * MiB;
constexpr size_t WS_MODP = 1 * MiB;
constexpr size_t WS_WIN = 4 * MiB;
constexpr size_t WS_WOUT = 13 * MiB;
constexpr size_t WS_WGU = 17 * MiB;
constexpr size_t WS_WD = 81 * MiB;
constexpr size_t WS_XC = 113 * MiB;
constexpr size_t WS_RE = 115 * MiB;
constexpr size_t WS_RW = WS_RE + 256 * 1024;
constexpr size_t WS_PERM = WS_RW + 256 * 1024;
constexpr size_t WS_S2P = 117 * MiB;
constexpr size_t WS_LRUW = 117 * MiB + 512 * 1024;
constexpr size_t WS_WQT = 118 * MiB;
constexpr size_t WS_WKVT = 118 * MiB + 512 * 1024;
constexpr size_t WS_AGG = 119 * MiB;
constexpr size_t WS_CARRY = 1 * MiB + 256 * 1024;
constexpr size_t WS_XB = 301 * MiB;
constexpr size_t WS_H = 125 * MiB;
constexpr size_t WS_P = 158 * MiB;
constexpr size_t WS_Q = 233 * MiB;
constexpr size_t WS_K = 246 * MiB;
constexpr size_t WS_V = 259 * MiB;
constexpr size_t WS_Y = 268 * MiB;
constexpr size_t WS_END = 333 * MiB;
constexpr int CW_CNT = 64;
constexpr int CW_BAR = 4096;

__device__ __forceinline__ float bf2f(bf16_t v) { return __uint_as_float(((unsigned)v) << 16); }
typedef __bf16 bf16x2_hw __attribute__((ext_vector_type(2)));
typedef float f32x2_hw __attribute__((ext_vector_type(2)));
__device__ __forceinline__ unsigned pk2(float lo, float hi) { const f32x2_hw v = {lo, hi}; return __builtin_bit_cast(unsigned, __builtin_convertvector(v, bf16x2_hw)); }
__device__ __forceinline__ unsigned f2bf(float f) { return pk2(f, 0.f) & 0xffffu; }
__device__ __forceinline__ float lo_bf(unsigned w) { return __uint_as_float(w << 16); }
__device__ __forceinline__ float hi_bf(unsigned w) { return __uint_as_float(w & 0xffff0000u); }
template <int CTRL> __device__ __forceinline__ float dpp_f(float v) { return __builtin_bit_cast(float, __builtin_amdgcn_update_dpp(0, __builtin_bit_cast(int, v), CTRL, 0xF, 0xF, true)); }
__device__ __forceinline__ float row16_sum(float v) {
    v += dpp_f<0xB1>(v);
    v += dpp_f<0x4E>(v);
    v += dpp_f<0x141>(v);
    v += dpp_f<0x140>(v);
    return v;
}
__device__ __forceinline__ float wave_sum(float v) {
    v = row16_sum(v);
    { auto r = __builtin_amdgcn_permlane16_swap(__float_as_uint(v), __float_as_uint(v), false, false); v = __uint_as_float(r[0]) + __uint_as_float(r[1]); }
    { auto r = __builtin_amdgcn_permlane32_swap(__float_as_uint(v), __float_as_uint(v), false, false); v = __uint_as_float(r[0]) + __uint_as_float(r[1]); }
    return v;
}
__device__ __forceinline__ float sigmoidf_(float x) { return __builtin_amdgcn_rcpf(1.f + __builtin_amdgcn_exp2f(-1.4426950408889634f * x)); }
__device__ __forceinline__ float siluf_(float x) { return x * sigmoidf_(x); }
__device__ __forceinline__ float gelu_tanh(float x) { return x * sigmoidf_(1.5957691216057308f * (x + 0.044715f * x * x * x)); }

struct Params {
    const float *x, *c, *ctx, *c_ctx, *w_ada, *b_ada, *g_norm, *w_in, *w_out, *na_rpb, *conv_w, *conv_b,
        *lru_w_a, *lru_b_a, *lru_w_i, *lru_b_i, *lru_lam, *mla_g_q, *mla_w_q, *mla_g_kv, *mla_w_kv,
        *router_w, *router_b, *exp_w_gate, *exp_w_up, *exp_w_down;
    float* out; unsigned char* ws; int ph_lo, ph_hi;
};

struct Ctx {
    int tid, lane, wave, bid, nb, gw, ngw;
    LAS unsigned char* lds;
};

__device__ __forceinline__ const float* xin_row(const Params& p, int m) {
    const int b = m / LT, t = m - b * LT;
    return t < CTX ? p.ctx + (size_t)(b * CTX + t) * D : p.x + (size_t)(b * S + t - CTX) * D;
}
__device__ __forceinline__ float* xc_row(const Params& p, int m) { const int b = m / LT, t = m - b * LT; return (float*)(p.ws + WS_XC) + (size_t)(b * CTX + t) * D; }
__device__ __forceinline__ bf16_t* xb_row(const Params& p, int m) { const int b = m / LT, t = m - b * LT; return (bf16_t*)(p.ws + WS_XB) + (size_t)(b * S + t - CTX) * D; }
__device__ __forceinline__ float* out_row(const Params& p, int m) { const int b = m / LT, t = m - b * LT; return p.out + (size_t)(b * S + t - CTX) * D; }
__device__ __forceinline__ f32x4 bf4(u32x2 w) { return (f32x4){lo_bf(w.x), hi_bf(w.x), lo_bf(w.y), hi_bf(w.y)}; }
__device__ __forceinline__ u32x2 pk4(f32x4 v) { u32x2 w; w.x = pk2(v.x, v.y); w.y = pk2(v.z, v.w); return w; }
__device__ __forceinline__ void load_mods(const Params& p, const Ctx& c, int l, int j, LAS float* dst) {
    const float* mp = (const float*)(p.ws + WS_MODP);
    for (int idx = c.tid; idx < 3 * D; idx += NTHREADS) {
        const int r = idx >> 10, n = idx & 1023;
        dst[idx] = mp[(size_t)(l * 3 + r) * 6144 + j * D + n];
    }
}

#define XB_TMO      128
#define XB_XCNT(j)  (256  + 64 * (j))
#define XB_XSUB(j)  (1280 + 64 * (j))
#define XB_XGEN(j)  (2304 + 64 * (j))
#define XB_TOP      3328
#define XB_TOPGEN   3392
#define XCD_BAR_WORDS 3456
#define XB_SPIN_CAP (1u << 18)
__device__ __forceinline__ unsigned xb_ld(unsigned* p)              { return __hip_atomic_load(p, __ATOMIC_RELAXED, __HIP_MEMORY_SCOPE_AGENT); }
__device__ __forceinline__ unsigned xb_add(unsigned* p, unsigned v) { return __hip_atomic_fetch_add(p, v, __ATOMIC_RELAXED, __HIP_MEMORY_SCOPE_AGENT); }
__device__ __forceinline__ unsigned xb_xcc_id() { return (unsigned)__builtin_amdgcn_s_getreg((3 << 11) | 20) & 0xFu; }
#define XB_SPIN(cond, bar) do { unsigned _sp = 0; while (cond) { __builtin_amdgcn_s_sleep(1); \
    if ((++_sp & 255u) == 0u) { if (xb_ld(&(bar)[XB_TMO])) break; if (_sp > XB_SPIN_CAP) { atomicAdd(&(bar)[XB_TMO], 1u); break; } } } } while (0)
struct XcdBarrier { unsigned* bar; unsigned x; volatile LAS unsigned* st; };
__device__ __forceinline__ XcdBarrier xcd_barrier_post(unsigned* bar, volatile LAS unsigned* st, int tid) {
    XcdBarrier b; b.bar = bar; b.x = xb_xcc_id(); b.st = st;
    if (tid == 0) (void)xb_add(&bar[XB_XCNT(b.x)], 1u);
    return b;
}
__device__ __forceinline__ void xcd_barrier_complete(unsigned* bar, unsigned x, unsigned& nloc, unsigned& nx) {
    const unsigned G = gridDim.x * gridDim.y * gridDim.z;
    unsigned sum, cnt, mine, sp = 0u;
    for (;;) {
        sum = 0u; cnt = 0u; mine = 0u;
#pragma unroll
        for (unsigned j = 0; j < 16; ++j) { const unsigned c = xb_ld(&bar[XB_XCNT(j)]); sum += c; cnt += (c > 0u) ? 1u : 0u; mine = (j == x) ? c : mine; }
        if (sum == G) break;
        __builtin_amdgcn_s_sleep(1);
        if ((++sp & 255u) == 0u) { if (xb_ld(&bar[XB_TMO])) break; if (sp > XB_SPIN_CAP) { atomicAdd(&bar[XB_TMO], 1u); break; } }
    }
    nloc = mine > 0u ? mine : 1u; nx = cnt > 0u ? cnt : 1u;
}
__device__ __forceinline__ void xcd_barrier(const XcdBarrier& b, int tid) {
    asm volatile("s_waitcnt vmcnt(0)" ::: "memory");
    __syncthreads();
    if (tid == 0) {
        unsigned* bar = b.bar;
        __builtin_amdgcn_s_waitcnt(0);
        unsigned nloc = b.st[0], nx = b.st[1];
        if (nloc == 0u) { xcd_barrier_complete(bar, b.x, nloc, nx); b.st[0] = nloc; b.st[1] = nx; }
        const unsigned old = xb_add(&bar[XB_XSUB(b.x)], 1u);
        const unsigned gen = old / nloc;
        if (old + 1u == (gen + 1u) * nloc) {
            __builtin_amdgcn_fence(__ATOMIC_RELEASE, "agent");
            asm volatile("s_waitcnt vmcnt(0)" ::: "memory");
            const unsigned og = xb_add(&bar[XB_TOP], 1u);
            const unsigned tg = og / nx;
            if (og + 1u == (tg + 1u) * nx) xb_add(&bar[XB_TOPGEN], 1u);
            else XB_SPIN(xb_ld(&bar[XB_TOPGEN]) == tg, bar);
            __builtin_amdgcn_fence(__ATOMIC_ACQUIRE, "agent");
            xb_add(&bar[XB_XGEN(b.x)], 1u);
            asm volatile("s_waitcnt vmcnt(0)" ::: "memory");
        } else {
            XB_SPIN(xb_ld(&bar[XB_XGEN(b.x)]) == gen, bar);
            __builtin_amdgcn_fence(__ATOMIC_ACQUIRE, "agent");
            asm volatile("s_waitcnt vmcnt(0)" ::: "memory");
        }
    }
    __syncthreads();
}


namespace pg8 {
#define PG8_LAS __attribute__((address_space(3)))
typedef unsigned short bf16_t;
typedef short bf16x8 __attribute__((ext_vector_type(8)));
typedef float f32x4 __attribute__((ext_vector_type(4)));
typedef unsigned u32x4 __attribute__((ext_vector_type(4)));
constexpr int BM = 256, BK = 64, HALF = 128, HTB = HALF * BK * 2  , STAGE_BYTES = 8 * HTB, NXCD = 8, WGM = 8;

__host__ __device__ __forceinline__ int lds_byte(int r, int c) { const int st = (r >> 4) * 2 + (c >> 5), rr = r & 15, cc = c & 31, ob = rr * 64 + cc * 2; return st * 1024 + (ob ^ (((ob >> 9) & 1) << 5)); }
__host__ __device__ __forceinline__ void stage_rc(int b, int& R, int& C) { const int st = b / 1024, sb = b % 1024, swz = sb ^ (((sb >> 9) & 1) << 5); R = (st >> 1) * 16 + swz / 64; C = (st & 1) * 32 + (swz % 64) / 2; }
__host__ __device__ __forceinline__ int perm32(int rho) { const int n = rho >> 4, i = rho & 15; return 8 * (i >> 2) + 4 * n + (i & 3); }

struct Unit { int pm, pn, aux0, aux1; };
struct Gemm { const bf16_t* A; const bf16_t* Bt; int M, N, K; };
__device__ __forceinline__ unsigned cvt_pk_bf16(float lo, float hi) { return ::pk2(lo, hi); }
typedef float f32x2 __attribute__((ext_vector_type(2)));
__device__ __forceinline__ f32x2 gelu_pk(f32x2 v) {
    const f32x2 av = __builtin_elementwise_abs(v), d = av * 0.2316418882f + 1.0f;
    f32x2 t; t.x = __builtin_amdgcn_rcpf(d.x); t.y = __builtin_amdgcn_rcpf(d.y);
    f32x2 q = t * 0.5307027145f + (-0.7265760135f); q = q * t + 0.7107068705f; q = q * t + (-0.142248368f); q = q * t + 0.127414796f; q = q * t;
    const f32x2 s = (v * v) * (-0.72134752044f);
    f32x2 e; e.x = __builtin_amdgcn_exp2f(s.x); e.y = __builtin_amdgcn_exp2f(s.y);
    const f32x2 m = v * (q * e), r = v - m;
    f32x2 o; o.x = v.x < 0.f ? m.x : r.x; o.y = v.y < 0.f ? m.y : r.y; return o;
}

template <int ACT  > struct EpiBf16 {
    static constexpr bool PERM = true, AFTER_DRAIN = false; static_assert(ACT == 0 || ACT == 1, "EpiBf16: ACT is 0 (none) or 1 (gelu_pk)");
    bf16_t* O; int ldc; const float* bias; int split_cols; size_t split_stride; float scale0;
    __device__ __forceinline__ void operator()(const f32x4 (&acc)[2][2][4][2], const Unit& u, int wr, int wc, int fr, int fq) const {
        const int row0 = u.pm * BM + wr * 64 + fr; int colt = u.pn * BM; bf16_t* base = O;
        float sc = 1.f; if (split_cols) { const int t = colt / split_cols; base += (size_t)t * split_stride; colt -= t * split_cols; if (t == 0) sc = scale0; }
        const int col0 = colt + wc * 32 + 8 * fq, bcol0 = u.pn * BM + wc * 32 + 8 * fq;
        f32x4 bv[2][2];
#pragma unroll
        for (int bj = 0; bj < 2; ++bj)
#pragma unroll
            for (int n = 0; n < 2; ++n) bv[bj][n] = bias ? *(const f32x4*)(bias + bcol0 + bj * HALF + 4 * n) : (f32x4){0.f, 0.f, 0.f, 0.f};
#pragma unroll
        for (int ai = 0; ai < 2; ++ai)
#pragma unroll
            for (int m = 0; m < 4; ++m) { bf16_t* rowp = base + (size_t)(row0 + ai * HALF + m * 16) * ldc + col0;
#pragma unroll
                for (int bj = 0; bj < 2; ++bj) { f32x4 v0 = acc[ai][bj][m][0] + bv[bj][0], v1 = acc[ai][bj][m][1] + bv[bj][1];
                    if (ACT == 1) { f32x2 a = gelu_pk((f32x2){v0[0], v0[1]}), b = gelu_pk((f32x2){v0[2], v0[3]}), c = gelu_pk((f32x2){v1[0], v1[1]}), d = gelu_pk((f32x2){v1[2], v1[3]});
                        v0 = (f32x4){a.x, a.y, b.x, b.y}; v1 = (f32x4){c.x, c.y, d.x, d.y}; }
                    v0 = v0 * sc; v1 = v1 * sc; u32x4 w; w.x = cvt_pk_bf16(v0[0], v0[1]); w.y = cvt_pk_bf16(v0[2], v0[3]); w.z = cvt_pk_bf16(v1[0], v1[1]); w.w = cvt_pk_bf16(v1[2], v1[3]);
                    *(u32x4*)(rowp + bj * HALF) = w; } }
    }
};

struct StaticOrder {
    int nM, nN, nwg, G, c;
    __host__ __device__ void init(int M, int N, int G_, int c_) { nM = M / BM; nN = N / BM; nwg = nM * nN; G = G_; c = c_; }
    __host__ __device__ bool next(int i, Unit& u) const {
        const long L = (long)i * G + c; if (L >= nwg) return false;
        int wgid = (int)L; { const int q = nwg / NXCD, r = nwg % NXCD, xcd = wgid % NXCD, off = wgid / NXCD; wgid = (xcd < r ? xcd * (q + 1) : r * (q + 1) + (xcd - r) * q) + off; }
        const int nig = WGM * nN, gid = wgid / nig, fm = gid * WGM, gsz = (nM - fm) < WGM ? (nM - fm) : WGM;
        u.pm = fm + ((wgid % nig) % gsz); u.pn = (wgid % nig) / gsz; return true;
    }
    __device__ __forceinline__ void a_ready(const Unit&) const {}
    __device__ __forceinline__ void done(const Unit&) const {}
};
struct EpiF32 {
    static constexpr bool PERM = false, AFTER_DRAIN = false;
    float* O; int ldc;
    __device__ __forceinline__ void operator()(const f32x4 (&acc)[2][2][4][2], const Unit& u, int wr, int wc, int fr, int fq) const {
        const int row0 = u.pm * BM + wr * 64 + fr, col0 = u.pn * BM + wc * 32 + 4 * fq;
#pragma unroll
        for (int ai = 0; ai < 2; ++ai)
#pragma unroll
            for (int m = 0; m < 4; ++m) { float* rowp = O + (size_t)(row0 + ai * HALF + m * 16) * ldc + col0;
#pragma unroll
                for (int bj = 0; bj < 2; ++bj)
#pragma unroll
                    for (int n = 0; n < 2; ++n) *(f32x4*)(rowp + bj * HALF + n * 16) = acc[ai][bj][m][n]; }
    }
};
struct EpiSwiGLU {
    static constexpr bool PERM = true, AFTER_DRAIN = false;
    bf16_t* O;
    __device__ __forceinline__ void operator()(const f32x4 (&acc)[2][2][4][2], const Unit& u, int wr, int wc, int fr, int fq) const {
        const int row0 = u.pm * BM + wr * 64 + fr, col0 = (u.pn & 3) * 128 + wc * 32 + 8 * fq;
#pragma unroll
        for (int ai = 0; ai < 2; ++ai)
#pragma unroll
            for (int m = 0; m < 4; ++m) {
                float v[8];
#pragma unroll
                for (int n = 0; n < 2; ++n)
#pragma unroll
                    for (int e = 0; e < 4; ++e) { const float g = acc[ai][0][m][n][e]; v[4 * n + e] = g * __builtin_amdgcn_rcpf(1.f + __builtin_amdgcn_exp2f(-1.4426950408889634f * g)) * acc[ai][1][m][n][e]; }
                u32x4 w; w.x = cvt_pk_bf16(v[0], v[1]); w.y = cvt_pk_bf16(v[2], v[3]); w.z = cvt_pk_bf16(v[4], v[5]); w.w = cvt_pk_bf16(v[6], v[7]);
                *(u32x4*)(O + (size_t)(row0 + ai * HALF + m * 16) * 512 + col0) = w; }
    }
};
struct EpiScatter {
    static constexpr bool PERM = true, AFTER_DRAIN = false;
    bf16_t* F; const int* slot2pk; const float* rw; int Mtok;
    __device__ __forceinline__ void operator()(const f32x4 (&acc)[2][2][4][2], const Unit& u, int wr, int wc, int fr, int fq) const {
        const int row0 = u.pm * BM + wr * 64 + fr, col0 = (u.pn & 3) * BM + wc * 32 + 8 * fq;
#pragma unroll
        for (int ai = 0; ai < 2; ++ai)
#pragma unroll
            for (int m = 0; m < 4; ++m) {
                const int pk = slot2pk[row0 + ai * HALF + m * 16];
                if (pk >= 0) { const float wgt = rw[pk]; bf16_t* rowp = F + ((size_t)(pk & 1) * Mtok + (pk >> 1)) * 1024 + col0;
#pragma unroll
                    for (int bj = 0; bj < 2; ++bj) { const f32x4 v0 = acc[ai][bj][m][0] * wgt, v1 = acc[ai][bj][m][1] * wgt;
                        u32x4 w; w.x = cvt_pk_bf16(v0[0], v0[1]); w.y = cvt_pk_bf16(v0[2], v0[3]); w.z = cvt_pk_bf16(v1[0], v1[1]); w.w = cvt_pk_bf16(v1[2], v1[3]);
                        *(u32x4*)(rowp + bj * HALF) = w; } } }
    }
};
struct LatentOrder4 {
    int G, c;
    __device__ bool next(int i, Unit& u) const {
        const int L = i * G + c; if (L >= 256) return false;
        const int x = L & 7, j = L >> 3, pi = x * 8 + (j >> 2);
        u.pm = pi + 1 + (pi >= 32 ? 1 : 0); u.pn = j & 3; u.aux0 = 0; u.aux1 = 0; return true;
    }
    __device__ __forceinline__ void a_ready(const Unit&) const {}
    __device__ __forceinline__ void done(const Unit&) const {}
};
struct G1Order {
    int G, c; bool deferred;
    __device__ bool next(int i, Unit& u) const {
        u.aux0 = 0; u.aux1 = 0;
        if (deferred) { if (i > 0 || c >= 82) return false; if (c < 66) { u.pm = c; u.pn = 8; } else { u.pm = c - 66; u.pn = 0; } return true; }
        const int L = i * G + c; if (L >= 512) return false;
        const int n = (L & ~255) + (L & 7) * 32 + ((L & 255) >> 3);
        if (n < 462) { u.pm = n / 7; u.pn = 1 + n % 7; } else { u.pm = 16 + (n - 462); u.pn = 0; }
        return true;
    }
    __device__ __forceinline__ void a_ready(const Unit&) const {}
    __device__ __forceinline__ void done(const Unit&) const {}
};
struct MoeGatherA {
    static constexpr bool GATHER = true; const PG8_LAS int* map;
    __device__ __forceinline__ int row(int ui, int r) const { const int pk = map[ui * 256 + r]; return pk >= 0 ? (pk >> 1) : 0; }
};
struct MoeOrderL {
    const PG8_LAS int* cnt; int G, c;
    __device__ bool next(int i, Unit& u) const {
        const int L = i * G + c, rt = L >> 2;
        int acc = 0, e = -1;
#pragma unroll
        for (int j = 0; j < 16; ++j) { const int nt = (cnt[j] + 255) >> 8; if (e < 0 && rt < acc + nt) e = j; acc += nt; }
        if (e < 0) return false;
        u.pm = rt; u.pn = e * 4 + (L & 3); u.aux0 = e; u.aux1 = 0; return true;
    }
    __device__ __forceinline__ void a_ready(const Unit&) const {}
    __device__ __forceinline__ void done(const Unit&) const {}
};
struct MoeOrder {
    const unsigned* cnt; int G, c;
    __device__ bool next(int i, Unit& u) const {
        const int L = i * G + c, rt = L >> 2;
        int acc = 0, e = -1;
#pragma unroll
        for (int j = 0; j < 16; ++j) { const int nt = ((int)cnt[j] + 255) >> 8; if (e < 0 && rt < acc + nt) e = j; acc += nt; }
        if (e < 0) return false;
        u.pm = rt; u.pn = e * 4 + (L & 3); u.aux0 = e; u.aux1 = 0; return true;
    }
    __device__ __forceinline__ void a_ready(const Unit&) const {}
    __device__ __forceinline__ void done(const Unit&) const {}
};
struct DenseA { static constexpr bool GATHER = false; __device__ __forceinline__ int row(int, int) const { return 0; } };
template <class Epi, class Sched, bool ALIGN_EPI = false, bool SP2 = false, class AG = DenseA>
__device__ __forceinline__ void gemm_phase(PG8_LAS unsigned char* lds, const Gemm g, const Sched& S, const Epi& E, const int tid, const AG& G = AG()) {
    static_assert(!AG::GATHER || SP2, "the gather policy is wired into the SP2 loop only");
    const int wid = __builtin_amdgcn_readfirstlane(tid >> 6), lane = tid & 63, wr = wid >> 2, wc = wid & 3, fr = lane & 15, fq = lane >> 4;
    const int K = g.K, nt = K / BK;
    unsigned voffA[2], voffB[2]; int RA[2], CA[2];
#pragma unroll
    for (int i = 0; i < 2; ++i) { int R, C; stage_rc(tid * 16 + i * 8192, R, C); const int Rb = Epi::PERM ? ((R & ~31) + perm32(R & 31)) : R;
        voffA[i] = (unsigned)(R * K + C) * 2u; voffB[i] = (unsigned)(Rb * K + C) * 2u; RA[i] = R; CA[i] = C; }
    const size_t kstep = (size_t)(BK * 2);
    const size_t hstep = (size_t)HALF * K * 2;
    const size_t tstep = 2 * hstep;
    const unsigned ldsw = (unsigned)wid * 1024u;
    const int aoff = lds_byte(wr * 64 + fr, fq * 8), boff = lds_byte(wc * 32 + fr, fq * 8);
#define PG8_SA(b, h) (((b) * 2 + (h)) * HTB)
#define PG8_SB(b, h) ((4 + (b) * 2 + (h)) * HTB)
#define PG8_STAGE(bufoff, gbase, voff) do { _Pragma("unroll") for (int _i = 0; _i < 2; ++_i) \
        __builtin_amdgcn_global_load_lds((const unsigned*)((const char*)(gbase) + (voff)[_i]), (PG8_LAS unsigned*)(lds + (bufoff) + ldsw + _i * 8192), 16, 0, 0); } while (0)
#define PG8_LDA(dst, b, h) do { _Pragma("unroll") for (int m = 0; m < 4; ++m) _Pragma("unroll") for (int k = 0; k < 2; ++k) dst[m][k] = *(const PG8_LAS bf16x8*)(lds + PG8_SA(b, h) + aoff + m * 2048 + k * 1024); } while (0)
#define PG8_LDB(dst, b, h) do { _Pragma("unroll") for (int n = 0; n < 2; ++n) _Pragma("unroll") for (int k = 0; k < 2; ++k) dst[n][k] = *(const PG8_LAS bf16x8*)(lds + PG8_SB(b, h) + boff + n * 2048 + k * 1024); } while (0)
#define PG8_MMA(ai, bj, At, Bt) do { __builtin_amdgcn_s_setprio(1); _Pragma("unroll") for (int m = 0; m < 4; ++m) _Pragma("unroll") for (int n = 0; n < 2; ++n) _Pragma("unroll") for (int k = 0; k < 2; ++k) \
        acc[ai][bj][m][n] = __builtin_amdgcn_mfma_f32_16x16x32_bf16(Bt[n][k], At[m][k], acc[ai][bj][m][n], 0, 0, 0); __builtin_amdgcn_s_setprio(0); } while (0)
#define PG8_WAIT_V(n) asm volatile("s_waitcnt vmcnt(" #n ")" ::: "memory")
#define PG8_WAIT_L(n) asm volatile("s_waitcnt lgkmcnt(" #n ")" ::: "memory")
#define PG8_BAR __builtin_amdgcn_s_barrier()
#define PG8_SCHED __builtin_amdgcn_sched_barrier(0)
    Unit cur, nxt; int ui = 0;
    if (!S.next(0, cur)) return;
    f32x4 acc[2][2][4][2];
#pragma unroll
    for (int a = 0; a < 2; ++a)
#pragma unroll
        for (int b = 0; b < 2; ++b)
#pragma unroll
            for (int m = 0; m < 4; ++m)
#pragma unroll
                for (int n = 0; n < 2; ++n) acc[a][b][m][n] = (f32x4){0.f, 0.f, 0.f, 0.f};
    bf16x8 At[4][2], B0[2][2], B1[2][2];
    const char* cA = AG::GATHER ? (const char*)g.A : (const char*)g.A + (size_t)cur.pm * tstep; const char* cB = (const char*)g.Bt + (size_t)cur.pn * tstep;
    unsigned vc[2][2], vn[2][2];
#pragma unroll
    for (int h = 0; h < 2; ++h)
#pragma unroll
        for (int i = 0; i < 2; ++i) { vc[h][i] = AG::GATHER ? (unsigned)(G.row(0, h * HALF + RA[i]) * K + CA[i]) * 2u : voffA[i] + (unsigned)(h * hstep); vn[h][i] = vc[h][i]; }
    S.a_ready(cur);
    if constexpr (SP2) {
        PG8_STAGE(PG8_SB(0, 0), cB, voffB); PG8_STAGE(PG8_SB(0, 1), cB + hstep, voffB); PG8_STAGE(PG8_SA(0, 0), cA, vc[0]); PG8_STAGE(PG8_SA(0, 1), cA, vc[1]);
        if (wr == 1) PG8_BAR;
        PG8_WAIT_V(2); PG8_BAR;
        PG8_STAGE(PG8_SB(1, 0), cB + kstep, voffB); PG8_STAGE(PG8_SA(1, 0), cA + kstep, vc[0]); PG8_STAGE(PG8_SB(1, 1), cB + hstep + kstep, voffB);
        PG8_WAIT_V(6); PG8_BAR;
    } else {
        PG8_STAGE(PG8_SB(0, 0), cB, voffB); PG8_STAGE(PG8_SA(0, 0), cA, voffA); PG8_STAGE(PG8_SB(0, 1), cB + hstep, voffB); PG8_STAGE(PG8_SA(0, 1), cA + hstep, voffA);
        if (wr == 1) PG8_BAR;
        PG8_WAIT_V(4); PG8_BAR;
        PG8_STAGE(PG8_SB(1, 0), cB + kstep, voffB); PG8_STAGE(PG8_SA(1, 0), cA + kstep, voffA); PG8_STAGE(PG8_SB(1, 1), cB + hstep + kstep, voffB);
        PG8_WAIT_V(6); PG8_BAR;
    }
    for (;;) {
        const bool has_next = S.next(ui + 1, nxt);
        const char* nA = AG::GATHER ? cA : (has_next ? (const char*)g.A + (size_t)nxt.pm * tstep : cA); const char* nB = has_next ? (const char*)g.Bt + (size_t)nxt.pn * tstep : cB;
        if (AG::GATHER && has_next) {
#pragma unroll
            for (int h = 0; h < 2; ++h)
#pragma unroll
                for (int i = 0; i < 2; ++i) vn[h][i] = (unsigned)(G.row(ui + 1, h * HALF + RA[i]) * K + CA[i]) * 2u;
        }
        for (int t = 0; t < nt; t += 2) {
            const bool last = (t == nt - 2);
            const char* a1 = cA + (size_t)(t + 1) * kstep;
            const char* a2 = last ? nA : cA + (size_t)(t + 2) * kstep; const char* b2 = last ? nB : cB + (size_t)(t + 2) * kstep;
            const char* a3 = a2 + kstep; const char* b3 = b2 + kstep;
            if (last && has_next) S.a_ready(nxt);
            unsigned v2[2][2];
#pragma unroll
            for (int h = 0; h < 2; ++h)
#pragma unroll
                for (int i = 0; i < 2; ++i) v2[h][i] = last ? vn[h][i] : vc[h][i];
            if constexpr (SP2) {
            PG8_LDB(B0, 0, 0); PG8_LDB(B1, 0, 1); PG8_SCHED; PG8_LDA(At, 0, 0); PG8_STAGE(PG8_SA(1, 1), a1, vc[1]);
            PG8_WAIT_V(8); PG8_WAIT_L(0); PG8_BAR; PG8_MMA(0, 0, At, B0); PG8_MMA(0, 1, At, B1); PG8_BAR; PG8_SCHED;
            PG8_LDA(At, 0, 1); PG8_STAGE(PG8_SB(0, 0), b2, voffB); PG8_STAGE(PG8_SB(0, 1), b2 + hstep, voffB); PG8_STAGE(PG8_SA(0, 0), a2, v2[0]);
            PG8_WAIT_V(8); PG8_WAIT_L(0); PG8_BAR; PG8_MMA(1, 0, At, B0); PG8_MMA(1, 1, At, B1); PG8_BAR; PG8_SCHED;
            PG8_LDB(B0, 1, 0); PG8_LDB(B1, 1, 1); PG8_SCHED; PG8_LDA(At, 1, 0); PG8_STAGE(PG8_SA(0, 1), a2, v2[1]);
            PG8_WAIT_V(8); PG8_WAIT_L(0); PG8_BAR; PG8_MMA(0, 0, At, B0); PG8_MMA(0, 1, At, B1); PG8_BAR; PG8_SCHED;
            PG8_LDA(At, 1, 1); PG8_STAGE(PG8_SB(1, 0), b3, voffB); PG8_STAGE(PG8_SB(1, 1), b3 + hstep, voffB); PG8_STAGE(PG8_SA(1, 0), a3, v2[0]);
            PG8_WAIT_V(8); PG8_WAIT_L(0); PG8_BAR; PG8_MMA(1, 0, At, B0); PG8_MMA(1, 1, At, B1); PG8_BAR; PG8_SCHED;
            } else {
            PG8_LDB(B0, 0, 0); PG8_SCHED; PG8_LDA(At, 0, 0); PG8_STAGE(PG8_SA(1, 1), a1 + hstep, voffA);
            PG8_WAIT_L(8); PG8_BAR; PG8_WAIT_L(0); PG8_MMA(0, 0, At, B0); PG8_BAR; PG8_SCHED;
            PG8_LDB(B1, 0, 1); PG8_STAGE(PG8_SB(0, 0), b2, voffB);
            PG8_BAR; PG8_WAIT_L(0); PG8_MMA(0, 1, At, B1); PG8_BAR;
            PG8_LDA(At, 0, 1); PG8_STAGE(PG8_SA(0, 0), a2, voffA);
            PG8_BAR; PG8_WAIT_L(0); PG8_MMA(1, 0, At, B0); PG8_BAR; PG8_SCHED;
            PG8_STAGE(PG8_SB(0, 1), b2 + hstep, voffB);
            PG8_WAIT_V(6); PG8_BAR; PG8_MMA(1, 1, At, B1); PG8_BAR;
            PG8_LDB(B0, 1, 0); PG8_SCHED; PG8_LDA(At, 1, 0); PG8_STAGE(PG8_SA(0, 1), a2 + hstep, voffA);
            PG8_WAIT_L(8); PG8_BAR; PG8_WAIT_L(0); PG8_MMA(0, 0, At, B0); PG8_BAR; PG8_SCHED;
            PG8_LDB(B1, 1, 1); PG8_STAGE(PG8_SB(1, 0), b3, voffB);
            PG8_BAR; PG8_WAIT_L(0); PG8_MMA(0, 1, At, B1); PG8_BAR;
            PG8_LDA(At, 1, 1); PG8_STAGE(PG8_SA(1, 0), a3, voffA);
            PG8_BAR; PG8_WAIT_L(0); PG8_MMA(1, 0, At, B0); PG8_BAR; PG8_SCHED;
            PG8_STAGE(PG8_SB(1, 1), b3 + hstep, voffB);
            PG8_WAIT_V(6); PG8_BAR; PG8_MMA(1, 1, At, B1); PG8_BAR;
            }
        }
        if constexpr (ALIGN_EPI) { if (wr == 0) PG8_BAR; }
        if constexpr (!Epi::AFTER_DRAIN) { E(acc, cur, wr, wc, fr, fq); S.done(cur); }
        if (!has_next) break;
#pragma unroll
        for (int a = 0; a < 2; ++a)
#pragma unroll
            for (int b = 0; b < 2; ++b)
#pragma unroll
                for (int m = 0; m < 4; ++m)
#pragma unroll
                    for (int n = 0; n < 2; ++n) acc[a][b][m][n] = (f32x4){0.f, 0.f, 0.f, 0.f};
        cur = nxt; cA = nA; cB = nB; ++ui;
#pragma unroll
        for (int h = 0; h < 2; ++h)
#pragma unroll
            for (int i = 0; i < 2; ++i) vc[h][i] = vn[h][i];
        if constexpr (ALIGN_EPI) { if (wr == 1) PG8_BAR; }
    }
    PG8_WAIT_V(0);
    if constexpr (!ALIGN_EPI) { if (wr == 0) PG8_BAR; }
    PG8_BAR;
    if constexpr (Epi::AFTER_DRAIN) { E.fused(acc, cur, wr, wc, fr, fq, lds, wid, lane); S.done(cur); }
#undef PG8_SA
#undef PG8_SB
#undef PG8_STAGE
#undef PG8_LDA
#undef PG8_LDB
#undef PG8_MMA
#undef PG8_WAIT_V
#undef PG8_WAIT_L
#undef PG8_BAR
#undef PG8_SCHED
}
}

__device__ __forceinline__ void transpose_item(const float* W, int K, int N, bf16_t* WT, int item, LAS float* scr, int lane, int rmode = 0) {
    const int nblk = N / 32, kb = item / nblk, nbk = item % nblk, k0 = 64 * kb, n0 = 32 * nbk;
#pragma unroll 8
    for (int i = 0; i < 32; ++i) { const int kk = 2 * i + (lane >> 5); scr[kk * 33 + (lane & 31)] = W[(size_t)(k0 + kk) * N + n0 + (lane & 31)]; }
    asm volatile("s_waitcnt lgkmcnt(0)" ::: "memory");
    const int cc = lane & 7;
#pragma unroll
    for (int j = 0; j < 4; ++j) { const int n = (lane >> 3) + 8 * j; const LAS float* s = scr + (8 * cc) * 33 + n;
        u32x4 o; o.x = pk2(s[0 * 33], s[1 * 33]); o.y = pk2(s[2 * 33], s[3 * 33]); o.z = pk2(s[4 * 33], s[5 * 33]); o.w = pk2(s[6 * 33], s[7 * 33]);
        const int nn = n0 + n, row = rmode == 0 ? nn : ((nn >> 7) * 256 + (rmode - 1) * 128 + (nn & 127));
        *(u32x4*)(WT + (size_t)row * K + k0 + 8 * cc) = o; }
    asm volatile("s_waitcnt lgkmcnt(0)" ::: "memory");
}
constexpr int CV_IN = 16 * 69, CV_OUT = 16 * 32, CV_E = 16 * 256, CV_Q = 4 * 12, CV_KV = 2 * 16;
constexpr int CV_S = CV_IN + CV_OUT + CV_Q + CV_KV;
constexpr int CV_ALL = CV_S + 3 * CV_E;
__device__ __forceinline__ void convert_weights(const Params& p, const Ctx& c, int l, int lo, int hi, int widx, int nw) {
    LAS float* scr = (LAS float*)(c.lds + c.wave * 16384);
    for (int it = lo + widx; it < hi; it += nw) {
        int r = it;
        if (r < CV_IN) { transpose_item(p.w_in + (size_t)l * D * INW, D, INW, (bf16_t*)(p.ws + WS_WIN) + (size_t)l * INP * D, r, scr, c.lane); continue; } r -= CV_IN;
        if (r < CV_OUT) { transpose_item(p.w_out + (size_t)l * D * D, D, D, (bf16_t*)(p.ws + WS_WOUT) + (size_t)l * D * D, r, scr, c.lane); continue; } r -= CV_OUT;
        if (r < CV_Q) { transpose_item(p.mla_w_q + (size_t)l * 256 * 384, 256, 384, (bf16_t*)(p.ws + WS_WQT) + (size_t)l * 384 * 256, r, scr, c.lane); continue; } r -= CV_Q;
        if (r < CV_KV) { transpose_item(p.mla_w_kv + (size_t)l * 128 * 512, 128, 512, (bf16_t*)(p.ws + WS_WKVT) + (size_t)l * 512 * 128, r, scr, c.lane); continue; } r -= CV_KV;
        if (r < CV_E) { const int e = r / 256; transpose_item(p.exp_w_gate + (size_t)(l * NE + e) * D * DE, D, DE, (bf16_t*)(p.ws + WS_WGU) + (size_t)(l * NE + e) * 1024 * 1024, r % 256, scr, c.lane, 1); continue; } r -= CV_E;
        if (r < CV_E) { const int e = r / 256; transpose_item(p.exp_w_up + (size_t)(l * NE + e) * D * DE, D, DE, (bf16_t*)(p.ws + WS_WGU) + (size_t)(l * NE + e) * 1024 * 1024, r % 256, scr, c.lane, 2); continue; } r -= CV_E;
        { const int e = r / 256; transpose_item(p.exp_w_down + (size_t)(l * NE + e) * DE * D, DE, D, (bf16_t*)(p.ws + WS_WD) + (size_t)(l * NE + e) * 1024 * 512, r % 256, scr, c.lane); }
    }
}
__device__ __forceinline__ void phase_pro(const Params& p, const Ctx& c) {
    convert_weights(p, c, 0, 0, CV_S, c.gw, c.ngw);
    for (int i = c.bid * NTHREADS + c.tid; i < 2 * 2 * 2 * 8 * 64 * 64; i += c.nb * NTHREADS) {
        const int k = i & 63, j = (i >> 6) & 63, n = (i >> 12) & 7, g = (i >> 15) & 1, ld = i >> 16;
        const float* src = g ? p.lru_w_i : p.lru_w_a;
        ((bf16_t*)(p.ws + WS_LRUW))[i] = (bf16_t)f2bf(src[((size_t)(ld * 8 + n) * 64 + k) * 64 + j]);
    }
    for (int i = c.bid * NTHREADS + c.tid; i < 2 * 96 * D / 8; i += c.nb * NTHREADS) {
        const int l = i / (96 * D / 8), r = i % (96 * D / 8);
        *(u32x4*)((bf16_t*)(p.ws + WS_WIN) + (size_t)l * INP * D + (size_t)INW * D + (size_t)r * 8) = (u32x4){0u, 0u, 0u, 0u};
    }
    __syncthreads();
    LAS float* sv = (LAS float*)c.lds;
    LAS float* red = sv + 3 * D;
    for (int i = c.tid; i < 3 * D; i += NTHREADS) { const int r = i >> 10, k = i & 1023; sv[i] = siluf_(r < 2 ? p.c[r * D + k] : p.c_ctx[k]); }
    __syncthreads();
    float* mo = (float*)(p.ws + WS_MODP);
    for (int it = c.bid; it < 2 * 96; it += c.nb) {
        const int l = it / 96, n = (it % 96) * 64 + (c.tid & 63), kg = c.tid >> 6;
        const float* w = p.w_ada + ((size_t)l * D + kg * 128) * 6144 + n;
        float a0 = 0.f, a1 = 0.f, a2 = 0.f;
#pragma unroll 8
        for (int kk = 0; kk < 128; ++kk) { const float wv = w[(size_t)kk * 6144]; const int k = kg * 128 + kk; a0 += sv[k] * wv; a1 += sv[D + k] * wv; a2 += sv[2 * D + k] * wv; }
        red[(kg * 3 + 0) * 64 + (c.tid & 63)] = a0; red[(kg * 3 + 1) * 64 + (c.tid & 63)] = a1; red[(kg * 3 + 2) * 64 + (c.tid & 63)] = a2;
        __syncthreads();
        if (c.tid < 192) { const int r = c.tid >> 6, cc = c.tid & 63; float v = p.b_ada[l * 6144 + (it % 96) * 64 + cc];
#pragma unroll
            for (int g = 0; g < 8; ++g) v += red[(g * 3 + r) * 64 + cc];
            mo[(size_t)(l * 3 + r) * 6144 + (it % 96) * 64 + cc] = v; }
        __syncthreads();
    }
}

__device__ __forceinline__ void phase_n1(const Params& p, const Ctx& c, int l) {
    LAS float* sh = (LAS float*)c.lds;
    LAS float* sc = sh + 3 * D;
    load_mods(p, c, l, 0, sh); load_mods(p, c, l, 1, sc);
    __syncthreads();
    const float* g = p.g_norm + (size_t)(l * 4 + 0) * D;
    bf16_t* H = (bf16_t*)(p.ws + WS_H);
#define N1_LOAD(mm) do { const float* xr_ = xin_row(p, mm);        _Pragma("unroll") for (int j = 0; j < 4; ++j) vn[j] = *(const f32x4*)(xr_ + 4 * (c.lane + 64 * j)); } while (0)
    f32x4 vn[4];
    if (c.gw < M) N1_LOAD(c.gw);
#pragma unroll 1
    for (int m = c.gw; m < M; m += c.ngw) {
        const int b = m / LT, t = m - b * LT, r = t < CTX ? 2 : b;
        f32x4 v[4]; float ss = 0.f;
#pragma unroll
        for (int j = 0; j < 4; ++j) { v[j] = vn[j]; ss += v[j].x * v[j].x + v[j].y * v[j].y + v[j].z * v[j].z + v[j].w * v[j].w; }
        if (m + c.ngw < M) N1_LOAD(m + c.ngw);
        const float rstd = rsqrtf(wave_sum(ss) * (1.f / D) + 1e-6f);
#pragma unroll
        for (int j = 0; j < 4; ++j) {
            const int n = 4 * (c.lane + 64 * j);
            const f32x4 gg = *(const f32x4*)(g + n);
            float o[4];
#pragma unroll
            for (int e = 0; e < 4; ++e) o[e] = v[j][e] * rstd * gg[e] * (1.f + sc[r * D + n + e]) + sh[r * D + n + e];
            u32x2 w; w.x = pk2(o[0], o[1]); w.y = pk2(o[2], o[3]);
            *(u32x2*)(H + (size_t)m * D + n) = w;
        }
    }
}

template <int NJ, class Op>
__device__ __forceinline__ void wave_gemm_tile(const Op& op, int r0, int c0, int K, int lane) {
    const int fr = lane & 15, fq = lane >> 4;
    const bf16_t* ap[4]; const bf16_t* bp[NJ];
#pragma unroll
    for (int i = 0; i < 4; ++i) ap[i] = op.arow(r0 + 16 * i + fr) + 8 * fq;
#pragma unroll
    for (int j = 0; j < NJ; ++j) bp[j] = op.brow(c0 + 16 * j + fr) + 8 * fq;
    f32x4 acc[4][NJ];
#pragma unroll
    for (int i = 0; i < 4; ++i)
#pragma unroll
        for (int j = 0; j < NJ; ++j) acc[i][j] = (f32x4){0.f, 0.f, 0.f, 0.f};
    for (int k0 = 0; k0 < K; k0 += 32) {
        bf16x8 a[4], b[NJ];
#pragma unroll
        for (int i = 0; i < 4; ++i) a[i] = *(const bf16x8*)(ap[i] + k0);
#pragma unroll
        for (int j = 0; j < NJ; ++j) b[j] = *(const bf16x8*)(bp[j] + k0);
#pragma unroll
        for (int i = 0; i < 4; ++i)
#pragma unroll
            for (int j = 0; j < NJ; ++j) acc[i][j] = __builtin_amdgcn_mfma_f32_16x16x32_bf16(a[i], b[j], acc[i][j], 0, 0, 0);
    }
#pragma unroll
    for (int i = 0; i < 4; ++i)
#pragma unroll
        for (int j = 0; j < NJ; ++j)
#pragma unroll
            for (int e = 0; e < 4; ++e) op.store(r0 + 16 * i + 4 * fq + e, c0 + 16 * j + fr, acc[i][j][e]);
}

__device__ __forceinline__ void phase_g1(const Params& p, const Ctx& c, int l, bool deferred) {
    pg8::Gemm g{(const bf16_t*)(p.ws + WS_H), (const bf16_t*)(p.ws + WS_WIN) + (size_t)l * INP * D, M, INP, D};
    pg8::EpiBf16<0> E{(bf16_t*)(p.ws + WS_P), INP, nullptr, 0, 0, 1.f};
    if (c.nb == 256) { pg8::G1Order S{c.nb, c.bid, deferred}; pg8::gemm_phase<pg8::EpiBf16<0>, pg8::G1Order, true, true>(c.lds, g, S, E, c.tid); }
    else if (!deferred) { pg8::StaticOrder S; S.init(M, INP, c.nb, c.bid); pg8::gemm_phase<pg8::EpiBf16<0>, pg8::StaticOrder, true, true>(c.lds, g, S, E, c.tid); }
}
__device__ __forceinline__ void phase_o1(const Params& p, const Ctx& c, int l, bool last) {
    pg8::Gemm g{(const bf16_t*)(p.ws + WS_Y), (const bf16_t*)(p.ws + WS_WOUT) + (size_t)l * D * D, M, D, D};
    pg8::EpiBf16<0> E{(bf16_t*)(p.ws + WS_P), D, nullptr, 0, 0, 1.f};
    if (last) { pg8::LatentOrder4 S{c.nb, c.bid}; pg8::gemm_phase<pg8::EpiBf16<0>, pg8::LatentOrder4, true, true>(c.lds, g, S, E, c.tid); }
    else { pg8::StaticOrder S; S.init(M, D, c.nb, c.bid); pg8::gemm_phase<pg8::EpiBf16<0>, pg8::StaticOrder, true, true>(c.lds, g, S, E, c.tid);
        constexpr int FULL = (M / 256) * (D / 256) - 256;
        if (c.nb == 256 && c.bid >= FULL) { __syncthreads(); convert_weights(p, c, 0, CV_S, CV_ALL, (c.bid - FULL) * NWAVES + c.wave, (256 - FULL) * NWAVES); }
        else if (c.nb != 256) { __syncthreads(); convert_weights(p, c, 0, CV_S, CV_ALL, c.gw, c.ngw); } }
}

__device__ __forceinline__ void rope_cs(int fi, int pos, float& cs, float& sn) {
    const float ang = (float)pos * __builtin_amdgcn_exp2f(-(float)fi * 1.6609640474436813f); cs = __cosf(ang); sn = __sinf(ang); }
struct C1W { bf16x8 q[3][8]; };
__device__ __forceinline__ void c1_load_q(const Params& p, const Ctx& c, int l, C1W& W) {
    const bf16_t* WqT = (const bf16_t*)(p.ws + WS_WQT) + (size_t)l * 384 * 256; const int fr = c.lane & 15, fq = c.lane >> 4;
#pragma unroll
    for (int i = 0; i < 3; ++i)
#pragma unroll
        for (int ks = 0; ks < 8; ++ks) W.q[i][ks] = *(const bf16x8*)(WqT + (size_t)(48 * c.wave + 16 * i + fr) * 256 + ks * 32 + fq * 8);
}
template <int VAR = 0>
__device__ __forceinline__ void c1_compute(const Params& p, const Ctx& c, int l, const C1W& W, int b, int t0, LAS const unsigned char* aq, LAS const unsigned char* akv) {
    constexpr int PQ = 528, PKV = 272, ROWS = 66, RT = 5;
    bf16_t* Q = (bf16_t*)(p.ws + WS_Q); bf16_t* Kb = (bf16_t*)(p.ws + WS_K); bf16_t* Vb = (bf16_t*)(p.ws + WS_V);
    const bf16_t* WkvT = (const bf16_t*)(p.ws + WS_WKVT) + (size_t)l * 512 * 128;
    const int fr = c.lane & 15, fq = c.lane >> 4, w = c.wave, h = w >> 1;
    bf16x8 bkv[4][4];
    {
        f32x4 acc[3][RT];
#pragma unroll
        for (int i = 0; i < 3; ++i)
#pragma unroll
            for (int rt = 0; rt < RT; ++rt) acc[i][rt] = (f32x4){0.f, 0.f, 0.f, 0.f};
#pragma unroll
        for (int ks = 0; ks < 8; ++ks) {
            bf16x8 a[RT];
#pragma unroll
            for (int rt = 0; rt < RT; ++rt) a[rt] = *(LAS const bf16x8*)(aq + (rt * 16 + fr) * PQ + (ks * 32 + fq * 8) * 2);
#pragma unroll
            for (int i = 0; i < 3; ++i)
#pragma unroll
                for (int rt = 0; rt < RT; ++rt) { if (VAR & 2) { asm volatile("" :: "v"(a[rt]), "v"(W.q[i][ks])); } else acc[i][rt] = __builtin_amdgcn_mfma_f32_16x16x32_bf16(a[rt], W.q[i][ks], acc[i][rt], 0, 0, 0); }
        }
        __builtin_amdgcn_sched_barrier(0);
#pragma unroll
        for (int i = 0; i < 3; ++i) {
            const int d = (w & 1) * 48 + 16 * i + fr;
            const bool rope_tile = (w & 1) && i >= 1;
#pragma unroll
            for (int rt = 0; rt < RT; ++rt)
#pragma unroll
                for (int e = 0; e < 4; ++e) { const int r = 16 * rt + 4 * fq + e, t = t0 + r; float v = acc[i][rt][e];
                    if (rope_tile) { const float pv = dpp_f<0x128>(v);
                        if (t >= CTX) { const int sidx = t - CTX, pos = (i == 2) ? (sidx % GW) : (sidx / GW); float cs, sn; rope_cs(fr & 7, pos, cs, sn); v = fr < 8 ? v * cs - pv * sn : v * cs + pv * sn; } }
                    if (VAR & 1) { asm volatile("" :: "v"(v)); } else if (r < ROWS) Q[((size_t)(b * 4 + h) * LT + t) * 96 + d] = (bf16_t)f2bf(v * 0.14724444602590306f); }
        }
    }
    __builtin_amdgcn_sched_barrier(0);
#pragma unroll
    for (int i = 0; i < 4; ++i)
#pragma unroll
        for (int ks = 0; ks < 4; ++ks) bkv[i][ks] = *(const bf16x8*)(WkvT + (size_t)(64 * w + 16 * i + fr) * 128 + ks * 32 + fq * 8);
    {
        f32x4 acc[4][RT];
#pragma unroll
        for (int i = 0; i < 4; ++i)
#pragma unroll
            for (int rt = 0; rt < RT; ++rt) acc[i][rt] = (f32x4){0.f, 0.f, 0.f, 0.f};
#pragma unroll
        for (int ks = 0; ks < 4; ++ks) {
            bf16x8 a[RT];
#pragma unroll
            for (int rt = 0; rt < RT; ++rt) a[rt] = *(LAS const bf16x8*)(akv + (rt * 16 + fr) * PKV + (ks * 32 + fq * 8) * 2);
#pragma unroll
            for (int i = 0; i < 4; ++i)
#pragma unroll
                for (int rt = 0; rt < RT; ++rt) { if (VAR & 2) { asm volatile("" :: "v"(a[rt]), "v"(bkv[i][ks])); } else acc[i][rt] = __builtin_amdgcn_mfma_f32_16x16x32_bf16(a[rt], bkv[i][ks], acc[i][rt], 0, 0, 0); }
        }
#pragma unroll
        for (int i = 0; i < 4; ++i)
#pragma unroll
            for (int rt = 0; rt < RT; ++rt)
#pragma unroll
                for (int e = 0; e < 4; ++e) { const int r = 16 * rt + 4 * fq + e, t = t0 + r, d = 16 * i + fr; const bf16_t v = (bf16_t)f2bf(acc[i][rt][e]);
                    if (VAR & 1) { asm volatile("" :: "v"(v)); } else if (r < ROWS) { if (w & 1) Vb[((size_t)(b * 4 + h) * LT + t) * 64 + d] = v; else Kb[((size_t)(b * 4 + h) * LT + t) * 96 + d] = v; } }
    }
}
template <int VAR = 0>
__device__ __forceinline__ void phase_c1(const Params& p, const Ctx& c, int l) {
    constexpr int PQ = 528, PKV = 272, ROWS = 66;
    LAS unsigned char* aq = c.lds; LAS unsigned char* akv = c.lds + 80 * PQ;
    const bf16_t* P = (const bf16_t*)(p.ws + WS_P); bf16_t* Kb = (bf16_t*)(p.ws + WS_K);
    for (int g = c.bid; g < M / ROWS; g += c.nb) {
        const int m0 = g * ROWS, b = m0 / LT, t0 = m0 - b * LT;
        C1W W; c1_load_q(p, c, l, W);
        __syncthreads();
#pragma unroll 1
        for (int it = 0; it < 3; ++it) {
            const int r = it * 32 + (c.tid >> 4), q16 = c.tid & 15;
            if (r >= 80 || (VAR & 4)) continue;
            const bool real = r < ROWS; const int rr = real ? r : 0;
            const bf16_t* pr = P + (size_t)(m0 + rr) * INP;
            const u32x4 c0 = *(const u32x4*)(pr + OFF_CQ + q16 * 16), c1 = *(const u32x4*)(pr + OFF_CQ + q16 * 16 + 8), k0 = *(const u32x4*)(pr + OFF_CKV + q16 * 8);
            const unsigned krw = *(const unsigned*)(pr + OFF_KR + q16 * 2);
            float cv[16], kv[8];
            cv[0] = lo_bf(c0.x); cv[1] = hi_bf(c0.x); cv[2] = lo_bf(c0.y); cv[3] = hi_bf(c0.y); cv[4] = lo_bf(c0.z); cv[5] = hi_bf(c0.z); cv[6] = lo_bf(c0.w); cv[7] = hi_bf(c0.w);
            cv[8] = lo_bf(c1.x); cv[9] = hi_bf(c1.x); cv[10] = lo_bf(c1.y); cv[11] = hi_bf(c1.y); cv[12] = lo_bf(c1.z); cv[13] = hi_bf(c1.z); cv[14] = lo_bf(c1.w); cv[15] = hi_bf(c1.w);
            kv[0] = lo_bf(k0.x); kv[1] = hi_bf(k0.x); kv[2] = lo_bf(k0.y); kv[3] = hi_bf(k0.y); kv[4] = lo_bf(k0.z); kv[5] = hi_bf(k0.z); kv[6] = lo_bf(k0.w); kv[7] = hi_bf(k0.w);
            float s1 = 0.f, s2 = 0.f;
#pragma unroll
            for (int i = 0; i < 16; ++i) s1 += cv[i] * cv[i];
#pragma unroll
            for (int i = 0; i < 8; ++i) s2 += kv[i] * kv[i];
            s1 = row16_sum(s1); s2 = row16_sum(s2);
            const float r1 = real ? rsqrtf(s1 * (1.f / 256.f) + 1e-6f) : 0.f, r2 = real ? rsqrtf(s2 * (1.f / 128.f) + 1e-6f) : 0.f;
            const float* gq = p.mla_g_q + l * 256 + q16 * 16; const float* gk = p.mla_g_kv + l * 128 + q16 * 8;
            u32x4 o0, o1, o2;
            o0.x = pk2(cv[0] * r1 * gq[0], cv[1] * r1 * gq[1]); o0.y = pk2(cv[2] * r1 * gq[2], cv[3] * r1 * gq[3]); o0.z = pk2(cv[4] * r1 * gq[4], cv[5] * r1 * gq[5]); o0.w = pk2(cv[6] * r1 * gq[6], cv[7] * r1 * gq[7]);
            o1.x = pk2(cv[8] * r1 * gq[8], cv[9] * r1 * gq[9]); o1.y = pk2(cv[10] * r1 * gq[10], cv[11] * r1 * gq[11]); o1.z = pk2(cv[12] * r1 * gq[12], cv[13] * r1 * gq[13]); o1.w = pk2(cv[14] * r1 * gq[14], cv[15] * r1 * gq[15]);
            o2.x = pk2(kv[0] * r2 * gk[0], kv[1] * r2 * gk[1]); o2.y = pk2(kv[2] * r2 * gk[2], kv[3] * r2 * gk[3]); o2.z = pk2(kv[4] * r2 * gk[4], kv[5] * r2 * gk[5]); o2.w = pk2(kv[6] * r2 * gk[6], kv[7] * r2 * gk[7]);
            *(LAS u32x4*)(aq + r * PQ + q16 * 32) = o0; *(LAS u32x4*)(aq + r * PQ + q16 * 32 + 16) = o1; *(LAS u32x4*)(akv + r * PKV + q16 * 16) = o2;
            float z0 = lo_bf(krw), z1 = hi_bf(krw);
            const float y0 = __shfl_xor(z0, 4), y1 = __shfl_xor(z1, 4);
            const int t = t0 + r;
            if (t >= CTX) { const int sidx = t - CTX, pos = (q16 >> 3) ? (sidx % GW) : (sidx / GW); const int li0 = (2 * q16) & 15; const bool first = li0 < 8;
                float cs, sn; rope_cs(li0 & 7, pos, cs, sn); z0 = first ? z0 * cs - y0 * sn : z0 * cs + y0 * sn;
                rope_cs((li0 + 1) & 7, pos, cs, sn); z1 = first ? z1 * cs - y1 * sn : z1 * cs + y1 * sn; }
            const unsigned kw = pk2(z0, z1);
            if (real) {
#pragma unroll
                for (int h = 0; h < 4; ++h) *(unsigned*)(Kb + ((size_t)(b * 4 + h) * LT + t) * 96 + 64 + 2 * q16) = kw; }
        }
        __syncthreads();
        c1_compute<VAR>(p, c, l, W, b, t0, aq, akv);
    }
}

namespace lru {
typedef float f32x16 __attribute__((ext_vector_type(16)));
constexpr int PITCH = 1040;
__device__ __forceinline__ void load_uc(const Params& p, const Ctx& c, int l, int b, int ch, LAS unsigned char* ucb) {
    const int chn = c.tid, t0 = ch * CH, seq_lo = (ch < NCH_CTX) ? 0 : CTX, seq_hi = (ch < NCH_CTX) ? CTX : LT;
    const bf16_t* Pb = (const bf16_t*)(p.ws + WS_P) + (size_t)(b * LT) * INP + OFF_U + chn;
    const float w0 = p.conv_w[(l * 4 + 0) * LRU_W + chn], w1 = p.conv_w[(l * 4 + 1) * LRU_W + chn], w2 = p.conv_w[(l * 4 + 2) * LRU_W + chn], w3 = p.conv_w[(l * 4 + 3) * LRU_W + chn];
    const float cb = p.conv_b[l * LRU_W + chn];
    float u[CH + 3];
#pragma unroll
    for (int i = 0; i < CH + 3; ++i) { const int t = t0 - 1 + i, tc = min(max(t, seq_lo), seq_hi - 1); u[i] = bf2f(Pb[(size_t)tc * INP]); }
    if (t0 == seq_lo) u[0] = 0.f;
    if (t0 + CH == seq_hi) { u[CH + 1] = 0.f; u[CH + 2] = 0.f; }
#pragma unroll
    for (int i = 0; i < CH; ++i) *(LAS bf16_t*)(ucb + i * PITCH + chn * 2) = (bf16_t)f2bf(u[i] * w0 + u[i + 1] * w1 + u[i + 2] * w2 + u[i + 3] * w3 + cb);
}
struct WF { bf16x8 a[4], i[4]; };
__device__ __forceinline__ WF load_w(const Params& p, int l, int d, int n, int ct, int r32, int hi) {
    const bf16_t* wa = (const bf16_t*)(p.ws + WS_LRUW) + ((size_t)((((l * 2 + d) * 2 + 0) * 8 + n) * 64 + ct * 32 + r32)) * 64 + hi * 8;
    const bf16_t* wi = wa + (size_t)8 * 64 * 64;
    WF w;
#pragma unroll
    for (int ks = 0; ks < 4; ++ks) { w.a[ks] = *(const bf16x8*)(wa + ks * 16); w.i[ks] = *(const bf16x8*)(wi + ks * 16); }
    return w;
}
__device__ __forceinline__ void gates_mm(const WF& w, const bf16x8 (&af)[4], f32x16& za, f32x16& zi) {
    za = f32x16{}; zi = f32x16{};
#pragma unroll
    for (int ks = 0; ks < 4; ++ks) { za = __builtin_amdgcn_mfma_f32_32x32x16_bf16(af[ks], w.a[ks], za, 0, 0, 0); zi = __builtin_amdgcn_mfma_f32_32x32x16_bf16(af[ks], w.i[ks], zi, 0, 0, 0); }
}
__device__ __forceinline__ void gates_ew(const f32x16& za, const f32x16& zi, float bias_a, float bias_i, float lam, const float (&ucv)[16], float (&a)[16], float (&x)[16]) {
    const float ee = __builtin_amdgcn_exp2f(-1.4426950408889634f * lam);
    const float sp = ee * (1.f + ee * (-0.5f + ee * (0.33333333f - 0.25f * ee)));
#pragma unroll
    for (int r = 0; r < 16; ++r) { const float la = -8.f * sigmoidf_(za[r] + bias_a) * sp, y = 2.f * la;
        const float g2 = -y * (1.f + y * (0.5f + y * (0.16666667f + y * (0.041666667f + y * 0.0083333333f))));
        a[r] = __builtin_amdgcn_exp2f(1.4426950408889634f * la); x[r] = __builtin_amdgcn_sqrtf(g2) * sigmoidf_(zi[r] + bias_i) * ucv[r]; }
}
template <bool HS>
__device__ __forceinline__ float scan32(const float (&a)[16], const float (&x)[16], int d, int hi, float h0, float (&hs)[16], float& ap) {
    float As[4], Xs[4];
#pragma unroll
    for (int g = 0; g < 4; ++g) { float A = 1.f, X = 0.f;
#pragma unroll
        for (int e4 = 0; e4 < 4; ++e4) { const int r = 4 * g + (d == 0 ? e4 : 3 - e4); X = a[r] * X + x[r]; A *= a[r]; }
        As[g] = A; Xs[g] = X; }
    float Alo[4], Ahi[4], Xlo[4], Xhi[4];
#pragma unroll
    for (int g = 0; g < 4; ++g) {
        auto ra = __builtin_amdgcn_permlane32_swap(__float_as_uint(As[g]), __float_as_uint(As[g]), false, false);
        auto rx = __builtin_amdgcn_permlane32_swap(__float_as_uint(Xs[g]), __float_as_uint(Xs[g]), false, false);
        Alo[g] = __uint_as_float(ra[0]); Ahi[g] = __uint_as_float(ra[1]); Xlo[g] = __uint_as_float(rx[0]); Xhi[g] = __uint_as_float(rx[1]); }
    float h = h0, hin[4]; ap = 1.f;
#pragma unroll
    for (int s8 = 0; s8 < 8; ++s8) { const int sg = d == 0 ? s8 : 7 - s8, g = sg >> 1; const bool up = (sg & 1) != 0;
        const float A = up ? Ahi[g] : Alo[g], X = up ? Xhi[g] : Xlo[g];
        if (up == (hi != 0)) hin[g] = h;
        h = A * h + X; ap *= A; }
    if (HS) {
#pragma unroll
        for (int g = 0; g < 4; ++g) { float hh = hin[g];
#pragma unroll
            for (int e4 = 0; e4 < 4; ++e4) { const int r = 4 * g + (d == 0 ? e4 : 3 - e4); hh = a[r] * hh + x[r]; hs[r] = hh; } }
    }
    return h;
}
template <int MODE, int VAR = 0>
__device__ __forceinline__ void chunk(const Params& p, const Ctx& c, int l, int b, int ch, LAS const unsigned char* ucb, WF w) {
    const int n = c.wave, r32 = c.lane & 31, hi = c.lane >> 5;
    bf16x8 af[4];
#pragma unroll
    for (int ks = 0; ks < 4; ++ks) af[ks] = *(LAS const bf16x8*)(ucb + r32 * PITCH + (n * 64 + ks * 16 + hi * 8) * 2);
    constexpr int D0 = MODE == 0 ? 0 : 1, D1 = 1 - D0;
#pragma unroll 1
    for (int ct = 0; ct < 2; ++ct) {
        const int chn = n * 64 + ct * 32 + r32;
        float ucv[16], hr[16], a[16], x[16], ap; f32x16 za, zi;
#pragma unroll
        for (int r = 0; r < 16; ++r) ucv[r] = bf2f(*(LAS const bf16_t*)(ucb + (8 * (r >> 2) + 4 * hi + (r & 3)) * PITCH + chn * 2));
        float c0 = 0.f, c1 = 0.f;
        if (MODE == 1) { const float* cr = (const float*)(p.ws + WS_CARRY);
            c1 = cr[((size_t)((b * 2 + 1) * NCH + ch)) * LRU_W + chn]; c0 = cr[((size_t)((b * 2 + 0) * NCH + ch)) * LRU_W + chn]; }
        { const float bias_a = p.lru_b_a[(l * 2 + D0) * LRU_W + chn], bias_i = p.lru_b_i[(l * 2 + D0) * LRU_W + chn], lam = p.lru_lam[(l * 2 + D0) * LRU_W + chn];
          gates_mm(w, af, za, zi);
          w = load_w(p, l, D1, n, ct, r32, hi);
          __builtin_amdgcn_sched_barrier(0);
          if (VAR & 1) { _Pragma("unroll") for (int r = 0; r < 16; ++r) { a[r] = za[r] * bias_a; x[r] = zi[r] * lam + bias_i; } } else gates_ew(za, zi, bias_a, bias_i, lam, ucv, a, x); }
        if (MODE == 0) { const float he = scan32<false>(a, x, D0, hi, 0.f, hr, ap);
            if (hi == 0) { float* ag = (float*)(p.ws + WS_AGG) + 2 * (((size_t)((b * 2 + D0) * NCH + ch)) * LRU_W + chn); ag[0] = ap; ag[1] = he; } }
        else if (VAR & 2) { _Pragma("unroll") for (int r = 0; r < 16; ++r) hr[r] = a[r] + x[r] + c1; } else (void)scan32<true>(a, x, D0, hi, c1, hr, ap);
        __builtin_amdgcn_sched_barrier(0);
        unsigned short gv[16];
        if (MODE == 1 && !(VAR & 4)) {
            const char* gp = (const char*)((const bf16_t*)(p.ws + WS_P) + ((size_t)b * LT + ch * CH) * INP + OFF_G + n * 64 + ct * 32);
            const unsigned go = (unsigned)((4 * hi * INP + r32) * 2);
#pragma unroll
            for (int r = 0; r < 16; ++r) gv[r] = *(const bf16_t*)(gp + (size_t)(8 * (r >> 2) + (r & 3)) * INP * 2 + go);
        }
        { const float bias_a = p.lru_b_a[(l * 2 + D1) * LRU_W + chn], bias_i = p.lru_b_i[(l * 2 + D1) * LRU_W + chn], lam = p.lru_lam[(l * 2 + D1) * LRU_W + chn];
          gates_mm(w, af, za, zi);
          if (ct == 0) w = load_w(p, l, D0, n, 1, r32, hi);
          __builtin_amdgcn_sched_barrier(0);
          if (VAR & 1) { _Pragma("unroll") for (int r = 0; r < 16; ++r) { a[r] = za[r] * bias_a; x[r] = zi[r] * lam + bias_i; } } else gates_ew(za, zi, bias_a, bias_i, lam, ucv, a, x); }
        if (MODE == 0) { float hs[16]; const float he = scan32<false>(a, x, D1, hi, 0.f, hs, ap);
            if (hi == 0) { float* ag = (float*)(p.ws + WS_AGG) + 2 * (((size_t)((b * 2 + D1) * NCH + ch)) * LRU_W + chn); ag[0] = ap; ag[1] = he; } }
        else {
            float hs[16];
            if (VAR & 2) { _Pragma("unroll") for (int r = 0; r < 16; ++r) hs[r] = a[r] + x[r] + c0; } else (void)scan32<true>(a, x, D1, hi, c0, hs, ap);
            if (VAR & 4) { _Pragma("unroll") for (int r = 0; r < 16; ++r) asm volatile("" :: "v"(hs[r]), "v"(hr[r])); } else {
            char* yp = (char*)((bf16_t*)(p.ws + WS_Y) + ((size_t)b * LT + ch * CH) * D + 256 + n * 64 + ct * 32);
            const unsigned yo = (unsigned)((4 * hi * D + r32) * 2);
#pragma unroll
            for (int r = 0; r < 16; ++r) *(bf16_t*)(yp + (size_t)(8 * (r >> 2) + (r & 3)) * D * 2 + yo) = (bf16_t)f2bf((hr[r] + hs[r]) * gelu_tanh(bf2f(gv[r])));
            }
        }
        __builtin_amdgcn_sched_barrier(0);
    }
}
constexpr int TILE = CH * PITCH;
template <int MODE>
__device__ __forceinline__ void chunk2(const Params& p, const Ctx& c, int l, const int (&bb)[2], const int (&cc)[2], LAS const unsigned char* ucb, WF w) {
    const int n = c.wave, r32 = c.lane & 31, hi = c.lane >> 5;
    constexpr int D0 = MODE == 0 ? 0 : 1, D1 = 1 - D0;
#pragma unroll 1
    for (int ct = 0; ct < 2; ++ct) {
        const int chn = n * 64 + ct * 32 + r32;
        unsigned hrp[2][8];
        { const float bias_a = p.lru_b_a[(l * 2 + D0) * LRU_W + chn], bias_i = p.lru_b_i[(l * 2 + D0) * LRU_W + chn], lam = p.lru_lam[(l * 2 + D0) * LRU_W + chn];
          WF wn = w;
#pragma unroll
          for (int j = 0; j < 2; ++j) {
              LAS const unsigned char* tb = ucb + j * TILE;
              bf16x8 af[4]; float ucv[16], a[16], x[16], hs[16], ap; f32x16 za, zi;
#pragma unroll
              for (int ks = 0; ks < 4; ++ks) af[ks] = *(LAS const bf16x8*)(tb + r32 * PITCH + (n * 64 + ks * 16 + hi * 8) * 2);
#pragma unroll
              for (int r = 0; r < 16; ++r) ucv[r] = bf2f(*(LAS const bf16_t*)(tb + (8 * (r >> 2) + 4 * hi + (r & 3)) * PITCH + chn * 2));
              float cin = 0.f;
              if (MODE == 1) cin = ((const float*)(p.ws + WS_CARRY))[((size_t)((bb[j] * 2 + D0) * NCH + cc[j])) * LRU_W + chn];
              gates_mm(w, af, za, zi);
              if (j == 1) wn = load_w(p, l, D1, n, ct, r32, hi);
              __builtin_amdgcn_sched_barrier(0);
              gates_ew(za, zi, bias_a, bias_i, lam, ucv, a, x);
              if (MODE == 0) { const float he = scan32<false>(a, x, D0, hi, 0.f, hs, ap);
                  if (hi == 0) { float* ag = (float*)(p.ws + WS_AGG) + 2 * (((size_t)((bb[j] * 2 + D0) * NCH + cc[j])) * LRU_W + chn); ag[0] = ap; ag[1] = he; } }
              else { (void)scan32<true>(a, x, D0, hi, cin, hs, ap);
#pragma unroll
                  for (int r = 0; r < 8; ++r) hrp[j][r] = pk2(hs[2 * r], hs[2 * r + 1]); }
              __builtin_amdgcn_sched_barrier(0);
          }
          w = wn; }
        { const float bias_a = p.lru_b_a[(l * 2 + D1) * LRU_W + chn], bias_i = p.lru_b_i[(l * 2 + D1) * LRU_W + chn], lam = p.lru_lam[(l * 2 + D1) * LRU_W + chn];
          WF wn = w;
#pragma unroll
          for (int j = 0; j < 2; ++j) {
              LAS const unsigned char* tb = ucb + j * TILE;
              bf16x8 af[4]; float ucv[16], a[16], x[16], hs[16], ap; f32x16 za, zi; unsigned short gv[16];
#pragma unroll
              for (int ks = 0; ks < 4; ++ks) af[ks] = *(LAS const bf16x8*)(tb + r32 * PITCH + (n * 64 + ks * 16 + hi * 8) * 2);
#pragma unroll
              for (int r = 0; r < 16; ++r) ucv[r] = bf2f(*(LAS const bf16_t*)(tb + (8 * (r >> 2) + 4 * hi + (r & 3)) * PITCH + chn * 2));
              float cin = 0.f;
              if (MODE == 1) { cin = ((const float*)(p.ws + WS_CARRY))[((size_t)((bb[j] * 2 + D1) * NCH + cc[j])) * LRU_W + chn];
                  const char* gp = (const char*)((const bf16_t*)(p.ws + WS_P) + ((size_t)bb[j] * LT + cc[j] * CH) * INP + OFF_G + n * 64 + ct * 32);
                  const unsigned go = (unsigned)((4 * hi * INP + r32) * 2);
#pragma unroll
                  for (int r = 0; r < 16; ++r) gv[r] = *(const bf16_t*)(gp + (size_t)(8 * (r >> 2) + (r & 3)) * INP * 2 + go); }
              gates_mm(w, af, za, zi);
              if (j == 1 && ct == 0) wn = load_w(p, l, D0, n, 1, r32, hi);
              __builtin_amdgcn_sched_barrier(0);
              gates_ew(za, zi, bias_a, bias_i, lam, ucv, a, x);
              if (MODE == 0) { const float he = scan32<false>(a, x, D1, hi, 0.f, hs, ap);
                  if (hi == 0) { float* ag = (float*)(p.ws + WS_AGG) + 2 * (((size_t)((bb[j] * 2 + D1) * NCH + cc[j])) * LRU_W + chn); ag[0] = ap; ag[1] = he; } }
              else { (void)scan32<true>(a, x, D1, hi, cin, hs, ap);
                  char* yp = (char*)((bf16_t*)(p.ws + WS_Y) + ((size_t)bb[j] * LT + cc[j] * CH) * D + 256 + n * 64 + ct * 32);
                  const unsigned yo = (unsigned)((4 * hi * D + r32) * 2);
#pragma unroll
                  for (int r = 0; r < 16; ++r) { const float h1 = (r & 1) ? hi_bf(hrp[j][r >> 1]) : lo_bf(hrp[j][r >> 1]);
                      *(bf16_t*)(yp + (size_t)(8 * (r >> 2) + (r & 3)) * D * 2 + yo) = (bf16_t)f2bf((h1 + hs[r]) * gelu_tanh(bf2f(gv[r]))); } }
              __builtin_amdgcn_sched_barrier(0);
          }
          w = wn; }
    }
}
}
__device__ __forceinline__ void phase_c2(const Params& p, const Ctx& c, int l) {
    constexpr int ND = 82;
    const bool split = c.nb == 256;
    if (split && c.bid < ND) { phase_g1(p, c, l, true); __syncthreads(); }
    else if (!split) { phase_g1(p, c, l, true); __syncthreads(); }
    const int first = split ? (c.bid < ND ? c.bid : ND + (c.bid - ND)) : c.bid;
    const int stride = split ? (c.bid < ND ? NB * NCH : c.nb - ND) : c.nb;
    for (int it = first; it < NB * NCH; it += 2 * stride) {
        const int it2 = it + stride;
        const lru::WF w0 = lru::load_w(p, l, 0, c.wave, 0, c.lane & 31, c.lane >> 5);
        __syncthreads();
        lru::load_uc(p, c, l, it / NCH, it % NCH, c.lds);
        if (it2 < NB * NCH) lru::load_uc(p, c, l, it2 / NCH, it2 % NCH, c.lds + lru::TILE);
        __syncthreads();
        if (it2 < NB * NCH) { const int bb[2] = {it / NCH, it2 / NCH}, cc[2] = {it % NCH, it2 % NCH}; lru::chunk2<0>(p, c, l, bb, cc, c.lds, w0); }
        else lru::chunk<0>(p, c, l, it / NCH, it % NCH, c.lds, w0);
    }
}
__device__ __forceinline__ void phase_c3(const Params& p, const Ctx& c) {
    LAS float* sA = (LAS float*)c.lds; LAS float* sE = sA + 512;
    const float* ag = (const float*)(p.ws + WS_AGG); float* cr = (float*)(p.ws + WS_CARRY);
    for (int u = c.nb - 1 - c.bid; u < 32; u += c.nb) {
        const int b = u >> 4, d = (u >> 3) & 1, chn = (u & 7) * 64 + c.lane, seg = c.wave;
        float aa[33], ee[33];
#pragma unroll
        for (int k = 0; k < 33; ++k) { const int s = seg * 33 + k, ch = d == 0 ? s : (s < NCH_CTX ? NCH_CTX - 1 - s : NCH - 1 - (s - NCH_CTX));
            const size_t idx = ((size_t)((b * 2 + d) * NCH + ch)) * LRU_W + chn; const f32x2 v = *(const f32x2*)(ag + 2 * idx); aa[k] = v.x; ee[k] = v.y; }
        float A = 1.f, E = 0.f;
#pragma unroll
        for (int k = 0; k < 33; ++k) { E = aa[k] * E + ee[k]; A *= aa[k]; }
        __syncthreads();
        sA[seg * 64 + c.lane] = A; sE[seg * 64 + c.lane] = E;
        __syncthreads();
        float st = 0.f;
        for (int s2 = 0; s2 < seg; ++s2) st = sA[s2 * 64 + c.lane] * st + sE[s2 * 64 + c.lane];
#pragma unroll
        for (int k = 0; k < 33; ++k) { const int s = seg * 33 + k, ch = d == 0 ? s : (s < NCH_CTX ? NCH_CTX - 1 - s : NCH - 1 - (s - NCH_CTX));
            const size_t idx = ((size_t)((b * 2 + d) * NCH + ch)) * LRU_W + chn; cr[idx] = st; st = aa[k] * st + ee[k]; }
    }
}
template <int VAR = 0>
__device__ __forceinline__ void phase_c4(const Params& p, const Ctx& c, int l, bool last) {
    const int i0 = c.bid, i1 = c.nb + c.bid;
    const bool v0 = i0 < NB * NCH && !(last && (i0 % NCH) < NCH_CTX), v1 = i1 < NB * NCH && !(last && (i1 % NCH) < NCH_CTX);
    if (v0 && v1 && VAR == 0) {
        const lru::WF w0 = lru::load_w(p, l, 1, c.wave, 0, c.lane & 31, c.lane >> 5);
        __syncthreads();
        lru::load_uc(p, c, l, i0 / NCH, i0 % NCH, c.lds); lru::load_uc(p, c, l, i1 / NCH, i1 % NCH, c.lds + lru::TILE);
        __syncthreads();
        const int bb[2] = {i0 / NCH, i1 / NCH}, cc[2] = {i0 % NCH, i1 % NCH};
        lru::chunk2<1>(p, c, l, bb, cc, c.lds, w0);
    } else {
        for (int k = 0; k < 2; ++k) { const int it = k ? i1 : i0; if (!(k ? v1 : v0)) continue;
            const lru::WF w0 = lru::load_w(p, l, 1, c.wave, 0, c.lane & 31, c.lane >> 5);
            __syncthreads();
            if (!(VAR & 8)) lru::load_uc(p, c, l, it / NCH, it % NCH, c.lds);
            __syncthreads();
            lru::chunk<1, VAR>(p, c, l, it / NCH, it % NCH, c.lds, w0); }
    }
    for (int k = 2; k * c.nb < NB * NCH; ++k) {
        const int it = (c.nb == 256) ? k * c.nb + (c.nb - 1 - c.bid) : k * c.nb + c.bid;
        if (it >= NB * NCH) continue;
        const int b = it / NCH, ch = it % NCH;
        if (last && ch < NCH_CTX) continue;
        const lru::WF w0 = lru::load_w(p, l, 1, c.wave, 0, c.lane & 31, c.lane >> 5);
        __syncthreads();
        if (!(VAR & 8)) lru::load_uc(p, c, l, b, ch, c.lds);
        __syncthreads();
        lru::chunk<1, VAR>(p, c, l, b, ch, c.lds, w0);
    }
}

namespace mla {
typedef float f32x16 __attribute__((ext_vector_type(16)));
typedef short s16x4 __attribute__((ext_vector_type(4)));
constexpr int DQ = 96, DV = 64, KVB = 64;
constexpr float SCALE = 0.10206207261596575f, THR = 8.f;
constexpr int SHM_V = KVB * DV * 2  , SHM_K = KVB * 256  , SHM_ATTN = 3 * SHM_V + 3 * SHM_K + NWAVES * 64 * 4;
#define KSWZ(row, colB) ((row) * 256 + ((colB) ^ (((row) & 15) << 4)))
#define SBAR() __builtin_amdgcn_sched_barrier(0)
__device__ __forceinline__ int crow(int r, int hi) { return (r & 3) + 8 * (r >> 2) + 4 * hi; }
__device__ __forceinline__ unsigned cvtpk(float lo, float hi) { return ::pk2(lo, hi); }
__device__ __forceinline__ void finishSM(f32x16& p0, f32x16& p1, float alpha, float& l_reg, bf16x8& pa0, bf16x8& pa1, bf16x8& pa2, bf16x8& pa3) {
#pragma unroll
    for (int r = 0; r < 16; ++r) p1[r] = __builtin_amdgcn_exp2f(p1[r]);
    float ps, ps0 = 0, ps1 = 0, ps2 = 0, ps3 = 0;
#pragma unroll
    for (int r = 0; r < 16; r += 2) { ps0 += p0[r]; ps1 += p0[r + 1]; ps2 += p1[r]; ps3 += p1[r + 1]; }
    ps = (ps0 + ps1) + (ps2 + ps3);
    { auto rr = __builtin_amdgcn_permlane32_swap(__float_as_uint(ps), __float_as_uint(ps), false, false);
      ps = __uint_as_float(rr[0]) + __uint_as_float(rr[1]); }
    l_reg = l_reg * alpha + ps;
#define PK4(P, BASE, OUT) do { unsigned a0 = cvtpk(P[BASE + 0], P[BASE + 1]), a1 = cvtpk(P[BASE + 2], P[BASE + 3]);   \
    unsigned b0 = cvtpk(P[BASE + 4], P[BASE + 5]), b1 = cvtpk(P[BASE + 6], P[BASE + 7]);                              \
    auto r0 = __builtin_amdgcn_permlane32_swap(a0, b0, false, false); auto r1 = __builtin_amdgcn_permlane32_swap(a1, b1, false, false); \
    u32x4 w = {r0[0], r1[0], r0[1], r1[1]}; OUT = *reinterpret_cast<bf16x8*>(&w); } while (0)
    PK4(p0, 0, pa0); PK4(p0, 8, pa1); PK4(p1, 0, pa2); PK4(p1, 8, pa3);
#undef PK4
}
template <int VAR = 0>
__device__ __forceinline__ void qkt(f32x16& p0, f32x16& p1, LAS const unsigned char* Ks, const bf16x8* qr, int r32, int hi, float m_reg) {
#pragma unroll
    for (int r = 0; r < 16; ++r) { p0[r] = -m_reg; p1[r] = -m_reg; }
#pragma unroll
    for (int d0 = 0; d0 < DQ / 16; ++d0) { const int cb = (d0 * 16 + hi * 8) * 2;
        const bf16x8 b0 = *(LAS const bf16x8*)(Ks + KSWZ(r32, cb));
        const bf16x8 b1 = *(LAS const bf16x8*)(Ks + KSWZ(32 + r32, cb));
        if (VAR & 2) { asm volatile("" :: "v"(b0), "v"(b1)); }
        else { p0 = __builtin_amdgcn_mfma_f32_32x32x16_bf16(b0, qr[d0], p0, 0, 0, 0);
               p1 = __builtin_amdgcn_mfma_f32_32x32x16_bf16(b1, qr[d0], p1, 0, 0, 0); } }
}
__device__ __forceinline__ int v_st(int k, int cc) { const int kk = (k & ~0xC) | ((k & 4) << 1) | ((k & 8) >> 1); return ((kk >> 3) * 2 + (cc >> 5)) * 512 + ((kk & 7) * 32 + (cc & 31)) * 2; }
__device__ __forceinline__ int v_rd_base(int lane) { return ((lane & 3) << 3) | (((lane >> 2) & 3) << 6) | (((lane >> 4) & 1) << 5) | (((lane >> 5) & 1) << 8); }
constexpr int v_rd_off(int d0, int ks, int half) { return d0 * 512 + ks * 2048 + half * 1024; }
template <int OFF> __device__ __forceinline__ s16x4 tr_read(int vb) { return __builtin_amdgcn_ds_read_tr16_b64_v4i16((LAS s16x4*)(uintptr_t)(unsigned)(vb + OFF)); }
template <int D0, int VAR = 0> __device__ __forceinline__ void pv_one(f32x16& od, int vb, bf16x8 pa0, bf16x8 pa1, bf16x8 pa2, bf16x8 pa3) {
    const s16x4 l0 = tr_read<v_rd_off(D0, 0, 0)>(vb), h0 = tr_read<v_rd_off(D0, 0, 1)>(vb), l1 = tr_read<v_rd_off(D0, 1, 0)>(vb), h1 = tr_read<v_rd_off(D0, 1, 1)>(vb);
    const s16x4 l2 = tr_read<v_rd_off(D0, 2, 0)>(vb), h2 = tr_read<v_rd_off(D0, 2, 1)>(vb), l3 = tr_read<v_rd_off(D0, 3, 0)>(vb), h3 = tr_read<v_rd_off(D0, 3, 1)>(vb);
#define PKV(L, H) (bf16x8){L[0], L[1], L[2], L[3], H[0], H[1], H[2], H[3]}
    if (VAR & 2) { asm volatile("" :: "v"(l0), "v"(h0), "v"(l1), "v"(h1), "v"(l2), "v"(h2), "v"(l3), "v"(h3), "v"(pa0), "v"(pa1), "v"(pa2), "v"(pa3)); return; }
    od = __builtin_amdgcn_mfma_f32_32x32x16_bf16(pa0, PKV(l0, h0), od, 0, 0, 0);
    od = __builtin_amdgcn_mfma_f32_32x32x16_bf16(pa1, PKV(l1, h1), od, 0, 0, 0);
    od = __builtin_amdgcn_mfma_f32_32x32x16_bf16(pa2, PKV(l2, h2), od, 0, 0, 0);
    od = __builtin_amdgcn_mfma_f32_32x32x16_bf16(pa3, PKV(l3, h3), od, 0, 0, 0);
#undef PKV
}
template <int VAR = 0> __device__ __forceinline__ void pv_all(f32x16* o, int vb, bf16x8 pa0, bf16x8 pa1, bf16x8 pa2, bf16x8 pa3) { pv_one<0, VAR>(o[0], vb, pa0, pa1, pa2, pa3); pv_one<1, VAR>(o[1], vb, pa0, pa1, pa2, pa3); }

constexpr float THR2 = THR * 1.4426950408889634f;
__device__ __forceinline__ void decideSM(f32x16& p0, f32x16& p1, float& m_reg, float& alpha) {
    float pmax = p0[0], pmx1 = p1[0];
#pragma unroll
    for (int r = 1; r < 16; ++r) { pmax = fmaxf(pmax, p0[r]); pmx1 = fmaxf(pmx1, p1[r]); }
    pmax = fmaxf(pmax, pmx1);
    { auto rr = __builtin_amdgcn_permlane32_swap(__float_as_uint(pmax), __float_as_uint(pmax), false, false);
      pmax = fmaxf(__uint_as_float(rr[0]), __uint_as_float(rr[1])); }
    if (__builtin_expect(__all(pmax <= THR2), 1)) { alpha = 1.f; }
    else { const float d = fmaxf(pmax, 0.f);
        alpha = __builtin_amdgcn_exp2f(-d); m_reg += d;
#pragma unroll
        for (int r = 0; r < 16; ++r) { p0[r] -= d; p1[r] -= d; } }
}
__device__ __forceinline__ void decideSM_first(f32x16& p0, f32x16& p1, float& m_reg, float& alpha) {
    float pmax = p0[0], pmx1 = p1[0];
#pragma unroll
    for (int r = 1; r < 16; ++r) { pmax = fmaxf(pmax, p0[r]); pmx1 = fmaxf(pmx1, p1[r]); }
    pmax = fmaxf(pmax, pmx1);
    { auto rr = __builtin_amdgcn_permlane32_swap(__float_as_uint(pmax), __float_as_uint(pmax), false, false);
      pmax = fmaxf(__uint_as_float(rr[0]), __uint_as_float(rr[1])); }
    alpha = 1.f; m_reg += pmax;
#pragma unroll
    for (int r = 0; r < 16; ++r) { p0[r] -= pmax; p1[r] -= pmax; }
}
__device__ __forceinline__ void scaleexp(f32x16& p0, f32x16& p1) {
#pragma unroll
    for (int r = 0; r < 16; ++r) p0[r] = __builtin_amdgcn_exp2f(p0[r]);
}
template <int VAR = 0>
__device__ __forceinline__ void pv_sm(f32x16* o, int vb, bf16x8 pa0, bf16x8 pa1, bf16x8 pa2, bf16x8 pa3, f32x16& q0, f32x16& q1) {
    pv_one<0, VAR>(o[0], vb, pa0, pa1, pa2, pa3);
    if (!(VAR & 1)) {
#pragma unroll
        for (int r = 0; r < 16; ++r) q0[r] = __builtin_amdgcn_exp2f(q0[r]); }
    pv_one<1, VAR>(o[1], vb, pa0, pa1, pa2, pa3);
}
__device__ __forceinline__ void fake_finish(const f32x16& p0, const f32x16& p1, bf16x8& pa0, bf16x8& pa1, bf16x8& pa2, bf16x8& pa3) {
    u32x4 w0 = {__float_as_uint(p0[0]), __float_as_uint(p0[1]), __float_as_uint(p0[2]), __float_as_uint(p0[3])}; pa0 = *reinterpret_cast<bf16x8*>(&w0);
    u32x4 w1 = {__float_as_uint(p0[4]), __float_as_uint(p0[5]), __float_as_uint(p0[6]), __float_as_uint(p0[7])}; pa1 = *reinterpret_cast<bf16x8*>(&w1);
    u32x4 w2 = {__float_as_uint(p1[0]), __float_as_uint(p1[1]), __float_as_uint(p1[2]), __float_as_uint(p1[3])}; pa2 = *reinterpret_cast<bf16x8*>(&w2);
    u32x4 w3 = {__float_as_uint(p1[4]), __float_as_uint(p1[5]), __float_as_uint(p1[6]), __float_as_uint(p1[7])}; pa3 = *reinterpret_cast<bf16x8*>(&w3);
}

template <int VAR = 0>
__device__ __forceinline__ void attn_unit(const bf16_t* __restrict__ Qb, const bf16_t* __restrict__ Kh, const bf16_t* __restrict__ Vh, bf16_t* __restrict__ Ob, int seq, LAS unsigned char* lds, int tid) {
    const int wid = tid >> 6, lane = tid & 63, r32 = lane & 31, hi = lane >> 5;
    LAS unsigned char* V_lds = lds; LAS unsigned char* K_lds = lds + 3 * SHM_V;
    LAS float* wsf = (LAS float*)(lds + 3 * SHM_V + 3 * SHM_K) + wid * 64; LAS float* li_l = wsf; LAS float* al_l = wsf + 32;
    float m_reg = 0.f, l_reg = 0; f32x16 o[2] = {}; bf16x8 qr[6];
    const bf16_t* Qw = Qb + (size_t)(wid * 32 + r32) * DQ + hi * 8;
#pragma unroll
    for (int d0 = 0; d0 < 6; ++d0) qr[d0] = *(const bf16x8*)(Qw + d0 * 16);
    const int vrow = tid >> 3, vcol = (tid & 7) * 8, vst = v_st(vrow, vcol);
    const int k0row = tid / 12, k0ch = tid % 12, k1row = (512 + tid) / 12, k1ch = (512 + tid) % 12;
    const int kst0 = KSWZ(k0row, k0ch * 16), kst1 = KSWZ(k1row, k1ch * 16);
    const bool has1 = tid < 256;
    const int vb0 = (int)(uintptr_t)V_lds + v_rd_base(lane);
    unsigned vsrc, ksrc[2];
    { const int ov = wid * 1024 + lane * 16, sbt = ov >> 9, kk = (sbt >> 1) * 8 + ((ov >> 6) & 7), k = (kk & ~0xC) | ((kk & 4) << 1) | ((kk & 8) >> 1), cc = (sbt & 1) * 32 + ((ov >> 4) & 3) * 8;
      vsrc = (unsigned)(k * DV + cc) * 2u;
#pragma unroll
      for (int i = 0; i < 2; ++i) { const int ok = wid * 2048 + i * 1024 + lane * 16, row = ok >> 8, slot = (ok >> 4) & 15, ch = slot ^ (row & 15); ksrc[i] = (unsigned)(row * DQ + (ch < 12 ? ch : 0) * 8) * 2u; } }
#define SLOAD(i, kk) do { } while (0)
#define SWRITE(b, i) do { } while (0)
#define DMA(b, kk) do { if (VAR & 4) break; \
    __builtin_amdgcn_global_load_lds((const unsigned*)((const char*)(Vh + (size_t)(kk) * DV) + vsrc), (LAS unsigned*)(V_lds + (b) * SHM_V + wid * 1024), 16, 0, 0); \
    __builtin_amdgcn_global_load_lds((const unsigned*)((const char*)(Kh + (size_t)(kk) * DQ) + ksrc[0]), (LAS unsigned*)(K_lds + (b) * SHM_K + wid * 2048), 16, 0, 0); \
    __builtin_amdgcn_global_load_lds((const unsigned*)((const char*)(Kh + (size_t)(kk) * DQ) + ksrc[1]), (LAS unsigned*)(K_lds + (b) * SHM_K + wid * 2048 + 1024), 16, 0, 0); } while (0)
#define RESC(a) do { if (__any((a) < 1.f)) { if (hi == 0) al_l[r32] = (a); asm volatile("s_waitcnt lgkmcnt(0)" ::: "memory"); \
    _Pragma("unroll") for (int d = 0; d < 2; ++d) _Pragma("unroll") for (int r = 0; r < 16; ++r) o[d][r] *= al_l[crow(r, hi)]; } } while (0)
    f32x16 pA0, pA1, pB0, pB1; float alA, alB; bf16x8 pa0, pa1, pa2, pa3; const int NT = seq / KVB;
    DMA(0, 0); DMA(1, KVB); __syncthreads();
    qkt<VAR>(pA0, pA1, K_lds, qr, r32, hi, m_reg); if (VAR & 1) { alA = 1.f; } else { decideSM_first(pA0, pA1, m_reg, alA); scaleexp(pA0, pA1); }
    int bq = 1, bp = 0, bw = 2;
    constexpr bool ordB = false;
#define FIN(P0, P1, AL) do { if (VAR & 1) fake_finish(P0, P1, pa0, pa1, pa2, pa3); else finishSM(P0, P1, AL, l_reg, pa0, pa1, pa2, pa3); } while (0)
#define DEC(P0, P1, MC, AL) do { if (VAR & 1) { AL = 1.f; } else decideSM(P0, P1, m_reg, AL); } while (0)
#define STEP(PX0, PX1, ALX, PY0, PY1, ALY, LOADSTMT, WSLOT) do { \
        if (!ordB) { LOADSTMT; qkt<VAR>(PX0, PX1, K_lds + bq * SHM_K, qr, r32, hi, m_reg); FIN(PY0, PY1, ALY); \
            DEC(PX0, PX1, 0, ALX); \
            pv_sm<VAR>(o, vb0 + bp * SHM_V, pa0, pa1, pa2, pa3, PX0, PX1); } \
        else { SBAR(); FIN(PY0, PY1, ALY); SBAR(); \
            pv_all<VAR>(o, vb0 + bp * SHM_V, pa0, pa1, pa2, pa3); SBAR(); \
            LOADSTMT; qkt<VAR>(PX0, PX1, K_lds + bq * SHM_K, qr, r32, hi, m_reg); SBAR(); \
            DEC(PX0, PX1, 0, ALX); if (!(VAR & 1)) scaleexp(PX0, PX1); SBAR(); } \
        SWRITE(bw, WSLOT); RESC(ALX); if (!(VAR & 8)) __syncthreads(); \
        { const int t3 = bp; bp = bq; bq = bw; bw = t3; } } while (0)
    for (int t = 1; t + 1 < NT; t += 2) {
        STEP(pB0, pB1, alB, pA0, pA1, alA, DMA(bw, (t + 1) * KVB), 0);
        STEP(pA0, pA1, alA, pB0, pB1, alB, DMA(bw, (t + 2) * KVB), 1);
    }
#undef STEP
    qkt<VAR>(pB0, pB1, K_lds + bq * SHM_K, qr, r32, hi, m_reg);
    if (VAR & 1) fake_finish(pA0, pA1, pa0, pa1, pa2, pa3); else finishSM(pA0, pA1, alA, l_reg, pa0, pa1, pa2, pa3);
    if (VAR & 1) { alB = 1.f; } else decideSM(pB0, pB1, m_reg, alB);
    pv_sm<VAR>(o, vb0 + bp * SHM_V, pa0, pa1, pa2, pa3, pB0, pB1);
    RESC(alB);
    if (VAR & 1) fake_finish(pB0, pB1, pa0, pa1, pa2, pa3); else finishSM(pB0, pB1, alB, l_reg, pa0, pa1, pa2, pa3);
    pv_all<VAR>(o, vb0 + bq * SHM_V, pa0, pa1, pa2, pa3);
    if (hi == 0) li_l[r32] = l_reg;
    asm volatile("s_waitcnt lgkmcnt(0)" ::: "memory");
    float rli[16];
#pragma unroll
    for (int r = 0; r < 16; ++r) rli[r] = __builtin_amdgcn_rcpf(li_l[crow(r, hi)]);
    bf16_t* Ow = Ob + (size_t)(wid * 32) * D;
#pragma unroll
    for (int r = 0; r < 16; ++r) { const int orow = crow(r, hi);
#pragma unroll
        for (int d0 = 0; d0 < 2; ++d0) Ow[(size_t)orow * D + d0 * 32 + r32] = (bf16_t)f2bf(o[d0][r] * rli[r]); }
    __syncthreads();
#undef SLOAD
#undef SWRITE
#undef DMA
#undef RESC
#undef FIN
#undef DEC
}
#undef KSWZ
#undef SBAR
}
namespace nab {
using mla::f32x16;
constexpr int SHM_V = 8192, SHM_K = 16384, RING = 3 * (SHM_V + SHM_K);
constexpr int LDS_NEED = RING + NWAVES * 256 + 2048;
constexpr float SCALE = 0.125f, C = SCALE * 1.4426950408889634f;
#define KSWZ(row, colB) ((row) * 256 + ((colB) ^ (((row) & 15) << 4)))
#define SBAR() __builtin_amdgcn_sched_barrier(0)
__device__ __forceinline__ void qkt64(f32x16& p0, f32x16& p1, LAS const unsigned char* Ks, const bf16x8* qr, int r32, int hi, float m_reg) {
#pragma unroll
    for (int r = 0; r < 16; ++r) { p0[r] = -m_reg; p1[r] = -m_reg; }
#pragma unroll
    for (int d0 = 0; d0 < 4; ++d0) { const int cb = (d0 * 16 + hi * 8) * 2;
        const bf16x8 b0 = *(LAS const bf16x8*)(Ks + KSWZ(r32, cb));
        const bf16x8 b1 = *(LAS const bf16x8*)(Ks + KSWZ(32 + r32, cb));
        p0 = __builtin_amdgcn_mfma_f32_32x32x16_bf16(b0, qr[d0], p0, 0, 0, 0);
        p1 = __builtin_amdgcn_mfma_f32_32x32x16_bf16(b1, qr[d0], p1, 0, 0, 0); }
}
__device__ __forceinline__ void unit(const bf16_t* __restrict__ Pb, int h, bool lat, int r0, LAS const float* rp, bf16_t* __restrict__ Yb, LAS unsigned char* lds, int tid) {
    const int wid = __builtin_amdgcn_readfirstlane(tid >> 6), lane = tid & 63, r32 = lane & 31, hi = lane >> 5;
    LAS unsigned char* V_lds = lds; LAS unsigned char* K_lds = lds + 3 * SHM_V;
    LAS float* wsf = (LAS float*)(lds + RING) + wid * 64; LAS float* li_l = wsf; LAS float* al_l = wsf + 32;
    const int r = r0 + (wid >> 1), qc = (wid & 1) * 32 + r32, cs = min(max(qc - 8, 0), 48);
    const int qtok = lat ? CTX + r * GW + qc : wid * 32 + r32;
    const int rs_me = min(max(r - 4, 0), 120), rs_min = min(max(r0 - 4, 0), 120), nrows = lat ? (min(max(r0 + 3 - 4, 0), 120) + 8 - rs_min) : 0;
    const int NT = (4 + nrows + 1) & ~1;
    float m_reg = 0.f, l_reg = 0; f32x16 o[2] = {}; bf16x8 qr[4];
    { const bf16_t* Qw = Pb + (size_t)qtok * INP + OFF_QA + h * 64 + hi * 8;
#pragma unroll
      for (int d0 = 0; d0 < 4; ++d0) { const u32x4 w = *(const u32x4*)(Qw + d0 * 16);
          u32x4 o4; o4.x = pk2(lo_bf(w.x) * C, hi_bf(w.x) * C); o4.y = pk2(lo_bf(w.y) * C, hi_bf(w.y) * C); o4.z = pk2(lo_bf(w.z) * C, hi_bf(w.z) * C); o4.w = pk2(lo_bf(w.w) * C, hi_bf(w.w) * C);
          qr[d0] = *reinterpret_cast<bf16x8*>(&o4); } }
    const int srow = tid >> 3, sch = tid & 7, vst = mla::v_st(srow, sch * 8), kst = KSWZ(srow, sch * 16);
    const unsigned svo = (unsigned)((srow * INP + h * 64 + sch * 8) * 2);
    const int vb0 = (int)(uintptr_t)V_lds + mla::v_rd_base(lane);
    struct { bf16x8 v, k; } sr_[2];
#define TOK0(t) ((t) < 4 ? (t) * 64 : CTX + min(rs_min + (t) - 4, 127) * GW)
#define SLOAD(i, t) do { const char* kb = (const char*)(Pb + (size_t)TOK0(t) * INP); sr_[i].k = *(const bf16x8*)(kb + svo + OFF_KA * 2); sr_[i].v = *(const bf16x8*)(kb + svo + OFF_VA * 2); } while (0)
#define SWRITE(b, i) do { *(LAS bf16x8*)(V_lds + (b) * SHM_V + vst) = sr_[i].v; *(LAS bf16x8*)(K_lds + (b) * SHM_K + kst) = sr_[i].k; } while (0)
#define RESC(a) do { if (__any((a) < 1.f)) { if (hi == 0) al_l[r32] = (a); asm volatile("s_waitcnt lgkmcnt(0)" ::: "memory"); \
    _Pragma("unroll") for (int d = 0; d < 2; ++d) _Pragma("unroll") for (int rr = 0; rr < 16; ++rr) o[d][rr] *= al_l[mla::crow(rr, hi)]; } } while (0)
#define MASK(P0, P1, t) do { if ((t) >= 4) { const int kr = rs_min + (t) - 4; \
        if ((unsigned)(kr - rs_me) < 8u) { int qcl = qc; asm volatile("" : "+v"(qcl)); const int csl = min(max(qcl - 8, 0), 48); \
            LAS const float* rl_ = rp + (kr - r + 7) * 32 + (4 * hi - qcl + 15); const int rel = 4 * hi - csl; \
            _Pragma("unroll") for (int rr = 0; rr < 16; ++rr) { const int k0c = mla::crow(rr, 0); \
                P0[rr] = ((unsigned)(rel + k0c) < 16u) ? P0[rr] + rl_[k0c] : -1e30f; \
                P1[rr] = ((unsigned)(rel + k0c + 32) < 16u) ? P1[rr] + rl_[k0c + 32] : -1e30f; } } \
        else { _Pragma("unroll") for (int rr = 0; rr < 16; ++rr) { P0[rr] = -1e30f; P1[rr] = -1e30f; } } } } while (0)
    f32x16 pA0, pA1, pB0, pB1; float alA, alB; bf16x8 pa0, pa1, pa2, pa3;
    SLOAD(0, 0); SLOAD(1, 1); SWRITE(0, 0); SWRITE(1, 1); __syncthreads();
    SLOAD(0, 2);
    qkt64(pA0, pA1, K_lds, qr, r32, hi, m_reg); mla::decideSM_first(pA0, pA1, m_reg, alA); mla::scaleexp(pA0, pA1);
    int bq = 1, bp = 0, bw = 2;
#define STEP(PX0, PX1, ALX, PY0, PY1, ALY, t, LOADSTMT, WSLOT) do { \
        qkt64(PX0, PX1, K_lds + bq * SHM_K, qr, r32, hi, m_reg); mla::finishSM(PY0, PY1, ALY, l_reg, pa0, pa1, pa2, pa3); \
        LOADSTMT; MASK(PX0, PX1, t); mla::decideSM(PX0, PX1, m_reg, ALX); \
        mla::pv_sm<0>(o, vb0 + bp * SHM_V, pa0, pa1, pa2, pa3, PX0, PX1); \
        SWRITE(bw, WSLOT); RESC(ALX); __syncthreads(); \
        { const int t3 = bp; bp = bq; bq = bw; bw = t3; } } while (0)
    for (int t = 1; t + 1 < NT; t += 2) {
        STEP(pB0, pB1, alB, pA0, pA1, alA, t, SLOAD(1, t + 2), 0);
        STEP(pA0, pA1, alA, pB0, pB1, alB, t + 1, if (t + 3 < NT) SLOAD(0, t + 3), 1);
    }
#undef STEP
    qkt64(pB0, pB1, K_lds + bq * SHM_K, qr, r32, hi, m_reg);
    mla::finishSM(pA0, pA1, alA, l_reg, pa0, pa1, pa2, pa3);
    MASK(pB0, pB1, NT - 1); mla::decideSM(pB0, pB1, m_reg, alB);
    mla::pv_sm<0>(o, vb0 + bp * SHM_V, pa0, pa1, pa2, pa3, pB0, pB1);
    RESC(alB);
    mla::finishSM(pB0, pB1, alB, l_reg, pa0, pa1, pa2, pa3);
    mla::pv_all<0>(o, vb0 + bq * SHM_V, pa0, pa1, pa2, pa3);
    if (hi == 0) li_l[r32] = l_reg;
    asm volatile("s_waitcnt lgkmcnt(0)" ::: "memory");
    const int qtok0 = lat ? CTX + r * GW + (wid & 1) * 32 : wid * 32;
    bf16_t* Ow = Yb + (size_t)qtok0 * D + h * 64;
#pragma unroll
    for (int rr = 0; rr < 16; ++rr) { const int orow = mla::crow(rr, hi); const float rl = __builtin_amdgcn_rcpf(li_l[orow]);
#pragma unroll
        for (int d0 = 0; d0 < 2; ++d0) Ow[(size_t)orow * D + d0 * 32 + r32] = (bf16_t)f2bf(o[d0][rr] * rl); }
    __syncthreads();
#undef TOK0
#undef SLOAD
#undef SWRITE
#undef RESC
#undef MASK
}
#undef KSWZ
#undef SBAR
}
__device__ __forceinline__ void phase_a1b(const Params& p, const Ctx& c, int l, bool last) {
    const bf16_t* P = (const bf16_t*)(p.ws + WS_P); bf16_t* Y = (bf16_t*)(p.ws + WS_Y);
    LAS float* rp = (LAS float*)(c.lds + nab::RING + NWAVES * 256);
    const int n_units = 256 + (last ? 0 : 8);
    for (int u = c.bid; u < n_units; u += c.nb) {
        const int bh = u & 7, b = bh >> 2, h = bh & 3; const bool lat = u < 256;
        __syncthreads();
        if (lat) { const float* rpb = p.na_rpb + (size_t)((l * 4 + h) * 15) * 31;
            for (int i = c.tid; i < 15 * 32; i += NTHREADS) { const int dr = i >> 5, dc = i & 31; rp[i] = dc < 31 ? rpb[dr * 31 + dc] * 1.4426950408889634f : 0.f; } }
        __syncthreads();
        nab::unit(P + (size_t)(b * LT) * INP, h, lat, lat ? (u >> 3) * 4 : 0, rp, Y + (size_t)(b * LT) * D, c.lds, c.tid);
    }
}

template <int VAR = 0>
__device__ __forceinline__ void phase_a2(const Params& p, const Ctx& c, bool last) {
    const bf16_t* Q = (const bf16_t*)(p.ws + WS_Q); const bf16_t* Kb = (const bf16_t*)(p.ws + WS_K); const bf16_t* Vb = (const bf16_t*)(p.ws + WS_V);
    bf16_t* Y = (bf16_t*)(p.ws + WS_Y);
    const int n_units = 256 + (last ? 0 : 8);
    for (int u = c.bid; u < n_units; u += c.nb) {
        const int bh = u & 7, b = bh >> 2, h = bh & 3;
        const int t0 = u < 256 ? CTX + (u >> 3) * 256 : 0, seq = u < 256 ? LT : CTX;
        const size_t hb = (size_t)(b * 4 + h) * LT;
        mla::attn_unit<VAR>(Q + (hb + t0) * 96, Kb + hb * 96, Vb + hb * 64, Y + (size_t)(b * LT + t0) * D + 768 + h * 64, seq, c.lds, c.tid);
    }
}

__device__ __forceinline__ void phase_o2(const Params& p, const Ctx& c, int l, bool last) {
    LAS float* gt = (LAS float*)c.lds;
    LAS float* sh = gt + 3 * D;
    LAS float* sc = sh + 3 * D;
    LAS int* lcnt = (LAS int*)(sc + 3 * D);
    load_mods(p, c, l, 2, gt); load_mods(p, c, l, 3, sh); load_mods(p, c, l, 4, sc);
    if (c.tid < NE) lcnt[c.tid] = 0;
    LAS float* rwl = (LAS float*)(c.lds + 40960);
    for (int i = c.tid; i < D * 4; i += NTHREADS) { const int n = i >> 2, q4 = i & 3; *(LAS f32x4*)(rwl + ((n & 3) * 256 + (n >> 2)) * 20 + 4 * q4) = *(const f32x4*)(p.router_w + (size_t)n * 16 + 4 * q4); }
    LAS float* g1 = (LAS float*)(c.lds + 122880); LAS float* g2 = g1 + D;
    for (int i = c.tid; i < D; i += NTHREADS) { g1[i] = p.g_norm[(size_t)(l * 4 + 1) * D + i]; g2[i] = p.g_norm[(size_t)(l * 4 + 2) * D + i]; }
    __syncthreads();
    const bf16_t* YO = (const bf16_t*)(p.ws + WS_P); bf16_t* H = (bf16_t*)(p.ws + WS_H);
    int* RE = (int*)(p.ws + WS_RE); float* RW = (float*)(p.ws + WS_RW);
    const int nrow = last ? NB * S : M;
#define O2_ROW(i) (last ? ((i) / S) * LT + CTX + ((i) % S) : (i))
#define O2_LOAD(i) do { const int m_ = O2_ROW(i); const bf16_t* yr_ = YO + (size_t)m_ * D; \
        _Pragma("unroll") for (int j = 0; j < 4; ++j) ywn[j] = *(const u32x2*)((const char*)yr_ + (unsigned)(8 * (c.lane + 64 * j))); \
        if (l == 0) { const float* xr_ = xin_row(p, m_); _Pragma("unroll") for (int j = 0; j < 4; ++j) xvn[j] = *(const f32x4*)((const char*)xr_ + (unsigned)(16 * (c.lane + 64 * j))); } \
        else { const bf16_t* xr_ = xb_row(p, m_); _Pragma("unroll") for (int j = 0; j < 4; ++j) xbn[j] = *(const u32x2*)((const char*)xr_ + (unsigned)(8 * (c.lane + 64 * j))); } } while (0)
    u32x2 ywn[4], xbn[4]; f32x4 xvn[4];
    if (c.gw < nrow) O2_LOAD(c.gw);
#pragma unroll 1
    for (int ri = c.gw; ri < nrow; ri += c.ngw) {
        const int m = O2_ROW(ri);
        const int b = m / LT, t = m - b * LT, r = t < CTX ? 2 : b;
        f32x4 y[4], xv[4]; float ss = 0.f;
#pragma unroll
        for (int j = 0; j < 4; ++j) { y[j] = bf4(ywn[j]); xv[j] = (l == 0) ? xvn[j] : bf4(xbn[j]);
            ss += y[j].x * y[j].x + y[j].y * y[j].y + y[j].z * y[j].z + y[j].w * y[j].w; }
        if (ri + c.ngw < nrow) O2_LOAD(ri + c.ngw);
        const float rstd = rsqrtf(wave_sum(ss) * (1.f / D) + 1e-6f);
        float s2 = 0.f;
#pragma unroll
        for (int j = 0; j < 4; ++j) { const int n = 4 * (c.lane + 64 * j); const f32x4 gg = *(LAS const f32x4*)(g1 + n);
#pragma unroll
            for (int e = 0; e < 4; ++e) { xv[j][e] += gt[r * D + n + e] * (y[j][e] * rstd * gg[e]); s2 += xv[j][e] * xv[j][e]; }
            if (t < CTX) *(f32x4*)((char*)xc_row(p, m) + (unsigned)(n * 4)) = xv[j]; else *(u32x2*)((char*)xb_row(p, m) + (unsigned)(n * 2)) = pk4(xv[j]); }
        const float rstd2 = rsqrtf(wave_sum(s2) * (1.f / D) + 1e-6f);
        float lg[16];
#pragma unroll
        for (int e = 0; e < 16; ++e) lg[e] = 0.f;
#pragma unroll
        for (int j = 0; j < 4; ++j) { const int n = 4 * (c.lane + 64 * j); const f32x4 gg = *(LAS const f32x4*)(g2 + n);
            float o[4];
#pragma unroll
            for (int e = 0; e < 4; ++e) { o[e] = xv[j][e] * rstd2 * gg[e] * (1.f + sc[r * D + n + e]) + sh[r * D + n + e];
                LAS const f32x4* rw = (LAS const f32x4*)(rwl + (e * 256 + c.lane + 64 * j) * 20);
#pragma unroll
                for (int q4 = 0; q4 < 4; ++q4) { const f32x4 w = rw[q4]; lg[4 * q4] += o[e] * w.x; lg[4 * q4 + 1] += o[e] * w.y; lg[4 * q4 + 2] += o[e] * w.z; lg[4 * q4 + 3] += o[e] * w.w; } }
            u32x2 w; w.x = pk2(o[0], o[1]); w.y = pk2(o[2], o[3]);
            *(u32x2*)(H + (size_t)m * D + n) = w; }
        float aff[16], sel[16];
#pragma unroll
        for (int e = 0; e < 16; ++e) { aff[e] = sigmoidf_(wave_sum(lg[e])); sel[e] = aff[e] + p.router_b[e]; }
        float bv = -INFINITY, ba0 = 0.f, ba1 = 0.f; int bi0 = 0, bi1 = 0;
#pragma unroll
        for (int g = 0; g < 4; ++g) {
            float m1 = sel[4 * g], a1 = aff[4 * g]; int i0 = 0;
#pragma unroll
            for (int i = 1; i < 4; ++i) if (sel[4 * g + i] > m1) { m1 = sel[4 * g + i]; a1 = aff[4 * g + i]; i0 = i; }
            float m2 = -INFINITY, a2 = 0.f; int i1 = 0;
#pragma unroll
            for (int i = 0; i < 4; ++i) if (i != i0 && sel[4 * g + i] > m2) { m2 = sel[4 * g + i]; a2 = aff[4 * g + i]; i1 = i; }
            const float gs = m1 + m2;
            if (gs > bv) { bv = gs; bi0 = 4 * g + i0; bi1 = 4 * g + i1; ba0 = a1; ba1 = a2; }
        }
        if (c.lane == 0) {
            const float inv = 1.f / (ba0 + ba1);
            const int lp0 = __hip_atomic_fetch_add(lcnt + bi0, 1, __ATOMIC_RELAXED, __HIP_MEMORY_SCOPE_WORKGROUP);
            const int lp1 = __hip_atomic_fetch_add(lcnt + bi1, 1, __ATOMIC_RELAXED, __HIP_MEMORY_SCOPE_WORKGROUP);
            RE[2 * m] = bi0 + 16 * lp0; RE[2 * m + 1] = bi1 + 16 * lp1; RW[2 * m] = ba0 * inv; RW[2 * m + 1] = ba1 * inv;
        }
    }
    __syncthreads();
    if (c.tid < NE) ((int*)(p.ws + WS_PERM))[c.bid * NE + c.tid] = lcnt[c.tid];
}

__device__ __forceinline__ void phase_r2(const Params& p, const Ctx& c, int l, bool last) {
    LAS int* cntT = (LAS int*)c.lds;
    LAS int* map = (LAS int*)(c.lds + 131072); LAS int* nE = map + 768; LAS int* ebase = nE + NE;
    const int* BC = (const int*)(p.ws + WS_PERM); const int* RE = (const int*)(p.ws + WS_RE);
    for (int i = c.tid; i < c.nb * NE; i += NTHREADS) cntT[i] = BC[i];
    for (int i = c.tid; i < 768; i += NTHREADS) map[i] = -1;
    __syncthreads();
    if (c.tid < NE) { int acc = 0; for (int b2 = 0; b2 < c.nb; ++b2) { const int v = cntT[b2 * NE + c.tid]; cntT[b2 * NE + c.tid] = acc; acc += v; } nE[c.tid] = acc; }
    __syncthreads();
    if (c.tid < NE) { int acc = 0; for (int e = 0; e < c.tid; ++e) acc += (nE[e] + 255) >> 8; ebase[c.tid] = acc * 256;
        if (c.bid == 0) ((unsigned*)(p.ws + WS_CTL))[CW_CNT + l * 64 + c.tid] = (unsigned)nE[c.tid]; }
    __syncthreads();
    const int rt0 = c.bid >> 2, rt1 = (c.nb + c.bid) >> 2, rt2 = (2 * c.nb + c.bid) >> 2, ngw = c.nb * NWAVES;
    for (int m = c.tid; m < M; m += NTHREADS) {
        const int b = m / LT, t = m - b * LT;
        if (last && t < CTX) continue;
        const int blk = ((last ? b * S + (t - CTX) : m) % ngw) >> 3;
#pragma unroll
        for (int k = 0; k < 2; ++k) { const int info = RE[2 * m + k], e = info & 15, pos = ebase[e] + cntT[blk * NE + e] + (info >> 4), rt = pos >> 8;
            if (rt == rt0) map[pos & 255] = 2 * m + k; else if (rt == rt1) map[256 + (pos & 255)] = 2 * m + k; else if (rt == rt2) map[512 + (pos & 255)] = 2 * m + k; }
    }
    __syncthreads();
    if ((c.bid & 3) == 0) { int tot = 0; for (int e = 0; e < NE; ++e) tot += (nE[e] + 255) >> 8;
        int* S2P = (int*)(p.ws + WS_S2P);
        for (int i = c.tid; i < 768; i += NTHREADS) { const int rt = (i < 256) ? rt0 : (i < 512 ? rt1 : rt2); if (rt < tot) S2P[rt * 256 + (i & 255)] = map[i]; } }
    pg8::Gemm g{(const bf16_t*)(p.ws + WS_H), (const bf16_t*)(p.ws + WS_WGU) + (size_t)l * NE * 1024 * 1024, 0, 0, D};
    pg8::MoeOrderL S{nE, c.nb, c.bid};
    pg8::EpiSwiGLU E{(bf16_t*)(p.ws + WS_Q)};
    pg8::MoeGatherA GA{map};
    pg8::gemm_phase<pg8::EpiSwiGLU, pg8::MoeOrderL, true, true, pg8::MoeGatherA>(c.lds, g, S, E, c.tid, GA);
    if (l == 0) {
        int tot = 0; for (int e = 0; e < NE; ++e) tot += (nE[e] + 255) >> 8;
        const int nfull = min(max(4 * tot - 2 * c.nb, 0), c.nb);
        __syncthreads();
        if (c.bid >= nfull) convert_weights(p, c, 1, 0, CV_ALL, (c.bid - nfull) * NWAVES + c.wave, (c.nb - nfull) * NWAVES);
        else if (nfull == c.nb) convert_weights(p, c, 1, 0, CV_ALL, c.gw, c.ngw);
    }
}
__device__ __forceinline__ void phase_r3(const Params& p, const Ctx& c, int l) {
    pg8::Gemm g{(const bf16_t*)(p.ws + WS_Q), (const bf16_t*)(p.ws + WS_WD) + (size_t)l * NE * 1024 * 512, 0, 0, DE};
    pg8::MoeOrder S{(const unsigned*)(p.ws + WS_CTL) + CW_CNT + l * 64, c.nb, c.bid};
    pg8::EpiScatter E{(bf16_t*)(p.ws + WS_P), (const int*)(p.ws + WS_S2P), (const float*)(p.ws + WS_RW), M};
    pg8::gemm_phase<pg8::EpiScatter, pg8::MoeOrder, true, true>(c.lds, g, S, E, c.tid);
}

__device__ __forceinline__ void phase_f(const Params& p, const Ctx& c, int l, bool last) {
    LAS float* gt = (LAS float*)c.lds; LAS float* sh = gt + 3 * D; LAS float* sc = sh + 3 * D;
    load_mods(p, c, l, 5, gt);
    if (!last) { load_mods(p, c, l + 1, 0, sh); load_mods(p, c, l + 1, 1, sc); }
    __syncthreads();
    const float* g0n = p.g_norm + (size_t)((l + 1) * 4 + 0) * D; bf16_t* H = (bf16_t*)(p.ws + WS_H);
    const float* g3 = p.g_norm + (size_t)(l * 4 + 3) * D;
    const bf16_t* F0 = (const bf16_t*)(p.ws + WS_P); const bf16_t* F1 = F0 + (size_t)M * D;
    const int nrow = last ? NB * S : M;
#define F_ROW(i) (last ? ((i) / S) * LT + CTX + ((i) % S) : (i))
#define F_LOAD(i) do { const int m_ = F_ROW(i); const bool cx_ = (m_ % LT) < CTX; \
        _Pragma("unroll") for (int j = 0; j < 4; ++j) { const int n_ = 4 * (c.lane + 64 * j); fan[j] = *(const u32x2*)(F0 + (size_t)m_ * D + n_); fbn[j] = *(const u32x2*)(F1 + (size_t)m_ * D + n_); } \
        if (cx_) { const float* xr_ = xc_row(p, m_); _Pragma("unroll") for (int j = 0; j < 4; ++j) xn[j] = *(const f32x4*)(xr_ + 4 * (c.lane + 64 * j)); } \
        else { const bf16_t* xr_ = xb_row(p, m_); _Pragma("unroll") for (int j = 0; j < 4; ++j) xbn[j] = *(const u32x2*)(xr_ + 4 * (c.lane + 64 * j)); } } while (0)
    u32x2 fan[4], fbn[4], xbn[4]; f32x4 xn[4];
    if (c.gw < nrow) F_LOAD(c.gw);
#pragma unroll 1
    for (int ri = c.gw; ri < nrow; ri += c.ngw) {
        const int m = F_ROW(ri);
        const int b = m / LT, t = m - b * LT, r = t < CTX ? 2 : b;
        float f[16]; float ss = 0.f; f32x4 xc[4];
#pragma unroll
        for (int j = 0; j < 4; ++j) {
            const u32x2 a = fan[j], bb = fbn[j]; xc[j] = (t < CTX) ? xn[j] : bf4(xbn[j]);
            f[4 * j] = lo_bf(a.x) + lo_bf(bb.x); f[4 * j + 1] = hi_bf(a.x) + hi_bf(bb.x); f[4 * j + 2] = lo_bf(a.y) + lo_bf(bb.y); f[4 * j + 3] = hi_bf(a.y) + hi_bf(bb.y);
#pragma unroll
            for (int e = 0; e < 4; ++e) ss += f[4 * j + e] * f[4 * j + e]; }
        if (ri + c.ngw < nrow) F_LOAD(ri + c.ngw);
        const float rstd = rsqrtf(wave_sum(ss) * (1.f / D) + 1e-6f);
        float s2 = 0.f;
#pragma unroll
        for (int j = 0; j < 4; ++j) { const int n = 4 * (c.lane + 64 * j); const f32x4 gg = *(const f32x4*)(g3 + n); f32x4 xv = xc[j];
#pragma unroll
            for (int e = 0; e < 4; ++e) { xv[e] += gt[r * D + n + e] * (f[4 * j + e] * rstd * gg[e]); f[4 * j + e] = xv[e]; s2 += xv[e] * xv[e]; }
            if (last) *(f32x4*)(out_row(p, m) + n) = xv; else if (t < CTX) *(f32x4*)(xc_row(p, m) + n) = xv; else *(u32x2*)(xb_row(p, m) + n) = pk4(xv); }
        if (!last) {
            const float rstd2 = rsqrtf(wave_sum(s2) * (1.f / D) + 1e-6f);
#pragma unroll
            for (int j = 0; j < 4; ++j) { const int n = 4 * (c.lane + 64 * j); const f32x4 gg = *(const f32x4*)(g0n + n); float o[4];
#pragma unroll
                for (int e = 0; e < 4; ++e) o[e] = f[4 * j + e] * rstd2 * gg[e] * (1.f + sc[r * D + n + e]) + sh[r * D + n + e];
                u32x2 w; w.x = pk2(o[0], o[1]); w.y = pk2(o[2], o[3]);
                *(u32x2*)(H + (size_t)m * D + n) = w; }
        }
    }
}

__device__ __forceinline__ int lane_id() { int l; asm volatile("v_mbcnt_lo_u32_b32 %0, -1, 0\n\tv_mbcnt_hi_u32_b32 %0, -1, %0" : "=v"(l)); return l; }
__global__ void __launch_bounds__(NTHREADS, 2) fwd_kernel(Params p_unused) {
    extern __shared__ __attribute__((aligned(16))) unsigned char lds_raw[];
    const int wave = __builtin_amdgcn_readfirstlane((int)threadIdx.x >> 6);
    LAS unsigned char* lds = (LAS unsigned char*)lds_raw;
    volatile LAS unsigned* misc = (volatile LAS unsigned*)(lds + LDS_BYTES - 64);
#define TID() (wave * 64 + lane_id())
#define GP_(T, i) (T*)(__attribute__((address_space(1))) T*)kp_[i]
#define KARG(q) const __attribute__((address_space(4))) unsigned long long* kp_ = (const __attribute__((address_space(4))) unsigned long long*)__builtin_amdgcn_kernarg_segment_ptr(); asm volatile("" : "+s"(kp_)); \
    Params q; q.x = GP_(const float, 0); q.c = GP_(const float, 1); q.ctx = GP_(const float, 2); q.c_ctx = GP_(const float, 3); q.w_ada = GP_(const float, 4); q.b_ada = GP_(const float, 5); \
    q.g_norm = GP_(const float, 6); q.w_in = GP_(const float, 7); q.w_out = GP_(const float, 8); q.na_rpb = GP_(const float, 9); q.conv_w = GP_(const float, 10); q.conv_b = GP_(const float, 11); \
    q.lru_w_a = GP_(const float, 12); q.lru_b_a = GP_(const float, 13); q.lru_w_i = GP_(const float, 14); q.lru_b_i = GP_(const float, 15); q.lru_lam = GP_(const float, 16); q.mla_g_q = GP_(const float, 17); \
    q.mla_w_q = GP_(const float, 18); q.mla_g_kv = GP_(const float, 19); q.mla_w_kv = GP_(const float, 20); q.router_w = GP_(const float, 21); q.router_b = GP_(const float, 22); \
    q.exp_w_gate = GP_(const float, 23); q.exp_w_up = GP_(const float, 24); q.exp_w_down = GP_(const float, 25); q.out = GP_(float, 26); q.ws = GP_(unsigned char, 27); q.ph_lo = 0; q.ph_hi = 0
    { const int t = TID(); if (t < 16) misc[t] = 0u; }
    __syncthreads();
    { KARG(q); (void)xcd_barrier_post((unsigned*)(q.ws + WS_CTL) + CW_BAR, misc, TID()); }
#define GBAR() do { KARG(q); XcdBarrier b_; b_.bar = (unsigned*)(q.ws + WS_CTL) + CW_BAR; b_.x = xb_xcc_id(); b_.st = misc; xcd_barrier(b_, TID()); } while (0)
#ifndef PROBE_MASK
#define PROBE_MASK 0
#endif
#ifndef PROBE_VAR
#define PROBE_VAR 0
#endif
#ifndef PROBE_C1
#define PROBE_C1 0
#endif
#ifndef PROBE_C4
#define PROBE_C4 0
#endif
#define RP(bit, stmt) do { stmt; if ((PROBE_MASK >> (bit)) & 1) { GBAR(); stmt; } } while (0)
#define PH(call) do { KARG(q); Ctx cc; cc.lds = lds; cc.wave = wave; cc.lane = lane_id(); cc.tid = wave * 64 + cc.lane; \
        cc.bid = blockIdx.x; cc.nb = gridDim.x; cc.gw = cc.bid * NWAVES + wave; cc.ngw = cc.nb * NWAVES; call; } while (0)
    RP(0, PH(phase_pro(q, cc))); GBAR();
#define LAYER(l, last) do { \
        if ((l) == 0) { RP(1, PH(phase_n1(q, cc, l))); GBAR(); } \
        RP(2, PH(phase_g1(q, cc, l, false))); GBAR(); \
        RP(4, PH(phase_c2(q, cc, l))); GBAR(); \
        RP(6, PH(phase_c3(q, cc))); __syncthreads(); if (PROBE_C1) { PH(phase_c1<PROBE_C1>(q, cc, l)); GBAR(); } RP(3, PH(phase_c1(q, cc, l))); __syncthreads(); RP(5, PH(phase_a1b(q, cc, l, last))); GBAR(); \
        if (PROBE_C4) { PH(phase_c4<PROBE_C4>(q, cc, l, last)); GBAR(); } RP(7, PH(phase_c4(q, cc, l, last))); __syncthreads(); if (PROBE_VAR) { PH(phase_a2<PROBE_VAR>(q, cc, last)); GBAR(); } RP(8, PH(phase_a2(q, cc, last))); GBAR(); \
        RP(9, PH(phase_o1(q, cc, l, last))); GBAR(); \
        PH(phase_o2(q, cc, l, last)); if (((PROBE_MASK >> 13) & 1) && (l) == 0) { GBAR(); PH(phase_o2(q, cc, l, last)); } GBAR(); \
        RP(11, PH(phase_r2(q, cc, l, last))); GBAR(); \
        RP(12, PH(phase_r3(q, cc, l))); GBAR(); \
        PH(phase_f(q, cc, l, last)); } while (0)
    LAYER(0, false); GBAR();
    LAYER(1, true);
#undef LAYER
#undef PH
#undef RP
#undef GBAR
#undef TID
#undef KARG
#undef GP_
}

#ifdef DBG_PHASE
__global__ void __launch_bounds__(NTHREADS, 2) dbg_kernel(Params p, int l) {
    extern __shared__ __attribute__((aligned(16))) unsigned char lds_raw[];
    Ctx cc; cc.lds = (LAS unsigned char*)lds_raw; cc.wave = __builtin_amdgcn_readfirstlane((int)threadIdx.x >> 6); cc.lane = threadIdx.x & 63; cc.tid = threadIdx.x;
    cc.bid = blockIdx.x; cc.nb = gridDim.x; cc.gw = cc.bid * NWAVES + cc.wave; cc.ngw = cc.nb * NWAVES;
    DBG_PHASE;
}
#endif
#define MAIN_KERNEL fwd_kernel

extern "C" void kernel_launch(void* const* d_in, const int* in_sizes, int n_in, void* d_out, int out_size, void* d_ws, size_t ws_size, hipStream_t stream) {
    static int grid = 0;
    if (grid == 0) {
        if (n_in != 26 || out_size != NB * S * D || ws_size < WS_END) { fprintf(stderr, "kernel_launch: unexpected shapes (n_in %d out %d ws %zu)\n", n_in, out_size, ws_size); grid = -1; return; }
        int dev = 0, cus = 0, per_cu = 0;
        hipGetDevice(&dev);
        hipDeviceGetAttribute(&cus, hipDeviceAttributeMultiprocessorCount, dev);
        hipFuncSetAttribute((const void*)fwd_kernel, hipFuncAttributeMaxDynamicSharedMemorySize, LDS_BYTES);
        hipOccupancyMaxActiveBlocksPerMultiprocessor(&per_cu, (const void*)MAIN_KERNEL, NTHREADS, LDS_BYTES);
        (void)hipGetLastError();
        if (per_cu < 1) { fprintf(stderr, "kernel_launch: occupancy query says %d blocks per CU\n", per_cu); grid = -1; return; }
        if (cus < 256) { fprintf(stderr, "kernel_launch: this build's unit orders assume a 256-workgroup grid (one per CU of a 256-CU device); the device reports %d CUs\n", cus); grid = -1; return; }
        grid = 256;
    }
    if (grid < 0) return;
    hipMemsetAsync((char*)d_ws + WS_CTL, 0, CTL_BYTES, stream);
    Params p{};
    const float** pp = (const float**)&p;
    for (int i = 0; i < 26; ++i) pp[i] = (const float*)d_in[i];
    p.out = (float*)d_out; p.ws = (unsigned char*)d_ws;
    void* args[] = {&p};
    hipLaunchCooperativeKernel((const void*)fwd_kernel, dim3(grid), dim3(NTHREADS), args, LDS_BYTES, stream);
}
```

```cpp
#include <hip/hip_runtime.h>
#include <cstdio>
#include <cstdint>


#define LAS __attribute__((address_space(3)))
typedef unsigned short bf16_t;
typedef short bf16x8 __attribute__((ext_vector_type(8)));
typedef float f32x4 __attribute__((ext_vector_type(4)));
typedef float f32x2 __attribute__((ext_vector_type(2)));
typedef unsigned u32x4 __attribute__((ext_vector_type(4)));
typedef unsigned u32x2 __attribute__((ext_vector_type(2)));

constexpr int D = 1024, NB = 2, S = 8192, CTX = 256, LT = CTX + S, M = NB * LT;
constexpr int GW = 64;
constexpr int INW = 2208, INP = 2304;
constexpr int OFF_QA = 0, OFF_KA = 256, OFF_VA = 512, OFF_U = 768, OFF_G = 1280, OFF_CQ = 1792, OFF_CKV = 2048, OFF_KR = 2176;
constexpr int LRU_W = 512;
constexpr int CH = 32, NCH = LT / CH, NCH_CTX = CTX / CH;
constexpr int NE = 16, DE = 512;
constexpr int NTHREADS = 512, NWAVES = 8;
constexpr int LDS_BYTES = 147456;

constexpr size_t MiB = 1u << 20;
constexpr size_t WS_CTL = 0, CTL_BYTES = 1 * MiB;
constexpr size_t WS_MODP = 1 * MiB;
constexpr size_t WS_WIN = 4 * MiB;
constexpr size_t WS_WOUT = 13 * MiB;
constexpr size_t WS_WGU = 17 * MiB;
constexpr size_t WS_WD = 81 * MiB;
constexpr size_t WS_XC = 113 * MiB;
constexpr size_t WS_RE = 115 * MiB;
constexpr size_t WS_RW = WS_RE + 256 * 1024;
constexpr size_t WS_PERM = WS_RW + 256 * 1024;
constexpr size_t WS_S2P = 117 * MiB;
constexpr size_t WS_LRUW = 117 * MiB + 512 * 1024;
constexpr size_t WS_WQT = 118 * MiB;
constexpr size_t WS_WKVT = 118 * MiB + 512 * 1024;
constexpr size_t WS_AGG = 119 * MiB;
constexpr size_t WS_CARRY = 1 * MiB + 256 * 1024;
constexpr size_t WS_XB = 301 * MiB;
constexpr size_t WS_H = 125 * MiB;
constexpr size_t WS_P = 158 * MiB;
constexpr size_t WS_Q = 233 * MiB;
constexpr size_t WS_K = 246 * MiB;
constexpr size_t WS_V = 259 * MiB;
constexpr size_t WS_Y = 268 * MiB;
constexpr size_t WS_END = 333 * MiB;
constexpr int CW_CNT = 64;
constexpr int CW_BAR = 4096;
#ifndef R3_KA0
#define R3_KA0 1
#endif
constexpr int CW_DONE = 16384;

__device__ __forceinline__ float bf2f(bf16_t v) { return __uint_as_float(((unsigned)v) << 16); }
typedef __bf16 bf16x2_hw __attribute__((ext_vector_type(2)));
typedef float f32x2_hw __attribute__((ext_vector_type(2)));
__device__ __forceinline__ unsigned pk2(float lo, float hi) { const f32x2_hw v = {lo, hi}; return __builtin_bit_cast(unsigned, __builtin_convertvector(v, bf16x2_hw)); }
__device__ __forceinline__ unsigned f2bf(float f) { return pk2(f, 0.f) & 0xffffu; }
__device__ __forceinline__ float lo_bf(unsigned w) { return __uint_as_float(w << 16); }
__device__ __forceinline__ float hi_bf(unsigned w) { return __uint_as_float(w & 0xffff0000u); }
template <int CTRL> __device__ __forceinline__ float dpp_f(float v) { return __builtin_bit_cast(float, __builtin_amdgcn_update_dpp(0, __builtin_bit_cast(int, v), CTRL, 0xF, 0xF, true)); }
__device__ __forceinline__ float row16_sum(float v) {
    v += dpp_f<0xB1>(v);
    v += dpp_f<0x4E>(v);
    v += dpp_f<0x141>(v);
    v += dpp_f<0x140>(v);
    return v;
}
__device__ __forceinline__ float wave_sum(float v) {
    v = row16_sum(v);
    { auto r = __builtin_amdgcn_permlane16_swap(__float_as_uint(v), __float_as_uint(v), false, false); v = __uint_as_float(r[0]) + __uint_as_float(r[1]); }
    { auto r = __builtin_amdgcn_permlane32_swap(__float_as_uint(v), __float_as_uint(v), false, false); v = __uint_as_float(r[0]) + __uint_as_float(r[1]); }
    return v;
}
__device__ __forceinline__ float sigmoidf_(float x) { return __builtin_amdgcn_rcpf(1.f + __builtin_amdgcn_exp2f(-1.4426950408889634f * x)); }
__device__ __forceinline__ float siluf_(float x) { return x * sigmoidf_(x); }
__device__ __forceinline__ float gelu_tanh(float x) { return x * sigmoidf_(1.5957691216057308f * (x + 0.044715f * x * x * x)); }

struct Params {
    const float *x, *c, *ctx, *c_ctx, *w_ada, *b_ada, *g_norm, *w_in, *w_out, *na_rpb, *conv_w, *conv_b,
        *lru_w_a, *lru_b_a, *lru_w_i, *lru_b_i, *lru_lam, *mla_g_q, *mla_w_q, *mla_g_kv, *mla_w_kv,
        *router_w, *router_b, *exp_w_gate, *exp_w_up, *exp_w_down;
    float* out; unsigned char* ws; int ph_lo, ph_hi;
};

struct Ctx {
    int tid, lane, wave, bid, nb, gw, ngw;
    LAS unsigned char* lds;
};

__device__ __forceinline__ const float* xin_row(const Params& p, int m) {
    const int b = m / LT, t = m - b * LT;
    return t < CTX ? p.ctx + (size_t)(b * CTX + t) * D : p.x + (size_t)(b * S + t - CTX) * D;
}
__device__ __forceinline__ float* xc_row(const Params& p, int m) { const int b = m / LT, t = m - b * LT; return (float*)(p.ws + WS_XC) + (size_t)(b * CTX + t) * D; }
__device__ __forceinline__ bf16_t* xb_row(const Params& p, int m) { const int b = m / LT, t = m - b * LT; return (bf16_t*)(p.ws + WS_XB) + (size_t)(b * S + t - CTX) * D; }
__device__ __forceinline__ float* out_row(const Params& p, int m) { const int b = m / LT, t = m - b * LT; return p.out + (size_t)(b * S + t - CTX) * D; }
__device__ __forceinline__ f32x4 bf4(u32x2 w) { return (f32x4){lo_bf(w.x), hi_bf(w.x), lo_bf(w.y), hi_bf(w.y)}; }
__device__ __forceinline__ u32x2 pk4(f32x4 v) { u32x2 w; w.x = pk2(v.x, v.y); w.y = pk2(v.z, v.w); return w; }
__device__ __forceinline__ void load_mods(const Params& p, const Ctx& c, int l, int j, LAS float* dst) {
    const float* mp = (const float*)(p.ws + WS_MODP);
    for (int idx = c.tid; idx < 3 * D; idx += NTHREADS) {
        const int r = idx >> 10, n = idx & 1023;
        dst[idx] = mp[(size_t)(l * 3 + r) * 6144 + j * D + n];
    }
}

#define XB_TMO      128
#define XB_XCNT(j)  (256  + 64 * (j))
#define XB_XSUB(j)  (1280 + 64 * (j))
#define XB_XGEN(j)  (2304 + 64 * (j))
#define XB_TOP      3328
#define XB_TOPGEN   3392
#define XCD_BAR_WORDS 3456
#define XB_SPIN_CAP (1u << 18)
__device__ __forceinline__ unsigned xb_ld(unsigned* p)              { return __hip_atomic_load(p, __ATOMIC_RELAXED, __HIP_MEMORY_SCOPE_AGENT); }
__device__ __forceinline__ unsigned xb_add(unsigned* p, unsigned v) { return __hip_atomic_fetch_add(p, v, __ATOMIC_RELAXED, __HIP_MEMORY_SCOPE_AGENT); }
__device__ __forceinline__ unsigned xb_xcc_id() { return (unsigned)__builtin_amdgcn_s_getreg((3 << 11) | 20) & 0xFu; }
#define XB_SPIN(cond, bar) do { unsigned _sp = 0; while (cond) { __builtin_amdgcn_s_sleep(1); \
    if ((++_sp & 255u) == 0u) { if (xb_ld(&(bar)[XB_TMO])) break; if (_sp > XB_SPIN_CAP) { atomicAdd(&(bar)[XB_TMO], 1u); break; } } } } while (0)
struct XcdBarrier { unsigned* bar; unsigned x; volatile LAS unsigned* st; };
__device__ __forceinline__ XcdBarrier xcd_barrier_post(unsigned* bar, volatile LAS unsigned* st, int tid) {
    XcdBarrier b; b.bar = bar; b.x = xb_xcc_id(); b.st = st;
    if (tid == 0) (void)xb_add(&bar[XB_XCNT(b.x)], 1u);
    return b;
}
__device__ __forceinline__ void xcd_barrier_complete(unsigned* bar, unsigned x, unsigned& nloc, unsigned& nx) {
    const unsigned G = gridDim.x * gridDim.y * gridDim.z;
    unsigned sum, cnt, mine, sp = 0u;
    for (;;) {
        sum = 0u; cnt = 0u; mine = 0u;
#pragma unroll
        for (unsigned j = 0; j < 16; ++j) { const unsigned c = xb_ld(&bar[XB_XCNT(j)]); sum += c; cnt += (c > 0u) ? 1u : 0u; mine = (j == x) ? c : mine; }
        if (sum == G) break;
        __builtin_amdgcn_s_sleep(1);
        if ((++sp & 255u) == 0u) { if (xb_ld(&bar[XB_TMO])) break; if (sp > XB_SPIN_CAP) { atomicAdd(&bar[XB_TMO], 1u); break; } }
    }
    nloc = mine > 0u ? mine : 1u; nx = cnt > 0u ? cnt : 1u;
}
__device__ __forceinline__ void xcd_barrier(const XcdBarrier& b, int tid) {
    asm volatile("s_waitcnt vmcnt(0)" ::: "memory");
    __syncthreads();
    if (tid == 0) {
        unsigned* bar = b.bar;
        __builtin_amdgcn_s_waitcnt(0);
        unsigned nloc = b.st[0], nx = b.st[1];
        if (nloc == 0u) { xcd_barrier_complete(bar, b.x, nloc, nx); b.st[0] = nloc; b.st[1] = nx; }
        const unsigned old = xb_add(&bar[XB_XSUB(b.x)], 1u);
        const unsigned gen = old / nloc;
        if (old + 1u == (gen + 1u) * nloc) {
            __builtin_amdgcn_fence(__ATOMIC_RELEASE, "agent");
            asm volatile("s_waitcnt vmcnt(0)" ::: "memory");
            const unsigned og = xb_add(&bar[XB_TOP], 1u);
            const unsigned tg = og / nx;
            if (og + 1u == (tg + 1u) * nx) xb_add(&bar[XB_TOPGEN], 1u);
            else XB_SPIN(xb_ld(&bar[XB_TOPGEN]) == tg, bar);
            __builtin_amdgcn_fence(__ATOMIC_ACQUIRE, "agent");
            xb_add(&bar[XB_XGEN(b.x)], 1u);
            asm volatile("s_waitcnt vmcnt(0)" ::: "memory");
        } else {
            XB_SPIN(xb_ld(&bar[XB_XGEN(b.x)]) == gen, bar);
            __builtin_amdgcn_fence(__ATOMIC_ACQUIRE, "agent");
            asm volatile("s_waitcnt vmcnt(0)" ::: "memory");
        }
    }
    __syncthreads();
}


namespace pg8 {
#define PG8_LAS __attribute__((address_space(3)))
typedef unsigned short bf16_t;
typedef short bf16x8 __attribute__((ext_vector_type(8)));
typedef float f32x4 __attribute__((ext_vector_type(4)));
typedef unsigned u32x4 __attribute__((ext_vector_type(4)));
constexpr int BM = 256, BK = 64, HALF = 128, HTB = HALF * BK * 2  , STAGE_BYTES = 8 * HTB, NXCD = 8, WGM = 8;

__host__ __device__ __forceinline__ int lds_byte(int r, int c) { const int st = (r >> 4) * 2 + (c >> 5), rr = r & 15, cc = c & 31, ob = rr * 64 + cc * 2; return st * 1024 + (ob ^ (((ob >> 9) & 1) << 5)); }
__host__ __device__ __forceinline__ void stage_rc(int b, int& R, int& C) { const int st = b / 1024, sb = b % 1024, swz = sb ^ (((sb >> 9) & 1) << 5); R = (st >> 1) * 16 + swz / 64; C = (st & 1) * 32 + (swz % 64) / 2; }
__host__ __device__ __forceinline__ int perm32(int rho) { const int n = rho >> 4, i = rho & 15; return 8 * (i >> 2) + 4 * n + (i & 3); }

struct Unit { int pm, pn, aux0, aux1; };
struct Gemm { const bf16_t* A; const bf16_t* Bt; int M, N, K; };
__device__ __forceinline__ unsigned cvt_pk_bf16(float lo, float hi) { return ::pk2(lo, hi); }
typedef float f32x2 __attribute__((ext_vector_type(2)));
__device__ __forceinline__ f32x2 gelu_pk(f32x2 v) {
    const f32x2 av = __builtin_elementwise_abs(v), d = av * 0.2316418882f + 1.0f;
    f32x2 t; t.x = __builtin_amdgcn_rcpf(d.x); t.y = __builtin_amdgcn_rcpf(d.y);
    f32x2 q = t * 0.5307027145f + (-0.7265760135f); q = q * t + 0.7107068705f; q = q * t + (-0.142248368f); q = q * t + 0.127414796f; q = q * t;
    const f32x2 s = (v * v) * (-0.72134752044f);
    f32x2 e; e.x = __builtin_amdgcn_exp2f(s.x); e.y = __builtin_amdgcn_exp2f(s.y);
    const f32x2 m = v * (q * e), r = v - m;
    f32x2 o; o.x = v.x < 0.f ? m.x : r.x; o.y = v.y < 0.f ? m.y : r.y; return o;
}

template <int ACT  > struct EpiBf16 {
    static constexpr bool PERM = true, AFTER_DRAIN = false; static_assert(ACT == 0 || ACT == 1, "EpiBf16: ACT is 0 (none) or 1 (gelu_pk)");
    bf16_t* O; int ldc; const float* bias; int split_cols; size_t split_stride; float scale0;
    __device__ __forceinline__ void operator()(const f32x4 (&acc)[2][2][4][2], const Unit& u, int wr, int wc, int fr, int fq) const {
        const int row0 = u.pm * BM + wr * 64 + fr; int colt = u.pn * BM; bf16_t* base = O;
        float sc = 1.f; if (split_cols) { const int t = colt / split_cols; base += (size_t)t * split_stride; colt -= t * split_cols; if (t == 0) sc = scale0; }
        const int col0 = colt + wc * 32 + 8 * fq, bcol0 = u.pn * BM + wc * 32 + 8 * fq;
        f32x4 bv[2][2];
#pragma unroll
        for (int bj = 0; bj < 2; ++bj)
#pragma unroll
            for (int n = 0; n < 2; ++n) bv[bj][n] = bias ? *(const f32x4*)(bias + bcol0 + bj * HALF + 4 * n) : (f32x4){0.f, 0.f, 0.f, 0.f};
#pragma unroll
        for (int ai = 0; ai < 2; ++ai)
#pragma unroll
            for (int m = 0; m < 4; ++m) { bf16_t* rowp = base + (size_t)(row0 + ai * HALF + m * 16) * ldc + col0;
#pragma unroll
                for (int bj = 0; bj < 2; ++bj) { f32x4 v0 = acc[ai][bj][m][0] + bv[bj][0], v1 = acc[ai][bj][m][1] + bv[bj][1];
                    if (ACT == 1) { f32x2 a = gelu_pk((f32x2){v0[0], v0[1]}), b = gelu_pk((f32x2){v0[2], v0[3]}), c = gelu_pk((f32x2){v1[0], v1[1]}), d = gelu_pk((f32x2){v1[2], v1[3]});
                        v0 = (f32x4){a.x, a.y, b.x, b.y}; v1 = (f32x4){c.x, c.y, d.x, d.y}; }
                    v0 = v0 * sc; v1 = v1 * sc; u32x4 w; w.x = cvt_pk_bf16(v0[0], v0[1]); w.y = cvt_pk_bf16(v0[2], v0[3]); w.z = cvt_pk_bf16(v1[0], v1[1]); w.w = cvt_pk_bf16(v1[2], v1[3]);
                    *(u32x4*)(rowp + bj * HALF) = w; } }
    }
};

struct StaticOrder {
    int nM, nN, nwg, G, c;
    __host__ __device__ void init(int M, int N, int G_, int c_) { nM = M / BM; nN = N / BM; nwg = nM * nN; G = G_; c = c_; }
    __host__ __device__ bool next(int i, Unit& u) const {
        const long L = (long)i * G + c; if (L >= nwg) return false;
        int wgid = (int)L; { const int q = nwg / NXCD, r = nwg % NXCD, xcd = wgid % NXCD, off = wgid / NXCD; wgid = (xcd < r ? xcd * (q + 1) : r * (q + 1) + (xcd - r) * q) + off; }
        const int nig = WGM * nN, gid = wgid / nig, fm = gid * WGM, gsz = (nM - fm) < WGM ? (nM - fm) : WGM;
        u.pm = fm + ((wgid % nig) % gsz); u.pn = (wgid % nig) / gsz; return true;
    }
    static constexpr int A_AUX = 0;
    __device__ __forceinline__ void a_ready(const Unit&) const {}
    __device__ __forceinline__ void done(const Unit&) const {}
};
struct EpiF32 {
    static constexpr bool PERM = false, AFTER_DRAIN = false;
    float* O; int ldc;
    __device__ __forceinline__ void operator()(const f32x4 (&acc)[2][2][4][2], const Unit& u, int wr, int wc, int fr, int fq) const {
        const int row0 = u.pm * BM + wr * 64 + fr, col0 = u.pn * BM + wc * 32 + 4 * fq;
#pragma unroll
        for (int ai = 0; ai < 2; ++ai)
#pragma unroll
            for (int m = 0; m < 4; ++m) { float* rowp = O + (size_t)(row0 + ai * HALF + m * 16) * ldc + col0;
#pragma unroll
                for (int bj = 0; bj < 2; ++bj)
#pragma unroll
                    for (int n = 0; n < 2; ++n) *(f32x4*)(rowp + bj * HALF + n * 16) = acc[ai][bj][m][n]; }
    }
};
struct EpiSwiGLU {
    static constexpr bool PERM = true, AFTER_DRAIN = false;
    bf16_t* O;
    __device__ __forceinline__ void operator()(const f32x4 (&acc)[2][2][4][2], const Unit& u, int wr, int wc, int fr, int fq) const {
        const int row0 = u.pm * BM + wr * 64 + fr, col0 = (u.pn & 3) * 128 + wc * 32 + 8 * fq;
        const __amdgpu_buffer_rsrc_t rs = __builtin_amdgcn_make_buffer_rsrc(O, 0, 0x7fffffff, 0x00020000);
#pragma unroll
        for (int ai = 0; ai < 2; ++ai)
#pragma unroll
            for (int m = 0; m < 4; ++m) {
                float v[8];
#pragma unroll
                for (int n = 0; n < 2; ++n)
#pragma unroll
                    for (int e = 0; e < 4; ++e) { const float g = acc[ai][0][m][n][e]; v[4 * n + e] = g * __builtin_amdgcn_rcpf(1.f + __builtin_amdgcn_exp2f(-1.4426950408889634f * g)) * acc[ai][1][m][n][e]; }
                u32x4 w; w.x = cvt_pk_bf16(v[0], v[1]); w.y = cvt_pk_bf16(v[2], v[3]); w.z = cvt_pk_bf16(v[4], v[5]); w.w = cvt_pk_bf16(v[6], v[7]);
                __builtin_amdgcn_raw_buffer_store_b128(w, rs, (unsigned)(((row0 + ai * HALF + m * 16) * 512 + col0) * 2), 0,   16); }
    }
};
struct EpiScatter {
    static constexpr bool PERM = true, AFTER_DRAIN = false;
    bf16_t* F; const int* slot2pk; const float* rw; int Mtok;
    __device__ __forceinline__ void operator()(const f32x4 (&acc)[2][2][4][2], const Unit& u, int wr, int wc, int fr, int fq) const {
        const int row0 = u.pm * BM + wr * 64 + fr, col0 = (u.pn & 3) * BM + wc * 32 + 8 * fq;
#pragma unroll
        for (int ai = 0; ai < 2; ++ai)
#pragma unroll
            for (int m = 0; m < 4; ++m) {
                const int pk = __hip_atomic_load(slot2pk + row0 + ai * HALF + m * 16, __ATOMIC_RELAXED, __HIP_MEMORY_SCOPE_AGENT);
                if (pk >= 0) { const float wgt = rw[pk]; bf16_t* rowp = F + ((size_t)(pk & 1) * Mtok + (pk >> 1)) * 1024 + col0;
#pragma unroll
                    for (int bj = 0; bj < 2; ++bj) { const f32x4 v0 = acc[ai][bj][m][0] * wgt, v1 = acc[ai][bj][m][1] * wgt;
                        u32x4 w; w.x = cvt_pk_bf16(v0[0], v0[1]); w.y = cvt_pk_bf16(v0[2], v0[3]); w.z = cvt_pk_bf16(v1[0], v1[1]); w.w = cvt_pk_bf16(v1[2], v1[3]);
                        *(u32x4*)(rowp + bj * HALF) = w; } } }
    }
};
struct LatentOrder4 {
    int G, c;
    __device__ bool next(int i, Unit& u) const {
        const int L = i * G + c; if (L >= 256) return false;
        const int x = L & 7, j = L >> 3, pi = x * 8 + (j >> 2);
        u.pm = pi + 1 + (pi >= 32 ? 1 : 0); u.pn = j & 3; u.aux0 = 0; u.aux1 = 0; return true;
    }
    static constexpr int A_AUX = 0;
    __device__ __forceinline__ void a_ready(const Unit&) const {}
    __device__ __forceinline__ void done(const Unit&) const {}
};
struct G1Order {
    int G, c; bool deferred;
    __device__ bool next(int i, Unit& u) const {
        u.aux0 = 0; u.aux1 = 0;
        if (deferred) { if (i > 0 || c >= 82) return false; if (c < 66) { u.pm = c; u.pn = 8; } else { u.pm = c - 66; u.pn = 0; } return true; }
        const int L = i * G + c; if (L >= 512) return false;
        const int n = (L & ~255) + (L & 7) * 32 + ((L & 255) >> 3);
        if (n < 462) { u.pm = n / 7; u.pn = 1 + n % 7; } else { u.pm = 16 + (n - 462); u.pn = 0; }
        return true;
    }
    static constexpr int A_AUX = 0;
    __device__ __forceinline__ void a_ready(const Unit&) const {}
    __device__ __forceinline__ void done(const Unit&) const {}
};
struct MoeGatherA {
    static constexpr bool GATHER = true; const PG8_LAS int* map;
    __device__ __forceinline__ int row(int ui, int r) const { const int pk = map[ui * 256 + r]; return pk >= 0 ? (pk >> 1) : 0; }
};
struct MoeOrderL {
    const PG8_LAS int* cnt; int G, c;
    __device__ bool next(int i, Unit& u) const {
        const int L = i * G + c, rt = L >> 2;
        int acc = 0, e = -1;
#pragma unroll
        for (int j = 0; j < 16; ++j) { const int nt = (cnt[j] + 255) >> 8; if (e < 0 && rt < acc + nt) e = j; acc += nt; }
        if (e < 0) return false;
        u.pm = rt; u.pn = e * 4 + (L & 3); u.aux0 = e; u.aux1 = 0; return true;
    }
    static constexpr int A_AUX = 0;
    __device__ __forceinline__ void a_ready(const Unit&) const {}
    __device__ __forceinline__ void done(const Unit&) const {}
};
struct MoeOrderLP {
    const PG8_LAS int* cnt; int G, c; unsigned* dcnt;
    __device__ bool next(int i, Unit& u) const {
        const int L = i * G + c, rt = L >> 2;
        int acc = 0, e = -1;
#pragma unroll
        for (int j = 0; j < 16; ++j) { const int nt = (cnt[j] + 255) >> 8; if (e < 0 && rt < acc + nt) e = j; acc += nt; }
        if (e < 0) return false;
        u.pm = rt; u.pn = e * 4 + (L & 3); u.aux0 = e; u.aux1 = 0; return true;
    }
    static constexpr int A_AUX = 0;
    __device__ __forceinline__ void a_ready(const Unit&) const {}
    __device__ __forceinline__ void done(const Unit& u) const {
        asm volatile("s_waitcnt vmcnt(0)" ::: "memory");
        if (__builtin_amdgcn_mbcnt_hi(~0u, __builtin_amdgcn_mbcnt_lo(~0u, 0u)) == 0u) (void)::xb_add(dcnt + u.pm * 16, 1u);
    }
};
struct MoeOrderC {
    const PG8_LAS int* cnt; int G, c, nA, ka; unsigned* dcnt;
    __device__ bool next(int i, Unit& u) const {
        int tot = 0;
#pragma unroll
        for (int j = 0; j < 16; ++j) tot += (cnt[j] + 255) >> 8;
        const int U = 4 * tot; int L;
        if (nA > 0) { if (c < nA) { if (i >= ka) return false; L = U - ka * nA + i * nA + c; } else { L = i * (G - nA) + (c - nA); if (L >= U - ka * nA) return false; } }
        else L = i * G + c;
        const int rt = L >> 2;
        int acc = 0, e = -1;
#pragma unroll
        for (int j = 0; j < 16; ++j) { const int nt = (cnt[j] + 255) >> 8; if (e < 0 && rt < acc + nt) e = j; acc += nt; }
        if (e < 0) return false;
        u.pm = rt; u.pn = e * 4 + (L & 3); u.aux0 = e; u.aux1 = 0; return true;
    }
    static constexpr int A_AUX = 0;
    __device__ __forceinline__ void a_ready(const Unit& u) const {
        if (__builtin_amdgcn_mbcnt_hi(~0u, __builtin_amdgcn_mbcnt_lo(~0u, 0u)) == 0u) {
            unsigned sp = 0; while (::xb_ld(dcnt + u.pm * 16) < 32u) { __builtin_amdgcn_s_sleep(2); if (++sp > (1u << 20)) break; } }
        asm volatile("" ::: "memory");
    }
    __device__ __forceinline__ void done(const Unit&) const {}
};
struct MoeOrder {
    const unsigned* cnt; int G, c;
    __device__ bool next(int i, Unit& u) const {
        const int L = i * G + c, rt = L >> 2;
        int acc = 0, e = -1;
#pragma unroll
        for (int j = 0; j < 16; ++j) { const int nt = ((int)cnt[j] + 255) >> 8; if (e < 0 && rt < acc + nt) e = j; acc += nt; }
        if (e < 0) return false;
        u.pm = rt; u.pn = e * 4 + (L & 3); u.aux0 = e; u.aux1 = 0; return true;
    }
    static constexpr int A_AUX = 0;
    __device__ __forceinline__ void a_ready(const Unit&) const {}
    __device__ __forceinline__ void done(const Unit&) const {}
};
struct DenseA { static constexpr bool GATHER = false; __device__ __forceinline__ int row(int, int) const { return 0; } };
template <class Epi, class Sched, bool ALIGN_EPI = false, bool SP2 = false, class AG = DenseA>
__device__ __forceinline__ void gemm_phase(PG8_LAS unsigned char* lds, const Gemm g, const Sched& S, const Epi& E, const int tid, const AG& G = AG()) {
    static_assert(!AG::GATHER || SP2, "the gather policy is wired into the SP2 loop only");
    const int wid = __builtin_amdgcn_readfirstlane(tid >> 6), lane = tid & 63, wr = wid >> 2, wc = wid & 3, fr = lane & 15, fq = lane >> 4;
    const int K = g.K, nt = K / BK;
    unsigned voffA[2], voffB[2]; int RA[2], CA[2];
#pragma unroll
    for (int i = 0; i < 2; ++i) { int R, C; stage_rc(tid * 16 + i * 8192, R, C); const int Rb = Epi::PERM ? ((R & ~31) + perm32(R & 31)) : R;
        voffA[i] = (unsigned)(R * K + C) * 2u; voffB[i] = (unsigned)(Rb * K + C) * 2u; RA[i] = R; CA[i] = C; }
    const size_t kstep = (size_t)(BK * 2);
    const size_t hstep = (size_t)HALF * K * 2;
    const size_t tstep = 2 * hstep;
    const unsigned ldsw = (unsigned)wid * 1024u;
    const int aoff = lds_byte(wr * 64 + fr, fq * 8), boff = lds_byte(wc * 32 + fr, fq * 8);
#define PG8_SA(b, h) (((b) * 2 + (h)) * HTB)
#define PG8_SB(b, h) ((4 + (b) * 2 + (h)) * HTB)
#define PG8_STAGE(bufoff, gbase, voff) do { _Pragma("unroll") for (int _i = 0; _i < 2; ++_i) \
        __builtin_amdgcn_global_load_lds((const unsigned*)((const char*)(gbase) + (voff)[_i]), (PG8_LAS unsigned*)(lds + (bufoff) + ldsw + _i * 8192), 16, 0, 0); } while (0)
#define PG8_STAGEA(bufoff, gbase, voff) do { _Pragma("unroll") for (int _i = 0; _i < 2; ++_i) \
        __builtin_amdgcn_global_load_lds((const unsigned*)((const char*)(gbase) + (voff)[_i]), (PG8_LAS unsigned*)(lds + (bufoff) + ldsw + _i * 8192), 16, 0, Sched::A_AUX); } while (0)
#define PG8_LDA(dst, b, h) do { _Pragma("unroll") for (int m = 0; m < 4; ++m) _Pragma("unroll") for (int k = 0; k < 2; ++k) dst[m][k] = *(const PG8_LAS bf16x8*)(lds + PG8_SA(b, h) + aoff + m * 2048 + k * 1024); } while (0)
#define PG8_LDB(dst, b, h) do { _Pragma("unroll") for (int n = 0; n < 2; ++n) _Pragma("unroll") for (int k = 0; k < 2; ++k) dst[n][k] = *(const PG8_LAS bf16x8*)(lds + PG8_SB(b, h) + boff + n * 2048 + k * 1024); } while (0)
#define PG8_MMA(ai, bj, At, Bt) do { __builtin_amdgcn_s_setprio(1); _Pragma("unroll") for (int m = 0; m < 4; ++m) _Pragma("unroll") for (int n = 0; n < 2; ++n) _Pragma("unroll") for (int k = 0; k < 2; ++k) \
        acc[ai][bj][m][n] = __builtin_amdgcn_mfma_f32_16x16x32_bf16(Bt[n][k], At[m][k], acc[ai][bj][m][n], 0, 0, 0); __builtin_amdgcn_s_setprio(0); } while (0)
#define PG8_WAIT_V(n) asm volatile("s_waitcnt vmcnt(" #n ")" ::: "memory")
#define PG8_WAIT_L(n) asm volatile("s_waitcnt lgkmcnt(" #n ")" ::: "memory")
#define PG8_BAR __builtin_amdgcn_s_barrier()
#define PG8_SCHED __builtin_amdgcn_sched_barrier(0)
    Unit cur, nxt; int ui = 0;
    if (!S.next(0, cur)) return;
    f32x4 acc[2][2][4][2];
#pragma unroll
    for (int a = 0; a < 2; ++a)
#pragma unroll
        for (int b = 0; b < 2; ++b)
#pragma unroll
            for (int m = 0; m < 4; ++m)
#pragma unroll
                for (int n = 0; n < 2; ++n) acc[a][b][m][n] = (f32x4){0.f, 0.f, 0.f, 0.f};
    bf16x8 At[4][2], B0[2][2], B1[2][2];
    const char* cA = AG::GATHER ? (const char*)g.A : (const char*)g.A + (size_t)cur.pm * tstep; const char* cB = (const char*)g.Bt + (size_t)cur.pn * tstep;
    unsigned vc[2][2], vn[2][2];
#pragma unroll
    for (int h = 0; h < 2; ++h)
#pragma unroll
        for (int i = 0; i < 2; ++i) { vc[h][i] = AG::GATHER ? (unsigned)(G.row(0, h * HALF + RA[i]) * K + CA[i]) * 2u : voffA[i] + (unsigned)(h * hstep); vn[h][i] = vc[h][i]; }
    S.a_ready(cur);
    if constexpr (SP2) {
        PG8_STAGE(PG8_SB(0, 0), cB, voffB); PG8_STAGE(PG8_SB(0, 1), cB + hstep, voffB); PG8_STAGEA(PG8_SA(0, 0), cA, vc[0]); PG8_STAGEA(PG8_SA(0, 1), cA, vc[1]);
        if (wr == 1) PG8_BAR;
        PG8_WAIT_V(2); PG8_BAR;
        PG8_STAGE(PG8_SB(1, 0), cB + kstep, voffB); PG8_STAGEA(PG8_SA(1, 0), cA + kstep, vc[0]); PG8_STAGE(PG8_SB(1, 1), cB + hstep + kstep, voffB);
        PG8_WAIT_V(6); PG8_BAR;
    } else {
        PG8_STAGE(PG8_SB(0, 0), cB, voffB); PG8_STAGEA(PG8_SA(0, 0), cA, voffA); PG8_STAGE(PG8_SB(0, 1), cB + hstep, voffB); PG8_STAGEA(PG8_SA(0, 1), cA + hstep, voffA);
        if (wr == 1) PG8_BAR;
        PG8_WAIT_V(4); PG8_BAR;
        PG8_STAGE(PG8_SB(1, 0), cB + kstep, voffB); PG8_STAGEA(PG8_SA(1, 0), cA + kstep, voffA); PG8_STAGE(PG8_SB(1, 1), cB + hstep + kstep, voffB);
        PG8_WAIT_V(6); PG8_BAR;
    }
    for (;;) {
        const bool has_next = S.next(ui + 1, nxt);
        const char* nA = AG::GATHER ? cA : (has_next ? (const char*)g.A + (size_t)nxt.pm * tstep : cA); const char* nB = has_next ? (const char*)g.Bt + (size_t)nxt.pn * tstep : cB;
        if (AG::GATHER && has_next) {
#pragma unroll
            for (int h = 0; h < 2; ++h)
#pragma unroll
                for (int i = 0; i < 2; ++i) vn[h][i] = (unsigned)(G.row(ui + 1, h * HALF + RA[i]) * K + CA[i]) * 2u;
        }
        for (int t = 0; t < nt; t += 2) {
            const bool last = (t == nt - 2);
            const char* a1 = cA + (size_t)(t + 1) * kstep;
            const char* a2 = last ? nA : cA + (size_t)(t + 2) * kstep; const char* b2 = last ? nB : cB + (size_t)(t + 2) * kstep;
            const char* a3 = a2 + kstep; const char* b3 = b2 + kstep;
            if (last && has_next) S.a_ready(nxt);
            unsigned v2[2][2];
#pragma unroll
            for (int h = 0; h < 2; ++h)
#pragma unroll
                for (int i = 0; i < 2; ++i) v2[h][i] = last ? vn[h][i] : vc[h][i];
            if constexpr (SP2) {
            PG8_LDB(B0, 0, 0); PG8_LDB(B1, 0, 1); PG8_SCHED; PG8_LDA(At, 0, 0); PG8_STAGEA(PG8_SA(1, 1), a1, vc[1]);
            PG8_WAIT_V(8); PG8_WAIT_L(0); PG8_BAR; PG8_MMA(0, 0, At, B0); PG8_MMA(0, 1, At, B1); PG8_BAR; PG8_SCHED;
            PG8_LDA(At, 0, 1); PG8_STAGE(PG8_SB(0, 0), b2, voffB); PG8_STAGE(PG8_SB(0, 1), b2 + hstep, voffB); PG8_STAGEA(PG8_SA(0, 0), a2, v2[0]);
            PG8_WAIT_V(8); PG8_WAIT_L(0); PG8_BAR; PG8_MMA(1, 0, At, B0); PG8_MMA(1, 1, At, B1); PG8_BAR; PG8_SCHED;
            PG8_LDB(B0, 1, 0); PG8_LDB(B1, 1, 1); PG8_SCHED; PG8_LDA(At, 1, 0); PG8_STAGEA(PG8_SA(0, 1), a2, v2[1]);
            PG8_WAIT_V(8); PG8_WAIT_L(0); PG8_BAR; PG8_MMA(0, 0, At, B0); PG8_MMA(0, 1, At, B1); PG8_BAR; PG8_SCHED;
            PG8_LDA(At, 1, 1); PG8_STAGE(PG8_SB(1, 0), b3, voffB); PG8_STAGE(PG8_SB(1, 1), b3 + hstep, voffB); PG8_STAGEA(PG8_SA(1, 0), a3, v2[0]);
            PG8_WAIT_V(8); PG8_WAIT_L(0); PG8_BAR; PG8_MMA(1, 0, At, B0); PG8_MMA(1, 1, At, B1); PG8_BAR; PG8_SCHED;
            } else {
            PG8_LDB(B0, 0, 0); PG8_SCHED; PG8_LDA(At, 0, 0); PG8_STAGEA(PG8_SA(1, 1), a1 + hstep, voffA);
            PG8_WAIT_L(8); PG8_BAR; PG8_WAIT_L(0); PG8_MMA(0, 0, At, B0); PG8_BAR; PG8_SCHED;
            PG8_LDB(B1, 0, 1); PG8_STAGE(PG8_SB(0, 0), b2, voffB);
            PG8_BAR; PG8_WAIT_L(0); PG8_MMA(0, 1, At, B1); PG8_BAR;
            PG8_LDA(At, 0, 1); PG8_STAGEA(PG8_SA(0, 0), a2, voffA);
            PG8_BAR; PG8_WAIT_L(0); PG8_MMA(1, 0, At, B0); PG8_BAR; PG8_SCHED;
            PG8_STAGE(PG8_SB(0, 1), b2 + hstep, voffB);
            PG8_WAIT_V(6); PG8_BAR; PG8_MMA(1, 1, At, B1); PG8_BAR;
            PG8_LDB(B0, 1, 0); PG8_SCHED; PG8_LDA(At, 1, 0); PG8_STAGEA(PG8_SA(0, 1), a2 + hstep, voffA);
            PG8_WAIT_L(8); PG8_BAR; PG8_WAIT_L(0); PG8_MMA(0, 0, At, B0); PG8_BAR; PG8_SCHED;
            PG8_LDB(B1, 1, 1); PG8_STAGE(PG8_SB(1, 0), b3, voffB);
            PG8_BAR; PG8_WAIT_L(0); PG8_MMA(0, 1, At, B1); PG8_BAR;
            PG8_LDA(At, 1, 1); PG8_STAGEA(PG8_SA(1, 0), a3, voffA);
            PG8_BAR; PG8_WAIT_L(0); PG8_MMA(1, 0, At, B0); PG8_BAR; PG8_SCHED;
            PG8_STAGE(PG8_SB(1, 1), b3 + hstep, voffB);
            PG8_WAIT_V(6); PG8_BAR; PG8_MMA(1, 1, At, B1); PG8_BAR;
            }
        }
        if constexpr (ALIGN_EPI) { if (wr == 0) PG8_BAR; }
        if constexpr (!Epi::AFTER_DRAIN) { E(acc, cur, wr, wc, fr, fq); S.done(cur); }
        if (!has_next) break;
#pragma unroll
        for (int a = 0; a < 2; ++a)
#pragma unroll
            for (int b = 0; b < 2; ++b)
#pragma unroll
                for (int m = 0; m < 4; ++m)
#pragma unroll
                    for (int n = 0; n < 2; ++n) acc[a][b][m][n] = (f32x4){0.f, 0.f, 0.f, 0.f};
        cur = nxt; cA = nA; cB = nB; ++ui;
#pragma unroll
        for (int h = 0; h < 2; ++h)
#pragma unroll
            for (int i = 0; i < 2; ++i) vc[h][i] = vn[h][i];
        if constexpr (ALIGN_EPI) { if (wr == 1) PG8_BAR; }
    }
    PG8_WAIT_V(0);
    if constexpr (!ALIGN_EPI) { if (wr == 0) PG8_BAR; }
    PG8_BAR;
    if constexpr (Epi::AFTER_DRAIN) { E.fused(acc, cur, wr, wc, fr, fq, lds, wid, lane); S.done(cur); }
#undef PG8_SA
#undef PG8_SB
#undef PG8_STAGE
#undef PG8_STAGEA
#undef PG8_LDA
#undef PG8_LDB
#undef PG8_MMA
#undef PG8_WAIT_V
#undef PG8_WAIT_L
#undef PG8_BAR
#undef PG8_SCHED
}
}

__device__ __forceinline__ void transpose_item(const float* W, int K, int N, bf16_t* WT, int item, LAS float* scr, int lane, int rmode = 0) {
    const int nblk = N / 32, kb = item / nblk, nbk = item % nblk, k0 = 64 * kb, n0 = 32 * nbk;
#pragma unroll 8
    for (int i = 0; i < 32; ++i) { const int kk = 2 * i + (lane >> 5); scr[kk * 33 + (lane & 31)] = W[(size_t)(k0 + kk) * N + n0 + (lane & 31)]; }
    asm volatile("s_waitcnt lgkmcnt(0)" ::: "memory");
    const int cc = lane & 7;
#pragma unroll
    for (int j = 0; j < 4; ++j) { const int n = (lane >> 3) + 8 * j; const LAS float* s = scr + (8 * cc) * 33 + n;
        u32x4 o; o.x = pk2(s[0 * 33], s[1 * 33]); o.y = pk2(s[2 * 33], s[3 * 33]); o.z = pk2(s[4 * 33], s[5 * 33]); o.w = pk2(s[6 * 33], s[7 * 33]);
        const int nn = n0 + n, row = rmode == 0 ? nn : ((nn >> 7) * 256 + (rmode - 1) * 128 + (nn & 127));
        *(u32x4*)(WT + (size_t)row * K + k0 + 8 * cc) = o; }
    asm volatile("s_waitcnt lgkmcnt(0)" ::: "memory");
}
constexpr int CV_IN = 16 * 69, CV_OUT = 16 * 32, CV_E = 16 * 256, CV_Q = 4 * 12, CV_KV = 2 * 16;
constexpr int CV_S = CV_IN + CV_OUT + CV_Q + CV_KV;
constexpr int CV_ALL = CV_S + 3 * CV_E;
#ifndef CV_FA
#define CV_FA 8640
#endif
#ifndef CV_FB
#define CV_FB 7424
#endif
__device__ __forceinline__ void convert_weights(const Params& p, const Ctx& c, int l, int lo, int hi, int widx, int nw) {
    LAS float* scr = (LAS float*)(c.lds + c.wave * 16384);
    for (int it = lo + widx; it < hi; it += nw) {
        int r = it;
        if (r < CV_IN) { transpose_item(p.w_in + (size_t)l * D * INW, D, INW, (bf16_t*)(p.ws + WS_WIN) + (size_t)l * INP * D, r, scr, c.lane); continue; } r -= CV_IN;
        if (r < CV_OUT) { transpose_item(p.w_out + (size_t)l * D * D, D, D, (bf16_t*)(p.ws + WS_WOUT) + (size_t)l * D * D, r, scr, c.lane); continue; } r -= CV_OUT;
        if (r < CV_Q) { transpose_item(p.mla_w_q + (size_t)l * 256 * 384, 256, 384, (bf16_t*)(p.ws + WS_WQT) + (size_t)l * 384 * 256, r, scr, c.lane); continue; } r -= CV_Q;
        if (r < CV_KV) { transpose_item(p.mla_w_kv + (size_t)l * 128 * 512, 128, 512, (bf16_t*)(p.ws + WS_WKVT) + (size_t)l * 512 * 128, r, scr, c.lane); continue; } r -= CV_KV;
        if (r < CV_E) { const int e = r / 256; transpose_item(p.exp_w_gate + (size_t)(l * NE + e) * D * DE, D, DE, (bf16_t*)(p.ws + WS_WGU) + (size_t)(l * NE + e) * 1024 * 1024, r % 256, scr, c.lane, 1); continue; } r -= CV_E;
        if (r < CV_E) { const int e = r / 256; transpose_item(p.exp_w_up + (size_t)(l * NE + e) * D * DE, D, DE, (bf16_t*)(p.ws + WS_WGU) + (size_t)(l * NE + e) * 1024 * 1024, r % 256, scr, c.lane, 2); continue; } r -= CV_E;
        { const int e = r / 256; transpose_item(p.exp_w_down + (size_t)(l * NE + e) * DE * D, DE, D, (bf16_t*)(p.ws + WS_WD) + (size_t)(l * NE + e) * 1024 * 512, r % 256, scr, c.lane); }
    }
}
__device__ __forceinline__ void phase_fill(const Params& p, const Ctx& c, int lo, int hi, int wg_lo, int wg_hi) {
    if (c.nb != 256 || c.bid < wg_lo || c.bid >= wg_hi || lo >= hi) return;
    __syncthreads();
    convert_weights(p, c, 1, lo, hi, (c.bid - wg_lo) * NWAVES + c.wave, (wg_hi - wg_lo) * NWAVES);
}
__device__ __forceinline__ void phase_pro(const Params& p, const Ctx& c) {
    convert_weights(p, c, 0, 0, CV_S, c.gw, c.ngw);
    for (int i = c.bid * NTHREADS + c.tid; i < 2 * 2 * 2 * 8 * 64 * 64; i += c.nb * NTHREADS) {
        const int k = i & 63, j = (i >> 6) & 63, n = (i >> 12) & 7, g = (i >> 15) & 1, ld = i >> 16;
        const float* src = g ? p.lru_w_i : p.lru_w_a;
        ((bf16_t*)(p.ws + WS_LRUW))[i] = (bf16_t)f2bf(src[((size_t)(ld * 8 + n) * 64 + k) * 64 + j]);
    }
    for (int i = c.bid * NTHREADS + c.tid; i < 2 * 96 * D / 8; i += c.nb * NTHREADS) {
        const int l = i / (96 * D / 8), r = i % (96 * D / 8);
        *(u32x4*)((bf16_t*)(p.ws + WS_WIN) + (size_t)l * INP * D + (size_t)INW * D + (size_t)r * 8) = (u32x4){0u, 0u, 0u, 0u};
    }
    __syncthreads();
    LAS float* sv = (LAS float*)c.lds;
    LAS float* red = sv + 3 * D;
    for (int i = c.tid; i < 3 * D; i += NTHREADS) { const int r = i >> 10, k = i & 1023; sv[i] = siluf_(r < 2 ? p.c[r * D + k] : p.c_ctx[k]); }
    __syncthreads();
    float* mo = (float*)(p.ws + WS_MODP);
    for (int it = c.bid; it < 2 * 96; it += c.nb) {
        const int l = it / 96, n = (it % 96) * 64 + (c.tid & 63), kg = c.tid >> 6;
        const float* w = p.w_ada + ((size_t)l * D + kg * 128) * 6144 + n;
        float a0 = 0.f, a1 = 0.f, a2 = 0.f;
#pragma unroll 8
        for (int kk = 0; kk < 128; ++kk) { const float wv = w[(size_t)kk * 6144]; const int k = kg * 128 + kk; a0 += sv[k] * wv; a1 += sv[D + k] * wv; a2 += sv[2 * D + k] * wv; }
        red[(kg * 3 + 0) * 64 + (c.tid & 63)] = a0; red[(kg * 3 + 1) * 64 + (c.tid & 63)] = a1; red[(kg * 3 + 2) * 64 + (c.tid & 63)] = a2;
        __syncthreads();
        if (c.tid < 192) { const int r = c.tid >> 6, cc = c.tid & 63; float v = p.b_ada[l * 6144 + (it % 96) * 64 + cc];
#pragma unroll
            for (int g = 0; g < 8; ++g) v += red[(g * 3 + r) * 64 + cc];
            mo[(size_t)(l * 3 + r) * 6144 + (it % 96) * 64 + cc] = v; }
        __syncthreads();
    }
}

__device__ __forceinline__ void phase_n1(const Params& p, const Ctx& c, int l) {
    LAS float* sh = (LAS float*)c.lds;
    LAS float* sc = sh + 3 * D;
    load_mods(p, c, l, 0, sh); load_mods(p, c, l, 1, sc);
    __syncthreads();
    const float* g = p.g_norm + (size_t)(l * 4 + 0) * D;
    bf16_t* H = (bf16_t*)(p.ws + WS_H);
#define N1_LOAD(mm) do { const float* xr_ = xin_row(p, mm);        _Pragma("unroll") for (int j = 0; j < 4; ++j) vn[j] = *(const f32x4*)(xr_ + 4 * (c.lane + 64 * j)); } while (0)
    f32x4 vn[4];
    if (c.gw < M) N1_LOAD(c.gw);
#pragma unroll 1
    for (int m = c.gw; m < M; m += c.ngw) {
        const int b = m / LT, t = m - b * LT, r = t < CTX ? 2 : b;
        f32x4 v[4]; float ss = 0.f;
#pragma unroll
        for (int j = 0; j < 4; ++j) { v[j] = vn[j]; ss += v[j].x * v[j].x + v[j].y * v[j].y + v[j].z * v[j].z + v[j].w * v[j].w; }
        if (m + c.ngw < M) N1_LOAD(m + c.ngw);
        const float rstd = rsqrtf(wave_sum(ss) * (1.f / D) + 1e-6f);
#pragma unroll
        for (int j = 0; j < 4; ++j) {
            const int n = 4 * (c.lane + 64 * j);
            const f32x4 gg = *(const f32x4*)(g + n);
            float o[4];
#pragma unroll
            for (int e = 0; e < 4; ++e) o[e] = v[j][e] * rstd * gg[e] * (1.f + sc[r * D + n + e]) + sh[r * D + n + e];
            u32x2 w; w.x = pk2(o[0], o[1]); w.y = pk2(o[2], o[3]);
            *(u32x2*)(H + (size_t)m * D + n) = w;
        }
    }
}

template <int NJ, class Op>
__device__ __forceinline__ void wave_gemm_tile(const Op& op, int r0, int c0, int K, int lane) {
    const int fr = lane & 15, fq = lane >> 4;
    const bf16_t* ap[4]; const bf16_t* bp[NJ];
#pragma unroll
    for (int i = 0; i < 4; ++i) ap[i] = op.arow(r0 + 16 * i + fr) + 8 * fq;
#pragma unroll
    for (int j = 0; j < NJ; ++j) bp[j] = op.brow(c0 + 16 * j + fr) + 8 * fq;
    f32x4 acc[4][NJ];
#pragma unroll
    for (int i = 0; i < 4; ++i)
#pragma unroll
        for (int j = 0; j < NJ; ++j) acc[i][j] = (f32x4){0.f, 0.f, 0.f, 0.f};
    for (int k0 = 0; k0 < K; k0 += 32) {
        bf16x8 a[4], b[NJ];
#pragma unroll
        for (int i = 0; i < 4; ++i) a[i] = *(const bf16x8*)(ap[i] + k0);
#pragma unroll
        for (int j = 0; j < NJ; ++j) b[j] = *(const bf16x8*)(bp[j] + k0);
#pragma unroll
        for (int i = 0; i < 4; ++i)
#pragma unroll
            for (int j = 0; j < NJ; ++j) acc[i][j] = __builtin_amdgcn_mfma_f32_16x16x32_bf16(a[i], b[j], acc[i][j], 0, 0, 0);
    }
#pragma unroll
    for (int i = 0; i < 4; ++i)
#pragma unroll
        for (int j = 0; j < NJ; ++j)
#pragma unroll
            for (int e = 0; e < 4; ++e) op.store(r0 + 16 * i + 4 * fq + e, c0 + 16 * j + fr, acc[i][j][e]);
}

__device__ __forceinline__ void phase_g1(const Params& p, const Ctx& c, int l, bool deferred) {
    pg8::Gemm g{(const bf16_t*)(p.ws + WS_H), (const bf16_t*)(p.ws + WS_WIN) + (size_t)l * INP * D, M, INP, D};
    pg8::EpiBf16<0> E{(bf16_t*)(p.ws + WS_P), INP, nullptr, 0, 0, 1.f};
    if (c.nb == 256) { pg8::G1Order S{c.nb, c.bid, deferred}; pg8::gemm_phase<pg8::EpiBf16<0>, pg8::G1Order, true, true>(c.lds, g, S, E, c.tid); }
    else if (!deferred) { pg8::StaticOrder S; S.init(M, INP, c.nb, c.bid); pg8::gemm_phase<pg8::EpiBf16<0>, pg8::StaticOrder, true, true>(c.lds, g, S, E, c.tid); }
}
__device__ __forceinline__ void phase_o1(const Params& p, const Ctx& c, int l, bool last) {
    pg8::Gemm g{(const bf16_t*)(p.ws + WS_Y), (const bf16_t*)(p.ws + WS_WOUT) + (size_t)l * D * D, M, D, D};
    pg8::EpiBf16<0> E{(bf16_t*)(p.ws + WS_P), D, nullptr, 0, 0, 1.f};
    if (last) { pg8::LatentOrder4 S{c.nb, c.bid}; pg8::gemm_phase<pg8::EpiBf16<0>, pg8::LatentOrder4, true, true>(c.lds, g, S, E, c.tid); }
    else { pg8::StaticOrder S; S.init(M, D, c.nb, c.bid); pg8::gemm_phase<pg8::EpiBf16<0>, pg8::StaticOrder, true, true>(c.lds, g, S, E, c.tid);
        constexpr int FULL = (M / 256) * (D / 256) - 256;
        if (c.nb == 256 && c.bid >= FULL) { __syncthreads(); convert_weights(p, c, 0, CV_S, CV_ALL, (c.bid - FULL) * NWAVES + c.wave, (256 - FULL) * NWAVES); }
        else if (c.nb != 256) { __syncthreads(); convert_weights(p, c, 0, CV_S, CV_ALL, c.gw, c.ngw); } }
}

__device__ __forceinline__ void rope_cs(int fi, int pos, float& cs, float& sn) {
    const float ang = (float)pos * __builtin_amdgcn_exp2f(-(float)fi * 1.6609640474436813f); cs = __cosf(ang); sn = __sinf(ang); }
struct C1W { bf16x8 q[3][8]; };
__device__ __forceinline__ void c1_load_q(const Params& p, const Ctx& c, int l, C1W& W) {
    const bf16_t* WqT = (const bf16_t*)(p.ws + WS_WQT) + (size_t)l * 384 * 256; const int fr = c.lane & 15, fq = c.lane >> 4;
#pragma unroll
    for (int i = 0; i < 3; ++i)
#pragma unroll
        for (int ks = 0; ks < 8; ++ks) W.q[i][ks] = *(const bf16x8*)(WqT + (size_t)(48 * c.wave + 16 * i + fr) * 256 + ks * 32 + fq * 8);
}
template <int VAR = 0>
__device__ __forceinline__ void c1_compute(const Params& p, const Ctx& c, int l, const C1W& W, int b, int t0, LAS const unsigned char* aq, LAS const unsigned char* akv) {
    constexpr int PQ = 528, PKV = 272, ROWS = 66, RT = 5;
    bf16_t* Q = (bf16_t*)(p.ws + WS_Q); bf16_t* Kb = (bf16_t*)(p.ws + WS_K); bf16_t* Vb = (bf16_t*)(p.ws + WS_V);
    const bf16_t* WkvT = (const bf16_t*)(p.ws + WS_WKVT) + (size_t)l * 512 * 128;
    const int fr = c.lane & 15, fq = c.lane >> 4, w = c.wave, h = w >> 1;
    bf16x8 bkv[4][4];
    {
        f32x4 acc[3][RT];
#pragma unroll
        for (int i = 0; i < 3; ++i)
#pragma unroll
            for (int rt = 0; rt < RT; ++rt) acc[i][rt] = (f32x4){0.f, 0.f, 0.f, 0.f};
#pragma unroll
        for (int ks = 0; ks < 8; ++ks) {
            bf16x8 a[RT];
#pragma unroll
            for (int rt = 0; rt < RT; ++rt) a[rt] = *(LAS const bf16x8*)(aq + (rt * 16 + fr) * PQ + (ks * 32 + fq * 8) * 2);
#pragma unroll
            for (int i = 0; i < 3; ++i)
#pragma unroll
                for (int rt = 0; rt < RT; ++rt) { if (VAR & 2) { asm volatile("" :: "v"(a[rt]), "v"(W.q[i][ks])); } else acc[i][rt] = __builtin_amdgcn_mfma_f32_16x16x32_bf16(W.q[i][ks], a[rt], acc[i][rt], 0, 0, 0); }
        }
        __builtin_amdgcn_sched_barrier(0);
#pragma unroll
        for (int i = 0; i < 3; ++i) {
            const int d = (w & 1) * 48 + 16 * i + 4 * fq;
            const bool rope_tile = (w & 1) && i >= 1;
#pragma unroll
            for (int rt = 0; rt < RT; ++rt) { const int r = 16 * rt + fr, t = t0 + r; float v[4];
#pragma unroll
                for (int e = 0; e < 4; ++e) { v[e] = acc[i][rt][e];
                    if (rope_tile) { auto rr = __builtin_amdgcn_permlane32_swap(__float_as_uint(v[e]), __float_as_uint(v[e]), false, false);
                        const float pv = __uint_as_float(c.lane < 32 ? rr[1] : rr[0]);
                        if (t >= CTX) { const int sidx = t - CTX, pos = (i == 2) ? (sidx % GW) : (sidx / GW); float cs, sn; rope_cs((4 * fq + e) & 7, pos, cs, sn); v[e] = fq < 2 ? v[e] * cs - pv * sn : v[e] * cs + pv * sn; } }
                    v[e] *= 0.14724444602590306f; }
                if (VAR & 1) { asm volatile("" :: "v"(v[0]), "v"(v[1]), "v"(v[2]), "v"(v[3])); }
                else if (r < ROWS) { u32x2 o; o.x = pk2(v[0], v[1]); o.y = pk2(v[2], v[3]); *(u32x2*)(Q + ((size_t)(b * 4 + h) * LT + t) * 96 + d) = o; } }
        }
    }
    __builtin_amdgcn_sched_barrier(0);
#pragma unroll
    for (int i = 0; i < 4; ++i)
#pragma unroll
        for (int ks = 0; ks < 4; ++ks) bkv[i][ks] = *(const bf16x8*)(WkvT + (size_t)(64 * w + 16 * i + fr) * 128 + ks * 32 + fq * 8);
    {
        f32x4 acc[4][RT];
#pragma unroll
        for (int i = 0; i < 4; ++i)
#pragma unroll
            for (int rt = 0; rt < RT; ++rt) acc[i][rt] = (f32x4){0.f, 0.f, 0.f, 0.f};
#pragma unroll
        for (int ks = 0; ks < 4; ++ks) {
            bf16x8 a[RT];
#pragma unroll
            for (int rt = 0; rt < RT; ++rt) a[rt] = *(LAS const bf16x8*)(akv + (rt * 16 + fr) * PKV + (ks * 32 + fq * 8) * 2);
#pragma unroll
            for (int i = 0; i < 4; ++i)
#pragma unroll
                for (int rt = 0; rt < RT; ++rt) { if (VAR & 2) { asm volatile("" :: "v"(a[rt]), "v"(bkv[i][ks])); } else acc[i][rt] = __builtin_amdgcn_mfma_f32_16x16x32_bf16(bkv[i][ks], a[rt], acc[i][rt], 0, 0, 0); }
        }
#pragma unroll
        for (int i = 0; i < 4; ++i)
#pragma unroll
            for (int rt = 0; rt < RT; ++rt) { const int r = 16 * rt + fr, t = t0 + r, d = 16 * i + 4 * fq;
                u32x2 o; o.x = pk2(acc[i][rt][0], acc[i][rt][1]); o.y = pk2(acc[i][rt][2], acc[i][rt][3]);
                if (VAR & 1) { asm volatile("" :: "v"(o.x), "v"(o.y)); } else if (r < ROWS) { if (w & 1) *(u32x2*)(Vb + ((size_t)(b * 4 + h) * LT + t) * 64 + d) = o; else *(u32x2*)(Kb + ((size_t)(b * 4 + h) * LT + t) * 96 + d) = o; } }
    }
}
template <int VAR = 0>
__device__ __forceinline__ void phase_c1(const Params& p, const Ctx& c, int l) {
    constexpr int PQ = 528, PKV = 272, ROWS = 66;
    LAS unsigned char* aq = c.lds; LAS unsigned char* akv = c.lds + 80 * PQ;
    const bf16_t* P = (const bf16_t*)(p.ws + WS_P); bf16_t* Kb = (bf16_t*)(p.ws + WS_K);
    for (int g = c.bid; g < M / ROWS; g += c.nb) {
        const int m0 = g * ROWS, b = m0 / LT, t0 = m0 - b * LT;
        C1W W; c1_load_q(p, c, l, W);
        __syncthreads();
#pragma unroll 1
        for (int it = 0; it < 3; ++it) {
            const int r = it * 32 + (c.tid >> 4), q16 = c.tid & 15;
            if (r >= 80 || (VAR & 4)) continue;
            const bool real = r < ROWS; const int rr = real ? r : 0;
            const bf16_t* pr = P + (size_t)(m0 + rr) * INP;
            const u32x4 c0 = *(const u32x4*)(pr + OFF_CQ + q16 * 16), c1 = *(const u32x4*)(pr + OFF_CQ + q16 * 16 + 8), k0 = *(const u32x4*)(pr + OFF_CKV + q16 * 8);
            const unsigned krw = *(const unsigned*)(pr + OFF_KR + q16 * 2);
            float cv[16], kv[8];
            cv[0] = lo_bf(c0.x); cv[1] = hi_bf(c0.x); cv[2] = lo_bf(c0.y); cv[3] = hi_bf(c0.y); cv[4] = lo_bf(c0.z); cv[5] = hi_bf(c0.z); cv[6] = lo_bf(c0.w); cv[7] = hi_bf(c0.w);
            cv[8] = lo_bf(c1.x); cv[9] = hi_bf(c1.x); cv[10] = lo_bf(c1.y); cv[11] = hi_bf(c1.y); cv[12] = lo_bf(c1.z); cv[13] = hi_bf(c1.z); cv[14] = lo_bf(c1.w); cv[15] = hi_bf(c1.w);
            kv[0] = lo_bf(k0.x); kv[1] = hi_bf(k0.x); kv[2] = lo_bf(k0.y); kv[3] = hi_bf(k0.y); kv[4] = lo_bf(k0.z); kv[5] = hi_bf(k0.z); kv[6] = lo_bf(k0.w); kv[7] = hi_bf(k0.w);
            float s1 = 0.f, s2 = 0.f;
#pragma unroll
            for (int i = 0; i < 16; ++i) s1 += cv[i] * cv[i];
#pragma unroll
            for (int i = 0; i < 8; ++i) s2 += kv[i] * kv[i];
            s1 = row16_sum(s1); s2 = row16_sum(s2);
            const float r1 = real ? rsqrtf(s1 * (1.f / 256.f) + 1e-6f) : 0.f, r2 = real ? rsqrtf(s2 * (1.f / 128.f) + 1e-6f) : 0.f;
            const float* gq = p.mla_g_q + l * 256 + q16 * 16; const float* gk = p.mla_g_kv + l * 128 + q16 * 8;
            u32x4 o0, o1, o2;
            o0.x = pk2(cv[0] * r1 * gq[0], cv[1] * r1 * gq[1]); o0.y = pk2(cv[2] * r1 * gq[2], cv[3] * r1 * gq[3]); o0.z = pk2(cv[4] * r1 * gq[4], cv[5] * r1 * gq[5]); o0.w = pk2(cv[6] * r1 * gq[6], cv[7] * r1 * gq[7]);
            o1.x = pk2(cv[8] * r1 * gq[8], cv[9] * r1 * gq[9]); o1.y = pk2(cv[10] * r1 * gq[10], cv[11] * r1 * gq[11]); o1.z = pk2(cv[12] * r1 * gq[12], cv[13] * r1 * gq[13]); o1.w = pk2(cv[14] * r1 * gq[14], cv[15] * r1 * gq[15]);
            o2.x = pk2(kv[0] * r2 * gk[0], kv[1] * r2 * gk[1]); o2.y = pk2(kv[2] * r2 * gk[2], kv[3] * r2 * gk[3]); o2.z = pk2(kv[4] * r2 * gk[4], kv[5] * r2 * gk[5]); o2.w = pk2(kv[6] * r2 * gk[6], kv[7] * r2 * gk[7]);
            *(LAS u32x4*)(aq + r * PQ + q16 * 32) = o0; *(LAS u32x4*)(aq + r * PQ + q16 * 32 + 16) = o1; *(LAS u32x4*)(akv + r * PKV + q16 * 16) = o2;
            float z0 = lo_bf(krw), z1 = hi_bf(krw);
            const float y0 = __shfl_xor(z0, 4), y1 = __shfl_xor(z1, 4);
            const int t = t0 + r;
            if (t >= CTX) { const int sidx = t - CTX, pos = (q16 >> 3) ? (sidx % GW) : (sidx / GW); const int li0 = (2 * q16) & 15; const bool first = li0 < 8;
                float cs, sn; rope_cs(li0 & 7, pos, cs, sn); z0 = first ? z0 * cs - y0 * sn : z0 * cs + y0 * sn;
                rope_cs((li0 + 1) & 7, pos, cs, sn); z1 = first ? z1 * cs - y1 * sn : z1 * cs + y1 * sn; }
            const unsigned kw = pk2(z0, z1);
            if (real) {
#pragma unroll
                for (int h = 0; h < 4; ++h) *(unsigned*)(Kb + ((size_t)(b * 4 + h) * LT + t) * 96 + 64 + 2 * q16) = kw; }
        }
        __syncthreads();
        c1_compute<VAR>(p, c, l, W, b, t0, aq, akv);
    }
}

namespace lru {
typedef float f32x16 __attribute__((ext_vector_type(16)));
constexpr int PITCH = 1040;
__device__ __forceinline__ void load_uc(const Params& p, const Ctx& c, int l, int b, int ch, LAS unsigned char* ucb) {
    const int chn = c.tid, t0 = ch * CH, seq_lo = (ch < NCH_CTX) ? 0 : CTX, seq_hi = (ch < NCH_CTX) ? CTX : LT;
    const bf16_t* Pb = (const bf16_t*)(p.ws + WS_P) + (size_t)(b * LT) * INP + OFF_U + chn;
    const float w0 = p.conv_w[(l * 4 + 0) * LRU_W + chn], w1 = p.conv_w[(l * 4 + 1) * LRU_W + chn], w2 = p.conv_w[(l * 4 + 2) * LRU_W + chn], w3 = p.conv_w[(l * 4 + 3) * LRU_W + chn];
    const float cb = p.conv_b[l * LRU_W + chn];
    float u[CH + 3];
#pragma unroll
    for (int i = 0; i < CH + 3; ++i) { const int t = t0 - 1 + i, tc = min(max(t, seq_lo), seq_hi - 1); u[i] = bf2f(Pb[(size_t)tc * INP]); }
    if (t0 == seq_lo) u[0] = 0.f;
    if (t0 + CH == seq_hi) { u[CH + 1] = 0.f; u[CH + 2] = 0.f; }
#pragma unroll
    for (int i = 0; i < CH; ++i) *(LAS bf16_t*)(ucb + i * PITCH + chn * 2) = (bf16_t)f2bf(u[i] * w0 + u[i + 1] * w1 + u[i + 2] * w2 + u[i + 3] * w3 + cb);
}
struct WF { bf16x8 a[4], i[4]; };
__device__ __forceinline__ WF load_w(const Params& p, int l, int d, int n, int ct, int r32, int hi) {
    const bf16_t* wa = (const bf16_t*)(p.ws + WS_LRUW) + ((size_t)((((l * 2 + d) * 2 + 0) * 8 + n) * 64 + ct * 32 + r32)) * 64 + hi * 8;
    const bf16_t* wi = wa + (size_t)8 * 64 * 64;
    WF w;
#pragma unroll
    for (int ks = 0; ks < 4; ++ks) { w.a[ks] = *(const bf16x8*)(wa + ks * 16); w.i[ks] = *(const bf16x8*)(wi + ks * 16); }
    return w;
}
__device__ __forceinline__ void gates_mm(const WF& w, const bf16x8 (&af)[4], f32x16& za, f32x16& zi) {
    za = f32x16{}; zi = f32x16{};
#pragma unroll
    for (int ks = 0; ks < 4; ++ks) { za = __builtin_amdgcn_mfma_f32_32x32x16_bf16(af[ks], w.a[ks], za, 0, 0, 0); zi = __builtin_amdgcn_mfma_f32_32x32x16_bf16(af[ks], w.i[ks], zi, 0, 0, 0); }
}
__device__ __forceinline__ void gates_ew(const f32x16& za, const f32x16& zi, float bias_a, float bias_i, float lam, const float (&ucv)[16], float (&a)[16], float (&x)[16]) {
    const float ee = __builtin_amdgcn_exp2f(-1.4426950408889634f * lam);
    const float sp = ee * (1.f + ee * (-0.5f + ee * (0.33333333f - 0.25f * ee)));
#pragma unroll
    for (int r = 0; r < 16; ++r) { const float la = -8.f * sigmoidf_(za[r] + bias_a) * sp, y = 2.f * la;
        const float g2 = -y * (1.f + y * (0.5f + y * (0.16666667f + y * (0.041666667f + y * 0.0083333333f))));
        a[r] = __builtin_amdgcn_exp2f(1.4426950408889634f * la); x[r] = __builtin_amdgcn_sqrtf(g2) * sigmoidf_(zi[r] + bias_i) * ucv[r]; }
}
template <bool HS>
__device__ __forceinline__ float scan32(const float (&a)[16], const float (&x)[16], int d, int hi, float h0, float (&hs)[16], float& ap) {
    float As[4], Xs[4];
#pragma unroll
    for (int g = 0; g < 4; ++g) { float A = 1.f, X = 0.f;
#pragma unroll
        for (int e4 = 0; e4 < 4; ++e4) { const int r = 4 * g + (d == 0 ? e4 : 3 - e4); X = a[r] * X + x[r]; A *= a[r]; }
        As[g] = A; Xs[g] = X; }
    float Alo[4], Ahi[4], Xlo[4], Xhi[4];
#pragma unroll
    for (int g = 0; g < 4; ++g) {
        auto ra = __builtin_amdgcn_permlane32_swap(__float_as_uint(As[g]), __float_as_uint(As[g]), false, false);
        auto rx = __builtin_amdgcn_permlane32_swap(__float_as_uint(Xs[g]), __float_as_uint(Xs[g]), false, false);
        Alo[g] = __uint_as_float(ra[0]); Ahi[g] = __uint_as_float(ra[1]); Xlo[g] = __uint_as_float(rx[0]); Xhi[g] = __uint_as_float(rx[1]); }
    float h = h0, hin[4]; ap = 1.f;
#pragma unroll
    for (int s8 = 0; s8 < 8; ++s8) { const int sg = d == 0 ? s8 : 7 - s8, g = sg >> 1; const bool up = (sg & 1) != 0;
        const float A = up ? Ahi[g] : Alo[g], X = up ? Xhi[g] : Xlo[g];
        if (up == (hi != 0)) hin[g] = h;
        h = A * h + X; ap *= A; }
    if (HS) {
#pragma unroll
        for (int g = 0; g < 4; ++g) { float hh = hin[g];
#pragma unroll
            for (int e4 = 0; e4 < 4; ++e4) { const int r = 4 * g + (d == 0 ? e4 : 3 - e4); hh = a[r] * hh + x[r]; hs[r] = hh; } }
    }
    return h;
}
template <int MODE, int VAR = 0>
__device__ __forceinline__ void chunk(const Params& p, const Ctx& c, int l, int b, int ch, LAS const unsigned char* ucb, WF w) {
    const int n = c.wave, r32 = c.lane & 31, hi = c.lane >> 5;
    bf16x8 af[4];
#pragma unroll
    for (int ks = 0; ks < 4; ++ks) af[ks] = *(LAS const bf16x8*)(ucb + r32 * PITCH + (n * 64 + ks * 16 + hi * 8) * 2);
    constexpr int D0 = MODE == 0 ? 0 : 1, D1 = 1 - D0;
#pragma unroll 1
    for (int ct = 0; ct < 2; ++ct) {
        const int chn = n * 64 + ct * 32 + r32;
        float ucv[16], hr[16], a[16], x[16], ap; f32x16 za, zi;
#pragma unroll
        for (int r = 0; r < 16; ++r) ucv[r] = bf2f(*(LAS const bf16_t*)(ucb + (8 * (r >> 2) + 4 * hi + (r & 3)) * PITCH + chn * 2));
        float c0 = 0.f, c1 = 0.f;
        if (MODE == 1) { const float* cr = (const float*)(p.ws + WS_CARRY);
            c1 = cr[((size_t)((b * 2 + 1) * NCH + ch)) * LRU_W + chn]; c0 = cr[((size_t)((b * 2 + 0) * NCH + ch)) * LRU_W + chn]; }
        { const float bias_a = p.lru_b_a[(l * 2 + D0) * LRU_W + chn], bias_i = p.lru_b_i[(l * 2 + D0) * LRU_W + chn], lam = p.lru_lam[(l * 2 + D0) * LRU_W + chn];
          gates_mm(w, af, za, zi);
          w = load_w(p, l, D1, n, ct, r32, hi);
          __builtin_amdgcn_sched_barrier(0);
          if (VAR & 1) { _Pragma("unroll") for (int r = 0; r < 16; ++r) { a[r] = za[r] * bias_a; x[r] = zi[r] * lam + bias_i; } } else gates_ew(za, zi, bias_a, bias_i, lam, ucv, a, x); }
        if (MODE == 0) { const float he = scan32<false>(a, x, D0, hi, 0.f, hr, ap);
            if (hi == 0) { float* ag = (float*)(p.ws + WS_AGG) + 2 * (((size_t)((b * 2 + D0) * NCH + ch)) * LRU_W + chn); ag[0] = ap; ag[1] = he; } }
        else if (VAR & 2) { _Pragma("unroll") for (int r = 0; r < 16; ++r) hr[r] = a[r] + x[r] + c1; } else (void)scan32<true>(a, x, D0, hi, c1, hr, ap);
        __builtin_amdgcn_sched_barrier(0);
        unsigned short gv[16];
        if (MODE == 1 && !(VAR & 4)) {
            const char* gp = (const char*)((const bf16_t*)(p.ws + WS_P) + ((size_t)b * LT + ch * CH) * INP + OFF_G + n * 64 + ct * 32);
            const unsigned go = (unsigned)((4 * hi * INP + r32) * 2);
#pragma unroll
            for (int r = 0; r < 16; ++r) gv[r] = *(const bf16_t*)(gp + (size_t)(8 * (r >> 2) + (r & 3)) * INP * 2 + go);
        }
        { const float bias_a = p.lru_b_a[(l * 2 + D1) * LRU_W + chn], bias_i = p.lru_b_i[(l * 2 + D1) * LRU_W + chn], lam = p.lru_lam[(l * 2 + D1) * LRU_W + chn];
          gates_mm(w, af, za, zi);
          if (ct == 0) w = load_w(p, l, D0, n, 1, r32, hi);
          __builtin_amdgcn_sched_barrier(0);
          if (VAR & 1) { _Pragma("unroll") for (int r = 0; r < 16; ++r) { a[r] = za[r] * bias_a; x[r] = zi[r] * lam + bias_i; } } else gates_ew(za, zi, bias_a, bias_i, lam, ucv, a, x); }
        if (MODE == 0) { float hs[16]; const float he = scan32<false>(a, x, D1, hi, 0.f, hs, ap);
            if (hi == 0) { float* ag = (float*)(p.ws + WS_AGG) + 2 * (((size_t)((b * 2 + D1) * NCH + ch)) * LRU_W + chn); ag[0] = ap; ag[1] = he; } }
        else {
            float hs[16];
            if (VAR & 2) { _Pragma("unroll") for (int r = 0; r < 16; ++r) hs[r] = a[r] + x[r] + c0; } else (void)scan32<true>(a, x, D1, hi, c0, hs, ap);
            if (VAR & 4) { _Pragma("unroll") for (int r = 0; r < 16; ++r) asm volatile("" :: "v"(hs[r]), "v"(hr[r])); } else {
            char* yp = (char*)((bf16_t*)(p.ws + WS_Y) + ((size_t)b * LT + ch * CH) * D + 256 + n * 64 + ct * 32);
            const unsigned yo = (unsigned)((4 * hi * D + r32) * 2);
#pragma unroll
            for (int r = 0; r < 16; ++r) *(bf16_t*)(yp + (size_t)(8 * (r >> 2) + (r & 3)) * D * 2 + yo) = (bf16_t)f2bf((hr[r] + hs[r]) * gelu_tanh(bf2f(gv[r])));
            }
        }
        __builtin_amdgcn_sched_barrier(0);
    }
}
constexpr int TILE = CH * PITCH;
template <int MODE>
__device__ __forceinline__ void chunk2(const Params& p, const Ctx& c, int l, const int (&bb)[2], const int (&cc)[2], LAS const unsigned char* ucb, WF w) {
    const int n = c.wave, r32 = c.lane & 31, hi = c.lane >> 5;
    constexpr int D0 = MODE == 0 ? 0 : 1, D1 = 1 - D0;
#pragma unroll 1
    for (int ct = 0; ct < 2; ++ct) {
        const int chn = n * 64 + ct * 32 + r32;
        unsigned hrp[2][8];
        { const float bias_a = p.lru_b_a[(l * 2 + D0) * LRU_W + chn], bias_i = p.lru_b_i[(l * 2 + D0) * LRU_W + chn], lam = p.lru_lam[(l * 2 + D0) * LRU_W + chn];
          WF wn = w;
#pragma unroll
          for (int j = 0; j < 2; ++j) {
              LAS const unsigned char* tb = ucb + j * TILE;
              bf16x8 af[4]; float ucv[16], a[16], x[16], hs[16], ap; f32x16 za, zi;
#pragma unroll
              for (int ks = 0; ks < 4; ++ks) af[ks] = *(LAS const bf16x8*)(tb + r32 * PITCH + (n * 64 + ks * 16 + hi * 8) * 2);
#pragma unroll
              for (int r = 0; r < 16; ++r) ucv[r] = bf2f(*(LAS const bf16_t*)(tb + (8 * (r >> 2) + 4 * hi + (r & 3)) * PITCH + chn * 2));
              float cin = 0.f;
              if (MODE == 1) cin = ((const float*)(p.ws + WS_CARRY))[((size_t)((bb[j] * 2 + D0) * NCH + cc[j])) * LRU_W + chn];
              gates_mm(w, af, za, zi);
              if (j == 1) wn = load_w(p, l, D1, n, ct, r32, hi);
              __builtin_amdgcn_sched_barrier(0);
              gates_ew(za, zi, bias_a, bias_i, lam, ucv, a, x);
              if (MODE == 0) { const float he = scan32<false>(a, x, D0, hi, 0.f, hs, ap);
                  if (hi == 0) { float* ag = (float*)(p.ws + WS_AGG) + 2 * (((size_t)((bb[j] * 2 + D0) * NCH + cc[j])) * LRU_W + chn); ag[0] = ap; ag[1] = he; } }
              else { (void)scan32<true>(a, x, D0, hi, cin, hs, ap);
#pragma unroll
                  for (int r = 0; r < 8; ++r) hrp[j][r] = pk2(hs[2 * r], hs[2 * r + 1]); }
              __builtin_amdgcn_sched_barrier(0);
          }
          w = wn; }
        { const float bias_a = p.lru_b_a[(l * 2 + D1) * LRU_W + chn], bias_i = p.lru_b_i[(l * 2 + D1) * LRU_W + chn], lam = p.lru_lam[(l * 2 + D1) * LRU_W + chn];
          WF wn = w;
#pragma unroll
          for (int j = 0; j < 2; ++j) {
              LAS const unsigned char* tb = ucb + j * TILE;
              bf16x8 af[4]; float ucv[16], a[16], x[16], hs[16], ap; f32x16 za, zi; unsigned short gv[16];
#pragma unroll
              for (int ks = 0; ks < 4; ++ks) af[ks] = *(LAS const bf16x8*)(tb + r32 * PITCH + (n * 64 + ks * 16 + hi * 8) * 2);
#pragma unroll
              for (int r = 0; r < 16; ++r) ucv[r] = bf2f(*(LAS const bf16_t*)(tb + (8 * (r >> 2) + 4 * hi + (r & 3)) * PITCH + chn * 2));
              float cin = 0.f;
              if (MODE == 1) { cin = ((const float*)(p.ws + WS_CARRY))[((size_t)((bb[j] * 2 + D1) * NCH + cc[j])) * LRU_W + chn];
                  const char* gp = (const char*)((const bf16_t*)(p.ws + WS_P) + ((size_t)bb[j] * LT + cc[j] * CH) * INP + OFF_G + n * 64 + ct * 32);
                  const unsigned go = (unsigned)((4 * hi * INP + r32) * 2);
#pragma unroll
                  for (int r = 0; r < 16; ++r) gv[r] = *(const bf16_t*)(gp + (size_t)(8 * (r >> 2) + (r & 3)) * INP * 2 + go); }
              gates_mm(w, af, za, zi);
              if (j == 1 && ct == 0) wn = load_w(p, l, D0, n, 1, r32, hi);
              __builtin_amdgcn_sched_barrier(0);
              gates_ew(za, zi, bias_a, bias_i, lam, ucv, a, x);
              if (MODE == 0) { const float he = scan32<false>(a, x, D1, hi, 0.f, hs, ap);
                  if (hi == 0) { float* ag = (float*)(p.ws + WS_AGG) + 2 * (((size_t)((bb[j] * 2 + D1) * NCH + cc[j])) * LRU_W + chn); ag[0] = ap; ag[1] = he; } }
              else { (void)scan32<true>(a, x, D1, hi, cin, hs, ap);
                  char* yp = (char*)((bf16_t*)(p.ws + WS_Y) + ((size_t)bb[j] * LT + cc[j] * CH) * D + 256 + n * 64 + ct * 32);
                  const unsigned yo = (unsigned)((4 * hi * D + r32) * 2);
#pragma unroll
                  for (int r = 0; r < 16; ++r) { const float h1 = (r & 1) ? hi_bf(hrp[j][r >> 1]) : lo_bf(hrp[j][r >> 1]);
                      *(bf16_t*)(yp + (size_t)(8 * (r >> 2) + (r & 3)) * D * 2 + yo) = (bf16_t)f2bf((h1 + hs[r]) * gelu_tanh(bf2f(gv[r]))); } }
              __builtin_amdgcn_sched_barrier(0);
          }
          w = wn; }
    }
}
}
__device__ __forceinline__ void phase_c2(const Params& p, const Ctx& c, int l) {
    constexpr int ND = 82;
    const bool split = c.nb == 256;
    if (split && c.bid < ND) { phase_g1(p, c, l, true); __syncthreads(); }
    else if (!split) { phase_g1(p, c, l, true); __syncthreads(); }
    const int first = split ? (c.bid < ND ? c.bid : ND + (c.bid - ND)) : c.bid;
    const int stride = split ? (c.bid < ND ? NB * NCH : c.nb - ND) : c.nb;
    for (int it = first; it < NB * NCH; it += 2 * stride) {
        const int it2 = it + stride;
        const lru::WF w0 = lru::load_w(p, l, 0, c.wave, 0, c.lane & 31, c.lane >> 5);
        __syncthreads();
        lru::load_uc(p, c, l, it / NCH, it % NCH, c.lds);
        if (it2 < NB * NCH) lru::load_uc(p, c, l, it2 / NCH, it2 % NCH, c.lds + lru::TILE);
        __syncthreads();
        if (it2 < NB * NCH) { const int bb[2] = {it / NCH, it2 / NCH}, cc[2] = {it % NCH, it2 % NCH}; lru::chunk2<0>(p, c, l, bb, cc, c.lds, w0); }
        else lru::chunk<0>(p, c, l, it / NCH, it % NCH, c.lds, w0);
    }
}
__device__ __forceinline__ void phase_c3(const Params& p, const Ctx& c) {
    LAS float* sA = (LAS float*)c.lds; LAS float* sE = sA + 512;
    const float* ag = (const float*)(p.ws + WS_AGG); float* cr = (float*)(p.ws + WS_CARRY);
    for (int u = c.nb - 1 - c.bid; u < 32; u += c.nb) {
        const int b = u >> 4, d = (u >> 3) & 1, chn = (u & 7) * 64 + c.lane, seg = c.wave;
        float aa[33], ee[33];
#pragma unroll
        for (int k = 0; k < 33; ++k) { const int s = seg * 33 + k, ch = d == 0 ? s : (s < NCH_CTX ? NCH_CTX - 1 - s : NCH - 1 - (s - NCH_CTX));
            const size_t idx = ((size_t)((b * 2 + d) * NCH + ch)) * LRU_W + chn; const f32x2 v = *(const f32x2*)(ag + 2 * idx); aa[k] = v.x; ee[k] = v.y; }
        float A = 1.f, E = 0.f;
#pragma unroll
        for (int k = 0; k < 33; ++k) { E = aa[k] * E + ee[k]; A *= aa[k]; }
        __syncthreads();
        sA[seg * 64 + c.lane] = A; sE[seg * 64 + c.lane] = E;
        __syncthreads();
        float st = 0.f;
        for (int s2 = 0; s2 < seg; ++s2) st = sA[s2 * 64 + c.lane] * st + sE[s2 * 64 + c.lane];
#pragma unroll
        for (int k = 0; k < 33; ++k) { const int s = seg * 33 + k, ch = d == 0 ? s : (s < NCH_CTX ? NCH_CTX - 1 - s : NCH - 1 - (s - NCH_CTX));
            const size_t idx = ((size_t)((b * 2 + d) * NCH + ch)) * LRU_W + chn; cr[idx] = st; st = aa[k] * st + ee[k]; }
    }
}
template <int VAR = 0>
__device__ __forceinline__ void phase_c4(const Params& p, const Ctx& c, int l, bool last) {
    const int i0 = c.bid, i1 = c.nb + c.bid;
    const bool v0 = i0 < NB * NCH && !(last && (i0 % NCH) < NCH_CTX), v1 = i1 < NB * NCH && !(last && (i1 % NCH) < NCH_CTX);
    if (v0 && v1 && VAR == 0) {
        const lru::WF w0 = lru::load_w(p, l, 1, c.wave, 0, c.lane & 31, c.lane >> 5);
        __syncthreads();
        lru::load_uc(p, c, l, i0 / NCH, i0 % NCH, c.lds); lru::load_uc(p, c, l, i1 / NCH, i1 % NCH, c.lds + lru::TILE);
        __syncthreads();
        const int bb[2] = {i0 / NCH, i1 / NCH}, cc[2] = {i0 % NCH, i1 % NCH};
        lru::chunk2<1>(p, c, l, bb, cc, c.lds, w0);
    } else {
        for (int k = 0; k < 2; ++k) { const int it = k ? i1 : i0; if (!(k ? v1 : v0)) continue;
            const lru::WF w0 = lru::load_w(p, l, 1, c.wave, 0, c.lane & 31, c.lane >> 5);
            __syncthreads();
            if (!(VAR & 8)) lru::load_uc(p, c, l, it / NCH, it % NCH, c.lds);
            __syncthreads();
            lru::chunk<1, VAR>(p, c, l, it / NCH, it % NCH, c.lds, w0); }
    }
    for (int k = 2; k * c.nb < NB * NCH; ++k) {
        const int it = (c.nb == 256) ? k * c.nb + (c.nb - 1 - c.bid) : k * c.nb + c.bid;
        if (it >= NB * NCH) continue;
        const int b = it / NCH, ch = it % NCH;
        if (last && ch < NCH_CTX) continue;
        const lru::WF w0 = lru::load_w(p, l, 1, c.wave, 0, c.lane & 31, c.lane >> 5);
        __syncthreads();
        if (!(VAR & 8)) lru::load_uc(p, c, l, b, ch, c.lds);
        __syncthreads();
        lru::chunk<1, VAR>(p, c, l, b, ch, c.lds, w0);
    }
}

namespace mla {
typedef float f32x16 __attribute__((ext_vector_type(16)));
typedef short s16x4 __attribute__((ext_vector_type(4)));
constexpr int DQ = 96, DV = 64, KVB = 64;
constexpr float SCALE = 0.10206207261596575f, THR = 8.f;
constexpr int SHM_V = KVB * DV * 2  , SHM_K = KVB * 256  , SHM_ATTN = 3 * SHM_V + 3 * SHM_K + NWAVES * 64 * 4;
#define KSWZ(row, colB) ((row) * 256 + ((colB) ^ (((row) & 15) << 4)))
#define SBAR() __builtin_amdgcn_sched_barrier(0)
__device__ __forceinline__ int crow(int r, int hi) { return (r & 3) + 8 * (r >> 2) + 4 * hi; }
__device__ __forceinline__ unsigned cvtpk(float lo, float hi) { return ::pk2(lo, hi); }
__device__ __forceinline__ void finishSM(f32x16& p0, f32x16& p1, float alpha, float& l_reg, bf16x8& pa0, bf16x8& pa1, bf16x8& pa2, bf16x8& pa3) {
#pragma unroll
    for (int r = 0; r < 16; ++r) p1[r] = __builtin_amdgcn_exp2f(p1[r]);
    float ps, ps0 = 0, ps1 = 0, ps2 = 0, ps3 = 0;
#pragma unroll
    for (int r = 0; r < 16; r += 2) { ps0 += p0[r]; ps1 += p0[r + 1]; ps2 += p1[r]; ps3 += p1[r + 1]; }
    ps = (ps0 + ps1) + (ps2 + ps3);
    { auto rr = __builtin_amdgcn_permlane32_swap(__float_as_uint(ps), __float_as_uint(ps), false, false);
      ps = __uint_as_float(rr[0]) + __uint_as_float(rr[1]); }
    l_reg = l_reg * alpha + ps;
#define PK4(P, BASE, OUT) do { unsigned a0 = cvtpk(P[BASE + 0], P[BASE + 1]), a1 = cvtpk(P[BASE + 2], P[BASE + 3]);   \
    unsigned b0 = cvtpk(P[BASE + 4], P[BASE + 5]), b1 = cvtpk(P[BASE + 6], P[BASE + 7]);                              \
    auto r0 = __builtin_amdgcn_permlane32_swap(a0, b0, false, false); auto r1 = __builtin_amdgcn_permlane32_swap(a1, b1, false, false); \
    u32x4 w = {r0[0], r1[0], r0[1], r1[1]}; OUT = *reinterpret_cast<bf16x8*>(&w); } while (0)
    PK4(p0, 0, pa0); PK4(p0, 8, pa1); PK4(p1, 0, pa2); PK4(p1, 8, pa3);
#undef PK4
}
template <int VAR = 0>
__device__ __forceinline__ void qkt(f32x16& p0, f32x16& p1, LAS const unsigned char* Ks, const bf16x8* qr, int r32, int hi, float m_reg) {
#pragma unroll
    for (int r = 0; r < 16; ++r) { p0[r] = -m_reg; p1[r] = -m_reg; }
#pragma unroll
    for (int d0 = 0; d0 < DQ / 16; ++d0) { const int cb = (d0 * 16 + hi * 8) * 2;
        const bf16x8 b0 = *(LAS const bf16x8*)(Ks + KSWZ(r32, cb));
        const bf16x8 b1 = *(LAS const bf16x8*)(Ks + KSWZ(32 + r32, cb));
        if (VAR & 2) { asm volatile("" :: "v"(b0), "v"(b1)); }
        else { p0 = __builtin_amdgcn_mfma_f32_32x32x16_bf16(b0, qr[d0], p0, 0, 0, 0);
               p1 = __builtin_amdgcn_mfma_f32_32x32x16_bf16(b1, qr[d0], p1, 0, 0, 0); } }
}
__device__ __forceinline__ int v_st(int k, int cc) { const int kk = (k & ~0xC) | ((k & 4) << 1) | ((k & 8) >> 1); return ((kk >> 3) * 2 + (cc >> 5)) * 512 + ((kk & 7) * 32 + (cc & 31)) * 2; }
__device__ __forceinline__ int v_rd_base(int lane) { return ((lane & 3) << 3) | (((lane >> 2) & 3) << 6) | (((lane >> 4) & 1) << 5) | (((lane >> 5) & 1) << 8); }
constexpr int v_rd_off(int d0, int ks, int half) { return d0 * 512 + ks * 2048 + half * 1024; }
template <int OFF> __device__ __forceinline__ s16x4 tr_read(int vb) { return __builtin_amdgcn_ds_read_tr16_b64_v4i16((LAS s16x4*)(uintptr_t)(unsigned)(vb + OFF)); }
template <int D0, int VAR = 0> __device__ __forceinline__ void pv_one(f32x16& od, int vb, bf16x8 pa0, bf16x8 pa1, bf16x8 pa2, bf16x8 pa3) {
    const s16x4 l0 = tr_read<v_rd_off(D0, 0, 0)>(vb), h0 = tr_read<v_rd_off(D0, 0, 1)>(vb), l1 = tr_read<v_rd_off(D0, 1, 0)>(vb), h1 = tr_read<v_rd_off(D0, 1, 1)>(vb);
    const s16x4 l2 = tr_read<v_rd_off(D0, 2, 0)>(vb), h2 = tr_read<v_rd_off(D0, 2, 1)>(vb), l3 = tr_read<v_rd_off(D0, 3, 0)>(vb), h3 = tr_read<v_rd_off(D0, 3, 1)>(vb);
#define PKV(L, H) (bf16x8){L[0], L[1], L[2], L[3], H[0], H[1], H[2], H[3]}
    if (VAR & 2) { asm volatile("" :: "v"(l0), "v"(h0), "v"(l1), "v"(h1), "v"(l2), "v"(h2), "v"(l3), "v"(h3), "v"(pa0), "v"(pa1), "v"(pa2), "v"(pa3)); return; }
    od = __builtin_amdgcn_mfma_f32_32x32x16_bf16(pa0, PKV(l0, h0), od, 0, 0, 0);
    od = __builtin_amdgcn_mfma_f32_32x32x16_bf16(pa1, PKV(l1, h1), od, 0, 0, 0);
    od = __builtin_amdgcn_mfma_f32_32x32x16_bf16(pa2, PKV(l2, h2), od, 0, 0, 0);
    od = __builtin_amdgcn_mfma_f32_32x32x16_bf16(pa3, PKV(l3, h3), od, 0, 0, 0);
#undef PKV
}
template <int VAR = 0> __device__ __forceinline__ void pv_all(f32x16* o, int vb, bf16x8 pa0, bf16x8 pa1, bf16x8 pa2, bf16x8 pa3) { pv_one<0, VAR>(o[0], vb, pa0, pa1, pa2, pa3); pv_one<1, VAR>(o[1], vb, pa0, pa1, pa2, pa3); }

constexpr float THR2 = THR * 1.4426950408889634f;
__device__ __forceinline__ void decideSM(f32x16& p0, f32x16& p1, float& m_reg, float& alpha) {
    float pmax = p0[0], pmx1 = p1[0];
#pragma unroll
    for (int r = 1; r < 16; ++r) { pmax = fmaxf(pmax, p0[r]); pmx1 = fmaxf(pmx1, p1[r]); }
    pmax = fmaxf(pmax, pmx1);
    { auto rr = __builtin_amdgcn_permlane32_swap(__float_as_uint(pmax), __float_as_uint(pmax), false, false);
      pmax = fmaxf(__uint_as_float(rr[0]), __uint_as_float(rr[1])); }
    if (__builtin_expect(__all(pmax <= THR2), 1)) { alpha = 1.f; }
    else { const float d = fmaxf(pmax, 0.f);
        alpha = __builtin_amdgcn_exp2f(-d); m_reg += d;
#pragma unroll
        for (int r = 0; r < 16; ++r) { p0[r] -= d; p1[r] -= d; } }
}
__device__ __forceinline__ void decideSM_first(f32x16& p0, f32x16& p1, float& m_reg, float& alpha) {
    float pmax = p0[0], pmx1 = p1[0];
#pragma unroll
    for (int r = 1; r < 16; ++r) { pmax = fmaxf(pmax, p0[r]); pmx1 = fmaxf(pmx1, p1[r]); }
    pmax = fmaxf(pmax, pmx1);
    { auto rr = __builtin_amdgcn_permlane32_swap(__float_as_uint(pmax), __float_as_uint(pmax), false, false);
      pmax = fmaxf(__uint_as_float(rr[0]), __uint_as_float(rr[1])); }
    alpha = 1.f; m_reg += pmax;
#pragma unroll
    for (int r = 0; r < 16; ++r) { p0[r] -= pmax; p1[r] -= pmax; }
}
__device__ __forceinline__ void scaleexp(f32x16& p0, f32x16& p1) {
#pragma unroll
    for (int r = 0; r < 16; ++r) p0[r] = __builtin_amdgcn_exp2f(p0[r]);
}
template <int VAR = 0>
__device__ __forceinline__ void pv_sm(f32x16* o, int vb, bf16x8 pa0, bf16x8 pa1, bf16x8 pa2, bf16x8 pa3, f32x16& q0, f32x16& q1) {
    pv_one<0, VAR>(o[0], vb, pa0, pa1, pa2, pa3);
    if (!(VAR & 1)) {
#pragma unroll
        for (int r = 0; r < 16; ++r) q0[r] = __builtin_amdgcn_exp2f(q0[r]); }
    pv_one<1, VAR>(o[1], vb, pa0, pa1, pa2, pa3);
}
__device__ __forceinline__ void fake_finish(const f32x16& p0, const f32x16& p1, bf16x8& pa0, bf16x8& pa1, bf16x8& pa2, bf16x8& pa3) {
    u32x4 w0 = {__float_as_uint(p0[0]), __float_as_uint(p0[1]), __float_as_uint(p0[2]), __float_as_uint(p0[3])}; pa0 = *reinterpret_cast<bf16x8*>(&w0);
    u32x4 w1 = {__float_as_uint(p0[4]), __float_as_uint(p0[5]), __float_as_uint(p0[6]), __float_as_uint(p0[7])}; pa1 = *reinterpret_cast<bf16x8*>(&w1);
    u32x4 w2 = {__float_as_uint(p1[0]), __float_as_uint(p1[1]), __float_as_uint(p1[2]), __float_as_uint(p1[3])}; pa2 = *reinterpret_cast<bf16x8*>(&w2);
    u32x4 w3 = {__float_as_uint(p1[4]), __float_as_uint(p1[5]), __float_as_uint(p1[6]), __float_as_uint(p1[7])}; pa3 = *reinterpret_cast<bf16x8*>(&w3);
}

template <int VAR = 0>
__device__ __forceinline__ void attn_unit(const bf16_t* __restrict__ Qb, const bf16_t* __restrict__ Kh, const bf16_t* __restrict__ Vh, bf16_t* __restrict__ Ob, int seq, LAS unsigned char* lds, int tid) {
    const int wid = tid >> 6, lane = tid & 63, r32 = lane & 31, hi = lane >> 5;
    LAS unsigned char* V_lds = lds; LAS unsigned char* K_lds = lds + 3 * SHM_V;
    LAS float* wsf = (LAS float*)(lds + 3 * SHM_V + 3 * SHM_K) + wid * 64; LAS float* li_l = wsf; LAS float* al_l = wsf + 32;
    float m_reg = 0.f, l_reg = 0; f32x16 o[2] = {}; bf16x8 qr[6];
    const bf16_t* Qw = Qb + (size_t)(wid * 32 + r32) * DQ + hi * 8;
#pragma unroll
    for (int d0 = 0; d0 < 6; ++d0) qr[d0] = *(const bf16x8*)(Qw + d0 * 16);
    const int vrow = tid >> 3, vcol = (tid & 7) * 8, vst = v_st(vrow, vcol);
    const int k0row = tid / 12, k0ch = tid % 12, k1row = (512 + tid) / 12, k1ch = (512 + tid) % 12;
    const int kst0 = KSWZ(k0row, k0ch * 16), kst1 = KSWZ(k1row, k1ch * 16);
    const bool has1 = tid < 256;
    const int vb0 = (int)(uintptr_t)V_lds + v_rd_base(lane);
    unsigned vsrc, ksrc[2];
    { const int ov = wid * 1024 + lane * 16, sbt = ov >> 9, kk = (sbt >> 1) * 8 + ((ov >> 6) & 7), k = (kk & ~0xC) | ((kk & 4) << 1) | ((kk & 8) >> 1), cc = (sbt & 1) * 32 + ((ov >> 4) & 3) * 8;
      vsrc = (unsigned)(k * DV + cc) * 2u;
#pragma unroll
      for (int i = 0; i < 2; ++i) { const int ok = wid * 2048 + i * 1024 + lane * 16, row = ok >> 8, slot = (ok >> 4) & 15, ch = slot ^ (row & 15); ksrc[i] = (unsigned)(row * DQ + (ch < 12 ? ch : 0) * 8) * 2u; } }
#define SLOAD(i, kk) do { } while (0)
#define SWRITE(b, i) do { } while (0)
#define DMA(b, kk) do { if (VAR & 4) break; \
    __builtin_amdgcn_global_load_lds((const unsigned*)((const char*)(Vh + (size_t)(kk) * DV) + vsrc), (LAS unsigned*)(V_lds + (b) * SHM_V + wid * 1024), 16, 0, 0); \
    __builtin_amdgcn_global_load_lds((const unsigned*)((const char*)(Kh + (size_t)(kk) * DQ) + ksrc[0]), (LAS unsigned*)(K_lds + (b) * SHM_K + wid * 2048), 16, 0, 0); \
    __builtin_amdgcn_global_load_lds((const unsigned*)((const char*)(Kh + (size_t)(kk) * DQ) + ksrc[1]), (LAS unsigned*)(K_lds + (b) * SHM_K + wid * 2048 + 1024), 16, 0, 0); } while (0)
#define RESC(a) do { if (__any((a) < 1.f)) { if (hi == 0) al_l[r32] = (a); asm volatile("s_waitcnt lgkmcnt(0)" ::: "memory"); \
    _Pragma("unroll") for (int d = 0; d < 2; ++d) _Pragma("unroll") for (int r = 0; r < 16; ++r) o[d][r] *= al_l[crow(r, hi)]; } } while (0)
    f32x16 pA0, pA1, pB0, pB1; float alA, alB; bf16x8 pa0, pa1, pa2, pa3; const int NT = seq / KVB;
    DMA(0, 0); DMA(1, KVB); __syncthreads();
    qkt<VAR>(pA0, pA1, K_lds, qr, r32, hi, m_reg); if (VAR & 1) { alA = 1.f; } else { decideSM_first(pA0, pA1, m_reg, alA); scaleexp(pA0, pA1); }
    int bq = 1, bp = 0, bw = 2;
    constexpr bool ordB = false;
#define FIN(P0, P1, AL) do { if (VAR & 1) fake_finish(P0, P1, pa0, pa1, pa2, pa3); else finishSM(P0, P1, AL, l_reg, pa0, pa1, pa2, pa3); } while (0)
#define DEC(P0, P1, MC, AL) do { if (VAR & 1) { AL = 1.f; } else decideSM(P0, P1, m_reg, AL); } while (0)
#define STEP(PX0, PX1, ALX, PY0, PY1, ALY, LOADSTMT, WSLOT) do { \
        if (!ordB) { LOADSTMT; qkt<VAR>(PX0, PX1, K_lds + bq * SHM_K, qr, r32, hi, m_reg); FIN(PY0, PY1, ALY); \
            DEC(PX0, PX1, 0, ALX); \
            pv_sm<VAR>(o, vb0 + bp * SHM_V, pa0, pa1, pa2, pa3, PX0, PX1); } \
        else { SBAR(); FIN(PY0, PY1, ALY); SBAR(); \
            pv_all<VAR>(o, vb0 + bp * SHM_V, pa0, pa1, pa2, pa3); SBAR(); \
            LOADSTMT; qkt<VAR>(PX0, PX1, K_lds + bq * SHM_K, qr, r32, hi, m_reg); SBAR(); \
            DEC(PX0, PX1, 0, ALX); if (!(VAR & 1)) scaleexp(PX0, PX1); SBAR(); } \
        SWRITE(bw, WSLOT); RESC(ALX); if (!(VAR & 8)) __syncthreads(); \
        { const int t3 = bp; bp = bq; bq = bw; bw = t3; } } while (0)
    for (int t = 1; t + 1 < NT; t += 2) {
        STEP(pB0, pB1, alB, pA0, pA1, alA, DMA(bw, (t + 1) * KVB), 0);
        STEP(pA0, pA1, alA, pB0, pB1, alB, DMA(bw, (t + 2) * KVB), 1);
    }
#undef STEP
    qkt<VAR>(pB0, pB1, K_lds + bq * SHM_K, qr, r32, hi, m_reg);
    if (VAR & 1) fake_finish(pA0, pA1, pa0, pa1, pa2, pa3); else finishSM(pA0, pA1, alA, l_reg, pa0, pa1, pa2, pa3);
    if (VAR & 1) { alB = 1.f; } else decideSM(pB0, pB1, m_reg, alB);
    pv_sm<VAR>(o, vb0 + bp * SHM_V, pa0, pa1, pa2, pa3, pB0, pB1);
    RESC(alB);
    if (VAR & 1) fake_finish(pB0, pB1, pa0, pa1, pa2, pa3); else finishSM(pB0, pB1, alB, l_reg, pa0, pa1, pa2, pa3);
    pv_all<VAR>(o, vb0 + bq * SHM_V, pa0, pa1, pa2, pa3);
    if (hi == 0) li_l[r32] = l_reg;
    asm volatile("s_waitcnt lgkmcnt(0)" ::: "memory");
    float rli[16];
#pragma unroll
    for (int r = 0; r < 16; ++r) rli[r] = __builtin_amdgcn_rcpf(li_l[crow(r, hi)]);
    bf16_t* Ow = Ob + (size_t)(wid * 32) * D;
#pragma unroll
    for (int r = 0; r < 16; ++r) { const int orow = crow(r, hi);
#pragma unroll
        for (int d0 = 0; d0 < 2; ++d0) Ow[(size_t)orow * D + d0 * 32 + r32] = (bf16_t)f2bf(o[d0][r] * rli[r]); }
    __syncthreads();
#undef SLOAD
#undef SWRITE
#undef DMA
#undef RESC
#undef FIN
#undef DEC
}
#undef KSWZ
#undef SBAR
}
namespace nab {
using mla::f32x16;
constexpr int SHM_V = 8192, SHM_K = 16384, RING = 3 * (SHM_V + SHM_K);
constexpr int LDS_NEED = RING + NWAVES * 256 + 2048;
constexpr float SCALE = 0.125f, C = SCALE * 1.4426950408889634f;
#define KSWZ(row, colB) ((row) * 256 + ((colB) ^ (((row) & 15) << 4)))
#define SBAR() __builtin_amdgcn_sched_barrier(0)
__device__ __forceinline__ void qkt64(f32x16& p0, f32x16& p1, LAS const unsigned char* Ks, const bf16x8* qr, int r32, int hi, float m_reg) {
#pragma unroll
    for (int r = 0; r < 16; ++r) { p0[r] = -m_reg; p1[r] = -m_reg; }
#pragma unroll
    for (int d0 = 0; d0 < 4; ++d0) { const int cb = (d0 * 16 + hi * 8) * 2;
        const bf16x8 b0 = *(LAS const bf16x8*)(Ks + KSWZ(r32, cb));
        const bf16x8 b1 = *(LAS const bf16x8*)(Ks + KSWZ(32 + r32, cb));
        p0 = __builtin_amdgcn_mfma_f32_32x32x16_bf16(b0, qr[d0], p0, 0, 0, 0);
        p1 = __builtin_amdgcn_mfma_f32_32x32x16_bf16(b1, qr[d0], p1, 0, 0, 0); }
}
__device__ __forceinline__ void unit(const bf16_t* __restrict__ Pb, int h, bool lat, int r0, LAS const float* rp, bf16_t* __restrict__ Yb, LAS unsigned char* lds, int tid) {
    const int wid = __builtin_amdgcn_readfirstlane(tid >> 6), lane = tid & 63, r32 = lane & 31, hi = lane >> 5;
    LAS unsigned char* V_lds = lds; LAS unsigned char* K_lds = lds + 3 * SHM_V;
    LAS float* wsf = (LAS float*)(lds + RING) + wid * 64; LAS float* li_l = wsf; LAS float* al_l = wsf + 32;
    const int r = r0 + (wid >> 1), qc = (wid & 1) * 32 + r32, cs = min(max(qc - 8, 0), 48);
    const int qtok = lat ? CTX + r * GW + qc : wid * 32 + r32;
    const int rs_me = min(max(r - 4, 0), 120), rs_min = min(max(r0 - 4, 0), 120), nrows = lat ? (min(max(r0 + 3 - 4, 0), 120) + 8 - rs_min) : 0;
    const int NT = (4 + nrows + 1) & ~1;
    float m_reg = 0.f, l_reg = 0; f32x16 o[2] = {}; bf16x8 qr[4];
    { const bf16_t* Qw = Pb + (size_t)qtok * INP + OFF_QA + h * 64 + hi * 8;
#pragma unroll
      for (int d0 = 0; d0 < 4; ++d0) { const u32x4 w = *(const u32x4*)(Qw + d0 * 16);
          u32x4 o4; o4.x = pk2(lo_bf(w.x) * C, hi_bf(w.x) * C); o4.y = pk2(lo_bf(w.y) * C, hi_bf(w.y) * C); o4.z = pk2(lo_bf(w.z) * C, hi_bf(w.z) * C); o4.w = pk2(lo_bf(w.w) * C, hi_bf(w.w) * C);
          qr[d0] = *reinterpret_cast<bf16x8*>(&o4); } }
    const int srow = tid >> 3, sch = tid & 7, vst = mla::v_st(srow, sch * 8), kst = KSWZ(srow, sch * 16);
    const unsigned svo = (unsigned)((srow * INP + h * 64 + sch * 8) * 2);
    const int vb0 = (int)(uintptr_t)V_lds + mla::v_rd_base(lane);
    struct { bf16x8 v, k; } sr_[2];
#define TOK0(t) ((t) < 4 ? (t) * 64 : CTX + min(rs_min + (t) - 4, 127) * GW)
#define SLOAD(i, t) do { const char* kb = (const char*)(Pb + (size_t)TOK0(t) * INP); sr_[i].k = *(const bf16x8*)(kb + svo + OFF_KA * 2); sr_[i].v = *(const bf16x8*)(kb + svo + OFF_VA * 2); } while (0)
#define SWRITE(b, i) do { *(LAS bf16x8*)(V_lds + (b) * SHM_V + vst) = sr_[i].v; *(LAS bf16x8*)(K_lds + (b) * SHM_K + kst) = sr_[i].k; } while (0)
#define RESC(a) do { if (__any((a) < 1.f)) { if (hi == 0) al_l[r32] = (a); asm volatile("s_waitcnt lgkmcnt(0)" ::: "memory"); \
    _Pragma("unroll") for (int d = 0; d < 2; ++d) _Pragma("unroll") for (int rr = 0; rr < 16; ++rr) o[d][rr] *= al_l[mla::crow(rr, hi)]; } } while (0)
#define MASK(P0, P1, t) do { if ((t) >= 4) { const int kr = rs_min + (t) - 4; \
        if ((unsigned)(kr - rs_me) < 8u) { int qcl = qc; asm volatile("" : "+v"(qcl)); const int csl = min(max(qcl - 8, 0), 48); \
            LAS const float* rl_ = rp + (kr - r + 7) * 32 + (4 * hi - qcl + 15); const int rel = 4 * hi - csl; \
            _Pragma("unroll") for (int rr = 0; rr < 16; ++rr) { const int k0c = mla::crow(rr, 0); \
                P0[rr] = ((unsigned)(rel + k0c) < 16u) ? P0[rr] + rl_[k0c] : -1e30f; \
                P1[rr] = ((unsigned)(rel + k0c + 32) < 16u) ? P1[rr] + rl_[k0c + 32] : -1e30f; } } \
        else { _Pragma("unroll") for (int rr = 0; rr < 16; ++rr) { P0[rr] = -1e30f; P1[rr] = -1e30f; } } } } while (0)
    f32x16 pA0, pA1, pB0, pB1; float alA, alB; bf16x8 pa0, pa1, pa2, pa3;
    SLOAD(0, 0); SLOAD(1, 1); SWRITE(0, 0); SWRITE(1, 1); __syncthreads();
    SLOAD(0, 2);
    qkt64(pA0, pA1, K_lds, qr, r32, hi, m_reg); mla::decideSM_first(pA0, pA1, m_reg, alA); mla::scaleexp(pA0, pA1);
    int bq = 1, bp = 0, bw = 2;
#define STEP(PX0, PX1, ALX, PY0, PY1, ALY, t, LOADSTMT, WSLOT) do { \
        qkt64(PX0, PX1, K_lds + bq * SHM_K, qr, r32, hi, m_reg); mla::finishSM(PY0, PY1, ALY, l_reg, pa0, pa1, pa2, pa3); \
        LOADSTMT; MASK(PX0, PX1, t); mla::decideSM(PX0, PX1, m_reg, ALX); \
        mla::pv_sm<0>(o, vb0 + bp * SHM_V, pa0, pa1, pa2, pa3, PX0, PX1); \
        SWRITE(bw, WSLOT); RESC(ALX); __syncthreads(); \
        { const int t3 = bp; bp = bq; bq = bw; bw = t3; } } while (0)
    for (int t = 1; t + 1 < NT; t += 2) {
        STEP(pB0, pB1, alB, pA0, pA1, alA, t, SLOAD(1, t + 2), 0);
        STEP(pA0, pA1, alA, pB0, pB1, alB, t + 1, if (t + 3 < NT) SLOAD(0, t + 3), 1);
    }
#undef STEP
    qkt64(pB0, pB1, K_lds + bq * SHM_K, qr, r32, hi, m_reg);
    mla::finishSM(pA0, pA1, alA, l_reg, pa0, pa1, pa2, pa3);
    MASK(pB0, pB1, NT - 1); mla::decideSM(pB0, pB1, m_reg, alB);
    mla::pv_sm<0>(o, vb0 + bp * SHM_V, pa0, pa1, pa2, pa3, pB0, pB1);
    RESC(alB);
    mla::finishSM(pB0, pB1, alB, l_reg, pa0, pa1, pa2, pa3);
    mla::pv_all<0>(o, vb0 + bq * SHM_V, pa0, pa1, pa2, pa3);
    if (hi == 0) li_l[r32] = l_reg;
    asm volatile("s_waitcnt lgkmcnt(0)" ::: "memory");
    const int qtok0 = lat ? CTX + r * GW + (wid & 1) * 32 : wid * 32;
    bf16_t* Ow = Yb + (size_t)qtok0 * D + h * 64;
#pragma unroll
    for (int rr = 0; rr < 16; ++rr) { const int orow = mla::crow(rr, hi); const float rl = __builtin_amdgcn_rcpf(li_l[orow]);
#pragma unroll
        for (int d0 = 0; d0 < 2; ++d0) Ow[(size_t)orow * D + d0 * 32 + r32] = (bf16_t)f2bf(o[d0][rr] * rl); }
    __syncthreads();
#undef TOK0
#undef SLOAD
#undef SWRITE
#undef RESC
#undef MASK
}
#undef KSWZ
#undef SBAR
}
__device__ __forceinline__ void phase_a1b(const Params& p, const Ctx& c, int l, bool last) {
    const bf16_t* P = (const bf16_t*)(p.ws + WS_P); bf16_t* Y = (bf16_t*)(p.ws + WS_Y);
    LAS float* rp = (LAS float*)(c.lds + nab::RING + NWAVES * 256);
    const int n_units = 256 + (last ? 0 : 8);
    const int wv = __builtin_amdgcn_readfirstlane(c.tid >> 6);
    for (int u = c.bid; u < n_units; u += c.nb) {
        const int bh = u & 7, b = bh >> 2, h = bh & 3; const bool lat = u < 256;
        __syncthreads();
        if (lat) { const float* rpb = p.na_rpb + (size_t)((l * 4 + h) * 15) * 31;
            for (int i = c.tid; i < 15 * 32; i += NTHREADS) { const int dr = i >> 5, dc = i & 31; rp[i] = dc < 31 ? rpb[dr * 31 + dc] * 1.4426950408889634f : 0.f; } }
        __syncthreads();
        nab::unit(P + (size_t)(b * LT) * INP, h, lat, lat ? (u >> 3) * 4 : 0, rp, Y + (size_t)(b * LT) * D, c.lds, c.tid);
    }
}

namespace mla2 {
using mla::f32x16; using mla::s16x4;
constexpr int DQ = 96, DV = 64, KVB = 64, SHM_V = KVB * DV * 2, SHM_K = KVB * 256, NSLOT = 5, RING = NSLOT * (SHM_V + SHM_K);
constexpr float THR2 = 8.f * 1.4426950408889634f;
#define KSWZ(row, colB) ((row) * 256 + ((colB) ^ (((row) & 15) << 4)))
#define PK4(P, BASE, OUT) do { u32x4 w = {pk2(P[BASE + 0], P[BASE + 1]), pk2(P[BASE + 2], P[BASE + 3]), pk2(P[BASE + 4], P[BASE + 5]), pk2(P[BASE + 6], P[BASE + 7])}; \
    OUT = *reinterpret_cast<bf16x8*>(&w); } while (0)
__device__ __forceinline__ float fadd_s(float a, float b) { float r; asm("v_add_f32_e32 %0, %1, %2" : "=v"(r) : "v"(a), "v"(b)); return r; }
__device__ __forceinline__ float fmax_s(float a, float b) { float r; asm("v_max_f32_e32 %0, %1, %2" : "=v"(r) : "v"(a), "v"(b)); return r; }
__device__ __forceinline__ float fmax3_s(float a, float b, float c) { float r; asm("v_max3_f32 %0, %1, %2, %3" : "=v"(r) : "v"(a), "v"(b), "v"(c)); return r; }
__device__ __forceinline__ void half_max2(const f32x16& p, const f32x16& q, float& xp, float& xq) {
    float a = fmax3_s(p[0], p[1], p[2]), c = fmax3_s(q[0], q[1], q[2]), b = fmax3_s(p[8], p[9], p[10]), d = fmax3_s(q[8], q[9], q[10]);
    a = fmax3_s(a, p[3], p[4]); c = fmax3_s(c, q[3], q[4]); b = fmax3_s(b, p[11], p[12]); d = fmax3_s(d, q[11], q[12]);
    a = fmax3_s(a, p[5], p[6]); c = fmax3_s(c, q[5], q[6]); b = fmax3_s(b, p[13], p[14]); d = fmax3_s(d, q[13], q[14]);
    a = fmax3_s(a, p[7], b); c = fmax3_s(c, q[7], d);
    a = fmaxf(a, p[15]); c = fmaxf(c, q[15]);
    auto ra = __builtin_amdgcn_permlane32_swap(__float_as_uint(a), __float_as_uint(a), false, false);
    auto rc = __builtin_amdgcn_permlane32_swap(__float_as_uint(c), __float_as_uint(c), false, false);
    xp = fmaxf(__uint_as_float(ra[0]), __uint_as_float(ra[1])); xq = fmaxf(__uint_as_float(rc[0]), __uint_as_float(rc[1]));
}
__device__ __forceinline__ float half_sum1(const f32x16& p) {
    float a0 = fadd_s(p[0], p[1]), a1 = fadd_s(p[2], p[3]), a2 = fadd_s(p[4], p[5]), a3 = fadd_s(p[6], p[7]);
    a0 = fadd_s(a0, p[8]); a1 = fadd_s(a1, p[9]); a2 = fadd_s(a2, p[10]); a3 = fadd_s(a3, p[11]);
    a0 = fadd_s(a0, p[12]); a1 = fadd_s(a1, p[13]); a2 = fadd_s(a2, p[14]); a3 = fadd_s(a3, p[15]);
    a0 = fadd_s(a0, a1); a2 = fadd_s(a2, a3);
    a0 = a0 + a2;
    auto ra = __builtin_amdgcn_permlane32_swap(__float_as_uint(a0), __float_as_uint(a0), false, false);
    return __uint_as_float(ra[0]) + __uint_as_float(ra[1]);
}
__device__ __forceinline__ void half_sum2(const f32x16& p, const f32x16& q, float& sp_, float& sq_) {
    float a0 = fadd_s(p[0], p[1]), c0 = fadd_s(q[0], q[1]), a1 = fadd_s(p[2], p[3]), c1 = fadd_s(q[2], q[3]);
    float a2 = fadd_s(p[4], p[5]), c2 = fadd_s(q[4], q[5]), a3 = fadd_s(p[6], p[7]), c3 = fadd_s(q[6], q[7]);
    a0 = fadd_s(a0, p[8]); c0 = fadd_s(c0, q[8]); a1 = fadd_s(a1, p[9]); c1 = fadd_s(c1, q[9]); a2 = fadd_s(a2, p[10]); c2 = fadd_s(c2, q[10]); a3 = fadd_s(a3, p[11]); c3 = fadd_s(c3, q[11]);
    a0 = fadd_s(a0, p[12]); c0 = fadd_s(c0, q[12]); a1 = fadd_s(a1, p[13]); c1 = fadd_s(c1, q[13]); a2 = fadd_s(a2, p[14]); c2 = fadd_s(c2, q[14]); a3 = fadd_s(a3, p[15]); c3 = fadd_s(c3, q[15]);
    a0 = fadd_s(a0, a1); c0 = fadd_s(c0, c1); a2 = fadd_s(a2, a3); c2 = fadd_s(c2, c3); a0 = fadd_s(a0, a2); c0 = fadd_s(c0, c2);
    auto ra = __builtin_amdgcn_permlane32_swap(__float_as_uint(a0), __float_as_uint(a0), false, false);
    auto rc = __builtin_amdgcn_permlane32_swap(__float_as_uint(c0), __float_as_uint(c0), false, false);
    sp_ = fadd_s(__uint_as_float(ra[0]), __uint_as_float(ra[1])); sq_ = fadd_s(__uint_as_float(rc[0]), __uint_as_float(rc[1]));
}
template <int VAR = 0>
__device__ __forceinline__ void attn_unit(const bf16_t* __restrict__ Qb, const bf16_t* __restrict__ Kh, const bf16_t* __restrict__ Vh, bf16_t* __restrict__ Ob, int seq, LAS unsigned char* lds, int tid_wave) {
    int lane_; asm volatile("v_mbcnt_lo_u32_b32 %0, -1, 0\n\tv_mbcnt_hi_u32_b32 %0, -1, %0" : "=v"(lane_));
    const int wid = tid_wave, lane = lane_, r32 = lane & 31, hi = lane >> 5, g = wid >> 1, kh = wid & 1;
    const bool grpY = (VAR & 2) ? false : (VAR & 1) ? (wid & 1) != 0 : wid >= 4;
    LAS unsigned char* V_lds = lds; LAS unsigned char* K_lds = lds + NSLOT * SHM_V;
    LAS float* wsf = (LAS float*)(lds + RING) + wid * 128;
    float m0 = 0.f, m1 = 0.f, l0 = 0.f, l1 = 0.f; f32x16 o0[2] = {}, o1[2] = {}; bf16x8 q0[6], q1[6];
    { const unsigned qo = (unsigned)(((g * 64 + r32) * DQ + hi * 8) * 2);
#pragma unroll
      for (int d0 = 0; d0 < 6; ++d0) { q0[d0] = *(const bf16x8*)((const char*)Qb + qo + d0 * 32); q1[d0] = *(const bf16x8*)((const char*)Qb + qo + 32 * DQ * 2 + d0 * 32); } }
    unsigned vsrc, ksrc[2];
    { const int ov = wid * 1024 + lane * 16, sbt = ov >> 9, k = (sbt >> 1) * 8 + ((ov >> 6) & 7), cc = (sbt & 1) * 32 + ((ov >> 4) & 3) * 8;
      vsrc = (unsigned)(k * DV + cc) * 2u;
#pragma unroll
      for (int i = 0; i < 2; ++i) { const int ok = wid * 2048 + i * 1024 + lane * 16, row = ok >> 8, slot = (ok >> 4) & 15, ch = slot ^ (row & 15); ksrc[i] = (unsigned)(row * DQ + (ch < 12 ? ch : 0) * 8) * 2u; } }
#define DMA_V(b, kk) do { const char* vb_ = (const char*)(Vh + (size_t)(kk) * DV); asm volatile("" : "+s"(vb_), "+v"(vsrc));        \
    __builtin_amdgcn_global_load_lds((const unsigned*)(vb_ + vsrc), (LAS unsigned*)(V_lds + (b) * SHM_V + wid * 1024), 16, 0, 0); } while (0)
#define DMA_K(b, kk) do { const char* kb_ = (const char*)(Kh + (size_t)(kk) * DQ); asm volatile("" : "+s"(kb_), "+v"(ksrc[0]), "+v"(ksrc[1])); \
    __builtin_amdgcn_global_load_lds((const unsigned*)(kb_ + ksrc[0]), (LAS unsigned*)(K_lds + (b) * SHM_K + wid * 2048), 16, 0, 0); \
    __builtin_amdgcn_global_load_lds((const unsigned*)(kb_ + ksrc[1]), (LAS unsigned*)(K_lds + (b) * SHM_K + wid * 2048 + 1024), 16, 0, 0); } while (0)
#define WAIT_V(n) asm volatile("s_waitcnt vmcnt(" #n ")" ::: "memory")
#define BAR() __builtin_amdgcn_s_barrier()
    const int vb0 = (int)(uintptr_t)V_lds + mla::v_rd_base(lane) + kh * 2 * 2048;
    const int kb0 = (int)(uintptr_t)K_lds + (32 * kh + r32) * 256;
    const int NT = seq / KVB;
    DMA_K(0, 0); DMA_V(0, 0); DMA_K(1, KVB); DMA_V(1, KVB); DMA_K(2, 2 * KVB); DMA_V(2, 2 * KVB); DMA_K(3, 3 * KVB);
    WAIT_V(0); BAR();
    if (grpY) BAR();
    f32x16 p0, p1; bf16x8 pa00, pa01, pa10, pa11, kf[6]; s16x4 vl[2][2], vh[2][2];
    s16x4 one0, one1, nmB;
    { u32x2 w0 = {hi == 0 ? 0x00003F80u : 0u, 0u}, w1 = {hi == 0 ? 0x3F800000u : 0u, 0u}, wz = {0u, 0u};
      one0 = *reinterpret_cast<s16x4*>(&w0); one1 = *reinterpret_cast<s16x4*>(&w1); nmB = *reinterpret_cast<s16x4*>(&wz); }
    const f32x16 zero16 = {};
#pragma unroll
    for (int r = 0; r < 16; ++r) { p0[r] = 0.f; p1[r] = 0.f; }
#define SB() __builtin_amdgcn_sched_barrier(0)
#define KREAD(sK, DLO) do { int bx = hi * 16 ^ ((r32 & 15) << 4); asm volatile("" : "+v"(bx));        \
        _Pragma("unroll") for (int d0 = DLO; d0 < DLO + 3; ++d0) kf[d0] = *(LAS const bf16x8*)(uintptr_t)(unsigned)(kb0 + (sK) * SHM_K + (bx ^ (d0 * 32))); } while (0)
#define KREAD1(sK, D0_) do { kf[D0_] = *(LAS const bf16x8*)(uintptr_t)(unsigned)(kb0 + (sK) * SHM_K + (bxm ^ ((D0_) * 32))); } while (0)
#define QK1(D0_) do { if (VAR & 8) { asm volatile("" :: "v"(kf[D0_]), "v"(q0[D0_]), "v"(q1[D0_])); } else { \
        p0 = __builtin_amdgcn_mfma_f32_32x32x16_bf16(kf[D0_], q0[D0_], p0, 0, 0, 0); p1 = __builtin_amdgcn_mfma_f32_32x32x16_bf16(kf[D0_], q1[D0_], p1, 0, 0, 0); } } while (0)
#define QK() do { _Pragma("unroll") for (int d0 = 0; d0 < 6; ++d0) { \
        if (VAR & 8) { asm volatile("" :: "v"(kf[d0]), "v"(q0[d0]), "v"(q1[d0])); } else { \
        p0 = __builtin_amdgcn_mfma_f32_32x32x16_bf16(kf[d0], q0[d0], p0, 0, 0, 0); p1 = __builtin_amdgcn_mfma_f32_32x32x16_bf16(kf[d0], q1[d0], p1, 0, 0, 0); } } } while (0)
#define PVSTEP(D0, KS, PA0, PA1) do { const bf16x8 vf = (bf16x8){vl[D0][KS][0], vl[D0][KS][1], vl[D0][KS][2], vl[D0][KS][3], vh[D0][KS][0], vh[D0][KS][1], vh[D0][KS][2], vh[D0][KS][3]}; \
        if (VAR & 8) { asm volatile("" :: "v"(vf), "v"(PA0), "v"(PA1)); } else { \
        o0[D0] = __builtin_amdgcn_mfma_f32_32x32x16_bf16(PA0, vf, o0[D0], 0, 0, 0); o1[D0] = __builtin_amdgcn_mfma_f32_32x32x16_bf16(PA1, vf, o1[D0], 0, 0, 0); } } while (0)
#define EXP4(P, R0) do { _Pragma("unroll") for (int r = R0; r < R0 + 4; ++r) P[r] = __builtin_amdgcn_exp2f(P[r]); } while (0)
#define PINIT(P, M, R0) do { _Pragma("unroll") for (int r = R0; r < R0 + 8; ++r) P[r] = -M; } while (0)
#define VREAD(sV, KS) do { const int vb = vb0 + (sV) * SHM_V; \
        vl[0][KS] = mla::tr_read<mla::v_rd_off(0, KS, 0)>(vb); vh[0][KS] = mla::tr_read<mla::v_rd_off(0, KS, 1)>(vb); vl[1][KS] = mla::tr_read<mla::v_rd_off(1, KS, 0)>(vb); vh[1][KS] = mla::tr_read<mla::v_rd_off(1, KS, 1)>(vb); } while (0)
#define FAKE4(P, BASE, OUT) do { u32x4 w = {__float_as_uint(P[BASE]), __float_as_uint(P[BASE + 1]), __float_as_uint(P[BASE + 2]), __float_as_uint(P[BASE + 3])}; OUT = *reinterpret_cast<bf16x8*>(&w); } while (0)
#define VBLOCK(HASK) do { if (VAR & 4) { FAKE4(p0, 0, pa00); FAKE4(p0, 8, pa01); FAKE4(p1, 0, pa10); FAKE4(p1, 8, pa11); SB(); BAR(); SB(); break; } \
        if (!(VAR & 128)) __builtin_amdgcn_s_setprio(1);        \
          \
        asm volatile("s_nop 15\n\ts_nop 3" ::: "memory"); SB();        \
        float x0, x1; half_max2(p0, p1, x0, x1); \
        float a0 = 1.f, a1 = 1.f; \
        if (t == 0 || !__all(fmaxf(x0, x1) <= THR2)) { \
              \
            const float mn0 = bf2f((bf16_t)f2bf(m0 + (t == 0 ? x0 : fmaxf(x0, 0.f)))), mn1 = bf2f((bf16_t)f2bf(m1 + (t == 0 ? x1 : fmaxf(x1, 0.f)))); \
            const float d0 = mn0 - m0, d1 = mn1 - m1; m0 = mn0; m1 = mn1; \
            a0 = t == 0 ? 1.f : __builtin_amdgcn_exp2f(-d0); a1 = t == 0 ? 1.f : __builtin_amdgcn_exp2f(-d1); \
            { u32x2 w = {hi == 0 ? pk2(-m0, -m1) : 0u, 0u}; nmB = *reinterpret_cast<s16x4*>(&w); } \
            _Pragma("unroll") for (int r = 0; r < 16; ++r) { p0[r] -= d0; p1[r] -= d1; } \
            if (t > 0) {        \
                int l2 = lane; asm volatile("" : "+v"(l2)); const int r2 = l2 & 31, h2 = l2 >> 5;        \
                if (h2 == 0) { wsf[r2] = a0; wsf[32 + r2] = a1; } \
                asm volatile("s_waitcnt lgkmcnt(0)" ::: "memory"); \
                _Pragma("unroll") for (int r = 0; r < 16; ++r) { const float f0 = wsf[mla::crow(r, h2)], f1 = wsf[32 + mla::crow(r, h2)]; o0[0][r] *= f0; o0[1][r] *= f0; o1[0][r] *= f1; o1[1][r] *= f1; } \
            } \
        } \
          \
        { float sa, sb, sc, sd; \
          EXP4(p0, 0); SB(); \
          EXP4(p0, 4); sa = fadd_s(p0[0], p0[1]); sb = fadd_s(p0[2], p0[3]); SB(); \
          EXP4(p0, 8); sa = fadd_s(sa, p0[4]); sb = fadd_s(sb, p0[5]); sa = fadd_s(sa, p0[6]); sb = fadd_s(sb, p0[7]); SB(); \
          EXP4(p0, 12); sa = fadd_s(sa, p0[8]); sb = fadd_s(sb, p0[9]); sa = fadd_s(sa, p0[10]); sb = fadd_s(sb, p0[11]); PK4(p0, 0, pa00); SB(); \
          EXP4(p1, 0); sa = fadd_s(sa, p0[12]); sb = fadd_s(sb, p0[13]); sa = fadd_s(sa, p0[14]); sb = fadd_s(sb, p0[15]); SB(); \
          EXP4(p1, 4); sc = fadd_s(p1[0], p1[1]); sd = fadd_s(p1[2], p1[3]); PK4(p0, 8, pa01); \
          { const float s0_ = sa + sb;        \
            auto rs = __builtin_amdgcn_permlane32_swap(__float_as_uint(s0_), __float_as_uint(s0_), false, false); l0 = l0 * a0 + (__uint_as_float(rs[0]) + __uint_as_float(rs[1])); } SB(); \
          EXP4(p1, 8); sc = fadd_s(sc, p1[4]); sd = fadd_s(sd, p1[5]); sc = fadd_s(sc, p1[6]); sd = fadd_s(sd, p1[7]); SB(); \
          EXP4(p1, 12); sc = fadd_s(sc, p1[8]); sd = fadd_s(sd, p1[9]); sc = fadd_s(sc, p1[10]); sd = fadd_s(sd, p1[11]); PK4(p1, 0, pa10); SB(); \
          sc = fadd_s(sc, p1[12]); sd = fadd_s(sd, p1[13]); sc = fadd_s(sc, p1[14]); sd = fadd_s(sd, p1[15]); PK4(p1, 8, pa11); \
          { const float s1_ = sc + sd; \
            auto rs = __builtin_amdgcn_permlane32_swap(__float_as_uint(s1_), __float_as_uint(s1_), false, false); l1 = l1 * a1 + (__uint_as_float(rs[0]) + __uint_as_float(rs[1])); } } \
        if (!(VAR & 128)) __builtin_amdgcn_s_setprio(0); SB(); BAR(); SB(); } while (0)
#define MBLOCK(FULL) do { const int j = t + 1; \
        if (VAR & 32) { } else if (FULL) { WAIT_V(3); DMA_K(s, (j + 4) * KVB); DMA_V(sm, (j + 3) * KVB); } else { WAIT_V(0); if (j + 3 < NT) DMA_V(sm, (j + 3) * KVB); } \
        if (VAR & 16) __builtin_amdgcn_s_setprio(1); \
        PVSTEP(0, 0, pa00, pa10); PVSTEP(1, 0, pa00, pa10); PVSTEP(0, 1, pa01, pa11); PVSTEP(1, 1, pa01, pa11); SB(); \
        if (VAR & 8) { PINIT(p0, m0, 0); PINIT(p0, m0, 8); PINIT(p1, m1, 0); PINIT(p1, m1, 8); } else { \
        p0 = __builtin_amdgcn_mfma_f32_32x32x8bf16_1k(one0, nmB, zero16, 0, 0, 0); p1 = __builtin_amdgcn_mfma_f32_32x32x8bf16_1k(one1, nmB, zero16, 0, 0, 0); } \
        { const int sp2 = sp == NSLOT - 1 ? 0 : sp + 1; const bool hk = (FULL) || j + 1 < NT; int bxm = hi * 16 ^ ((r32 & 15) << 4); asm volatile("" : "+v"(bxm));        \
          if (VAR & 64) { QK(); } else { \
          QK1(0); VREAD(sp, 0); SB(); QK1(1); VREAD(sp, 1); SB(); QK1(2); if (hk) { KREAD1(sp2, 0); KREAD1(sp2, 1); } SB(); QK1(3); if (hk) { KREAD1(sp2, 2); KREAD1(sp2, 3); } SB(); \
          QK1(4); if (hk) KREAD1(sp2, 4); SB(); QK1(5); if (hk) KREAD1(sp2, 5); } } \
        if (VAR & 16) __builtin_amdgcn_s_setprio(0); SB(); BAR(); SB(); \
        sm = s; s = sp; sp = sp == NSLOT - 1 ? 0 : sp + 1; } while (0)
    if (4 < NT) DMA_K(4, 4 * KVB);
    DMA_V(3, 3 * KVB);
    KREAD(0, 0); KREAD(0, 3); QK(); SB();
    VREAD(0, 0); VREAD(0, 1); KREAD(1, 0); KREAD(1, 3);
    SB(); BAR(); SB();
    int s = 0, sp = 1, sm = 4, t = 0;
#pragma unroll 1
    for (; t + 5 < NT; ++t) { VBLOCK(true); MBLOCK(true); }
#pragma unroll 1
    for (; t + 1 < NT; ++t) { VBLOCK(true); MBLOCK(false); }
    VBLOCK(false);
    PVSTEP(0, 0, pa00, pa10); PVSTEP(1, 0, pa00, pa10); PVSTEP(0, 1, pa01, pa11); PVSTEP(1, 1, pa01, pa11);
    SB(); BAR(); SB();
    if (!grpY) BAR();
#undef KREAD
#undef QK
#undef QK1
#undef KREAD1
#undef PVSTEP
#undef VREAD
#undef VBLOCK
#undef PINIT
#undef EXP4
#undef FAKE4
#undef MBLOCK
#undef SB
    LAS float* mg = (LAS float*)lds + g * (66 * 64);
    if (kh == 1) {
#pragma unroll
        for (int r = 0; r < 16; ++r) { mg[(r) * 64 + lane] = o0[0][r]; mg[(16 + r) * 64 + lane] = o0[1][r]; mg[(32 + r) * 64 + lane] = o1[0][r]; mg[(48 + r) * 64 + lane] = o1[1][r]; }
        if (hi == 0) { mg[64 * 64 + r32] = m0; mg[64 * 64 + 32 + r32] = l0; mg[65 * 64 + r32] = m1; mg[65 * 64 + 32 + r32] = l1; }
    }
    __syncthreads();
    if (kh == 0) {
        const float mb0 = mg[64 * 64 + r32], lb0 = mg[64 * 64 + 32 + r32], mb1 = mg[65 * 64 + r32], lb1 = mg[65 * 64 + 32 + r32];
        const float M0 = fmaxf(m0, mb0), M1 = fmaxf(m1, mb1);
        const float fa0 = __builtin_amdgcn_exp2f(m0 - M0), fb0 = __builtin_amdgcn_exp2f(mb0 - M0), fa1 = __builtin_amdgcn_exp2f(m1 - M1), fb1 = __builtin_amdgcn_exp2f(mb1 - M1);
        const float il0 = __builtin_amdgcn_rcpf(l0 * fa0 + lb0 * fb0), il1 = __builtin_amdgcn_rcpf(l1 * fa1 + lb1 * fb1);
        LAS float* fx = wsf;
        if (hi == 0) { fx[r32] = fa0 * il0; fx[32 + r32] = fb0 * il0; fx[64 + r32] = fa1 * il1; fx[96 + r32] = fb1 * il1; }
        asm volatile("s_waitcnt lgkmcnt(0)" ::: "memory");
        int ll = lane; asm volatile("" : "+v"(ll));
        char* Ol = (char*)(Ob + (size_t)(g * 64) * D) + (unsigned)(((ll >> 5) * 4 * D + (ll & 31)) * 2);
#pragma unroll
        for (int r = 0; r < 16; ++r) { const int orow = mla::crow(r, hi), rowc = (r & 3) + 8 * (r >> 2);
            const float ca0 = fx[orow], cb0 = fx[32 + orow], ca1 = fx[64 + orow], cb1 = fx[96 + orow];
#pragma unroll
            for (int d0 = 0; d0 < 2; ++d0) {
                *(bf16_t*)(Ol + (rowc * D + d0 * 32) * 2) = (bf16_t)f2bf(o0[d0][r] * ca0 + mg[(d0 * 16 + r) * 64 + lane] * cb0);
                *(bf16_t*)(Ol + ((32 + rowc) * D + d0 * 32) * 2) = (bf16_t)f2bf(o1[d0][r] * ca1 + mg[(32 + d0 * 16 + r) * 64 + lane] * cb1); } }
    }
    __syncthreads();
#undef DMA_V
#undef DMA_K
#undef WAIT_V
#undef BAR
}
#undef KSWZ
#undef PK4
}
template <int VAR = 0>
__device__ __forceinline__ void phase_a2(const Params& p, const Ctx& c, bool last) {
    const bf16_t* Q = (const bf16_t*)(p.ws + WS_Q); const bf16_t* Kb = (const bf16_t*)(p.ws + WS_K); const bf16_t* Vb = (const bf16_t*)(p.ws + WS_V);
    bf16_t* Y = (bf16_t*)(p.ws + WS_Y);
    const int n_units = 256 + (last ? 0 : 8);
    const int wv = __builtin_amdgcn_readfirstlane(c.tid >> 6);
    for (int u = c.bid; u < n_units; u += c.nb) {
        const int bh = u & 7, b = bh >> 2, h = bh & 3;
        const int t0 = u < 256 ? CTX + (u >> 3) * 256 : 0, seq = u < 256 ? LT : CTX;
        const size_t hb = (size_t)(b * 4 + h) * LT;
        if (VAR == 0 || VAR >= 16) mla2::attn_unit<(VAR >= 16 ? VAR - 16 : 0)>(Q + (hb + t0) * 96, Kb + hb * 96, Vb + hb * 64, Y + (size_t)(b * LT + t0) * D + 768 + h * 64, seq, c.lds, wv);
        else mla::attn_unit<VAR>(Q + (hb + t0) * 96, Kb + hb * 96, Vb + hb * 64, Y + (size_t)(b * LT + t0) * D + 768 + h * 64, seq, c.lds, c.tid);
    }
}

__device__ __forceinline__ void phase_o2(const Params& p, const Ctx& c, int l, bool last) {
    LAS float* gt = (LAS float*)c.lds;
    LAS float* sh = gt + 3 * D;
    LAS float* sc = sh + 3 * D;
    LAS int* lcnt = (LAS int*)(sc + 3 * D);
    load_mods(p, c, l, 2, gt); load_mods(p, c, l, 3, sh); load_mods(p, c, l, 4, sc);
    if (c.tid < NE) lcnt[c.tid] = 0;
    LAS float* rwl = (LAS float*)(c.lds + 40960);
    for (int i = c.tid; i < D * 4; i += NTHREADS) { const int n = i >> 2, q4 = i & 3; *(LAS f32x4*)(rwl + ((n & 3) * 256 + (n >> 2)) * 20 + 4 * q4) = *(const f32x4*)(p.router_w + (size_t)n * 16 + 4 * q4); }
    LAS float* g1 = (LAS float*)(c.lds + 122880); LAS float* g2 = g1 + D;
    for (int i = c.tid; i < D; i += NTHREADS) { g1[i] = p.g_norm[(size_t)(l * 4 + 1) * D + i]; g2[i] = p.g_norm[(size_t)(l * 4 + 2) * D + i]; }
    __syncthreads();
    const bf16_t* YO = (const bf16_t*)(p.ws + WS_P); bf16_t* H = (bf16_t*)(p.ws + WS_H);
    int* RE = (int*)(p.ws + WS_RE); float* RW = (float*)(p.ws + WS_RW);
    const int nrow = last ? NB * S : M;
#define O2_ROW(i) (last ? ((i) / S) * LT + CTX + ((i) % S) : (i))
#define O2_LOAD(i) do { const int m_ = O2_ROW(i); const bf16_t* yr_ = YO + (size_t)m_ * D; \
        _Pragma("unroll") for (int j = 0; j < 4; ++j) ywn[j] = *(const u32x2*)((const char*)yr_ + (unsigned)(8 * (c.lane + 64 * j))); \
        if (l == 0) { const float* xr_ = xin_row(p, m_); _Pragma("unroll") for (int j = 0; j < 4; ++j) xvn[j] = *(const f32x4*)((const char*)xr_ + (unsigned)(16 * (c.lane + 64 * j))); } \
        else { const bf16_t* xr_ = xb_row(p, m_); _Pragma("unroll") for (int j = 0; j < 4; ++j) xbn[j] = *(const u32x2*)((const char*)xr_ + (unsigned)(8 * (c.lane + 64 * j))); } } while (0)
    u32x2 ywn[4], xbn[4]; f32x4 xvn[4];
    if (c.gw < nrow) O2_LOAD(c.gw);
#pragma unroll 1
    for (int ri = c.gw; ri < nrow; ri += c.ngw) {
        const int m = O2_ROW(ri);
        const int b = m / LT, t = m - b * LT, r = t < CTX ? 2 : b;
        f32x4 y[4], xv[4]; float ss = 0.f;
#pragma unroll
        for (int j = 0; j < 4; ++j) { y[j] = bf4(ywn[j]); xv[j] = (l == 0) ? xvn[j] : bf4(xbn[j]);
            ss += y[j].x * y[j].x + y[j].y * y[j].y + y[j].z * y[j].z + y[j].w * y[j].w; }
        if (ri + c.ngw < nrow) O2_LOAD(ri + c.ngw);
        const float rstd = rsqrtf(wave_sum(ss) * (1.f / D) + 1e-6f);
        float s2 = 0.f;
#pragma unroll
        for (int j = 0; j < 4; ++j) { const int n = 4 * (c.lane + 64 * j); const f32x4 gg = *(LAS const f32x4*)(g1 + n);
#pragma unroll
            for (int e = 0; e < 4; ++e) { xv[j][e] += gt[r * D + n + e] * (y[j][e] * rstd * gg[e]); s2 += xv[j][e] * xv[j][e]; }
            if (t < CTX) *(f32x4*)((char*)xc_row(p, m) + (unsigned)(n * 4)) = xv[j]; else *(u32x2*)((char*)xb_row(p, m) + (unsigned)(n * 2)) = pk4(xv[j]); }
        const float rstd2 = rsqrtf(wave_sum(s2) * (1.f / D) + 1e-6f);
        float lg[16];
#pragma unroll
        for (int e = 0; e < 16; ++e) lg[e] = 0.f;
#pragma unroll
        for (int j = 0; j < 4; ++j) { const int n = 4 * (c.lane + 64 * j); const f32x4 gg = *(LAS const f32x4*)(g2 + n);
            float o[4];
#pragma unroll
            for (int e = 0; e < 4; ++e) { o[e] = xv[j][e] * rstd2 * gg[e] * (1.f + sc[r * D + n + e]) + sh[r * D + n + e];
                LAS const f32x4* rw = (LAS const f32x4*)(rwl + (e * 256 + c.lane + 64 * j) * 20);
#pragma unroll
                for (int q4 = 0; q4 < 4; ++q4) { const f32x4 w = rw[q4]; lg[4 * q4] += o[e] * w.x; lg[4 * q4 + 1] += o[e] * w.y; lg[4 * q4 + 2] += o[e] * w.z; lg[4 * q4 + 3] += o[e] * w.w; } }
            u32x2 w; w.x = pk2(o[0], o[1]); w.y = pk2(o[2], o[3]);
            *(u32x2*)(H + (size_t)m * D + n) = w; }
        float aff[16], sel[16];
#pragma unroll
        for (int e = 0; e < 16; ++e) { aff[e] = sigmoidf_(wave_sum(lg[e])); sel[e] = aff[e] + p.router_b[e]; }
        float bv = -INFINITY, ba0 = 0.f, ba1 = 0.f; int bi0 = 0, bi1 = 0;
#pragma unroll
        for (int g = 0; g < 4; ++g) {
            float m1 = sel[4 * g], a1 = aff[4 * g]; int i0 = 0;
#pragma unroll
            for (int i = 1; i < 4; ++i) if (sel[4 * g + i] > m1) { m1 = sel[4 * g + i]; a1 = aff[4 * g + i]; i0 = i; }
            float m2 = -INFINITY, a2 = 0.f; int i1 = 0;
#pragma unroll
            for (int i = 0; i < 4; ++i) if (i != i0 && sel[4 * g + i] > m2) { m2 = sel[4 * g + i]; a2 = aff[4 * g + i]; i1 = i; }
            const float gs = m1 + m2;
            if (gs > bv) { bv = gs; bi0 = 4 * g + i0; bi1 = 4 * g + i1; ba0 = a1; ba1 = a2; }
        }
        if (c.lane == 0) {
            const float inv = 1.f / (ba0 + ba1);
            const int lp0 = __hip_atomic_fetch_add(lcnt + bi0, 1, __ATOMIC_RELAXED, __HIP_MEMORY_SCOPE_WORKGROUP);
            const int lp1 = __hip_atomic_fetch_add(lcnt + bi1, 1, __ATOMIC_RELAXED, __HIP_MEMORY_SCOPE_WORKGROUP);
            RE[2 * m] = bi0 + 16 * lp0; RE[2 * m + 1] = bi1 + 16 * lp1; RW[2 * m] = ba0 * inv; RW[2 * m + 1] = ba1 * inv;
        }
    }
    __syncthreads();
    if (c.tid < NE) ((int*)(p.ws + WS_PERM))[c.bid * NE + c.tid] = lcnt[c.tid];
}

__device__ __forceinline__ void phase_r2(const Params& p, const Ctx& c, int l, bool last) {
    LAS int* cntT = (LAS int*)c.lds;
    LAS int* map = (LAS int*)(c.lds + 131072); LAS int* nE = map + 768; LAS int* ebase = nE + NE;
    const int* BC = (const int*)(p.ws + WS_PERM); const int* RE = (const int*)(p.ws + WS_RE);
    for (int i = c.tid; i < c.nb * NE; i += NTHREADS) cntT[i] = BC[i];
    for (int i = c.tid; i < 768; i += NTHREADS) map[i] = -1;
    __syncthreads();
    if (c.tid < NE) { int acc = 0; for (int b2 = 0; b2 < c.nb; ++b2) { const int v = cntT[b2 * NE + c.tid]; cntT[b2 * NE + c.tid] = acc; acc += v; } nE[c.tid] = acc; }
    __syncthreads();
    if (c.tid < NE) { int acc = 0; for (int e = 0; e < c.tid; ++e) acc += (nE[e] + 255) >> 8; ebase[c.tid] = acc * 256;
        if (c.bid == 0) ((unsigned*)(p.ws + WS_CTL))[CW_CNT + l * 64 + c.tid] = (unsigned)nE[c.tid]; }
    __syncthreads();
    const int rt0 = c.bid >> 2, rt1 = (c.nb + c.bid) >> 2, rt2 = (2 * c.nb + c.bid) >> 2, ngw = c.nb * NWAVES;
    for (int m = c.tid; m < M; m += NTHREADS) {
        const int b = m / LT, t = m - b * LT;
        if (last && t < CTX) continue;
        const int blk = ((last ? b * S + (t - CTX) : m) % ngw) >> 3;
#pragma unroll
        for (int k = 0; k < 2; ++k) { const int info = RE[2 * m + k], e = info & 15, pos = ebase[e] + cntT[blk * NE + e] + (info >> 4), rt = pos >> 8;
            if (rt == rt0) map[pos & 255] = 2 * m + k; else if (rt == rt1) map[256 + (pos & 255)] = 2 * m + k; else if (rt == rt2) map[512 + (pos & 255)] = 2 * m + k; }
    }
    __syncthreads();
    if ((c.bid & 3) == 0) { int tot = 0; for (int e = 0; e < NE; ++e) tot += (nE[e] + 255) >> 8;
        int* S2P = (int*)(p.ws + WS_S2P);
        for (int i = c.tid; i < 768; i += NTHREADS) { const int rt = (i < 256) ? rt0 : (i < 512 ? rt1 : rt2); if (rt < tot) __hip_atomic_store(&S2P[rt * 256 + (i & 255)], map[i], __ATOMIC_RELAXED, __HIP_MEMORY_SCOPE_AGENT); } }
    pg8::Gemm g{(const bf16_t*)(p.ws + WS_H), (const bf16_t*)(p.ws + WS_WGU) + (size_t)l * NE * 1024 * 1024, 0, 0, D};
    unsigned* dn = (unsigned*)(p.ws + WS_CTL) + CW_DONE + l * 8192;
    pg8::MoeOrderLP S{nE, c.nb, c.bid, dn};
    pg8::EpiSwiGLU E{(bf16_t*)(p.ws + WS_Q)};
    pg8::MoeGatherA GA{map};
    pg8::gemm_phase<pg8::EpiSwiGLU, pg8::MoeOrderLP, true, true, pg8::MoeGatherA>(c.lds, g, S, E, c.tid, GA);
    if (l == 0) {
        int tot = 0; for (int e = 0; e < NE; ++e) tot += (nE[e] + 255) >> 8;
        const int nfull = min(max(4 * tot - 2 * c.nb, 0), c.nb);
        __syncthreads();
        const int lo1 = c.nb == 256 ? (CV_FA + CV_FB < CV_ALL ? CV_FA + CV_FB : CV_ALL) : 0;
        if (c.bid >= nfull) convert_weights(p, c, 1, lo1, CV_ALL, (c.bid - nfull) * NWAVES + c.wave, (c.nb - nfull) * NWAVES);
        else if (nfull == c.nb) convert_weights(p, c, 1, lo1, CV_ALL, c.gw, c.ngw);
    }
    asm volatile("s_waitcnt vmcnt(0)" ::: "memory");
    if (c.wave == 0) __builtin_amdgcn_fence(__ATOMIC_ACQUIRE, "agent");
    __syncthreads();
    { int tot = 0; for (int e = 0; e < NE; ++e) tot += (nE[e] + 255) >> 8;
      const int U = 4 * tot, nA0 = U - 2 * c.nb;
      const int nA = (nA0 > 0 && nA0 < c.nb && U <= 3 * c.nb) ? nA0 : 0;
      const int ka = l == 0 ? R3_KA0 : 1;
      pg8::Gemm g3{(const bf16_t*)(p.ws + WS_Q), (const bf16_t*)(p.ws + WS_WD) + (size_t)l * NE * 1024 * 512, 0, 0, DE};
      pg8::MoeOrderC S3{nE, c.nb, c.bid, nA, ka, dn};
      pg8::EpiScatter E3{(bf16_t*)(p.ws + WS_P), (const int*)(p.ws + WS_S2P), (const float*)(p.ws + WS_RW), M};
      pg8::gemm_phase<pg8::EpiScatter, pg8::MoeOrderC, true, true>(c.lds, g3, S3, E3, c.tid); }
}
__device__ __forceinline__ void phase_r3(const Params& p, const Ctx& c, int l) {
    pg8::Gemm g{(const bf16_t*)(p.ws + WS_Q), (const bf16_t*)(p.ws + WS_WD) + (size_t)l * NE * 1024 * 512, 0, 0, DE};
    pg8::MoeOrder S{(const unsigned*)(p.ws + WS_CTL) + CW_CNT + l * 64, c.nb, c.bid};
    pg8::EpiScatter E{(bf16_t*)(p.ws + WS_P), (const int*)(p.ws + WS_S2P), (const float*)(p.ws + WS_RW), M};
    pg8::gemm_phase<pg8::EpiScatter, pg8::MoeOrder, true, true>(c.lds, g, S, E, c.tid);
}

__device__ __forceinline__ void phase_f(const Params& p, const Ctx& c, int l, bool last) {
    LAS float* gt = (LAS float*)c.lds; LAS float* sh = gt + 3 * D; LAS float* sc = sh + 3 * D;
    load_mods(p, c, l, 5, gt);
    if (!last) { load_mods(p, c, l + 1, 0, sh); load_mods(p, c, l + 1, 1, sc); }
    __syncthreads();
    const float* g0n = p.g_norm + (size_t)((l + 1) * 4 + 0) * D; bf16_t* H = (bf16_t*)(p.ws + WS_H);
    const float* g3 = p.g_norm + (size_t)(l * 4 + 3) * D;
    const bf16_t* F0 = (const bf16_t*)(p.ws + WS_P); const bf16_t* F1 = F0 + (size_t)M * D;
    const int nrow = last ? NB * S : M;
#define F_ROW(i) (last ? ((i) / S) * LT + CTX + ((i) % S) : (i))
#define F_LOAD(i) do { const int m_ = F_ROW(i); const bool cx_ = (m_ % LT) < CTX; \
        _Pragma("unroll") for (int j = 0; j < 4; ++j) { const int n_ = 4 * (c.lane + 64 * j); fan[j] = *(const u32x2*)(F0 + (size_t)m_ * D + n_); fbn[j] = *(const u32x2*)(F1 + (size_t)m_ * D + n_); } \
        if (cx_) { const float* xr_ = xc_row(p, m_); _Pragma("unroll") for (int j = 0; j < 4; ++j) xn[j] = *(const f32x4*)(xr_ + 4 * (c.lane + 64 * j)); } \
        else { const bf16_t* xr_ = xb_row(p, m_); _Pragma("unroll") for (int j = 0; j < 4; ++j) xbn[j] = *(const u32x2*)(xr_ + 4 * (c.lane + 64 * j)); } } while (0)
    u32x2 fan[4], fbn[4], xbn[4]; f32x4 xn[4];
    if (c.gw < nrow) F_LOAD(c.gw);
#pragma unroll 1
    for (int ri = c.gw; ri < nrow; ri += c.ngw) {
        const int m = F_ROW(ri);
        const int b = m / LT, t = m - b * LT, r = t < CTX ? 2 : b;
        float f[16]; float ss = 0.f; f32x4 xc[4];
#pragma unroll
        for (int j = 0; j < 4; ++j) {
            const u32x2 a = fan[j], bb = fbn[j]; xc[j] = (t < CTX) ? xn[j] : bf4(xbn[j]);
            f[4 * j] = lo_bf(a.x) + lo_bf(bb.x); f[4 * j + 1] = hi_bf(a.x) + hi_bf(bb.x); f[4 * j + 2] = lo_bf(a.y) + lo_bf(bb.y); f[4 * j + 3] = hi_bf(a.y) + hi_bf(bb.y);
#pragma unroll
            for (int e = 0; e < 4; ++e) ss += f[4 * j + e] * f[4 * j + e]; }
        if (ri + c.ngw < nrow) F_LOAD(ri + c.ngw);
        const float rstd = rsqrtf(wave_sum(ss) * (1.f / D) + 1e-6f);
        float s2 = 0.f;
#pragma unroll
        for (int j = 0; j < 4; ++j) { const int n = 4 * (c.lane + 64 * j); const f32x4 gg = *(const f32x4*)(g3 + n); f32x4 xv = xc[j];
#pragma unroll
            for (int e = 0; e < 4; ++e) { xv[e] += gt[r * D + n + e] * (f[4 * j + e] * rstd * gg[e]); f[4 * j + e] = xv[e]; s2 += xv[e] * xv[e]; }
            if (last) *(f32x4*)(out_row(p, m) + n) = xv; else if (t < CTX) *(f32x4*)(xc_row(p, m) + n) = xv; else *(u32x2*)(xb_row(p, m) + n) = pk4(xv); }
        if (!last) {
            const float rstd2 = rsqrtf(wave_sum(s2) * (1.f / D) + 1e-6f);
#pragma unroll
            for (int j = 0; j < 4; ++j) { const int n = 4 * (c.lane + 64 * j); const f32x4 gg = *(const f32x4*)(g0n + n); float o[4];
#pragma unroll
                for (int e = 0; e < 4; ++e) o[e] = f[4 * j + e] * rstd2 * gg[e] * (1.f + sc[r * D + n + e]) + sh[r * D + n + e];
                u32x2 w; w.x = pk2(o[0], o[1]); w.y = pk2(o[2], o[3]);
                *(u32x2*)(H + (size_t)m * D + n) = w; }
        }
    }
}

__device__ __forceinline__ int lane_id() { int l; asm volatile("v_mbcnt_lo_u32_b32 %0, -1, 0\n\tv_mbcnt_hi_u32_b32 %0, -1, %0" : "=v"(l)); return l; }
__global__ void __launch_bounds__(NTHREADS, 2) fwd_kernel(Params p_unused) {
    extern __shared__ __attribute__((aligned(16))) unsigned char lds_raw[];
    const int wave = __builtin_amdgcn_readfirstlane((int)threadIdx.x >> 6);
    LAS unsigned char* lds = (LAS unsigned char*)lds_raw;
    volatile LAS unsigned* misc = (volatile LAS unsigned*)(lds + LDS_BYTES - 64);
#define TID() (wave * 64 + lane_id())
#define GP_(T, i) (T*)(__attribute__((address_space(1))) T*)kp_[i]
#define KARG(q) const __attribute__((address_space(4))) unsigned long long* kp_ = (const __attribute__((address_space(4))) unsigned long long*)__builtin_amdgcn_kernarg_segment_ptr(); asm volatile("" : "+s"(kp_)); \
    Params q; q.x = GP_(const float, 0); q.c = GP_(const float, 1); q.ctx = GP_(const float, 2); q.c_ctx = GP_(const float, 3); q.w_ada = GP_(const float, 4); q.b_ada = GP_(const float, 5); \
    q.g_norm = GP_(const float, 6); q.w_in = GP_(const float, 7); q.w_out = GP_(const float, 8); q.na_rpb = GP_(const float, 9); q.conv_w = GP_(const float, 10); q.conv_b = GP_(const float, 11); \
    q.lru_w_a = GP_(const float, 12); q.lru_b_a = GP_(const float, 13); q.lru_w_i = GP_(const float, 14); q.lru_b_i = GP_(const float, 15); q.lru_lam = GP_(const float, 16); q.mla_g_q = GP_(const float, 17); \
    q.mla_w_q = GP_(const float, 18); q.mla_g_kv = GP_(const float, 19); q.mla_w_kv = GP_(const float, 20); q.router_w = GP_(const float, 21); q.router_b = GP_(const float, 22); \
    q.exp_w_gate = GP_(const float, 23); q.exp_w_up = GP_(const float, 24); q.exp_w_down = GP_(const float, 25); q.out = GP_(float, 26); q.ws = GP_(unsigned char, 27); q.ph_lo = 0; q.ph_hi = 0
    { const int t = TID(); if (t < 16) misc[t] = 0u; }
    __syncthreads();
    { KARG(q); (void)xcd_barrier_post((unsigned*)(q.ws + WS_CTL) + CW_BAR, misc, TID()); }
#define GBAR() do { KARG(q); XcdBarrier b_; b_.bar = (unsigned*)(q.ws + WS_CTL) + CW_BAR; b_.x = xb_xcc_id(); b_.st = misc; xcd_barrier(b_, TID()); } while (0)
#ifndef PROBE_MASK
#define PROBE_MASK 0
#endif
#ifndef PROBE_VAR
#define PROBE_VAR 0
#endif
#ifndef PROBE_C1
#define PROBE_C1 0
#endif
#ifndef PROBE_C4
#define PROBE_C4 0
#endif
#define RP(bit, stmt) do { stmt; if ((PROBE_MASK >> (bit)) & 1) { GBAR(); stmt; } } while (0)
#define PH(call) do { KARG(q); Ctx cc; cc.lds = lds; cc.wave = wave; cc.lane = lane_id(); cc.tid = wave * 64 + cc.lane; \
        cc.bid = blockIdx.x; cc.nb = gridDim.x; cc.gw = cc.bid * NWAVES + wave; cc.ngw = cc.nb * NWAVES; call; } while (0)
    RP(0, PH(phase_pro(q, cc))); GBAR();
#define LAYER(l, last) do { \
        if ((l) == 0) { RP(1, PH(phase_n1(q, cc, l))); GBAR(); } \
        RP(2, PH(phase_g1(q, cc, l, false))); GBAR(); \
        RP(4, PH(phase_c2(q, cc, l))); GBAR(); \
        RP(6, PH(phase_c3(q, cc))); __syncthreads(); if (PROBE_C1) { PH(phase_c1<PROBE_C1>(q, cc, l)); GBAR(); } RP(3, PH(phase_c1(q, cc, l))); __syncthreads(); RP(5, PH(phase_a1b(q, cc, l, last))); if ((l) == 0) PH(phase_fill(q, cc, 0, CV_FA, 8, 224)); GBAR(); \
        if (PROBE_C4) { PH(phase_c4<PROBE_C4>(q, cc, l, last)); GBAR(); } RP(7, PH(phase_c4(q, cc, l, last))); __syncthreads(); if (PROBE_VAR) { PH(phase_a2<PROBE_VAR>(q, cc, last)); GBAR(); } RP(8, PH(phase_a2(q, cc, last))); if ((l) == 0) PH(phase_fill(q, cc, CV_FA, (CV_FA + CV_FB < CV_ALL ? CV_FA + CV_FB : CV_ALL), 8, 240)); GBAR(); \
        RP(9, PH(phase_o1(q, cc, l, last))); GBAR(); \
        PH(phase_o2(q, cc, l, last)); if (((PROBE_MASK >> 13) & 1) && (l) == 0) { GBAR(); PH(phase_o2(q, cc, l, last)); } GBAR(); \
        PH(phase_r2(q, cc, l, last)); GBAR();        \
        PH(phase_f(q, cc, l, last)); } while (0)
    LAYER(0, false); GBAR();
    LAYER(1, true);
#undef LAYER
#undef PH
#undef RP
#undef GBAR
#undef TID
#undef KARG
#undef GP_
}

#ifdef DBG_PHASE
__global__ void __launch_bounds__(NTHREADS, 2) dbg_kernel(Params p, int l) {
    extern __shared__ __attribute__((aligned(16))) unsigned char lds_raw[];
    Ctx cc; cc.lds = (LAS unsigned char*)lds_raw; cc.wave = __builtin_amdgcn_readfirstlane((int)threadIdx.x >> 6); cc.lane = threadIdx.x & 63; cc.tid = threadIdx.x;
    cc.bid = blockIdx.x; cc.nb = gridDim.x; cc.gw = cc.bid * NWAVES + cc.wave; cc.ngw = cc.nb * NWAVES;
    DBG_PHASE;
}
#endif
#define MAIN_KERNEL fwd_kernel

extern "C" void kernel_launch(void* const* d_in, const int* in_sizes, int n_in, void* d_out, int out_size, void* d_ws, size_t ws_size, hipStream_t stream) {
    static int grid = 0;
    if (grid == 0) {
        if (n_in != 26 || out_size != NB * S * D || ws_size < WS_END) { fprintf(stderr, "kernel_launch: unexpected shapes (n_in %d out %d ws %zu)\n", n_in, out_size, ws_size); grid = -1; return; }
        int dev = 0, cus = 0, per_cu = 0;
        hipGetDevice(&dev);
        hipDeviceGetAttribute(&cus, hipDeviceAttributeMultiprocessorCount, dev);
        hipFuncSetAttribute((const void*)fwd_kernel, hipFuncAttributeMaxDynamicSharedMemorySize, LDS_BYTES);
        hipOccupancyMaxActiveBlocksPerMultiprocessor(&per_cu, (const void*)MAIN_KERNEL, NTHREADS, LDS_BYTES);
        (void)hipGetLastError();
        if (per_cu < 1) { fprintf(stderr, "kernel_launch: occupancy query says %d blocks per CU\n", per_cu); grid = -1; return; }
        if (cus < 256) { fprintf(stderr, "kernel_launch: this build's unit orders assume a 256-workgroup grid (one per CU of a 256-CU device); the device reports %d CUs\n", cus); grid = -1; return; }
        grid = 256;
    }
    if (grid < 0) return;
    hipMemsetAsync((char*)d_ws + WS_CTL, 0, CTL_BYTES, stream);
    Params p{};
    const float** pp = (const float**)&p;
    for (int i = 0; i < 26; ++i) pp[i] = (const float*)d_in[i];
    p.out = (float*)d_out; p.ws = (unsigned char*)d_ws;
    void* args[] = {&p};
    hipLaunchCooperativeKernel((const void*)fwd_kernel, dim3(grid), dim3(NTHREADS), args, LDS_BYTES, stream);
}
```
